# Optimizing an MI355X kernel written in HIP

```python
import math
import jax, jax.numpy as jnp
from jax import lax
import numpy as np


D_MODEL = 1024
BATCH = 2
SEQ = 8192
DEPTH = 4

GRID_W = 64
CTX_LEN = 256
LN_EPS = 1e-5

HEAD_DIM = 64
N_HEADS_A = D_MODEL // (2 * HEAD_DIM)
V_DIM = 2 * HEAD_DIM
QK_W = N_HEADS_A * 2 * HEAD_DIM
V_W = N_HEADS_A * V_DIM
ATTN_OUT = V_W
ATTN_SCALE = HEAD_DIM ** -0.5
Q_BLOCK = 128
ROPE_BASE = 10000.0
ROPE_AXIS_PAIRS = HEAD_DIM // 4

CHUNK = 128
SGU_GROUPS = 4
SGU_W = D_MODEL // 2
SGU_GC = SGU_W // SGU_GROUPS

AB_IN = 2 * QK_W + V_W + 2 * SGU_W
AB_OUT = ATTN_OUT + SGU_W
AB_SPLITS = [QK_W, 2 * QK_W, 2 * QK_W + V_W, 2 * QK_W + V_W + SGU_W]

POOL_WINDOWS = (2, 4, 8, 16)
N_POOL_GROUPS = len(POOL_WINDOWS)
POOL_W = D_MODEL
POOL_GC = POOL_W // N_POOL_GROUPS

P_HEADS = 8
N_KEYS = 128
N_EXPERTS = N_KEYS * N_KEYS
P_TOPK = 16
D_KEY = 256
D_KEY_HALF = D_KEY // 2
PEER_BLOCK = 128

kernel_name = 'hybrid_diffattn_sgu_pool_peer_trunk'


def layer_norm(h, g, b):
    h32 = h.astype(jnp.float32)
    mu = jnp.mean(h32, axis=-1, keepdims=True)
    var = jnp.mean(jnp.square(h32 - mu), axis=-1, keepdims=True)
    out = (h32 - mu) * lax.rsqrt(var + LN_EPS) * g.astype(jnp.float32) + b.astype(jnp.float32)
    return out.astype(h.dtype)


def modulate(h, shift, scale):
    return h * (1.0 + scale) + shift


def axial_rope_tables(rows):
    row = jnp.repeat(jnp.arange(rows, dtype=jnp.float32), GRID_W)
    col = jnp.tile(jnp.arange(GRID_W, dtype=jnp.float32), rows)
    inv = ROPE_BASE ** (-jnp.arange(ROPE_AXIS_PAIRS, dtype=jnp.float32) / ROPE_AXIS_PAIRS)
    ang = jnp.concatenate([row[:, None] * inv, col[:, None] * inv], axis=-1)
    return jnp.cos(ang), jnp.sin(ang)


def apply_rope(t, cos, sin):
    t32 = t.astype(jnp.float32)
    half = HEAD_DIM // 2
    a, b = t32[..., :half], t32[..., half:]
    cs = cos[None, :, None, None, :]
    sn = sin[None, :, None, None, :]
    return jnp.concatenate([a * cs - b * sn, a * sn + b * cs], axis=-1).astype(t.dtype)


def diff_attn_block(q, k, v, lam):
    s = jnp.einsum('bqhmd,bkhmd->bhmqk', q, k).astype(jnp.float32) * ATTN_SCALE
    p = jax.nn.softmax(s, axis=-1)
    a = (p[:, :, 0] - lam * p[:, :, 1]).astype(v.dtype)
    return jnp.einsum('bhqk,bkhe->bqhe', a, v)


def head_rms(o, g, lam_init):
    o32 = o.astype(jnp.float32)
    o32 = o32 * lax.rsqrt(jnp.mean(o32 * o32, axis=-1, keepdims=True) + LN_EPS)
    return (o32 * g.astype(jnp.float32) * (1.0 - lam_init)).astype(o.dtype)


def spatial_gate(gu, gv, ln_g, ln_b, w_s, b_s):
    u = jax.nn.gelu(gu)
    v = layer_norm(jax.nn.gelu(gv), ln_g, ln_b)
    bsz, t, _ = v.shape
    v = v.reshape(bsz, t // CHUNK, CHUNK, SGU_GROUPS, SGU_GC)
    s = jnp.einsum('gpq,bnqgc->bnpgc', w_s, v) + b_s.T[:, :, None]
    return u * s.reshape(bsz, t, SGU_W)


def mixer_ab(hx, hc, w_in, w_out, lam_vec, norm_g, sgu_ln_g, sgu_ln_b, sgu_w, sgu_b,
             lam_init, cos, sin, ctx_out):
    bsz, s_len, _ = hx.shape
    c_len = hc.shape[1]
    lq1, lk1, lq2, lk2 = lam_vec.astype(jnp.float32)
    lam = jnp.exp(jnp.sum(lq1 * lk1)) - jnp.exp(jnp.sum(lq2 * lk2)) + lam_init
    q_x, k_x, v_x, gu_x, gv_x = jnp.split(hx @ w_in, AB_SPLITS, axis=-1)
    q_x = apply_rope(q_x.reshape(bsz, s_len, N_HEADS_A, 2, HEAD_DIM), cos, sin)
    k_x = apply_rope(k_x.reshape(bsz, s_len, N_HEADS_A, 2, HEAD_DIM), cos, sin)
    v_x = v_x.reshape(bsz, s_len, N_HEADS_A, V_DIM)
    if ctx_out:
        q_c, k_c, v_c, gu_c, gv_c = jnp.split(hc @ w_in, AB_SPLITS, axis=-1)
    else:
        k_c, v_c = jnp.split(hc @ w_in[:, QK_W:2 * QK_W + V_W], [QK_W], axis=-1)
    k_c = k_c.reshape(bsz, c_len, N_HEADS_A, 2, HEAD_DIM)
    v_c = v_c.reshape(bsz, c_len, N_HEADS_A, V_DIM)
    k_all = jnp.concatenate([k_c, k_x], axis=1)
    v_all = jnp.concatenate([v_c, v_x], axis=1)
    n_blk = s_len // Q_BLOCK
    qb = jnp.moveaxis(q_x.reshape(bsz, n_blk, Q_BLOCK, N_HEADS_A, 2, HEAD_DIM), 1, 0)
    o_x = lax.map(lambda qblk: diff_attn_block(qblk, k_all, v_all, lam), qb)
    o_x = jnp.moveaxis(o_x, 0, 1).reshape(bsz, s_len, N_HEADS_A, V_DIM)
    a_x = head_rms(o_x, norm_g, lam_init).reshape(bsz, s_len, ATTN_OUT)
    g_x = spatial_gate(gu_x, gv_x, sgu_ln_g, sgu_ln_b, sgu_w, sgu_b)
    y_x = jnp.concatenate([a_x, g_x], axis=-1) @ w_out
    if not ctx_out:
        return y_x, None
    q_c = q_c.reshape(bsz, c_len, N_HEADS_A, 2, HEAD_DIM)
    o_c = diff_attn_block(q_c, k_c, v_c, lam)
    a_c = head_rms(o_c, norm_g, lam_init).reshape(bsz, c_len, ATTN_OUT)
    g_c = spatial_gate(gu_c, gv_c, sgu_ln_g, sgu_ln_b, sgu_w, sgu_b)
    y_c = jnp.concatenate([a_c, g_c], axis=-1) @ w_out
    return y_x, y_c


def multiscale_pool(h):
    bsz, t, _ = h.shape
    h32 = h.astype(jnp.float32)
    cs = jnp.concatenate([jnp.zeros((bsz, 1, POOL_W), jnp.float32), jnp.cumsum(h32, axis=1)], axis=1)
    pos = jnp.arange(t)
    outs = []
    for g, w in enumerate(POOL_WINDOWS):
        lo = jnp.clip(pos - w // 2, 0, t)
        hi = jnp.clip(pos + (w - w // 2), 0, t)
        seg = cs[:, :, g * POOL_GC:(g + 1) * POOL_GC]
        cnt = (hi - lo).astype(jnp.float32)[None, :, None]
        outs.append((seg[:, hi] - seg[:, lo]) / cnt)
    pooled = jnp.concatenate(outs, axis=-1)
    return (pooled - h32).astype(h.dtype)


def mixer_pool(h, w_in, w_grp, scale, w_out):
    m = multiscale_pool(h @ w_in)
    bsz, t, _ = m.shape
    m = jnp.einsum('btgc,gce->btge', m.reshape(bsz, t, N_POOL_GROUPS, POOL_GC), w_grp)
    return (m.reshape(bsz, t, POOL_W) * scale) @ w_out


def peer(h, wq, keys, u_tab, v_tab):
    n, d = h.shape
    hb = h.reshape(n // PEER_BLOCK, PEER_BLOCK, d)

    def block(hblk):
        q = (hblk @ wq).reshape(PEER_BLOCK, P_HEADS, 2, D_KEY_HALF)
        s = jnp.einsum('nhpd,hpkd->nhpk', q, keys).astype(jnp.float32)
        top_s, top_i = lax.top_k(s, P_TOPK)
        cand_s = (top_s[:, :, 0, :, None] + top_s[:, :, 1, None, :]).reshape(PEER_BLOCK, P_HEADS, P_TOPK * P_TOPK)
        cand_i = (top_i[:, :, 0, :, None] * N_KEYS + top_i[:, :, 1, None, :]).reshape(PEER_BLOCK, P_HEADS, P_TOPK * P_TOPK)
        best_s, best_pos = lax.top_k(cand_s, P_TOPK)
        idx = jnp.take_along_axis(cand_i, best_pos, axis=-1)
        gate = jax.nn.softmax(best_s, axis=-1)
        u = u_tab[idx]
        v = v_tab[idx]
        act = jax.nn.gelu(jnp.einsum('nd,nhkd->nhk', hblk, u))
        return jnp.einsum('nhk,nhkd->nd', (gate * act).astype(v.dtype), v)

    return lax.map(block, hb).reshape(n, d)


def setup_inputs(seed: int = 0) -> dict:
    key = jax.random.key(seed)
    ks = jax.random.split(key, 24)
    n_even = (DEPTH + 1) // 2
    n_odd = DEPTH // 2
    beta = (8.0 * DEPTH) ** -0.25

    def nrm(k, shape, s):
        return jax.random.normal(k, shape, jnp.float32) * s

    return {
        'x': nrm(ks[0], (BATCH, SEQ, D_MODEL), 1.0),
        'c': nrm(ks[1], (BATCH, D_MODEL), 1.0),
        'ctx': nrm(ks[2], (BATCH, CTX_LEN, D_MODEL), 1.0),
        'c_ctx': nrm(ks[3], (D_MODEL,), 1.0),
        'ada_w': nrm(ks[4], (DEPTH, D_MODEL, 6 * D_MODEL), 0.5 * D_MODEL ** -0.5),
        'ada_b': nrm(ks[5], (DEPTH, 6 * D_MODEL), 0.02),
        'ln_g': 1.0 + nrm(ks[6], (DEPTH, 2, D_MODEL), 0.05),
        'ln_b': nrm(ks[7], (DEPTH, 2, D_MODEL), 0.02),
        'ab_w_in': nrm(ks[8], (n_even, D_MODEL, AB_IN), D_MODEL ** -0.5),
        'ab_w_out': nrm(ks[9], (n_even, AB_OUT, D_MODEL), beta * AB_OUT ** -0.5),
        'diff_lam': nrm(ks[10], (n_even, 4, HEAD_DIM), 0.1),
        'diff_norm_g': 1.0 + nrm(ks[11], (n_even, V_DIM), 0.05),
        'sgu_ln_g': 1.0 + nrm(ks[12], (n_even, SGU_W), 0.05),
        'sgu_ln_b': nrm(ks[13], (n_even, SGU_W), 0.02),
        'sgu_w': nrm(ks[14], (n_even, SGU_GROUPS, CHUNK, CHUNK), CHUNK ** -0.5),
        'sgu_b': 1.0 + nrm(ks[15], (n_even, SGU_GROUPS, CHUNK), 0.1),
        'pool_w_in': nrm(ks[16], (n_odd, D_MODEL, POOL_W), D_MODEL ** -0.5),
        'pool_w_grp': nrm(ks[17], (n_odd, N_POOL_GROUPS, POOL_GC, POOL_GC), POOL_GC ** -0.5),
        'pool_scale': 1.0 + nrm(ks[18], (n_odd, POOL_W), 0.1),
        'pool_w_out': nrm(ks[19], (n_odd, POOL_W, D_MODEL), beta * POOL_W ** -0.5),
        'peer_wq': nrm(ks[20], (DEPTH, D_MODEL, P_HEADS * D_KEY), D_MODEL ** -0.5),
        'peer_keys': nrm(ks[21], (DEPTH, P_HEADS, 2, N_KEYS, D_KEY_HALF), D_KEY_HALF ** -0.5),
        'peer_u': nrm(ks[22], (DEPTH, N_EXPERTS, D_MODEL), D_MODEL ** -0.5),
        'peer_v': nrm(ks[23], (DEPTH, N_EXPERTS, D_MODEL), beta),
    }


def reference(x, c, ctx, c_ctx, ada_w, ada_b, ln_g, ln_b, ab_w_in, ab_w_out, diff_lam,
              diff_norm_g, sgu_ln_g, sgu_ln_b, sgu_w, sgu_b, pool_w_in, pool_w_grp,
              pool_scale, pool_w_out, peer_wq, peer_keys, peer_u, peer_v):
    bsz, s_len, d = x.shape
    c_len = ctx.shape[1]
    rows = s_len // GRID_W
    cos, sin = axial_rope_tables(rows)
    alpha = (2.0 * DEPTH) ** 0.25
    last_ctx_read = 2 * ((DEPTH - 1) // 2)
    silu_c = jax.nn.silu(c)
    silu_cc = jax.nn.silu(c_ctx)
    xs, cs = x, ctx
    for i in range(DEPTH):
        j = i // 2
        even = i % 2 == 0
        ctx_out = i < last_ctx_read
        sh1, sc1, g1, sh2, sc2, g2 = jnp.split((silu_c @ ada_w[i] + ada_b[i])[:, None, :], 6, axis=-1)
        hx = modulate(xs, sh1, sc1)
        if ctx_out or even:
            csh1, csc1, cg1, csh2, csc2, cg2 = jnp.split(silu_cc @ ada_w[i] + ada_b[i], 6, axis=-1)
            hc = modulate(cs, csh1, csc1)
        if even:
            lam_init = 0.8 - 0.6 * math.exp(-0.3 * i)
            yx, yc = mixer_ab(hx, hc, ab_w_in[j], ab_w_out[j], diff_lam[j], diff_norm_g[j],
                              sgu_ln_g[j], sgu_ln_b[j], sgu_w[j], sgu_b[j], lam_init, cos, sin, ctx_out)
        else:
            yx = mixer_pool(hx, pool_w_in[j], pool_w_grp[j], pool_scale[j], pool_w_out[j])
            yc = mixer_pool(hc, pool_w_in[j], pool_w_grp[j], pool_scale[j], pool_w_out[j]) if ctx_out else None
        xs = layer_norm(alpha * xs + g1 * yx, ln_g[i, 0], ln_b[i, 0])
        hx = modulate(xs, sh2, sc2)
        if ctx_out:
            cs = layer_norm(alpha * cs + cg1 * yc, ln_g[i, 0], ln_b[i, 0])
            hc = modulate(cs, csh2, csc2)
            f = peer(jnp.concatenate([hc, hx], axis=1).reshape(-1, d),
                     peer_wq[i], peer_keys[i], peer_u[i], peer_v[i]).reshape(bsz, c_len + s_len, d)
            fc, fx = f[:, :c_len], f[:, c_len:]
            cs = layer_norm(alpha * cs + cg2 * fc, ln_g[i, 1], ln_b[i, 1])
        else:
            fx = peer(hx.reshape(-1, d), peer_wq[i], peer_keys[i], peer_u[i], peer_v[i]).reshape(bsz, s_len, d)
        xs = layer_norm(alpha * xs + g2 * fx, ln_g[i, 1], ln_b[i, 1])
    return xs
```

```cpp
#include <hip/hip_runtime.h>
#include <hip/hip_cooperative_groups.h>
#include <cstdio>
#include <cstdint>
namespace cg = cooperative_groups;

typedef unsigned short bf16_t;
typedef short bf16x8 __attribute__((ext_vector_type(8)));
typedef float f32x4 __attribute__((ext_vector_type(4)));
typedef unsigned u32x4 __attribute__((ext_vector_type(4)));
typedef unsigned u32x2 __attribute__((ext_vector_type(2)));
typedef float f32x2v __attribute__((ext_vector_type(2)));
typedef __bf16 bf16x2_t __attribute__((ext_vector_type(2)));

constexpr int DM = 1024, NBATCH = 2, SEQ = 8192, CTXL = 256, DEPTH = 4;
constexpr int NLAT = NBATCH * SEQ;
constexpr int NCTX = NBATCH * CTXL;
constexpr int NTOK = NLAT + NCTX;
constexpr int LKV = CTXL + SEQ;
constexpr int NH = 8;
constexpr int NEXP = 16384;
constexpr float LN_EPS = 1e-5f;
constexpr float ALPHA = 1.6817928305074290f;
constexpr float QSCALE = 0.125f * 1.4426950408889634f;

constexpr size_t al256(size_t x) { return (x + 255) / 256 * 256; }
constexpr size_t SZ_TAB = (size_t)DEPTH * NEXP * DM;
constexpr size_t SZ_QKV = (size_t)NBATCH * NH * LKV * 128 * 2;
constexpr size_t SZ_XS = (size_t)NTOK * DM * 4;
constexpr size_t OFF_U8 = 0;
constexpr size_t OFF_V8 = OFF_U8 + SZ_TAB;
constexpr size_t OFF_Q = OFF_V8 + SZ_TAB;
constexpr size_t OFF_K = OFF_Q + SZ_QKV;
constexpr size_t OFF_V = OFF_K + SZ_QKV;
constexpr size_t OFF_XSA = OFF_V + SZ_QKV;
constexpr size_t OFF_XSB = OFF_XSA + SZ_XS;
constexpr size_t OFF_Z = OFF_XSB + SZ_XS;
constexpr size_t OFF_H = OFF_Z + SZ_XS;
constexpr size_t OFF_HB = OFF_H + (size_t)NTOK * DM * 2;
constexpr size_t OFF_CAT = OFF_HB + (size_t)NTOK * DM * 2;
constexpr size_t OFF_GU = OFF_CAT + (size_t)NTOK * 1536 * 2;
constexpr size_t OFF_GV = OFF_GU + (size_t)NTOK * 512 * 2;
constexpr size_t OFF_M1 = OFF_GV + (size_t)NTOK * 512 * 2;
constexpr size_t OFF_M2 = OFF_M1 + (size_t)NTOK * DM * 2;
constexpr size_t OFF_SC = OFF_M2 + (size_t)NTOK * DM * 2;
constexpr size_t OFF_IDX = OFF_SC;
constexpr size_t OFF_GATE = OFF_IDX + (size_t)NTOK * 128 * 4;
constexpr size_t OFF_WIN = OFF_GATE + (size_t)NTOK * 128 * 4;
constexpr size_t OFF_WOUT = OFF_WIN + (size_t)2 * 4096 * 1024 * 2;
constexpr size_t OFF_PIN = OFF_WOUT + (size_t)2 * 1024 * 1536 * 2;
constexpr size_t OFF_POUT = OFF_PIN + (size_t)2 * 1024 * 1024 * 2;
constexpr size_t OFF_WQK = OFF_POUT + (size_t)2 * 1024 * 1024 * 2;
constexpr size_t OFF_MOD = OFF_WQK + (size_t)4 * 2048 * 1024 * 2;
constexpr size_t OFF_MODP = OFF_MOD + al256((size_t)4 * 3 * 6144 * 4);
constexpr size_t OFF_ROPE = OFF_MODP + al256((size_t)2 * 4 * 3 * 6144 * 4);
constexpr size_t OFF_LAM = OFF_ROPE + al256((size_t)128 * 16 * 2 * 4);
constexpr size_t OFF_PART = OFF_LAM + 256;
constexpr size_t OFF_PW = OFF_PART + (size_t)NTOK * 8 * 128 * 4;
constexpr size_t OFF_H8 = OFF_PW + (size_t)NTOK * 128 * 4;
constexpr size_t OFF_BAR = OFF_H8 + (size_t)2 * NTOK * DM;
constexpr size_t WS_END = OFF_BAR + 512 + 8192;

struct KArgs {
  const float* in[24];
  float* out;
  char* ws;
};
struct Params {
  const float* const* in;
  float* out;
  char* ws;
};
enum { IN_x, IN_c, IN_ctx, IN_c_ctx, IN_ada_w, IN_ada_b, IN_ln_g, IN_ln_b, IN_ab_w_in, IN_ab_w_out, IN_diff_lam, IN_diff_norm_g, IN_sgu_ln_g, IN_sgu_ln_b,
       IN_sgu_w, IN_sgu_b, IN_pool_w_in, IN_pool_w_grp, IN_pool_scale, IN_pool_w_out, IN_peer_wq, IN_peer_keys, IN_peer_u, IN_peer_v };
#define AS_GLOBAL(T, ptr) ((T)(__attribute__((address_space(1))) char*)(char*)(ptr))
#define PIN(p, name) AS_GLOBAL(const float*, (p).in[IN_##name])

constexpr int LDS_BYTES = 144 * 1024;

__device__ __forceinline__ int make_tid(int swid) {
  int t;
  asm volatile("v_mbcnt_lo_u32_b32 %0, -1, 0\n\tv_mbcnt_hi_u32_b32 %0, -1, %0" : "=v"(t));
  return (swid << 6) | t;
}
__device__ __forceinline__ int lbid() { int b = blockIdx.x; asm volatile("" : "+s"(b)); return b; }
__device__ __forceinline__ bf16_t f2bf(float f) {
  unsigned u = __float_as_uint(f);
  u += 0x7fffu + ((u >> 16) & 1u);
  return (bf16_t)(u >> 16);
}
__device__ __forceinline__ float bf2f(bf16_t b) { return __uint_as_float(((unsigned)b) << 16); }
__device__ __forceinline__ unsigned pk2(float lo, float hi) { return (unsigned)f2bf(lo) | ((unsigned)f2bf(hi) << 16); }
typedef _Float16 f16x8 __attribute__((ext_vector_type(8)));
typedef _Float16 f16x2 __attribute__((ext_vector_type(2)));
__device__ __forceinline__ unsigned pk2h(float lo, float hi) { const f16x2 v = {(_Float16)lo, (_Float16)hi}; return __builtin_bit_cast(unsigned, v); }
__device__ __forceinline__ float hlo(unsigned w) { return (float)__builtin_bit_cast(f16x2, w)[0]; }
__device__ __forceinline__ float hhi(unsigned w) { return (float)__builtin_bit_cast(f16x2, w)[1]; }
typedef _Float16 hstream_t;
__device__ __forceinline__ f32x4 ld4h(const hstream_t* p) { const u32x2 w = *(const u32x2*)p; return (f32x4){hlo(w[0]), hhi(w[0]), hlo(w[1]), hhi(w[1])}; }
__device__ __forceinline__ void st4h(hstream_t* p, f32x4 v) { *(u32x2*)p = (u32x2){pk2h(v[0], v[1]), pk2h(v[2], v[3])}; }
__device__ __forceinline__ bf16_t f2h(float f) { return __builtin_bit_cast(unsigned short, (_Float16)f); }
__device__ __forceinline__ float h2f(bf16_t b) { return (float)__builtin_bit_cast(_Float16, b); }
__device__ __forceinline__ float bflo(unsigned w) { return __uint_as_float(w << 16); }
__device__ __forceinline__ float bfhi(unsigned w) { return __uint_as_float(w & 0xffff0000u); }
__device__ __forceinline__ float gelu_tanh(float x) {
  const float u = 0.7978845608028654f * (x + 0.044715f * x * x * x);
  return x / (1.0f + __expf(-2.0f * u));
}
__device__ __forceinline__ float dot2bf(unsigned a, unsigned b, float c) {
  return __builtin_amdgcn_fdot2_f32_bf16(__builtin_bit_cast(bf16x2_t, a), __builtin_bit_cast(bf16x2_t, b), c, false);
}
__device__ __forceinline__ float shx_f(float v, int mask, int lane) { return __int_as_float(__builtin_amdgcn_ds_bpermute((lane ^ mask) << 2, __float_as_int(v))); }
__device__ __forceinline__ int shx_i(int v, int mask, int lane) { return __builtin_amdgcn_ds_bpermute((lane ^ mask) << 2, v); }
__device__ __forceinline__ float shl_f(float v, int src) { return __int_as_float(__builtin_amdgcn_ds_bpermute(src << 2, __float_as_int(v))); }
__device__ __forceinline__ float wave_sum(float v, int  ) {
#define DPP_ADD(ctrl, rmask) v += __int_as_float(__builtin_amdgcn_update_dpp(0, __float_as_int(v), ctrl, rmask, 0xf, false))
  DPP_ADD(0xB1, 0xf);
  DPP_ADD(0x4E, 0xf);
  DPP_ADD(0x141, 0xf);
  DPP_ADD(0x140, 0xf);
  DPP_ADD(0x142, 0xa);
  DPP_ADD(0x143, 0xc);
#undef DPP_ADD
  return __int_as_float(__builtin_amdgcn_readlane(__float_as_int(v), 63));
}
__device__ __forceinline__ int who_of_row(int row) { return row < NLAT ? (row >= SEQ ? 1 : 0) : 2; }
__device__ __forceinline__ const float* mod_ptr(const Params& p, int layer, int who, int which) {
  return (const float*)(p.ws + OFF_MOD) + ((size_t)(layer * 3 + who) * 6 + which) * 1024;
}
__device__ __forceinline__ void row_bpos(int row, int& b, int& pos) {
  if (row < NLAT) { b = row >> 13; pos = CTXL + (row & (SEQ - 1)); }
  else { const int r = row - NLAT; b = r >> 8; pos = r & 255; }
}

__device__ __forceinline__ int lds_byte2(int r, int c) {
  int st = (r >> 4) * 2 + (c >> 5), ob = (r & 15) * 64 + (c & 31) * 2;
  return st * 1024 + (ob ^ (((ob >> 9) & 1) << 5));
}
__device__ __forceinline__ void stage_rc2(int b, int& R, int& C) {
  int st = b >> 10, sb = b & 1023, swz = sb ^ (((sb >> 9) & 1) << 5);
  R = (st / 2) * 16 + swz / 64;
  C = (st % 2) * 32 + (swz % 64) / 2;
}
#define WAIT_V0() asm volatile("s_waitcnt vmcnt(0)" ::: "memory")

template <bool F16, int MFR, class Epi>
__device__ __forceinline__ void gemm_tile(const bf16_t* __restrict__ Arow0, const bf16_t* __restrict__ Bcol0, int row0, int pn, int K,
                                          const Epi& epi, char* shm, int tid_) {
  constexpr int BK = 32, TILE_B = 256 * BK * 2, STAGE_B = 2 * TILE_B;
  constexpr int LPS = MFR == 8 ? 4 : 3;
  const int tid = tid_, wid = __builtin_amdgcn_readfirstlane(tid >> 6), lane = tid & 63, wr = wid >> 2, wc = wid & 3, fr = lane & 15, fq = lane >> 4;
  const int sb_ = lane * 16, swz_ = sb_ ^ (((sb_ >> 9) & 1) << 5);
  const int C0 = (swz_ % 64) / 2;
  const int R0b = wid * 16 + swz_ / 64;
  const int R0a = (MFR == 8 ? wid : (wid & 3)) * 16 + swz_ / 64;
  const char* Ab = (const char*)Arow0 + (unsigned)(R0a * K + C0) * 2u;
  const char* Bb = (const char*)Bcol0 + (unsigned)(R0b * K + C0) * 2u;
  const int ob_ = fr * 64 + fq * 16, frag_swz = ob_ ^ (((ob_ >> 9) & 1) << 5);
  const int a_base = wr * (MFR * 1024) + frag_swz, b_base = wc * 4096 + frag_swz;
  const int nt = K / BK;
  f32x4 acc[MFR][4];
#pragma unroll
  for (int m = 0; m < MFR; ++m)
#pragma unroll
    for (int n = 0; n < 4; ++n) acc[m][n] = (f32x4){0.f, 0.f, 0.f, 0.f};
  typename Epi::template Pre<MFR> pre;
  epi.template preload<MFR>(pre, row0, pn, wr, wc, fr, fq);
#define GLDS_STAGE(buf, kt)                                                                                                               \
  do {                                                                                                                                    \
    if (MFR == 8) {                                                                                                                       \
      _Pragma("unroll") for (int i = 0; i < 2; ++i)                                                                                       \
        __builtin_amdgcn_global_load_lds((const unsigned*)(Ab + (size_t)(i * 128) * K * 2 + (kt) * (BK * 2)),                           \
                                         (unsigned*)(shm + (buf) * STAGE_B + wid * 1024 + i * 8192), 16, 0, 0);                           \
    } else {                                                                                                                              \
      __builtin_amdgcn_global_load_lds((const unsigned*)(Ab + (kt) * (BK * 2)), (unsigned*)(shm + (buf) * STAGE_B + (wid & 3) * 1024), 16, 0, 0); \
    }                                                                                                                                     \
    _Pragma("unroll") for (int i = 0; i < 2; ++i)                                                                                         \
      __builtin_amdgcn_global_load_lds((const unsigned*)(Bb + (size_t)(i * 128) * K * 2 + (kt) * (BK * 2)),                             \
                                       (unsigned*)(shm + (buf) * STAGE_B + TILE_B + wid * 1024 + i * 8192), 16, 0, 0);                    \
  } while (0)
#define RAW_BARRIER() do { asm volatile("s_waitcnt lgkmcnt(0)" ::: "memory"); __builtin_amdgcn_s_barrier(); } while (0)
#define WAIT_2STAGES() do { if (LPS == 4) asm volatile("s_waitcnt vmcnt(8)" ::: "memory"); else asm volatile("s_waitcnt vmcnt(6)" ::: "memory"); } while (0)
#define WAIT_1STAGE() do { if (LPS == 4) asm volatile("s_waitcnt vmcnt(4)" ::: "memory"); else asm volatile("s_waitcnt vmcnt(3)" ::: "memory"); } while (0)
  GLDS_STAGE(0, 0); GLDS_STAGE(1, 1); GLDS_STAGE(2, 2);
  WAIT_2STAGES();
  RAW_BARRIER();
  for (int t = 0; t < nt; ++t) {
    if (t + 3 < nt) GLDS_STAGE((t + 3) & 3, t + 3);
    const char* sa = shm + (t & 3) * STAGE_B;
    const char* sb = sa + TILE_B;
    {
      bf16x8 At[MFR], Bf[4];
#pragma unroll
      for (int m = 0; m < MFR; ++m) At[m] = *(const bf16x8*)(sa + a_base + m * 1024);
#pragma unroll
      for (int n = 0; n < 4; ++n) Bf[n] = *(const bf16x8*)(sb + b_base + n * 1024);
#pragma unroll
      for (int m = 0; m < MFR; ++m)
#pragma unroll
        for (int n = 0; n < 4; ++n) {
          if (F16) acc[m][n] = __builtin_amdgcn_mfma_f32_16x16x32_f16(__builtin_bit_cast(f16x8, Bf[n]), __builtin_bit_cast(f16x8, At[m]), acc[m][n], 0, 0, 0);
          else acc[m][n] = __builtin_amdgcn_mfma_f32_16x16x32_bf16(Bf[n], At[m], acc[m][n], 0, 0, 0);
        }
    }
    if (t + 3 < nt) WAIT_2STAGES();
    else if (t + 2 < nt) WAIT_1STAGE();
    else asm volatile("s_waitcnt vmcnt(0)" ::: "memory");
    RAW_BARRIER();
  }
#undef GLDS_STAGE
#undef RAW_BARRIER
#undef WAIT_2STAGES
#undef WAIT_1STAGE
  epi.template run<MFR>(acc, pre, row0, pn, wr, wc, fr, fq, shm, tid_);
}

template <bool F16 = false, class Epi>
__device__ __forceinline__ void gemm_phase(const bf16_t* __restrict__ A, const bf16_t* __restrict__ Bt, int mt_big, int small_rows, int ntiles, int K,
                                           const Epi& epi, char* shm, int tid_) {
  const int nu_big = ((mt_big + 7) >> 3) * ntiles * 8, nu_small = (small_rows >> 6) * ntiles;
  int u = lbid();
  for (; u < nu_big; u += gridDim.x) {
    const int xcd = u & 7, v = u >> 3;
    const int pn = v % ntiles, pm = (v / ntiles) * 8 + xcd;
    if (pm >= mt_big) continue;
    gemm_tile<F16, 8>(A + (size_t)pm * 256 * K, Bt + (size_t)pn * 256 * K, pm * 256, pn, K, epi, shm, tid_);
  }
  for (; u < nu_big + nu_small; u += gridDim.x) {
    const int w = u - nu_big, pn = w % ntiles, row0 = mt_big * 256 + (w / ntiles) * 64;
    gemm_tile<F16, 2>(A + (size_t)row0 * K, Bt + (size_t)pn * 256 * K, row0, pn, K, epi, shm, tid_);
  }
}

struct EpiInProj {
  bf16_t *Q, *K, *V, *GU, *GV;
  const float* rope;
  unsigned* KMAX;
  template <int MFR> struct Pre {};
  template <int MFR> __device__ __forceinline__ void preload(Pre<MFR>&, int, int, int, int, int, int) const {}
  template <int MFR>
  __device__ __forceinline__ void run(const f32x4 (&acc)[MFR][4], const Pre<MFR>&, int row0, int pn, int wr, int wc, int fr, int fq, char*, int) const {
    const int region = pn >> 2;
    const int lane = fq * 16 + fr;
    float kn2 = 0.f, kmax2 = 0.f;
#pragma unroll
    for (int m = 0; m < MFR; ++m) {
      const int row = row0 + wr * (16 * MFR) + m * 16 + fr;
      int b, pos;
      row_bpos(row, b, pos);
      if (region <= 1) {
        bf16_t* dst = region == 0 ? Q : K;
        const int head = (pn & 3) * 2 + (wc >> 1), msub = wc & 1;
        bf16_t* rp = dst + ((size_t)(b * NH + head) * LKV + pos) * 128 + msub * 64;
        const bool lat = row < NLAT;
        const int t = row & (SEQ - 1);
        const int prow = t >> 6, pcol = t & 63;
#pragma unroll
        for (int n = 0; n < 2; ++n) {
          float oa[4], ob[4];
          if (n == 0) kn2 = 0.f;
          const int pp = (n == 0) ? prow : pcol;
          const f32x4 r0 = lat ? *(const f32x4*)(rope + (pp * 16 + fq * 4) * 2) : (f32x4){1.f, 0.f, 1.f, 0.f};
          const f32x4 r1 = lat ? *(const f32x4*)(rope + (pp * 16 + fq * 4) * 2 + 4) : (f32x4){1.f, 0.f, 1.f, 0.f};
          const float csv[4] = {r0[0], r0[2], r1[0], r1[2]}, snv[4] = {r0[1], r0[3], r1[1], r1[3]};
#pragma unroll
          for (int j = 0; j < 4; ++j) {
            const float a = acc[m][n][j], bb = acc[m][n + 2][j];
            oa[j] = a * csv[j] - bb * snv[j];
            ob[j] = a * snv[j] + bb * csv[j];
          }
          if (region == 0) {
#pragma unroll
            for (int j = 0; j < 4; ++j) { oa[j] *= QSCALE; ob[j] *= QSCALE; }
          } else {
#pragma unroll
            for (int j = 0; j < 4; ++j) kn2 += oa[j] * oa[j] + ob[j] * ob[j];
          }
          u32x2 wa = {pk2(oa[0], oa[1]), pk2(oa[2], oa[3])};
          u32x2 wb = {pk2(ob[0], ob[1]), pk2(ob[2], ob[3])};
          *(u32x2*)(rp + n * 16 + fq * 4) = wa;
          *(u32x2*)(rp + 32 + n * 16 + fq * 4) = wb;
        }
        if (region == 1) {
          kn2 += shx_f(kn2, 16, lane); kn2 += shx_f(kn2, 32, lane);
          kmax2 = fmaxf(kmax2, kn2);
        }
      } else if (region == 2) {
        const int head = (pn & 3) * 2 + (wc >> 1);
        bf16_t* rp = V + ((size_t)(b * NH + head) * LKV + pos) * 128 + (wc & 1) * 64;
#pragma unroll
        for (int n = 0; n < 4; ++n) {
          u32x2 w = {pk2(acc[m][n][0], acc[m][n][1]), pk2(acc[m][n][2], acc[m][n][3])};
          *(u32x2*)(rp + n * 16 + fq * 4) = w;
        }
      } else {
        const int isv = (pn >> 1) & 1;
        bf16_t* rp = (isv ? GV : GU) + (size_t)row * 512 + (pn & 1) * 256 + wc * 64;
#pragma unroll
        for (int n = 0; n < 4; ++n) {
          u32x2 w = {pk2(gelu_tanh(acc[m][n][0]), gelu_tanh(acc[m][n][1])), pk2(gelu_tanh(acc[m][n][2]), gelu_tanh(acc[m][n][3]))};
          *(u32x2*)(rp + n * 16 + fq * 4) = w;
        }
      }
      asm volatile("" ::: "memory");
    }
    if (region == 1) {
#pragma unroll
      for (int o = 1; o < 16; o <<= 1) kmax2 = fmaxf(kmax2, shx_f(kmax2, o, lane));
      if (lane == 0) {
        const int b = row0 < NLAT ? (row0 >> 13) : ((row0 - NLAT) >> 8);
        const int head = (pn & 3) * 2 + (wc >> 1), msub = wc & 1;
        atomicMax(KMAX + (b * NH + head) * 2 + msub, __float_as_uint(kmax2));
      }
    }
  }
};
struct EpiResid {
  const hstream_t* XS; hstream_t* Z; const float* modbase;
  int which;
  template <int MFR> struct Pre { u32x2 xs[MFR][4]; };
  template <int MFR> __device__ __forceinline__ void preload(Pre<MFR>& pre, int row0, int pn, int wr, int wc, int fr, int fq) const {
#pragma unroll
    for (int n = 0; n < 4; ++n)
#pragma unroll
      for (int m = 0; m < MFR; ++m)
        pre.xs[m][n] = *(const u32x2*)(XS + (size_t)(row0 + wr * (16 * MFR) + m * 16 + fr) * DM + pn * 256 + wc * 64 + n * 16 + fq * 4);
  }
  template <int MFR>
  __device__ __forceinline__ void run(const f32x4 (&acc)[MFR][4], const Pre<MFR>& pre, int row0, int pn, int wr, int wc, int fr, int fq, char*, int) const {
    const int who = row0 < SEQ ? 0 : (row0 < NLAT ? 1 : 2);
    const float* g = modbase + ((size_t)who * 6 + which) * 1024;
#pragma unroll
    for (int n = 0; n < 4; ++n) {
      const int col = pn * 256 + wc * 64 + n * 16 + fq * 4;
      const f32x4 gv = *(const f32x4*)(g + col);
#pragma unroll
      for (int m = 0; m < MFR; ++m) {
        const size_t off = (size_t)(row0 + wr * (16 * MFR) + m * 16 + fr) * DM + col;
        const u32x2 w = pre.xs[m][n];
        const f32x4 xs = {hlo(w[0]), hhi(w[0]), hlo(w[1]), hhi(w[1])};
        st4h(Z + off, xs * ALPHA + gv * acc[m][n]);
      }
    }
  }
};
struct EpiBf16Store {
  bf16_t* O; int ld;
  template <int MFR> struct Pre {};
  template <int MFR> __device__ __forceinline__ void preload(Pre<MFR>&, int, int, int, int, int, int) const {}
  template <int MFR>
  __device__ __forceinline__ void run(const f32x4 (&acc)[MFR][4], const Pre<MFR>&, int row0, int pn, int wr, int wc, int fr, int fq, char*, int) const {
#pragma unroll
    for (int m = 0; m < MFR; ++m) {
      bf16_t* rp = O + (size_t)(row0 + wr * (16 * MFR) + m * 16 + fr) * ld + pn * 256 + wc * 64;
#pragma unroll
      for (int n = 0; n < 4; ++n) {
        u32x2 w = {pk2h(acc[m][n][0], acc[m][n][1]), pk2h(acc[m][n][2], acc[m][n][3])};
        *(u32x2*)(rp + n * 16 + fq * 4) = w;
      }
    }
  }
};
#define FMX(a, b) __float_as_int(__builtin_fmaxf(__int_as_float(a), __int_as_float(b)))
#define FMN(a, b) __float_as_int(__builtin_fminf(__int_as_float(a), __int_as_float(b)))
#define CE(a, b) do { const int _h = FMX(a, b), _l = FMN(a, b); a = _h; b = _l; } while (0)
#define SORT16(v) do { CE(v[0], v[1]); CE(v[2], v[3]); CE(v[0], v[2]); CE(v[1], v[3]); CE(v[1], v[2]); CE(v[4], v[5]); CE(v[6], v[7]); CE(v[4], v[6]); CE(v[5], v[7]); CE(v[5], v[6]); CE(v[0], v[4]); CE(v[2], v[6]); CE(v[2], v[4]); CE(v[1], v[5]); CE(v[3], v[7]); CE(v[3], v[5]); CE(v[1], v[2]); CE(v[3], v[4]); CE(v[5], v[6]); CE(v[8], v[9]); CE(v[10], v[11]); CE(v[8], v[10]); CE(v[9], v[11]); CE(v[9], v[10]); CE(v[12], v[13]); CE(v[14], v[15]); CE(v[12], v[14]); CE(v[13], v[15]); CE(v[13], v[14]); CE(v[8], v[12]); CE(v[10], v[14]); CE(v[10], v[12]); CE(v[9], v[13]); CE(v[11], v[15]); CE(v[11], v[13]); CE(v[9], v[10]); CE(v[11], v[12]); CE(v[13], v[14]); CE(v[0], v[8]); CE(v[4], v[12]); CE(v[4], v[8]); CE(v[2], v[10]); CE(v[6], v[14]); CE(v[6], v[10]); CE(v[2], v[4]); CE(v[6], v[8]); CE(v[10], v[12]); CE(v[1], v[9]); CE(v[5], v[13]); CE(v[5], v[9]); CE(v[3], v[11]); CE(v[7], v[15]); CE(v[7], v[11]); CE(v[3], v[5]); CE(v[7], v[9]); CE(v[11], v[13]); CE(v[1], v[2]); CE(v[3], v[4]); CE(v[5], v[6]); CE(v[7], v[8]); CE(v[9], v[10]); CE(v[11], v[12]); CE(v[13], v[14]); } while (0)
#define BMERGE16(v) do { CE(v[0], v[8]); CE(v[1], v[9]); CE(v[2], v[10]); CE(v[3], v[11]); CE(v[4], v[12]); CE(v[5], v[13]); CE(v[6], v[14]); CE(v[7], v[15]); CE(v[0], v[4]); CE(v[1], v[5]); CE(v[2], v[6]); CE(v[3], v[7]); CE(v[8], v[12]); CE(v[9], v[13]); CE(v[10], v[14]); CE(v[11], v[15]); CE(v[0], v[2]); CE(v[1], v[3]); CE(v[4], v[6]); CE(v[5], v[7]); CE(v[8], v[10]); CE(v[9], v[11]); CE(v[12], v[14]); CE(v[13], v[15]); CE(v[0], v[1]); CE(v[2], v[3]); CE(v[4], v[5]); CE(v[6], v[7]); CE(v[8], v[9]); CE(v[10], v[11]); CE(v[12], v[13]); CE(v[14], v[15]); } while (0)
#define CAND_CHUNK0 do { T[0] = CK(0, 0); T[1] = CK(0, 1); T[2] = CK(0, 2); T[3] = CK(0, 3); T[4] = CK(0, 4); T[5] = CK(0, 5); T[6] = CK(0, 6); T[7] = CK(0, 7); T[8] = CK(0, 8); T[9] = CK(0, 9); T[10] = CK(0, 10); T[11] = CK(0, 11); T[12] = CK(0, 12); T[13] = CK(0, 13); T[14] = CK(0, 14); T[15] = CK(0, 15); } while (0)
#define CAND_CHUNK1 do { X[0] = CK(1, 0); X[1] = CK(1, 1); X[2] = CK(1, 2); X[3] = CK(1, 3); X[4] = CK(1, 4); X[5] = CK(1, 5); X[6] = CK(1, 6); X[7] = CK(1, 7); X[8] = CK(2, 0); X[9] = CK(2, 1); X[10] = CK(2, 2); X[11] = CK(2, 3); X[12] = CK(2, 4); X[13] = CK(3, 0); X[14] = CK(3, 1); X[15] = CK(3, 2); } while (0)
#define CAND_CHUNK2 do { X[0] = CK(3, 3); X[1] = CK(4, 0); X[2] = CK(4, 1); X[3] = CK(4, 2); X[4] = CK(5, 0); X[5] = CK(5, 1); X[6] = CK(6, 0); X[7] = CK(6, 1); X[8] = CK(7, 0); X[9] = CK(7, 1); X[10] = CK(8, 0); X[11] = CK(9, 0); X[12] = CK(10, 0); X[13] = CK(11, 0); X[14] = CK(12, 0); X[15] = CK(13, 0); } while (0)
#define CAND_CHUNK3 do { X[0] = CK(14, 0); X[1] = CK(15, 0); X[2] = (int)0xFF800000; X[3] = (int)0xFF800000; X[4] = (int)0xFF800000; X[5] = (int)0xFF800000; X[6] = (int)0xFF800000; X[7] = (int)0xFF800000; X[8] = (int)0xFF800000; X[9] = (int)0xFF800000; X[10] = (int)0xFF800000; X[11] = (int)0xFF800000; X[12] = (int)0xFF800000; X[13] = (int)0xFF800000; X[14] = (int)0xFF800000; X[15] = (int)0xFF800000; } while (0)

__device__ __forceinline__ int packkey7(float f, int idx) { return (__float_as_int(f) & ~0x7F) | (127 - idx); }
__device__ __forceinline__ float keyval7(int k) { return __int_as_float(k & ~0x7F); }
__device__ __forceinline__ int packkey8(float f, int pos) { return (__float_as_int(f) & ~0xFF) | (255 - pos); }
__device__ __forceinline__ float keyval8(int k) { return __int_as_float(k & ~0xFF); }
typedef int i32x4 __attribute__((ext_vector_type(4)));
#define LD16(dst, ptr) do { const i32x4 _a = *(const i32x4*)(ptr), _b = *(const i32x4*)((ptr) + 4), _c = *(const i32x4*)((ptr) + 8), _d = *(const i32x4*)((ptr) + 12); \
    dst[0] = _a[0]; dst[1] = _a[1]; dst[2] = _a[2]; dst[3] = _a[3]; dst[4] = _b[0]; dst[5] = _b[1]; dst[6] = _b[2]; dst[7] = _b[3];                                \
    dst[8] = _c[0]; dst[9] = _c[1]; dst[10] = _c[2]; dst[11] = _c[3]; dst[12] = _d[0]; dst[13] = _d[1]; dst[14] = _d[2]; dst[15] = _d[3]; } while (0)
#define ST16(ptr, src) do { *(i32x4*)(ptr) = (i32x4){src[0], src[1], src[2], src[3]}; *(i32x4*)((ptr) + 4) = (i32x4){src[4], src[5], src[6], src[7]};           \
    *(i32x4*)((ptr) + 8) = (i32x4){src[8], src[9], src[10], src[11]}; *(i32x4*)((ptr) + 12) = (i32x4){src[12], src[13], src[14], src[15]}; } while (0)
#define MERGE_TOP16(T, X) do { _Pragma("unroll") for (int _i = 0; _i < 16; ++_i) T[_i] = FMX(T[_i], X[15 - _i]); BMERGE16(T); } while (0)
struct EpiTopK {
  int* IDX; float* GATE;
  template <int MFR> struct Pre {};
  template <int MFR> __device__ __forceinline__ void preload(Pre<MFR>&, int, int, int, int, int, int) const {}
  template <int MFR>
  __device__ __forceinline__ void run(const f32x4 (&acc)[MFR][4], const Pre<MFR>&, int row0, int pn, int wr, int wc, int fr, int fq, char* shm, int tid_) const {
    constexpr int LST = 68, BM = 32 * MFR;
    int* lst = (int*)shm;
    const int tid = tid_, lane = tid_ & 63;
#pragma unroll
    for (int m = 0; m < MFR; ++m) {
      int T[16], X[16];
#pragma unroll
      for (int n = 0; n < 4; ++n)
#pragma unroll
        for (int j = 0; j < 4; ++j) T[n * 4 + j] = packkey7(acc[m][n][j], (wc & 1) * 64 + n * 16 + fq * 4 + j);
      SORT16(T);
#pragma unroll
      for (int i = 0; i < 16; ++i) { auto rr = __builtin_amdgcn_permlane16_swap(T[i], T[i], false, false); T[i] = rr[0]; X[i] = rr[1]; }
      MERGE_TOP16(T, X);
#pragma unroll
      for (int i = 0; i < 16; ++i) { auto rr = __builtin_amdgcn_permlane32_swap(T[i], T[i], false, false); T[i] = rr[0]; X[i] = rr[1]; }
      MERGE_TOP16(T, X);
      i32x4 w;
#pragma unroll
      for (int q = 0; q < 4; ++q) {
        const int m1 = -(fq & 1), m2 = -((fq >> 1) & 1);
        const int lo_ = (T[q] & ~m1) | (T[4 + q] & m1), hi_ = (T[8 + q] & ~m1) | (T[12 + q] & m1);
        w[q] = (lo_ & ~m2) | (hi_ & m2);
      }
      *(i32x4*)(lst + (wr * (16 * MFR) + m * 16 + fr) * LST + wc * 16 + fq * 4) = w;
    }
    __syncthreads();
    if (tid < 2 * BM) {
      const int row = tid & (BM - 1), pp = tid / BM;
      int T[16], X[16];
      LD16(T, lst + row * LST + pp * 32);
      LD16(X, lst + row * LST + pp * 32 + 16);
      MERGE_TOP16(T, X);
      ST16(lst + row * LST + pp * 32, T);
    }
    __syncthreads();
    if (tid < BM) {
      const int row = tid;
      int T[16], X[16];
      float a[16], b[16];
      LD16(T, lst + row * LST);
      LD16(X, lst + row * LST + 32);
#pragma unroll
      for (int i = 0; i < 16; ++i) { a[i] = keyval7(T[i]); b[i] = keyval7(X[i]); }
#define CK(i, j) packkey8(a[i] + b[j], (i) * 16 + (j))
      CAND_CHUNK0; SORT16(T);
      CAND_CHUNK1; SORT16(X); MERGE_TOP16(T, X);
      CAND_CHUNK2; SORT16(X); MERGE_TOP16(T, X);
      CAND_CHUNK3; SORT16(X); MERGE_TOP16(T, X);
#undef CK
      const float v0 = keyval8(T[0]);
      float e[16], sum = 0.f;
#pragma unroll
      for (int r = 0; r < 16; ++r) { e[r] = __expf(keyval8(T[r]) - v0); sum += e[r]; }
      const float inv = 1.0f / sum;
      const size_t go = ((size_t)pn * NTOK + (size_t)(row0 + row)) * 16;
#pragma unroll
      for (int r = 0; r < 16; ++r) {
        const int pos = 255 - (T[r] & 0xFF);
        const int ia = 127 - (lst[row * LST + (pos >> 4)] & 0x7F), ib = 127 - (lst[row * LST + 32 + (pos & 15)] & 0x7F);
        X[r] = ia * 128 + ib;
        e[r] *= inv;
      }
      ST16(IDX + go, X);
      *(f32x4*)(GATE + go) = (f32x4){e[0], e[1], e[2], e[3]}; *(f32x4*)(GATE + go + 4) = (f32x4){e[4], e[5], e[6], e[7]};
      *(f32x4*)(GATE + go + 8) = (f32x4){e[8], e[9], e[10], e[11]}; *(f32x4*)(GATE + go + 12) = (f32x4){e[12], e[13], e[14], e[15]};
    }
    __syncthreads();
  }
};

__device__ void transpose_unit(const float* __restrict__ W, bf16_t* __restrict__ Wt, int K, int N, int unit, char* shm, int tid_) {
  float* tl = (float*)shm;
  const int ntn = N / 64;
  const int k0 = (unit / ntn) * 64, n0 = (unit % ntn) * 64;
  const int tid = tid_;
#pragma unroll
  for (int i = 0; i < 8; ++i) {
    const int idx = tid + i * 512, r = idx >> 6, c = idx & 63;
    tl[r * 65 + c] = W[(size_t)(k0 + r) * N + n0 + c];
  }
  __syncthreads();
#pragma unroll
  for (int i = 0; i < 8; ++i) {
    const int idx = tid + i * 512, r = idx >> 6, c = idx & 63;
    Wt[(size_t)(n0 + r) * K + k0 + c] = f2h(tl[c * 65 + r]);
  }
  __syncthreads();
}

__device__ void foldqk_unit(const Params& p, int unit, char* shm, int tid_) {
  const int l = unit >> 8, hp = (unit >> 4) & 15, ct = unit & 15;
  float* kl = (float*)shm;
  float* wl = kl + 128 * 132;
  const float* keys = PIN(p, peer_keys) + ((size_t)(l * 16 + hp) * 128) * 128;
  const float* wq = PIN(p, peer_wq) + (size_t)l * 1024 * 2048;
  const int tid = tid_;
  for (int idx = tid; idx < 128 * 128; idx += 512) { const int k = idx >> 7, d = idx & 127; kl[d * 132 + k] = keys[k * 128 + d]; }
  for (int idx = tid; idx < 64 * 128; idx += 512) { const int c = idx >> 7, d = idx & 127; wl[d * 68 + c] = wq[(size_t)(ct * 64 + c) * 2048 + hp * 128 + d]; }
  __syncthreads();
  const int c0 = (tid & 15) * 4, k0 = (tid >> 4) * 4;
  f32x4 acc[4];
#pragma unroll
  for (int kk = 0; kk < 4; ++kk) acc[kk] = (f32x4){0.f, 0.f, 0.f, 0.f};
#pragma unroll 4
  for (int d = 0; d < 128; ++d) {
    const f32x4 a = *(const f32x4*)(wl + d * 68 + c0), bq = *(const f32x4*)(kl + d * 132 + k0);
#pragma unroll
    for (int kk = 0; kk < 4; ++kk) acc[kk] += a * bq[kk];
  }
  bf16_t* outp = (bf16_t*)(p.ws + OFF_WQK) + (size_t)l * 2048 * 1024;
#pragma unroll
  for (int kk = 0; kk < 4; ++kk) {
    u32x2 w = {pk2h(acc[kk][0], acc[kk][1]), pk2h(acc[kk][2], acc[kk][3])};
    *(u32x2*)(outp + (size_t)(hp * 128 + k0 + kk) * 1024 + ct * 64 + c0) = w;
  }
  __syncthreads();
}
__device__ void foldpool_unit(const Params& p, int unit, char* shm, int tid_) {
  const int j = unit >> 8, g = (unit >> 6) & 3, cit = (unit >> 4) & 3, et = unit & 15;
  float* gl = (float*)shm;
  float* ol = gl + 256 * 68;
  const float* wg = PIN(p, pool_w_grp) + ((size_t)(j * 4 + g) * 256) * 256;
  const float* sc = PIN(p, pool_scale) + (size_t)j * 1024 + g * 256;
  const float* wo = PIN(p, pool_w_out) + ((size_t)j * 1024 + g * 256) * 1024;
  const int tid = tid_;
  for (int idx = tid; idx < 64 * 256; idx += 512) { const int r = idx >> 8, m = idx & 255; gl[m * 68 + r] = wg[(size_t)(cit * 64 + r) * 256 + m] * sc[m]; }
  for (int idx = tid; idx < 256 * 64; idx += 512) { const int m = idx >> 6, e = idx & 63; ol[m * 68 + e] = wo[(size_t)m * 1024 + et * 64 + e]; }
  __syncthreads();
  const int ci0 = (tid & 31) * 2, e0 = (tid >> 5) * 4;
  f32x4 acc0 = {0.f, 0.f, 0.f, 0.f}, acc1 = {0.f, 0.f, 0.f, 0.f};
#pragma unroll 4
  for (int m = 0; m < 256; ++m) {
    const f32x2v a = *(const f32x2v*)(gl + m * 68 + ci0);
    const f32x4 bq = *(const f32x4*)(ol + m * 68 + e0);
    acc0 += bq * a[0]; acc1 += bq * a[1];
  }
  bf16_t* outp = (bf16_t*)(p.ws + OFF_POUT) + (size_t)j * 1024 * 1024;
#pragma unroll
  for (int ee = 0; ee < 4; ++ee)
    *(unsigned*)(outp + (size_t)(et * 64 + e0 + ee) * 1024 + g * 256 + cit * 64 + ci0) = pk2h(acc0[ee], acc1[ee]);
  __syncthreads();
}
__device__ void mod_unit(const Params& p, int unit, char* shm, int tid_) {
  const int l = unit / 48, rem = unit % 48, cgp = rem >> 1, kh = rem & 1;
  float* sv = (float*)shm;
  float* red = sv + 3 * 512;
  const int tid = tid_, lane = tid & 63, ks = __builtin_amdgcn_readfirstlane(tid >> 6);
  for (int idx = tid; idx < 3 * 512; idx += 512) {
    const int w = idx >> 9, k = kh * 512 + (idx & 511);
    const float xv = w < 2 ? PIN(p, c)[w * 1024 + k] : PIN(p, c_ctx)[k];
    sv[idx] = xv / (1.0f + __expf(-xv));
  }
  __syncthreads();
  const float* aw = PIN(p, ada_w) + (size_t)l * 1024 * 6144 + (size_t)(kh * 512 + ks * 64) * 6144 + cgp * 256 + lane * 4;
  f32x4 a0 = {0.f, 0.f, 0.f, 0.f}, a1 = a0, a2 = a0;
#pragma unroll 8
  for (int k = 0; k < 64; ++k) {
    const f32x4 w = *(const f32x4*)(aw + (size_t)k * 6144);
    a0 += w * sv[ks * 64 + k]; a1 += w * sv[512 + ks * 64 + k]; a2 += w * sv[1024 + ks * 64 + k];
  }
  *(f32x4*)(red + (ks * 3 + 0) * 256 + lane * 4) = a0; *(f32x4*)(red + (ks * 3 + 1) * 256 + lane * 4) = a1; *(f32x4*)(red + (ks * 3 + 2) * 256 + lane * 4) = a2;
  __syncthreads();
  for (int idx = tid; idx < 768; idx += 512) {
    const int w = idx >> 8, cc = idx & 255;
    float s = 0.f;
#pragma unroll
    for (int q = 0; q < 8; ++q) s += red[(q * 3 + w) * 256 + cc];
    const int n = cgp * 256 + cc;
    ((float*)(p.ws + OFF_MODP))[((size_t)kh * 12 + l * 3 + w) * 6144 + n] = s;
  }
  __syncthreads();
}

__device__ void phase_prologue_a(const Params& p, char* shm, int tid_) {
  constexpr int U_MOD = 192;
  constexpr int U_TWIN = 2 * 16 * 64, U_TWOUT = 2 * 24 * 16, U_TPIN = 2 * 16 * 16;
  constexpr int U_FQK = 1024, U_FP = 512, U_TAB = 2048, U_MISC = 1;
  constexpr int E0 = U_MOD, E1 = E0 + U_TWIN, E2 = E1 + U_TWOUT, E3 = E2 + U_TPIN, E4 = E3 + U_FQK, E5 = E4 + U_FP, E6 = E5 + U_TAB, E7 = E6 + U_MISC;
  for (int u = lbid(); u < E7; u += gridDim.x) {
    if (u < E0) mod_unit(p, u, shm, tid_);
    else if (u < E1) { const int v = u - E0, j = v / (16 * 64), r = v % (16 * 64);
      transpose_unit(PIN(p, ab_w_in) + (size_t)j * 1024 * 4096, (bf16_t*)(p.ws + OFF_WIN) + (size_t)j * 4096 * 1024, 1024, 4096, r, shm, tid_); }
    else if (u < E2) { const int v = u - E1, j = v / (24 * 16), r = v % (24 * 16);
      transpose_unit(PIN(p, ab_w_out) + (size_t)j * 1536 * 1024, (bf16_t*)(p.ws + OFF_WOUT) + (size_t)j * 1024 * 1536, 1536, 1024, r, shm, tid_); }
    else if (u < E3) { const int v = u - E2, j = v / 256, r = v % 256;
      transpose_unit(PIN(p, pool_w_in) + (size_t)j * 1024 * 1024, (bf16_t*)(p.ws + OFF_PIN) + (size_t)j * 1024 * 1024, 1024, 1024, r, shm, tid_); }
    else if (u < E4) foldqk_unit(p, u - E3, shm, tid_);
    else if (u < E5) foldpool_unit(p, u - E4, shm, tid_);
    else if (u < E6) {
      const int v = u - E5;
      const int tb = v >> 10;
      const float* src = tb ? PIN(p, peer_v) : PIN(p, peer_u);
      unsigned char* dst = (unsigned char*)(p.ws + (tb ? OFF_V8 : OFF_U8));
      const float scl = tb ? 8.0f : 64.0f;
      const int wid = __builtin_amdgcn_readfirstlane(tid_ >> 6), lane = tid_ & 63;
#pragma unroll 4
      for (int i = 0; i < 8; ++i) {
        const int row = (v & 1023) * 64 + i * 8 + wid;
        const int layer = row >> 14, e = row & 16383;
        const float* rp = src + (size_t)row * DM + lane * 16;
        const f32x4 a = *(const f32x4*)rp * scl, b = *(const f32x4*)(rp + 4) * scl, c = *(const f32x4*)(rp + 8) * scl, d = *(const f32x4*)(rp + 12) * scl;
        u32x4 w;
        w[0] = __builtin_amdgcn_cvt_pk_fp8_f32(a[2], a[3], __builtin_amdgcn_cvt_pk_fp8_f32(a[0], a[1], 0, false), true);
        w[1] = __builtin_amdgcn_cvt_pk_fp8_f32(b[2], b[3], __builtin_amdgcn_cvt_pk_fp8_f32(b[0], b[1], 0, false), true);
        w[2] = __builtin_amdgcn_cvt_pk_fp8_f32(c[2], c[3], __builtin_amdgcn_cvt_pk_fp8_f32(c[0], c[1], 0, false), true);
        w[3] = __builtin_amdgcn_cvt_pk_fp8_f32(d[2], d[3], __builtin_amdgcn_cvt_pk_fp8_f32(d[0], d[1], 0, false), true);
        *(u32x4*)(dst + ((size_t)(layer * 8 + (lane >> 3)) * NEXP + e) * 128 + (lane & 7) * 16) = w;
      }
    } else {
      float* rope = (float*)(p.ws + OFF_ROPE);
      for (int idx = tid_; idx < 128 * 16; idx += 512) {
        const int pos = idx >> 4, i = idx & 15;
        const float inv = powf(10000.0f, -(float)i / 16.0f);
        const float ang = (float)pos * inv;
        rope[idx * 2 + 0] = cosf(ang);
        rope[idx * 2 + 1] = sinf(ang);
      }
      if (tid_ < 2) {
        const int j = tid_;
        const float* lv = PIN(p, diff_lam) + (size_t)j * 4 * 64;
        float s1 = 0.f, s2 = 0.f;
        for (int d = 0; d < 64; ++d) { s1 += lv[d] * lv[64 + d]; s2 += lv[128 + d] * lv[192 + d]; }
        const float lam_init = 0.8f - 0.6f * expf(-0.3f * (float)(2 * j));
        float* lam = (float*)(p.ws + OFF_LAM);
        lam[j * 2 + 0] = expf(s1) - expf(s2) + lam_init;
        lam[j * 2 + 1] = lam_init;
      }
    }
  }
}

__device__ void phase_prologue_b(const Params& p, int tid_) {
  const int wid = __builtin_amdgcn_readfirstlane(tid_ >> 6), lane = tid_ & 63;
  {
    const float* mp = (const float*)(p.ws + OFF_MODP);
    float* md = (float*)(p.ws + OFF_MOD);
    for (int idx = lbid() * 512 + tid_; idx < 12 * 6144; idx += gridDim.x * 512) {
      const int l = idx / (3 * 6144), n = idx % 6144;
      md[idx] = mp[idx] + mp[12 * 6144 + idx] + PIN(p, ada_b)[(size_t)l * 6144 + n];
    }
  }
  hstream_t* XS = (hstream_t*)(p.ws + OFF_XSA);
  bf16_t* H = (bf16_t*)(p.ws + OFF_H);
  for (int row = lbid() * 8 + wid; row < NTOK; row += gridDim.x * 8) {
    const float* src = row < NLAT ? PIN(p, x) + (size_t)row * DM : PIN(p, ctx) + (size_t)(row - NLAT) * DM;
    const int who = who_of_row(row);
    const float* mp0 = (const float*)(p.ws + OFF_MODP) + (size_t)who * 6144;
    const float* mp1 = mp0 + 12 * 6144;
#pragma unroll
    for (int i = 0; i < 4; ++i) {
      const int col = i * 256 + lane * 4;
      const f32x4 v = *(const f32x4*)(src + col);
      st4h(XS + (size_t)row * DM + col, v);
      const f32x4 s1 = *(const f32x4*)(mp0 + col) + *(const f32x4*)(mp1 + col) + *(const f32x4*)(PIN(p, ada_b) + col);
      const f32x4 s2 = *(const f32x4*)(mp0 + 1024 + col) + *(const f32x4*)(mp1 + 1024 + col) + *(const f32x4*)(PIN(p, ada_b) + 1024 + col);
      const f32x4 h = v * (s2 + 1.0f) + s1;
      u32x2 w = {pk2h(h[0], h[1]), pk2h(h[2], h[3])};
      *(u32x2*)(H + (size_t)row * DM + col) = w;
    }
  }
}

__device__ void phase_ln(const Params& p, const hstream_t* Zin, hstream_t* XSo, int layer, int lnidx, int nrows, bf16_t* Hout, int mlayer, int msh, int nrows_h, bool final, int tid_) {
  const int wid = __builtin_amdgcn_readfirstlane(tid_ >> 6), lane = tid_ & 63;
  const float* g = PIN(p, ln_g) + (size_t)(layer * 2 + lnidx) * DM;
  const float* bt = PIN(p, ln_b) + (size_t)(layer * 2 + lnidx) * DM;
  for (int row = lbid() * 8 + wid; row < nrows; row += gridDim.x * 8) {
    const int who = who_of_row(row);
    f32x4 v[4];
    float s = 0.f;
#pragma unroll
    for (int i = 0; i < 4; ++i) { v[i] = ld4h(Zin + (size_t)row * DM + i * 256 + lane * 4); s += (v[i][0] + v[i][1]) + (v[i][2] + v[i][3]); }
    const float mu = wave_sum(s, lane) * (1.0f / DM);
    float q = 0.f;
#pragma unroll
    for (int i = 0; i < 4; ++i) { const f32x4 d = v[i] - mu; q += (d[0] * d[0] + d[1] * d[1]) + (d[2] * d[2] + d[3] * d[3]); }
    const float rstd = rsqrtf(wave_sum(q, lane) * (1.0f / DM) + LN_EPS);
#pragma unroll
    for (int i = 0; i < 4; ++i) {
      const int col = i * 256 + lane * 4;
      const f32x4 gg = *(const f32x4*)(g + col), bb = *(const f32x4*)(bt + col);
      const f32x4 xo = (v[i] - mu) * rstd * gg + bb;
      if (final) { *(f32x4*)(p.out + (size_t)row * DM + col) = xo; }
      else {
        st4h(XSo + (size_t)row * DM + col, xo);
        if (row < nrows_h) {
          const f32x4 s1 = *(const f32x4*)(mod_ptr(p, mlayer, who, msh) + col), s2 = *(const f32x4*)(mod_ptr(p, mlayer, who, msh + 1) + col);
          const f32x4 h = xo * (s2 + 1.0f) + s1;
          u32x2 w;
          w = (u32x2){pk2h(h[0], h[1]), pk2h(h[2], h[3])};
          *(u32x2*)(Hout + (size_t)row * DM + col) = w;
          if (lnidx == 0) {
            f32x4 h4;
#pragma unroll
            for (int j = 0; j < 4; ++j) h4[j] = fminf(fmaxf(h[j] * 4.0f, -448.0f), 448.0f);
            const unsigned hi = __builtin_amdgcn_cvt_pk_fp8_f32(h4[2], h4[3], __builtin_amdgcn_cvt_pk_fp8_f32(h4[0], h4[1], 0, false), true);
            const f32x2v b0 = __builtin_amdgcn_cvt_pk_f32_fp8((int)hi, false), b1 = __builtin_amdgcn_cvt_pk_f32_fp8((int)hi, true);
            const unsigned lo = __builtin_amdgcn_cvt_pk_fp8_f32(h4[2] - b1[0], h4[3] - b1[1], __builtin_amdgcn_cvt_pk_fp8_f32(h4[0] - b0[0], h4[1] - b0[1], 0, false), true);
            unsigned char* h8 = (unsigned char*)(p.ws + OFF_H8) + (size_t)row * DM + col;
            *(unsigned*)h8 = hi; *(unsigned*)(h8 + (size_t)NTOK * DM) = lo;
          }
        }
      }
    }
  }
}

typedef short s16x4 __attribute__((ext_vector_type(4)));
typedef float f32x16 __attribute__((ext_vector_type(16)));
#define KSWZ(row, colB) ((row) * 256 + ((colB) ^ (((row) & 7) << 4)))
#define SBAR() __builtin_amdgcn_sched_barrier(0)
constexpr float ATT_SCALE = 0.125f, ATT_THR = 8.f;
#ifndef ATT_SDEPTH
#define ATT_SDEPTH 1
#endif
constexpr int SHM_KV = 64 * 128 * 2;
__device__ __forceinline__ int crow(int r, int hi) { return (r & 3) + 8 * (r >> 2) + 4 * hi; }
__device__ __forceinline__ unsigned cvtpk(float lo, float hi) {
  unsigned r; asm volatile("v_cvt_pk_bf16_f32 %0, %1, %2" : "=v"(r) : "v"(lo), "v"(hi)); return r;
}
__device__ __forceinline__ void qkt(f32x16& p0, f32x16& p1, const char* Ks, const bf16x8* qr, int r32, int hi, int m, float negM) {
#pragma unroll
  for (int r = 0; r < 16; ++r) { p0[r] = negM; p1[r] = negM; }
#pragma unroll
  for (int d0 = 0; d0 < 4; ++d0) {
    const int cb = (m * 64 + d0 * 16 + hi * 8) * 2;
    const bf16x8 b0 = *reinterpret_cast<const bf16x8*>(Ks + KSWZ(r32, cb));
    const bf16x8 b1 = *reinterpret_cast<const bf16x8*>(Ks + KSWZ(32 + r32, cb));
    p0 = __builtin_amdgcn_mfma_f32_32x32x16_bf16(b0, qr[d0], p0, 0, 0, 0);
    p1 = __builtin_amdgcn_mfma_f32_32x32x16_bf16(b1, qr[d0], p1, 0, 0, 0);
  }
}
__device__ __forceinline__ int v_st(int k, int c) { const int kk = (k & ~0xC) | ((k & 4) << 1) | ((k & 8) >> 1); return ((kk >> 3) * 4 + (c >> 5)) * 512 + ((kk & 7) * 32 + (c & 31)) * 2; }
__device__ __forceinline__ int v_rd_base(int lane) { return ((lane & 3) << 3) | (((lane >> 2) & 3) << 6) | (((lane >> 4) & 1) << 5) | (((lane >> 5) & 1) << 8); }
constexpr int v_rd_off(int d0, int ks, int half) { return d0 * 512 + ks * 4096 + half * 2048; }
template <int OFF> __device__ __forceinline__ s16x4 tr_read(int vb) {
  s16x4 r; asm volatile("ds_read_b64_tr_b16 %0, %1 offset:%2" : "=&v"(r) : "v"(vb), "i"(OFF) : "memory"); return r;
}
template <int D0> __device__ __forceinline__ void pv_one(f32x16& od, int vb, bf16x8 pa0, bf16x8 pa1, bf16x8 pa2, bf16x8 pa3) {
  const s16x4 l0 = tr_read<v_rd_off(D0, 0, 0)>(vb), h0 = tr_read<v_rd_off(D0, 0, 1)>(vb), l1 = tr_read<v_rd_off(D0, 1, 0)>(vb), h1 = tr_read<v_rd_off(D0, 1, 1)>(vb);
  const s16x4 l2 = tr_read<v_rd_off(D0, 2, 0)>(vb), h2 = tr_read<v_rd_off(D0, 2, 1)>(vb), l3 = tr_read<v_rd_off(D0, 3, 0)>(vb), h3 = tr_read<v_rd_off(D0, 3, 1)>(vb);
  asm volatile("s_waitcnt lgkmcnt(0)" ::: "memory"); SBAR();
#define PKV(L, H) (bf16x8){L[0], L[1], L[2], L[3], H[0], H[1], H[2], H[3]}
  od = __builtin_amdgcn_mfma_f32_32x32x16_bf16(pa0, PKV(l0, h0), od, 0, 0, 0);
  od = __builtin_amdgcn_mfma_f32_32x32x16_bf16(pa1, PKV(l1, h1), od, 0, 0, 0);
  od = __builtin_amdgcn_mfma_f32_32x32x16_bf16(pa2, PKV(l2, h2), od, 0, 0, 0);
  od = __builtin_amdgcn_mfma_f32_32x32x16_bf16(pa3, PKV(l3, h3), od, 0, 0, 0);
#undef PKV
}
template <int D0> __device__ __forceinline__ void pv_one_t(f32x16& od, int vb, bf16x8 pa0, bf16x8 pa1, bf16x8 pa2, bf16x8 pa3) {
  const s16x4 l0 = tr_read<v_rd_off(D0, 0, 0)>(vb), h0 = tr_read<v_rd_off(D0, 0, 1)>(vb), l1 = tr_read<v_rd_off(D0, 1, 0)>(vb), h1 = tr_read<v_rd_off(D0, 1, 1)>(vb);
  const s16x4 l2 = tr_read<v_rd_off(D0, 2, 0)>(vb), h2 = tr_read<v_rd_off(D0, 2, 1)>(vb), l3 = tr_read<v_rd_off(D0, 3, 0)>(vb), h3 = tr_read<v_rd_off(D0, 3, 1)>(vb);
  asm volatile("s_waitcnt lgkmcnt(0)" ::: "memory"); SBAR();
#define PKV(L, H) (bf16x8){L[0], L[1], L[2], L[3], H[0], H[1], H[2], H[3]}
  od = __builtin_amdgcn_mfma_f32_32x32x16_bf16(PKV(l0, h0), pa0, od, 0, 0, 0);
  od = __builtin_amdgcn_mfma_f32_32x32x16_bf16(PKV(l1, h1), pa1, od, 0, 0, 0);
  od = __builtin_amdgcn_mfma_f32_32x32x16_bf16(PKV(l2, h2), pa2, od, 0, 0, 0);
  od = __builtin_amdgcn_mfma_f32_32x32x16_bf16(PKV(l3, h3), pa3, od, 0, 0, 0);
#undef PKV
}

__device__ __forceinline__ void attn_unit(const bf16_t* __restrict__ Qb, const bf16_t* __restrict__ Kh, const bf16_t* __restrict__ Vh, int seq,
                                          bf16_t* __restrict__ CATp  , const float* __restrict__ ng, float lam, float lam_init,
                                          const unsigned* __restrict__ kmaxp  , char* lds, int tid_) {
  const int tid = tid_, wid = __builtin_amdgcn_readfirstlane(tid >> 6), lane = tid & 63, r32 = lane & 31, hi = lane >> 5;
  const int rg = wid & 3, m = wid >> 2;
  constexpr int SLOT = 2 * SHM_KV;
  float* wsp = (float*)(lds + 4 * SLOT) + wid * 64; float* li_l = wsp;
  float l_reg = 0; f32x16 o[4] = {}; bf16x8 qr[4];
  const bf16_t* Qw = Qb + (size_t)(rg * 32 + r32) * 128 + m * 64 + hi * 8;
#pragma unroll
  for (int d0 = 0; d0 < 4; ++d0) qr[d0] = *reinterpret_cast<const bf16x8*>(Qw + d0 * 16);
  float negM;
  {
    float q2 = 0.f;
#pragma unroll
    for (int d0 = 0; d0 < 4; ++d0)
#pragma unroll
      for (int e = 0; e < 8; ++e) { const float v = bf2f((bf16_t)qr[d0][e]); q2 += v * v; }
    { auto rr = __builtin_amdgcn_permlane32_swap(__float_as_uint(q2), __float_as_uint(q2), false, false); q2 = __uint_as_float(rr[0]) + __uint_as_float(rr[1]); }
    const float k2 = __uint_as_float(kmaxp[m]);
    negM = -1.01f * sqrtf(q2 * k2);
  }
  unsigned vsrc[2], ksrc[2];
#pragma unroll
  for (int j = 0; j < 2; ++j) {
    const int p_ = wid + 8 * j;
    const int g_ = p_ * 64 + lane, sub = g_ >> 5, within = g_ & 31;
    const int kk = (sub >> 2) * 8 + (within >> 2), c_ = (sub & 3) * 32 + (within & 3) * 8;
    const int k_ = (kk & ~0xC) | ((kk & 4) << 1) | ((kk & 8) >> 1);
    vsrc[j] = (unsigned)(k_ * 256 + c_ * 2);
    const int row = p_ * 4 + (lane >> 4), chunk = (lane & 15) ^ (row & 7);
    ksrc[j] = (unsigned)(row * 256 + chunk * 16);
  }
  const int vb0 = (int)(uintptr_t)lds + v_rd_base(lane);
#define SLOAD_DMA(k0, slot) do { \
    const char* _vg = (const char*)(Vh + (size_t)(k0) * 128); const char* _kg = (const char*)(Kh + (size_t)(k0) * 128); char* _b = lds + (slot) * SLOT; \
    __builtin_amdgcn_global_load_lds((const unsigned*)(_vg + vsrc[0]), (unsigned*)(_b + wid * 1024), 16, 0, 0); \
    __builtin_amdgcn_global_load_lds((const unsigned*)(_vg + vsrc[1]), (unsigned*)(_b + (wid + 8) * 1024), 16, 0, 0); \
    __builtin_amdgcn_global_load_lds((const unsigned*)(_kg + ksrc[0]), (unsigned*)(_b + SHM_KV + wid * 1024), 16, 0, 0); \
    __builtin_amdgcn_global_load_lds((const unsigned*)(_kg + ksrc[1]), (unsigned*)(_b + SHM_KV + (wid + 8) * 1024), 16, 0, 0); } while (0)
#define TILE_PUBLISH() do { asm volatile("s_waitcnt vmcnt(0) lgkmcnt(0)" ::: "memory"); __builtin_amdgcn_s_barrier(); asm volatile("" ::: "memory"); } while (0)
#define PKV(L, H) (bf16x8){L[0], L[1], L[2], L[3], H[0], H[1], H[2], H[3]}
#define VRD(D0, KH, vb, f0, f1, f2, f3) do { f0 = tr_read<v_rd_off(D0, 2 * (KH), 0)>(vb); f1 = tr_read<v_rd_off(D0, 2 * (KH), 1)>(vb); \
    f2 = tr_read<v_rd_off(D0, 2 * (KH) + 1, 0)>(vb); f3 = tr_read<v_rd_off(D0, 2 * (KH) + 1, 1)>(vb); } while (0)
#define VMM(D0, qa, qb, f0, f1, f2, f3) do { \
    o[D0] = __builtin_amdgcn_mfma_f32_32x32x16_bf16(qa, PKV(f0, f1), o[D0], 0, 0, 0); \
    o[D0] = __builtin_amdgcn_mfma_f32_32x32x16_bf16(qb, PKV(f2, f3), o[D0], 0, 0, 0); } while (0)
#define LW4() do { asm volatile("s_waitcnt lgkmcnt(4)" ::: "memory"); SBAR(); } while (0)
#define LW0() do { asm volatile("s_waitcnt lgkmcnt(0)" ::: "memory"); SBAR(); } while (0)
#define PV_TILE(vb, q0, q1, q2, q3, C0, C1, C2, C3) do { \
    s16x4 a0, a1, a2, a3; \
    SBAR(); VRD(0, 0, vb, a0, a1, a2, a3); C0; LW0(); VMM(0, q0, q1, a0, a1, a2, a3); SBAR(); \
    VRD(0, 1, vb, a0, a1, a2, a3);     LW0(); VMM(0, q2, q3, a0, a1, a2, a3); SBAR(); \
    VRD(1, 0, vb, a0, a1, a2, a3); C1; LW0(); VMM(1, q0, q1, a0, a1, a2, a3); SBAR(); \
    VRD(1, 1, vb, a0, a1, a2, a3);     LW0(); VMM(1, q2, q3, a0, a1, a2, a3); SBAR(); \
    VRD(2, 0, vb, a0, a1, a2, a3); C2; LW0(); VMM(2, q0, q1, a0, a1, a2, a3); SBAR(); \
    VRD(2, 1, vb, a0, a1, a2, a3);     LW0(); VMM(2, q2, q3, a0, a1, a2, a3); SBAR(); \
    VRD(3, 0, vb, a0, a1, a2, a3); C3; LW0(); VMM(3, q0, q1, a0, a1, a2, a3); SBAR(); \
    VRD(3, 1, vb, a0, a1, a2, a3);     LW0(); VMM(3, q2, q3, a0, a1, a2, a3); SBAR(); } while (0)
#define PK4(P, BASE, OUT) do { unsigned a0 = cvtpk(P[BASE + 0], P[BASE + 1]), a1 = cvtpk(P[BASE + 2], P[BASE + 3]);   \
    unsigned b0 = cvtpk(P[BASE + 4], P[BASE + 5]), b1 = cvtpk(P[BASE + 6], P[BASE + 7]);                              \
    auto r0 = __builtin_amdgcn_permlane32_swap(a0, b0, false, false); auto r1 = __builtin_amdgcn_permlane32_swap(a1, b1, false, false); \
    u32x4 w = {r0[0], r1[0], r0[1], r1[1]}; OUT = *reinterpret_cast<bf16x8*>(&w); } while (0)
#define E1(S0) do { _Pragma("unroll") for (int r = 0; r < 16; ++r) S0[r] = __builtin_amdgcn_exp2f(S0[r]); } while (0)
#define E3(S0, S1) do { float ps = 0; _Pragma("unroll") for (int r = 0; r < 16; ++r) ps += S0[r]; _Pragma("unroll") for (int r = 0; r < 16; ++r) ps += S1[r]; l_reg += ps; } while (0)
#define E4(S0, S1, n0, n1, n2, n3) do { PK4(S0, 0, n0); PK4(S0, 8, n1); PK4(S1, 0, n2); PK4(S1, 8, n3); } while (0)
#define ITER(SN0, SN1, ks, SP0, SP1, vs) do { \
    const int _vb = vb0 + (vs) * SLOT; \
    PV_TILE(_vb, p0, p1, p2, p3, E1(SP0), E1(SP1), E3(SP0, SP1), (void)0); \
    qkt(SN0, SN1, lds + (ks) * SLOT + SHM_KV, qr, r32, hi, m, negM); \
    E4(SP0, SP1, p0, p1, p2, p3); SBAR(); } while (0)
  f32x16 sA0, sA1, sB0, sB1; bf16x8 p0, p1, p2, p3; const int NT = seq / 64;
  SLOAD_DMA(0, 0); TILE_PUBLISH();
  SLOAD_DMA(64, 1);
  qkt(sA0, sA1, lds + SHM_KV, qr, r32, hi, m, negM);
  TILE_PUBLISH();
  if (2 < NT) SLOAD_DMA(2 * 64, 2);
  qkt(sB0, sB1, lds + SLOT + SHM_KV, qr, r32, hi, m, negM);
  E1(sA0); E1(sA1); E3(sA0, sA1); E4(sA0, sA1, p0, p1, p2, p3);
  TILE_PUBLISH();
  for (int i = 2; i < NT; i += 2) {
    SLOAD_DMA((i + 1) * 64, (i + 1) & 3);
    ITER(sA0, sA1, i & 3, sB0, sB1, (i - 2) & 3);
    TILE_PUBLISH();
    if (i + 2 < NT) SLOAD_DMA((i + 2) * 64, (i + 2) & 3);
    ITER(sB0, sB1, (i + 1) & 3, sA0, sA1, (i - 1) & 3);
    TILE_PUBLISH();
  }
  {
    const int _vb = vb0 + ((NT - 2) & 3) * SLOT;
    PV_TILE(_vb, p0, p1, p2, p3, E1(sB0), E1(sB1), E3(sB0, sB1), (void)0);
    E4(sB0, sB1, p0, p1, p2, p3); SBAR();
    const int _vb2 = vb0 + ((NT - 1) & 3) * SLOT;
    PV_TILE(_vb2, p0, p1, p2, p3, (void)0, (void)0, (void)0, (void)0);
  }
#undef SLOAD_DMA
#undef TILE_PUBLISH
#undef PKV
#undef PV_TILE
#undef VRD
#undef VMM
#undef LW4
#undef LW0
#undef PK4
#undef E1
#undef E3
#undef E4
#undef ITER
  int r32e = r32, hie = hi;
  asm volatile("" : "+v"(r32e), "+v"(hie));
  { auto rr = __builtin_amdgcn_permlane32_swap(__float_as_uint(l_reg), __float_as_uint(l_reg), false, false); l_reg = __uint_as_float(rr[0]) + __uint_as_float(rr[1]); }
  if (hie == 0) li_l[r32e] = l_reg;
  asm volatile("s_waitcnt lgkmcnt(0)" ::: "memory");
  float rli[16];
#pragma unroll
  for (int r = 0; r < 16; ++r) rli[r] = __builtin_amdgcn_rcpf(li_l[crow(r, hie)]);
  __syncthreads();
  float* comb = (float*)lds;
  if (m == 1) {
#pragma unroll
    for (int r = 0; r < 16; ++r)
#pragma unroll
      for (int d0 = 0; d0 < 4; ++d0) comb[(rg * 32 + crow(r, hie)) * 128 + d0 * 32 + r32e] = o[d0][r] * rli[r] * lam;
  }
  __syncthreads();
  if (m == 0) {
    float ss[16];
#pragma unroll
    for (int r = 0; r < 16; ++r) {
      float a = 0.f;
#pragma unroll
      for (int d0 = 0; d0 < 4; ++d0) {
        const float v = o[d0][r] * rli[r] - comb[(rg * 32 + crow(r, hie)) * 128 + d0 * 32 + r32e];
        o[d0][r] = v; a += v * v;
      }
      ss[r] = a;
    }
#pragma unroll
    for (int off = 1; off < 32; off <<= 1)
#pragma unroll
      for (int r = 0; r < 16; ++r) ss[r] += shx_f(ss[r], off, lane);
    const float om = 1.0f - lam_init;
    float gq[4];
#pragma unroll
    for (int d0 = 0; d0 < 4; ++d0) gq[d0] = ng[d0 * 32 + r32e] * om;
#pragma unroll
    for (int r = 0; r < 16; ++r) {
      const float rs = rsqrtf(ss[r] * (1.0f / 128.0f) + LN_EPS);
      bf16_t* cp = CATp + (size_t)(rg * 32 + crow(r, hie)) * 1536;
#pragma unroll
      for (int d0 = 0; d0 < 4; ++d0) cp[d0 * 32 + r32e] = f2h(o[d0][r] * rs * gq[d0]);
    }
  }
  __syncthreads();
}

__device__ __forceinline__ void sgu_unit(const Params& p, int chunk, int jl, char* lds, int tid_) {
  const int tid = tid_, wid = __builtin_amdgcn_readfirstlane(tid >> 6), lane = tid & 63, r32 = lane & 31, hi = lane >> 5;
  const int row0 = chunk * 128;
  const bf16_t* GV = (const bf16_t*)(p.ws + OFF_GV);
  const bf16_t* GU = (const bf16_t*)(p.ws + OFF_GU);
  bf16_t* CAT = (bf16_t*)(p.ws + OFF_CAT);
  const float* lg = PIN(p, sgu_ln_g) + (size_t)jl * 512;
  const float* lb = PIN(p, sgu_ln_b) + (size_t)jl * 512;
  {
    const f32x4 g0 = *(const f32x4*)(lg + lane * 8), g1 = *(const f32x4*)(lg + lane * 8 + 4);
    const f32x4 b0 = *(const f32x4*)(lb + lane * 8), b1 = *(const f32x4*)(lb + lane * 8 + 4);
    const int c = lane * 8, g = c >> 7, cg = c & 127;
    for (int q = wid; q < 128; q += 8) {
      const u32x4 w = *(const u32x4*)(GV + (size_t)(row0 + q) * 512 + c);
      float v[8];
#pragma unroll
      for (int i = 0; i < 4; ++i) { v[2 * i] = bflo(w[i]); v[2 * i + 1] = bfhi(w[i]); }
      float s = 0.f;
#pragma unroll
      for (int i = 0; i < 8; ++i) s += v[i];
      const float mu = wave_sum(s, lane) * (1.0f / 512.0f);
      float qq = 0.f;
#pragma unroll
      for (int i = 0; i < 8; ++i) { const float d = v[i] - mu; qq += d * d; }
      const float rstd = rsqrtf(wave_sum(qq, lane) * (1.0f / 512.0f) + LN_EPS);
      u32x4 ow;
      ow[0] = pk2((v[0] - mu) * rstd * g0[0] + b0[0], (v[1] - mu) * rstd * g0[1] + b0[1]);
      ow[1] = pk2((v[2] - mu) * rstd * g0[2] + b0[2], (v[3] - mu) * rstd * g0[3] + b0[3]);
      ow[2] = pk2((v[4] - mu) * rstd * g1[0] + b1[0], (v[5] - mu) * rstd * g1[1] + b1[1]);
      ow[3] = pk2((v[6] - mu) * rstd * g1[2] + b1[2], (v[7] - mu) * rstd * g1[3] + b1[3]);
      *(u32x4*)(lds + (g * 2 + (q >> 6)) * SHM_KV + v_st(q & 63, cg)) = ow;
    }
  }
  __syncthreads();
  const int pg = wid & 3, ch = wid >> 2;
  const int vbase = (int)(uintptr_t)lds + v_rd_base(lane);
  for (int g = 0; g < 4; ++g) {
    const float* Wg = PIN(p, sgu_w) + ((size_t)(jl * 4 + g) * 128) * 128;
    bf16x8 af[8];
#pragma unroll
    for (int ks = 0; ks < 8; ++ks) {
      const float* wp = Wg + (size_t)(pg * 32 + r32) * 128 + ks * 16 + hi * 8;
      const f32x4 a = *(const f32x4*)wp, b = *(const f32x4*)(wp + 4);
      u32x4 w = {pk2(a[0], a[1]), pk2(a[2], a[3]), pk2(b[0], b[1]), pk2(b[2], b[3])};
      af[ks] = *reinterpret_cast<bf16x8*>(&w);
    }
    f32x16 acc[2] = {};
#pragma unroll
    for (int kt = 0; kt < 2; ++kt) {
      const int vb = vbase + (g * 2 + kt) * SHM_KV;
      if (ch == 0) { pv_one_t<0>(acc[0], vb, af[kt * 4 + 0], af[kt * 4 + 1], af[kt * 4 + 2], af[kt * 4 + 3]); pv_one_t<1>(acc[1], vb, af[kt * 4 + 0], af[kt * 4 + 1], af[kt * 4 + 2], af[kt * 4 + 3]); }
      else         { pv_one_t<2>(acc[0], vb, af[kt * 4 + 0], af[kt * 4 + 1], af[kt * 4 + 2], af[kt * 4 + 3]); pv_one_t<3>(acc[1], vb, af[kt * 4 + 0], af[kt * 4 + 1], af[kt * 4 + 2], af[kt * 4 + 3]); }
    }
    const int pp = pg * 32 + r32;
    const float bb = (PIN(p, sgu_b) + (size_t)(jl * 4 + g) * 128)[pp];
    const bf16_t* gup = GU + (size_t)(row0 + pp) * 512 + g * 128 + ch * 64 + 4 * hi;
    bf16_t* cap = CAT + (size_t)(row0 + pp) * 1536 + 1024 + g * 128 + ch * 64 + 4 * hi;
#pragma unroll
    for (int dd = 0; dd < 2; ++dd)
#pragma unroll
      for (int q = 0; q < 4; ++q) {
        const u32x2 uw = *(const u32x2*)(gup + dd * 32 + q * 8);
        const float s0 = acc[dd][4 * q] + bb, s1 = acc[dd][4 * q + 1] + bb, s2 = acc[dd][4 * q + 2] + bb, s3 = acc[dd][4 * q + 3] + bb;
        u32x2 ow = {pk2h(bflo(uw[0]) * s0, bfhi(uw[0]) * s1), pk2h(bflo(uw[1]) * s2, bfhi(uw[1]) * s3)};
        *(u32x2*)(cap + dd * 32 + q * 8) = ow;
      }
  }
  __syncthreads();
}

__device__ void phase_mixer_fast(const Params& p, int layer, char* shm, int tid_) {
  const int jl = layer >> 1;
  const bool ctxq = layer == 0;
  const float lam = ((const float*)(p.ws + OFF_LAM))[jl * 2 + 0];
  const float lam_init = ((const float*)(p.ws + OFF_LAM))[jl * 2 + 1];
  const float* ng = PIN(p, diff_norm_g) + (size_t)jl * 128;
  const bf16_t* Q = (const bf16_t*)(p.ws + OFF_Q);
  const bf16_t* K = (const bf16_t*)(p.ws + OFF_K);
  const bf16_t* V = (const bf16_t*)(p.ws + OFF_V);
  bf16_t* CAT = (bf16_t*)(p.ws + OFF_CAT);
  const int bid = lbid();
  const int NC = ctxq ? 32 : 0;
  const int NS = ctxq ? (NTOK / 128) : (NLAT / 128);
  for (int u = bid; u < 1024 + NC + NS; u += gridDim.x) {
    if (u < 1024 + NC) {
      int bh, pos0, seq, orow;
      if (u < 1024) {
        const int xcd = u & 7, ul = (u >> 8) * 32 + ((u & 255) >> 3), qb = ul & 63;
        bh = xcd * 2 + (ul >> 6);
        pos0 = CTXL + qb * 128; seq = LKV; orow = (bh >> 3) * SEQ + qb * 128;
      } else {
        const int v = u - 1024, qb = v & 1;
        bh = v >> 1;
        pos0 = qb * 128; seq = CTXL; orow = NLAT + (bh >> 3) * CTXL + qb * 128;
      }
      const size_t hb = (size_t)bh * LKV * 128;
      attn_unit(Q + hb + (size_t)pos0 * 128, K + hb, V + hb, seq, CAT + (size_t)orow * 1536 + (bh & 7) * 128, ng, lam, lam_init, (const unsigned*)(p.ws + OFF_BAR + 256) + jl * 32 + bh * 2, shm, tid_);
    } else {
      sgu_unit(p, u - 1024 - NC, jl, shm, tid_);
    }
  }
}

__device__ __forceinline__ void ld8h(const bf16_t* p, float (&v)[8]) {
  const u32x4 w = *(const u32x4*)p;
#pragma unroll
  for (int i = 0; i < 4; ++i) { v[2 * i] = hlo(w[i]); v[2 * i + 1] = hhi(w[i]); }
}
__device__ void phase_pool(const Params& p, int nrows, int tid_) {
  const bf16_t* M1 = (const bf16_t*)(p.ws + OFF_M1);
  bf16_t* M2 = (bf16_t*)(p.ws + OFF_M2);
  const int nitems = (nrows >> 5) * 128;
  for (int it = lbid() * 512 + tid_; it < nitems; it += gridDim.x * 512) {
    const int cg = it & 127, seg = it >> 7;
    const int row0 = seg * 32;
    int base, T;
    if (row0 < NLAT) { base = row0 & ~(SEQ - 1); T = SEQ; } else { base = NLAT + ((row0 - NLAT) & ~255); T = CTXL; }
    const int t0 = row0 - base;
    const int h = 1 << (cg >> 5);
    const bf16_t* colp = M1 + (size_t)base * 1024 + cg * 8;
    float S[8];
#pragma unroll
    for (int i = 0; i < 8; ++i) S[i] = 0.f;
    {
      const int lo = t0 - h < 0 ? 0 : t0 - h, hi = t0 + h > T ? T : t0 + h;
      for (int q = lo; q < hi; ++q) { float v[8]; ld8h(colp + (size_t)q * 1024, v);
#pragma unroll
        for (int i = 0; i < 8; ++i) S[i] += v[i]; }
    }
    for (int t = t0; t < t0 + 32; ++t) {
      const int lo = t - h < 0 ? 0 : t - h, hi = t + h > T ? T : t + h;
      const float inv = 1.0f / (float)(hi - lo);
      float x[8];
      ld8h(colp + (size_t)t * 1024, x);
      u32x4 w;
#pragma unroll
      for (int i = 0; i < 4; ++i) w[i] = pk2h(S[2 * i] * inv - x[2 * i], S[2 * i + 1] * inv - x[2 * i + 1]);
      *(u32x4*)(M2 + (size_t)(base + t) * 1024 + cg * 8) = w;
      if (t + h < T) { float v[8]; ld8h(colp + (size_t)(t + h) * 1024, v);
#pragma unroll
        for (int i = 0; i < 8; ++i) S[i] += v[i]; }
      if (t - h >= 0) { float v[8]; ld8h(colp + (size_t)(t - h) * 1024, v);
#pragma unroll
        for (int i = 0; i < 8; ++i) S[i] -= v[i]; }
    }
  }
}

__device__ __forceinline__ void fp8x16_to_f32(const u32x4 w, float (&f)[16]) {
#pragma unroll
  for (int q = 0; q < 4; ++q) {
    const f32x2v lo = __builtin_amdgcn_cvt_pk_f32_fp8((int)w[q], false), hi = __builtin_amdgcn_cvt_pk_f32_fp8((int)w[q], true);
    f[4 * q] = lo[0]; f[4 * q + 1] = lo[1]; f[4 * q + 2] = hi[0]; f[4 * q + 3] = hi[1];
  }
}
#define PEER_LOAD_IDS(dst, k) do { const int _t = wv + (k) * nwv; const i32x4* _ip = (const i32x4*)(IDX + ((size_t)g * NTOK + _t) * 16); \
    dst##0 = _ip[0]; dst##1 = _ip[1]; dst##2 = _ip[2]; dst##3 = _ip[3]; } while (0)
#define PEER_GATHER_H0(buf, TAB, id) do { \
    buf[0] = *(const u32x4*)(TAB + (size_t)id##0[0] * 128); buf[1] = *(const u32x4*)(TAB + (size_t)id##0[1] * 128); buf[2] = *(const u32x4*)(TAB + (size_t)id##0[2] * 128); buf[3] = *(const u32x4*)(TAB + (size_t)id##0[3] * 128); \
    buf[4] = *(const u32x4*)(TAB + (size_t)id##1[0] * 128); buf[5] = *(const u32x4*)(TAB + (size_t)id##1[1] * 128); buf[6] = *(const u32x4*)(TAB + (size_t)id##1[2] * 128); buf[7] = *(const u32x4*)(TAB + (size_t)id##1[3] * 128); } while (0)
#define PEER_GATHER_H1(buf, TAB, id) do { \
    buf[0] = *(const u32x4*)(TAB + (size_t)id##2[0] * 128); buf[1] = *(const u32x4*)(TAB + (size_t)id##2[1] * 128); buf[2] = *(const u32x4*)(TAB + (size_t)id##2[2] * 128); buf[3] = *(const u32x4*)(TAB + (size_t)id##2[3] * 128); \
    buf[4] = *(const u32x4*)(TAB + (size_t)id##3[0] * 128); buf[5] = *(const u32x4*)(TAB + (size_t)id##3[1] * 128); buf[6] = *(const u32x4*)(TAB + (size_t)id##3[2] * 128); buf[7] = *(const u32x4*)(TAB + (size_t)id##3[3] * 128); } while (0)

constexpr int PU_WLDS = 16384 + 1024;
__device__ void phase_peer_u(const Params& p, int layer, int nrows, char* shm, int tid_) {
  const int tid = tid_, wid = __builtin_amdgcn_readfirstlane(tid >> 6), lane = tid & 63, bid = lbid();
  const int s = bid & 7, wv = (bid >> 3) * 8 + wid, nwv = (gridDim.x >> 3) * 8;
  const int g = lane >> 3, c = lane & 7;
  const int m16 = lane & 15, kg = lane >> 4;
  const unsigned char* U = (const unsigned char*)(p.ws + OFF_U8) + (size_t)(layer * 8 + s) * NEXP * 128 + c * 16;
  const int* IDX = (const int*)(p.ws + OFF_IDX);
  float* PART = (float*)(p.ws + OFF_PART);
  const int e8 = (kg & 1) * 8;
  const unsigned char* HPa = (const unsigned char*)(p.ws + OFF_H8) + (size_t)(m16 & 1) * NTOK * DM + s * 128 + 32 * kg + e8;
  const unsigned char* HPb = HPa + 8 - 2 * e8;
  const int n = wv < nrows ? (nrows - wv + nwv - 1) / nwv : 0;
  if (n == 0) return;
  char* wl = shm + wid * PU_WLDS;
  const int wa0 = g * 128 + ((c ^ (g >> 1)) << 4), wa1 = (8 + g) * 128 + ((c ^ (4 + (g >> 1))) << 4);
  int ra[4];
#pragma unroll
  for (int j = 0; j < 4; ++j) ra[j] = m16 * 128 + (((2 * kg + (j >> 1)) ^ (m16 >> 1)) << 4) + (((j ^ kg) & 1) << 3);
  i32x4 idc0, idc1, idc2, idc3, idn0, idn1, idn2, idn3;
  u32x4 bufA[8], bufB[8];
  long hc[4], hn[4];
#define PU_HLOAD(h, k) do { const size_t _o = (size_t)(wv + (k) * nwv) * DM; h[0] = *(const long*)(HPa + _o); h[2] = *(const long*)(HPa + _o + 16); \
    h[1] = *(const long*)(HPb + _o); h[3] = *(const long*)(HPb + _o + 16); } while (0)
#define PU_HALF(buf, hb, ab) do { \
    _Pragma("unroll") for (int i = 0; i < 8; ++i) *(u32x4*)(wl + (hb) + (i >> 1) * 2048 + ((i & 1) ? wa1 : wa0)) = buf[i]; \
    asm volatile("" ::: "memory"); \
    _Pragma("unroll") for (int j = 0; j < 4; ++j) { \
      _Pragma("unroll") for (int q = 0; q < 4; ++q) { \
        const long a = *(const long*)(wl + (hb) + q * 2048 + ra[j]); \
        acc[(ab) + q] = __builtin_amdgcn_mfma_f32_16x16x32_fp8_fp8(a, hc[j], acc[(ab) + q], 0, 0, 0); } } } while (0)
  PEER_LOAD_IDS(idc, 0);
  PEER_GATHER_H0(bufA, U, idc); PU_HLOAD(hc, 0);
  if (n > 1) PEER_LOAD_IDS(idn, 1);
  for (int k = 0; k < n; ++k) {
    PEER_GATHER_H1(bufB, U, idc);
    __builtin_amdgcn_sched_barrier(0);
    f32x4 acc[8];
#pragma unroll
    for (int q = 0; q < 8; ++q) acc[q] = (f32x4){0.f, 0.f, 0.f, 0.f};
    PU_HALF(bufA, 0, 0);
    __builtin_amdgcn_sched_barrier(0);
    if (k + 1 < n) { PEER_GATHER_H0(bufA, U, idn); PU_HLOAD(hn, k + 1); }
    idc0 = idn0; idc1 = idn1; idc2 = idn2; idc3 = idn3;
    if (k + 2 < n) PEER_LOAD_IDS(idn, k + 2);
    __builtin_amdgcn_sched_barrier(0);
    PU_HALF(bufB, 8192, 4);
    if (m16 < 2) {
#pragma unroll
      for (int q = 0; q < 8; ++q) *(f32x4*)(wl + 16384 + m16 * 512 + (q * 16 + 4 * kg) * 4) = acc[q];
    }
    asm volatile("" ::: "memory");
    const f32x2v o0 = *(const f32x2v*)(wl + 16384 + lane * 8), o1 = *(const f32x2v*)(wl + 16384 + 512 + lane * 8);
    *(f32x2v*)(PART + ((size_t)(wv + k * nwv) * 8 + s) * 128 + lane * 2) = o0 + o1;
#pragma unroll
    for (int j = 0; j < 4; ++j) hc[j] = hn[j];
    __builtin_amdgcn_sched_barrier(0);
  }
#undef PU_HLOAD
#undef PU_HALF
}
__device__ void phase_peer_w(const Params& p, int nrows, int tid_) {
  const int wid = __builtin_amdgcn_readfirstlane(tid_ >> 6), lane = tid_ & 63;
  const float* PART = (const float*)(p.ws + OFF_PART);
  const float* GATE = (const float*)(p.ws + OFF_GATE);
  float* W = (float*)(p.ws + OFF_PW);
  for (int t = lbid() * 8 + wid; t < nrows; t += gridDim.x * 8) {
    f32x2v acc2 = {0.f, 0.f};
#pragma unroll
    for (int q = 0; q < 8; ++q) acc2 += *(const f32x2v*)(PART + ((size_t)t * 8 + q) * 128 + lane * 2);
    const int G = lane >> 3, m0 = 2 * (lane & 7), g0 = m0 & 7, ii = 2 * G + (m0 >> 3);
    const float gt0 = GATE[((size_t)g0 * NTOK + t) * 16 + ii], gt1 = GATE[((size_t)(g0 + 1) * NTOK + t) * 16 + ii];
    W[(size_t)t * 128 + g0 * 16 + ii] = gt0 * gelu_tanh(acc2[0] * (1.0f / 256.0f));
    W[(size_t)t * 128 + (g0 + 1) * 16 + ii] = gt1 * gelu_tanh(acc2[1] * (1.0f / 256.0f));
  }
}
__device__ void phase_peer_v(const Params& p, int layer, const hstream_t* XSin, hstream_t* Zout, int nrows, int tid_) {
  const int tid = tid_, wid = __builtin_amdgcn_readfirstlane(tid >> 6), lane = tid & 63, bid = lbid();
  const int s = bid & 7, wv = (bid >> 3) * 8 + wid, nwv = (gridDim.x >> 3) * 8;
  const int g = lane >> 3, c = lane & 7;
  const bool b5 = (lane & 32) != 0, b4 = (lane & 16) != 0, b3 = (lane & 8) != 0;
  const unsigned char* Vt = (const unsigned char*)(p.ws + OFF_V8) + (size_t)(layer * 8 + s) * NEXP * 128 + c * 16;
  const int* IDX = (const int*)(p.ws + OFF_IDX);
  const float* W = (const float*)(p.ws + OFF_PW);
  const int col = s * 128 + c * 16 + g * 2;
  const int n = wv < nrows ? (nrows - wv + nwv - 1) / nwv : 0;
  if (n == 0) return;
  i32x4 idc0, idc1, idc2, idc3, idn0, idn1, idn2, idn3;
  u32x4 bufA[8], bufB[8];
  f32x2v wc2, wn2, xc2, xn2;
#define PV_MLOAD(w2, x2, k) do { const int _t = wv + (k) * nwv; w2 = *(const f32x2v*)(W + (size_t)_t * 128 + lane * 2); { const unsigned _xw = *(const unsigned*)(XSin + (size_t)_t * DM + col); x2 = (f32x2v){hlo(_xw), hhi(_xw)}; } } while (0)
#define PV_HALF(buf, base) do { \
    _Pragma("unroll") for (int i = 0; i < 8; ++i) { \
      const float w = shl_f((i & 1) ? wc2[1] : wc2[0], (lane & 56) + (((base) + i) >> 1)); \
      float f[16]; fp8x16_to_f32(buf[i], f); \
      _Pragma("unroll") for (int j = 0; j < 16; ++j) o[j] = fmaf(w, f[j], o[j]); } } while (0)
  PEER_LOAD_IDS(idc, 0);
  PEER_GATHER_H0(bufA, Vt, idc); PV_MLOAD(wc2, xc2, 0);
  if (n > 1) PEER_LOAD_IDS(idn, 1);
  for (int k = 0; k < n; ++k) {
    PEER_GATHER_H1(bufB, Vt, idc);
    __builtin_amdgcn_sched_barrier(0);
    float o[16];
#pragma unroll
    for (int j = 0; j < 16; ++j) o[j] = 0.f;
    PV_HALF(bufA, 0);
    __builtin_amdgcn_sched_barrier(0);
    if (k + 1 < n) { PEER_GATHER_H0(bufA, Vt, idn); PV_MLOAD(wn2, xn2, k + 1); }
    idc0 = idn0; idc1 = idn1; idc2 = idn2; idc3 = idn3;
    if (k + 2 < n) PEER_LOAD_IDS(idn, k + 2);
    __builtin_amdgcn_sched_barrier(0);
    PV_HALF(bufB, 8);
    float r8[8], r4[4], r2[2];
#pragma unroll
    for (int i = 0; i < 8; ++i) { const float keep = b5 ? o[8 + i] : o[i], send = b5 ? o[i] : o[8 + i]; r8[i] = keep + shx_f(send, 32, lane); }
#pragma unroll
    for (int i = 0; i < 4; ++i) { const float keep = b4 ? r8[4 + i] : r8[i], send = b4 ? r8[i] : r8[4 + i]; r4[i] = keep + shx_f(send, 16, lane); }
#pragma unroll
    for (int i = 0; i < 2; ++i) { const float keep = b3 ? r4[2 + i] : r4[i], send = b3 ? r4[i] : r4[2 + i]; r2[i] = keep + shx_f(send, 8, lane); }
    const int t = wv + k * nwv;
    const f32x2v g2 = *(const f32x2v*)(mod_ptr(p, layer, who_of_row(t), 5) + col);
    *(unsigned*)(Zout + (size_t)t * DM + col) = pk2h(ALPHA * xc2[0] + g2[0] * r2[0] * 0.125f, ALPHA * xc2[1] + g2[1] * r2[1] * 0.125f);
    wc2 = wn2; xc2 = xn2;
    __builtin_amdgcn_sched_barrier(0);
  }
#undef PV_MLOAD
#undef PV_HALF
}

constexpr int NSTEP = 9;
constexpr int NPHASE = 2 + NSTEP * DEPTH;

__device__ void run_phase(const Params& pin, int ph, char* shm, int tid_) {
  Params p = pin;
  { unsigned zoff = 0; asm volatile("" : "+s"(zoff));
    p.ws = pin.ws + zoff; }
  if (ph == 0) { phase_prologue_a(p, shm, tid_); return; }
  if (ph == 1) { phase_prologue_b(p, tid_); return; }
  const int layer = (ph - 2) / NSTEP, step = (ph - 2) % NSTEP;
  const bool even = (layer & 1) == 0;
  const int jl = layer >> 1;
  const bool ctx_out = layer < 2;
  const int nrows = ctx_out ? NTOK : NLAT;
  const int mt_upd = nrows / 256;
  hstream_t* XSA = (hstream_t*)(p.ws + OFF_XSA);
  hstream_t* XSB = (hstream_t*)(p.ws + OFF_XSB);
  hstream_t* Z = (hstream_t*)(p.ws + OFF_Z);
  const bf16_t* H = (const bf16_t*)(p.ws + OFF_H);
  const float* modl = (const float*)(p.ws + OFF_MOD) + (size_t)layer * 3 * 6144;
  if (step == 0) {
    if (even) {
      EpiInProj e{(bf16_t*)(p.ws + OFF_Q), (bf16_t*)(p.ws + OFF_K), (bf16_t*)(p.ws + OFF_V), (bf16_t*)(p.ws + OFF_GU), (bf16_t*)(p.ws + OFF_GV),
                  (const float*)(p.ws + OFF_ROPE), (unsigned*)(p.ws + OFF_BAR + 256) + jl * 32};
      const int mt = (layer <= 2) ? NTOK / 256 : NLAT / 256;
      gemm_phase<true>(H, (const bf16_t*)(p.ws + OFF_WIN) + (size_t)jl * 4096 * 1024, NLAT / 256, (mt * 256) - NLAT, 16, 1024, e, shm, tid_);
    } else {
      EpiBf16Store e{(bf16_t*)(p.ws + OFF_M1), 1024};
      gemm_phase<true>(H, (const bf16_t*)(p.ws + OFF_PIN) + (size_t)jl * 1024 * 1024, NLAT / 256, nrows - NLAT, 4, 1024, e, shm, tid_);
    }
  } else if (step == 1) {
    if (even) phase_mixer_fast(p, layer, shm, tid_);
    else phase_pool(p, nrows, tid_);
  } else if (step == 2) {
    EpiResid e{XSA, Z, modl, 2};
    if (even) gemm_phase<true>((const bf16_t*)(p.ws + OFF_CAT), (const bf16_t*)(p.ws + OFF_WOUT) + (size_t)jl * 1024 * 1536, NLAT / 256, nrows - NLAT, 4, 1536, e, shm, tid_);
    else gemm_phase<true>((const bf16_t*)(p.ws + OFF_M2), (const bf16_t*)(p.ws + OFF_POUT) + (size_t)jl * 1024 * 1024, NLAT / 256, nrows - NLAT, 4, 1024, e, shm, tid_);
  } else if (step == 3) {
    phase_ln(p, Z, XSB, layer, 0, nrows, (bf16_t*)(p.ws + OFF_HB), layer, 3, nrows, false, tid_);
  } else if (step == 4) {
    EpiTopK e{(int*)(p.ws + OFF_IDX), (float*)(p.ws + OFF_GATE)};
    gemm_phase<true>((const bf16_t*)(p.ws + OFF_HB), (const bf16_t*)(p.ws + OFF_WQK) + (size_t)layer * 2048 * 1024, NLAT / 256, nrows - NLAT, 8, 1024, e, shm, tid_);
  } else if (step == 5) {
    phase_peer_u(p, layer, nrows, shm, tid_);
  } else if (step == 6) {
    phase_peer_w(p, nrows, tid_);
  } else if (step == 7) {
    phase_peer_v(p, layer, XSB, Z, nrows, tid_);
  } else {
    const int nl = layer + 1;
    const int nrows_next = (nl <= 2) ? NTOK : NLAT;
    phase_ln(p, Z, XSA, layer, 1, nrows, (bf16_t*)(p.ws + OFF_H), nl, 0, nrows_next < nrows ? nrows_next : nrows, layer == DEPTH - 1, tid_);
  }
}

#define XB_XCNT(j) (64 * (j))
#define XB_XSUB(j) (512 + 64 * (j))
#define XB_XGEN(j) (1024 + 64 * (j))
#define XB_TOP 1536
#define XB_TOPGEN 1600
#define XB_WORDS 1664
__device__ __forceinline__ unsigned xb_ld(unsigned* p) { return __hip_atomic_load(p, __ATOMIC_RELAXED, __HIP_MEMORY_SCOPE_AGENT); }
__device__ __forceinline__ unsigned xb_add(unsigned* p, unsigned v) { return __hip_atomic_fetch_add(p, v, __ATOMIC_RELAXED, __HIP_MEMORY_SCOPE_AGENT); }
__device__ __forceinline__ void grid_barrier(unsigned* bar, int xcc, unsigned nloc, unsigned nx, int tid_) {
  asm volatile("s_waitcnt vmcnt(0) lgkmcnt(0)" ::: "memory");
  __syncthreads();
  if (tid_ == 0) {
    const unsigned old = xb_add(&bar[XB_XSUB(xcc)], 1u);
    const unsigned gen = old / nloc;
    if (old + 1u == (gen + 1u) * nloc) {
      __builtin_amdgcn_fence(__ATOMIC_RELEASE, "agent");
      asm volatile("s_waitcnt vmcnt(0)" ::: "memory");
      const unsigned og = xb_add(&bar[XB_TOP], 1u);
      const unsigned tg = og / nx;
      if (og + 1u == (tg + 1u) * nx) xb_add(&bar[XB_TOPGEN], 1u);
      else while (xb_ld(&bar[XB_TOPGEN]) == tg) __builtin_amdgcn_s_sleep(1);
      __builtin_amdgcn_fence(__ATOMIC_ACQUIRE, "agent");
      xb_add(&bar[XB_XGEN(xcc)], 1u);
      asm volatile("s_waitcnt vmcnt(0)" ::: "memory");
    } else {
      while (xb_ld(&bar[XB_XGEN(xcc)]) == gen) __builtin_amdgcn_s_sleep(1);
      __builtin_amdgcn_fence(__ATOMIC_ACQUIRE, "agent");
      asm volatile("s_waitcnt vmcnt(0)" ::: "memory");
    }
  }
  __syncthreads();
}

__device__ __forceinline__ int phase_cat(int ph) {
  if (ph < 2) return 0;
  const int layer = (ph - 2) / NSTEP, step = (ph - 2) % NSTEP;
  const bool even = (layer & 1) == 0;
  if (step == 0) return even ? 1 : 7;
  if (step == 1) return even ? 2 : 8;
  if (step == 2) return 3;
  if (step == 3) return 4;
  if (step == 4) return 5;
  if (step == 5) return 6;
  if (step == 6) return 12;
  if (step == 7) return 10;
  return 11;
}

__global__ void __launch_bounds__(512) mega(KArgs ka, int ph_lo, int ph_hi) {
  Params p;
  p.in = (const float* const*)__builtin_amdgcn_kernarg_segment_ptr();
  p.out = ka.out; p.ws = ka.ws;
  __shared__ __attribute__((aligned(1024))) char shm[LDS_BYTES];
  cg::grid_group grid = cg::this_grid();
  unsigned* bar = (unsigned*)(p.ws + OFF_BAR + 512);
  int rep = 0;
  const int swid = __builtin_amdgcn_readfirstlane((int)(threadIdx.x >> 6));
  const int my_xcc = (int)(__builtin_amdgcn_s_getreg((3 << 11) | 20) & 0x7);
  if (threadIdx.x == 0) xb_add(&bar[XB_XCNT(my_xcc)], 1u);
  unsigned nloc = 1, nx = 1;
  for (int ph = ph_lo; ph < ph_hi;) {
    run_phase(p, ph, shm, make_tid(swid));
    bool again = false;
#ifdef DUP_CAT
    if (phase_cat(ph) == DUP_CAT && rep == 0) again = true;
#endif
    if (again || ph + 1 < ph_hi) {
      if (ph == ph_lo && !again && rep == 0) {
        grid.sync();
        unsigned cnt = 0, mine = 0;
#pragma unroll
        for (int j = 0; j < 8; ++j) { const unsigned c = xb_ld(&bar[XB_XCNT(j)]); cnt += c > 0u ? 1u : 0u; mine = j == my_xcc ? c : mine; }
        nloc = __builtin_amdgcn_readfirstlane(mine > 0u ? mine : 1u); nx = __builtin_amdgcn_readfirstlane(cnt > 0u ? cnt : 1u);
      } else grid_barrier(bar, my_xcc, nloc, nx, make_tid(swid));
    }
    if (again) rep = 1; else { rep = 0; ++ph; }
  }
}

extern "C" void kernel_launch(void* const* d_in, const int* in_sizes, int n_in, void* d_out, int out_size, void* d_ws, size_t ws_size,
                              hipStream_t stream) {
  static int grid_blocks = 0;
  if (!grid_blocks) {
    int dev = 0, cus = 0, per_cu = 0;
    (void)hipGetDevice(&dev);
    (void)hipDeviceGetAttribute(&cus, hipDeviceAttributeMultiprocessorCount, dev);
    (void)hipOccupancyMaxActiveBlocksPerMultiprocessor(&per_cu, mega, 512, 0);
    if (per_cu > 1) per_cu = 1;
    grid_blocks = cus * per_cu;
    if (ws_size < WS_END) fprintf(stderr, "kernel_launch: workspace too small: %zu < %zu\n", ws_size, (size_t)WS_END);
    if (grid_blocks <= 0) fprintf(stderr, "kernel_launch: occupancy query returned 0\n");
  }
  KArgs p{};
  for (int i = 0; i < 24; ++i) p.in[i] = (const float*)d_in[i];
  p.out = (float*)d_out;
  p.ws = (char*)d_ws;
  (void)hipMemsetAsync((char*)d_ws + OFF_BAR, 0, 512 + 8192, stream);
  int lo = 0, hi = NPHASE;
  void* args[] = {&p, &lo, &hi};
  hipError_t e = hipLaunchCooperativeKernel((void*)mega, dim3(grid_blocks), dim3(512), args, 0, stream);
  if (e != hipSuccess) fprintf(stderr, "cooperative launch failed: %s (grid %d)\n", hipGetErrorString(e), grid_blocks);
}
```

```cpp
#include <hip/hip_runtime.h>
#include <hip/hip_cooperative_groups.h>
#include <cstdio>
#include <cstdint>
namespace cg = cooperative_groups;

typedef unsigned short bf16_t;
typedef short bf16x8 __attribute__((ext_vector_type(8)));
typedef float f32x4 __attribute__((ext_vector_type(4)));
typedef unsigned u32x4 __attribute__((ext_vector_type(4)));
typedef unsigned u32x2 __attribute__((ext_vector_type(2)));
typedef float f32x2v __attribute__((ext_vector_type(2)));
typedef __bf16 bf16x2_t __attribute__((ext_vector_type(2)));

constexpr int DM = 1024, NBATCH = 2, SEQ = 8192, CTXL = 256, DEPTH = 4;
constexpr int NLAT = NBATCH * SEQ;
constexpr int NCTX = NBATCH * CTXL;
constexpr int NTOK = NLAT + NCTX;
constexpr int LKV = CTXL + SEQ;
constexpr int NH = 8;
constexpr int NEXP = 16384;
constexpr float LN_EPS = 1e-5f;
constexpr float ALPHA = 1.6817928305074290f;
constexpr float QSCALE = 0.125f * 1.4426950408889634f;

constexpr size_t al256(size_t x) { return (x + 255) / 256 * 256; }
constexpr size_t SZ_TAB = (size_t)DEPTH * NEXP * DM;
constexpr size_t SZ_QKV = (size_t)NBATCH * NH * LKV * 128 * 2;
constexpr size_t SZ_XS = (size_t)NTOK * DM * 4;
constexpr size_t OFF_U8 = 0;
constexpr size_t OFF_V8 = OFF_U8 + SZ_TAB;
constexpr size_t OFF_Q = OFF_V8 + SZ_TAB;
constexpr size_t OFF_K = OFF_Q + SZ_QKV;
constexpr size_t OFF_V = OFF_K + SZ_QKV;
constexpr size_t OFF_XSA = OFF_V + SZ_QKV;
constexpr size_t OFF_XSB = OFF_XSA + SZ_XS;
constexpr size_t OFF_Z = OFF_XSB + SZ_XS;
constexpr size_t OFF_H = OFF_Z + SZ_XS;
constexpr size_t OFF_HB = OFF_H + (size_t)NTOK * DM * 2;
constexpr size_t OFF_CAT = OFF_HB + (size_t)NTOK * DM * 2;
constexpr size_t OFF_GU = OFF_CAT + (size_t)NTOK * 1536 * 2;
constexpr size_t OFF_GV = OFF_GU + (size_t)NTOK * 512 * 2;
constexpr size_t OFF_M1 = OFF_GV + (size_t)NTOK * 512 * 2;
constexpr size_t OFF_M2 = OFF_M1 + (size_t)NTOK * DM * 2;
constexpr size_t OFF_SC = OFF_M2 + (size_t)NTOK * DM * 2;
constexpr size_t OFF_IDX = OFF_SC;
constexpr size_t OFF_GATE = OFF_IDX + (size_t)NTOK * 128 * 4;
constexpr size_t OFF_WIN = OFF_GATE + (size_t)NTOK * 128 * 4;
constexpr size_t OFF_WOUT = OFF_WIN + (size_t)2 * 4096 * 1024 * 2;
constexpr size_t OFF_PIN = OFF_WOUT + (size_t)2 * 1024 * 1536 * 2;
constexpr size_t OFF_POUT = OFF_PIN + (size_t)2 * 1024 * 1024 * 2;
constexpr size_t OFF_WQK = OFF_POUT + (size_t)2 * 1024 * 1024 * 2;
constexpr size_t OFF_MOD = OFF_WQK + (size_t)4 * 2048 * 1024 * 2;
constexpr size_t OFF_MODP = OFF_MOD + al256((size_t)4 * 3 * 6144 * 4);
constexpr size_t OFF_ROPE = OFF_MODP + al256((size_t)2 * 4 * 3 * 6144 * 4);
constexpr size_t OFF_LAM = OFF_ROPE + al256((size_t)128 * 16 * 2 * 4);
constexpr size_t OFF_PART = OFF_LAM + 256;
constexpr size_t OFF_PW = OFF_PART + (size_t)NTOK * 8 * 128 * 4;
constexpr size_t OFF_BAR = OFF_PW + (size_t)NTOK * 128 * 4;
constexpr size_t WS_END = OFF_BAR + 512 + 8192;

struct KArgs {
  const float* in[24];
  float* out;
  char* ws;
};
struct Params {
  const float* const* in;
  float* out;
  char* ws;
};
enum { IN_x, IN_c, IN_ctx, IN_c_ctx, IN_ada_w, IN_ada_b, IN_ln_g, IN_ln_b, IN_ab_w_in, IN_ab_w_out, IN_diff_lam, IN_diff_norm_g, IN_sgu_ln_g, IN_sgu_ln_b,
       IN_sgu_w, IN_sgu_b, IN_pool_w_in, IN_pool_w_grp, IN_pool_scale, IN_pool_w_out, IN_peer_wq, IN_peer_keys, IN_peer_u, IN_peer_v };
#define AS_GLOBAL(T, ptr) ((T)(__attribute__((address_space(1))) char*)(char*)(ptr))
#define PIN(p, name) AS_GLOBAL(const float*, (p).in[IN_##name])

constexpr int LDS_BYTES = 144 * 1024;

__device__ __forceinline__ int make_tid(int swid) {
  int t;
  asm volatile("v_mbcnt_lo_u32_b32 %0, -1, 0\n\tv_mbcnt_hi_u32_b32 %0, -1, %0" : "=v"(t));
  return (swid << 6) | t;
}
__device__ __forceinline__ int lbid() { int b = blockIdx.x; asm volatile("" : "+s"(b)); return b; }
__device__ __forceinline__ bf16_t f2bf(float f) {
  unsigned u = __float_as_uint(f);
  u += 0x7fffu + ((u >> 16) & 1u);
  return (bf16_t)(u >> 16);
}
__device__ __forceinline__ float bf2f(bf16_t b) { return __uint_as_float(((unsigned)b) << 16); }
__device__ __forceinline__ unsigned pk2(float lo, float hi) { return (unsigned)f2bf(lo) | ((unsigned)f2bf(hi) << 16); }
typedef _Float16 f16x8 __attribute__((ext_vector_type(8)));
typedef _Float16 f16x2 __attribute__((ext_vector_type(2)));
__device__ __forceinline__ unsigned pk2h(float lo, float hi) { const f16x2 v = {(_Float16)lo, (_Float16)hi}; return __builtin_bit_cast(unsigned, v); }
__device__ __forceinline__ float hlo(unsigned w) { return (float)__builtin_bit_cast(f16x2, w)[0]; }
__device__ __forceinline__ float hhi(unsigned w) { return (float)__builtin_bit_cast(f16x2, w)[1]; }
typedef _Float16 hstream_t;
__device__ __forceinline__ f32x4 ld4h(const hstream_t* p) { const u32x2 w = *(const u32x2*)p; return (f32x4){hlo(w[0]), hhi(w[0]), hlo(w[1]), hhi(w[1])}; }
__device__ __forceinline__ void st4h(hstream_t* p, f32x4 v) { *(u32x2*)p = (u32x2){pk2h(v[0], v[1]), pk2h(v[2], v[3])}; }
__device__ __forceinline__ bf16_t f2h(float f) { return __builtin_bit_cast(unsigned short, (_Float16)f); }
__device__ __forceinline__ float h2f(bf16_t b) { return (float)__builtin_bit_cast(_Float16, b); }
__device__ __forceinline__ float bflo(unsigned w) { return __uint_as_float(w << 16); }
__device__ __forceinline__ float bfhi(unsigned w) { return __uint_as_float(w & 0xffff0000u); }
__device__ __forceinline__ float gelu_tanh(float x) {
  const float u = 0.7978845608028654f * (x + 0.044715f * x * x * x);
  return x / (1.0f + __expf(-2.0f * u));
}
__device__ __forceinline__ float dot2bf(unsigned a, unsigned b, float c) {
  return __builtin_amdgcn_fdot2_f32_bf16(__builtin_bit_cast(bf16x2_t, a), __builtin_bit_cast(bf16x2_t, b), c, false);
}
__device__ __forceinline__ float shx_f(float v, int mask, int lane) { return __int_as_float(__builtin_amdgcn_ds_bpermute((lane ^ mask) << 2, __float_as_int(v))); }
__device__ __forceinline__ int shx_i(int v, int mask, int lane) { return __builtin_amdgcn_ds_bpermute((lane ^ mask) << 2, v); }
__device__ __forceinline__ float shl_f(float v, int src) { return __int_as_float(__builtin_amdgcn_ds_bpermute(src << 2, __float_as_int(v))); }
__device__ __forceinline__ float wave_sum(float v, int  ) {
#define DPP_ADD(ctrl, rmask) v += __int_as_float(__builtin_amdgcn_update_dpp(0, __float_as_int(v), ctrl, rmask, 0xf, false))
  DPP_ADD(0xB1, 0xf);
  DPP_ADD(0x4E, 0xf);
  DPP_ADD(0x141, 0xf);
  DPP_ADD(0x140, 0xf);
  DPP_ADD(0x142, 0xa);
  DPP_ADD(0x143, 0xc);
#undef DPP_ADD
  return __int_as_float(__builtin_amdgcn_readlane(__float_as_int(v), 63));
}
__device__ __forceinline__ int who_of_row(int row) { return row < NLAT ? (row >= SEQ ? 1 : 0) : 2; }
__device__ __forceinline__ const float* mod_ptr(const Params& p, int layer, int who, int which) {
  return (const float*)(p.ws + OFF_MOD) + ((size_t)(layer * 3 + who) * 6 + which) * 1024;
}
__device__ __forceinline__ void row_bpos(int row, int& b, int& pos) {
  if (row < NLAT) { b = row >> 13; pos = CTXL + (row & (SEQ - 1)); }
  else { const int r = row - NLAT; b = r >> 8; pos = r & 255; }
}

__device__ __forceinline__ int lds_byte2(int r, int c) {
  int st = (r >> 4) * 2 + (c >> 5), ob = (r & 15) * 64 + (c & 31) * 2;
  return st * 1024 + (ob ^ (((ob >> 9) & 1) << 5));
}
__device__ __forceinline__ void stage_rc2(int b, int& R, int& C) {
  int st = b >> 10, sb = b & 1023, swz = sb ^ (((sb >> 9) & 1) << 5);
  R = (st / 2) * 16 + swz / 64;
  C = (st % 2) * 32 + (swz % 64) / 2;
}
#define WAIT_V0() asm volatile("s_waitcnt vmcnt(0)" ::: "memory")

template <bool F16, int MFR, class Epi>
__device__ __forceinline__ void gemm_tile(const bf16_t* __restrict__ Arow0, const bf16_t* __restrict__ Bcol0, int row0, int pn, int K,
                                          const Epi& epi, char* shm, int tid_) {
  constexpr int BK = 32, TILE_B = 256 * BK * 2, STAGE_B = 2 * TILE_B;
  constexpr int LPS = MFR == 8 ? 4 : 3;
  const int tid = tid_, wid = __builtin_amdgcn_readfirstlane(tid >> 6), lane = tid & 63, wr = wid >> 2, wc = wid & 3, fr = lane & 15, fq = lane >> 4;
  const int sb_ = lane * 16, swz_ = sb_ ^ (((sb_ >> 9) & 1) << 5);
  const int C0 = (swz_ % 64) / 2;
  const int R0b = wid * 16 + swz_ / 64;
  const int R0a = (MFR == 8 ? wid : (wid & 3)) * 16 + swz_ / 64;
  const char* Ab = (const char*)Arow0 + (unsigned)(R0a * K + C0) * 2u;
  const char* Bb = (const char*)Bcol0 + (unsigned)(R0b * K + C0) * 2u;
  const int ob_ = fr * 64 + fq * 16, frag_swz = ob_ ^ (((ob_ >> 9) & 1) << 5);
  const int a_base = wr * (MFR * 1024) + frag_swz, b_base = wc * 4096 + frag_swz;
  const int nt = K / BK;
  f32x4 acc[MFR][4];
#pragma unroll
  for (int m = 0; m < MFR; ++m)
#pragma unroll
    for (int n = 0; n < 4; ++n) acc[m][n] = (f32x4){0.f, 0.f, 0.f, 0.f};
  typename Epi::template Pre<MFR> pre;
  epi.template preload<MFR>(pre, row0, pn, wr, wc, fr, fq);
#define GLDS_STAGE(buf, kt)                                                                                                               \
  do {                                                                                                                                    \
    if (MFR == 8) {                                                                                                                       \
      _Pragma("unroll") for (int i = 0; i < 2; ++i)                                                                                       \
        __builtin_amdgcn_global_load_lds((const unsigned*)(Ab + (size_t)(i * 128) * K * 2 + (kt) * (BK * 2)),                           \
                                         (unsigned*)(shm + (buf) * STAGE_B + wid * 1024 + i * 8192), 16, 0, 0);                           \
    } else {                                                                                                                              \
      __builtin_amdgcn_global_load_lds((const unsigned*)(Ab + (kt) * (BK * 2)), (unsigned*)(shm + (buf) * STAGE_B + (wid & 3) * 1024), 16, 0, 0); \
    }                                                                                                                                     \
    _Pragma("unroll") for (int i = 0; i < 2; ++i)                                                                                         \
      __builtin_amdgcn_global_load_lds((const unsigned*)(Bb + (size_t)(i * 128) * K * 2 + (kt) * (BK * 2)),                             \
                                       (unsigned*)(shm + (buf) * STAGE_B + TILE_B + wid * 1024 + i * 8192), 16, 0, 0);                    \
  } while (0)
#define RAW_BARRIER() do { asm volatile("s_waitcnt lgkmcnt(0)" ::: "memory"); __builtin_amdgcn_s_barrier(); } while (0)
#define WAIT_2STAGES() do { if (LPS == 4) asm volatile("s_waitcnt vmcnt(8)" ::: "memory"); else asm volatile("s_waitcnt vmcnt(6)" ::: "memory"); } while (0)
#define WAIT_1STAGE() do { if (LPS == 4) asm volatile("s_waitcnt vmcnt(4)" ::: "memory"); else asm volatile("s_waitcnt vmcnt(3)" ::: "memory"); } while (0)
  GLDS_STAGE(0, 0); GLDS_STAGE(1, 1); GLDS_STAGE(2, 2);
  WAIT_2STAGES();
  RAW_BARRIER();
  for (int t = 0; t < nt; ++t) {
    if (t + 3 < nt) GLDS_STAGE((t + 3) & 3, t + 3);
    const char* sa = shm + (t & 3) * STAGE_B;
    const char* sb = sa + TILE_B;
    {
      bf16x8 At[MFR], Bf[4];
#pragma unroll
      for (int m = 0; m < MFR; ++m) At[m] = *(const bf16x8*)(sa + a_base + m * 1024);
#pragma unroll
      for (int n = 0; n < 4; ++n) Bf[n] = *(const bf16x8*)(sb + b_base + n * 1024);
#pragma unroll
      for (int m = 0; m < MFR; ++m)
#pragma unroll
        for (int n = 0; n < 4; ++n) {
          if (F16) acc[m][n] = __builtin_amdgcn_mfma_f32_16x16x32_f16(__builtin_bit_cast(f16x8, Bf[n]), __builtin_bit_cast(f16x8, At[m]), acc[m][n], 0, 0, 0);
          else acc[m][n] = __builtin_amdgcn_mfma_f32_16x16x32_bf16(Bf[n], At[m], acc[m][n], 0, 0, 0);
        }
    }
    if (t + 3 < nt) WAIT_2STAGES();
    else if (t + 2 < nt) WAIT_1STAGE();
    else asm volatile("s_waitcnt vmcnt(0)" ::: "memory");
    RAW_BARRIER();
  }
#undef GLDS_STAGE
#undef RAW_BARRIER
#undef WAIT_2STAGES
#undef WAIT_1STAGE
  epi.template run<MFR>(acc, pre, row0, pn, wr, wc, fr, fq, shm, tid_);
}

template <bool F16 = false, class Epi>
__device__ __forceinline__ void gemm_phase(const bf16_t* __restrict__ A, const bf16_t* __restrict__ Bt, int mt_big, int small_rows, int ntiles, int K,
                                           const Epi& epi, char* shm, int tid_) {
  const int nu_big = ((mt_big + 7) >> 3) * ntiles * 8, nu_small = (small_rows >> 6) * ntiles;
  int u = lbid();
  for (; u < nu_big; u += gridDim.x) {
    const int xcd = u & 7, v = u >> 3;
    const int pn = v % ntiles, pm = (v / ntiles) * 8 + xcd;
    if (pm >= mt_big) continue;
    gemm_tile<F16, 8>(A + (size_t)pm * 256 * K, Bt + (size_t)pn * 256 * K, pm * 256, pn, K, epi, shm, tid_);
  }
  for (; u < nu_big + nu_small; u += gridDim.x) {
    const int w = u - nu_big, pn = w % ntiles, row0 = mt_big * 256 + (w / ntiles) * 64;
    gemm_tile<F16, 2>(A + (size_t)row0 * K, Bt + (size_t)pn * 256 * K, row0, pn, K, epi, shm, tid_);
  }
}

struct EpiInProj {
  bf16_t *Q, *K, *V, *GU, *GV;
  const float* rope;
  unsigned* KMAX;
  template <int MFR> struct Pre {};
  template <int MFR> __device__ __forceinline__ void preload(Pre<MFR>&, int, int, int, int, int, int) const {}
  template <int MFR>
  __device__ __forceinline__ void run(const f32x4 (&acc)[MFR][4], const Pre<MFR>&, int row0, int pn, int wr, int wc, int fr, int fq, char*, int) const {
    const int region = pn >> 2;
    const int lane = fq * 16 + fr;
    float kn2 = 0.f, kmax2 = 0.f;
#pragma unroll
    for (int m = 0; m < MFR; ++m) {
      const int row = row0 + wr * (16 * MFR) + m * 16 + fr;
      int b, pos;
      row_bpos(row, b, pos);
      if (region <= 1) {
        bf16_t* dst = region == 0 ? Q : K;
        const int head = (pn & 3) * 2 + (wc >> 1), msub = wc & 1;
        bf16_t* rp = dst + ((size_t)(b * NH + head) * LKV + pos) * 128 + msub * 64;
        const bool lat = row < NLAT;
        const int t = row & (SEQ - 1);
        const int prow = t >> 6, pcol = t & 63;
#pragma unroll
        for (int n = 0; n < 2; ++n) {
          float oa[4], ob[4];
          if (n == 0) kn2 = 0.f;
          const int pp = (n == 0) ? prow : pcol;
          const f32x4 r0 = lat ? *(const f32x4*)(rope + (pp * 16 + fq * 4) * 2) : (f32x4){1.f, 0.f, 1.f, 0.f};
          const f32x4 r1 = lat ? *(const f32x4*)(rope + (pp * 16 + fq * 4) * 2 + 4) : (f32x4){1.f, 0.f, 1.f, 0.f};
          const float csv[4] = {r0[0], r0[2], r1[0], r1[2]}, snv[4] = {r0[1], r0[3], r1[1], r1[3]};
#pragma unroll
          for (int j = 0; j < 4; ++j) {
            const float a = acc[m][n][j], bb = acc[m][n + 2][j];
            oa[j] = a * csv[j] - bb * snv[j];
            ob[j] = a * snv[j] + bb * csv[j];
          }
          if (region == 0) {
#pragma unroll
            for (int j = 0; j < 4; ++j) { oa[j] *= QSCALE; ob[j] *= QSCALE; }
          } else {
#pragma unroll
            for (int j = 0; j < 4; ++j) kn2 += oa[j] * oa[j] + ob[j] * ob[j];
          }
          u32x2 wa = {pk2(oa[0], oa[1]), pk2(oa[2], oa[3])};
          u32x2 wb = {pk2(ob[0], ob[1]), pk2(ob[2], ob[3])};
          *(u32x2*)(rp + n * 16 + fq * 4) = wa;
          *(u32x2*)(rp + 32 + n * 16 + fq * 4) = wb;
        }
        if (region == 1) {
          kn2 += shx_f(kn2, 16, lane); kn2 += shx_f(kn2, 32, lane);
          kmax2 = fmaxf(kmax2, kn2);
        }
      } else if (region == 2) {
        const int head = (pn & 3) * 2 + (wc >> 1);
        bf16_t* rp = V + ((size_t)(b * NH + head) * LKV + pos) * 128 + (wc & 1) * 64;
#pragma unroll
        for (int n = 0; n < 4; ++n) {
          u32x2 w = {pk2(acc[m][n][0], acc[m][n][1]), pk2(acc[m][n][2], acc[m][n][3])};
          *(u32x2*)(rp + n * 16 + fq * 4) = w;
        }
      } else {
        const int isv = (pn >> 1) & 1;
        bf16_t* rp = (isv ? GV : GU) + (size_t)row * 512 + (pn & 1) * 256 + wc * 64;
#pragma unroll
        for (int n = 0; n < 4; ++n) {
          u32x2 w = {pk2(gelu_tanh(acc[m][n][0]), gelu_tanh(acc[m][n][1])), pk2(gelu_tanh(acc[m][n][2]), gelu_tanh(acc[m][n][3]))};
          *(u32x2*)(rp + n * 16 + fq * 4) = w;
        }
      }
      asm volatile("" ::: "memory");
    }
    if (region == 1) {
#pragma unroll
      for (int o = 1; o < 16; o <<= 1) kmax2 = fmaxf(kmax2, shx_f(kmax2, o, lane));
      if (lane == 0) {
        const int b = row0 < NLAT ? (row0 >> 13) : ((row0 - NLAT) >> 8);
        const int head = (pn & 3) * 2 + (wc >> 1), msub = wc & 1;
        atomicMax(KMAX + (b * NH + head) * 2 + msub, __float_as_uint(kmax2));
      }
    }
  }
};
struct EpiResid {
  const hstream_t* XS; hstream_t* Z; const float* modbase;
  int which;
  template <int MFR> struct Pre { u32x2 xs[MFR][4]; };
  template <int MFR> __device__ __forceinline__ void preload(Pre<MFR>& pre, int row0, int pn, int wr, int wc, int fr, int fq) const {
#pragma unroll
    for (int n = 0; n < 4; ++n)
#pragma unroll
      for (int m = 0; m < MFR; ++m)
        pre.xs[m][n] = *(const u32x2*)(XS + (size_t)(row0 + wr * (16 * MFR) + m * 16 + fr) * DM + pn * 256 + wc * 64 + n * 16 + fq * 4);
  }
  template <int MFR>
  __device__ __forceinline__ void run(const f32x4 (&acc)[MFR][4], const Pre<MFR>& pre, int row0, int pn, int wr, int wc, int fr, int fq, char*, int) const {
    const int who = row0 < SEQ ? 0 : (row0 < NLAT ? 1 : 2);
    const float* g = modbase + ((size_t)who * 6 + which) * 1024;
#pragma unroll
    for (int n = 0; n < 4; ++n) {
      const int col = pn * 256 + wc * 64 + n * 16 + fq * 4;
      const f32x4 gv = *(const f32x4*)(g + col);
#pragma unroll
      for (int m = 0; m < MFR; ++m) {
        const size_t off = (size_t)(row0 + wr * (16 * MFR) + m * 16 + fr) * DM + col;
        const u32x2 w = pre.xs[m][n];
        const f32x4 xs = {hlo(w[0]), hhi(w[0]), hlo(w[1]), hhi(w[1])};
        st4h(Z + off, xs * ALPHA + gv * acc[m][n]);
      }
    }
  }
};
struct EpiBf16Store {
  bf16_t* O; int ld;
  template <int MFR> struct Pre {};
  template <int MFR> __device__ __forceinline__ void preload(Pre<MFR>&, int, int, int, int, int, int) const {}
  template <int MFR>
  __device__ __forceinline__ void run(const f32x4 (&acc)[MFR][4], const Pre<MFR>&, int row0, int pn, int wr, int wc, int fr, int fq, char*, int) const {
#pragma unroll
    for (int m = 0; m < MFR; ++m) {
      bf16_t* rp = O + (size_t)(row0 + wr * (16 * MFR) + m * 16 + fr) * ld + pn * 256 + wc * 64;
#pragma unroll
      for (int n = 0; n < 4; ++n) {
        u32x2 w = {pk2h(acc[m][n][0], acc[m][n][1]), pk2h(acc[m][n][2], acc[m][n][3])};
        *(u32x2*)(rp + n * 16 + fq * 4) = w;
      }
    }
  }
};
#define FMX(a, b) __float_as_int(__builtin_fmaxf(__int_as_float(a), __int_as_float(b)))
#define FMN(a, b) __float_as_int(__builtin_fminf(__int_as_float(a), __int_as_float(b)))
#define CE(a, b) do { const int _h = FMX(a, b), _l = FMN(a, b); a = _h; b = _l; } while (0)
#define SORT16(v) do { CE(v[0], v[1]); CE(v[2], v[3]); CE(v[0], v[2]); CE(v[1], v[3]); CE(v[1], v[2]); CE(v[4], v[5]); CE(v[6], v[7]); CE(v[4], v[6]); CE(v[5], v[7]); CE(v[5], v[6]); CE(v[0], v[4]); CE(v[2], v[6]); CE(v[2], v[4]); CE(v[1], v[5]); CE(v[3], v[7]); CE(v[3], v[5]); CE(v[1], v[2]); CE(v[3], v[4]); CE(v[5], v[6]); CE(v[8], v[9]); CE(v[10], v[11]); CE(v[8], v[10]); CE(v[9], v[11]); CE(v[9], v[10]); CE(v[12], v[13]); CE(v[14], v[15]); CE(v[12], v[14]); CE(v[13], v[15]); CE(v[13], v[14]); CE(v[8], v[12]); CE(v[10], v[14]); CE(v[10], v[12]); CE(v[9], v[13]); CE(v[11], v[15]); CE(v[11], v[13]); CE(v[9], v[10]); CE(v[11], v[12]); CE(v[13], v[14]); CE(v[0], v[8]); CE(v[4], v[12]); CE(v[4], v[8]); CE(v[2], v[10]); CE(v[6], v[14]); CE(v[6], v[10]); CE(v[2], v[4]); CE(v[6], v[8]); CE(v[10], v[12]); CE(v[1], v[9]); CE(v[5], v[13]); CE(v[5], v[9]); CE(v[3], v[11]); CE(v[7], v[15]); CE(v[7], v[11]); CE(v[3], v[5]); CE(v[7], v[9]); CE(v[11], v[13]); CE(v[1], v[2]); CE(v[3], v[4]); CE(v[5], v[6]); CE(v[7], v[8]); CE(v[9], v[10]); CE(v[11], v[12]); CE(v[13], v[14]); } while (0)
#define BMERGE16(v) do { CE(v[0], v[8]); CE(v[1], v[9]); CE(v[2], v[10]); CE(v[3], v[11]); CE(v[4], v[12]); CE(v[5], v[13]); CE(v[6], v[14]); CE(v[7], v[15]); CE(v[0], v[4]); CE(v[1], v[5]); CE(v[2], v[6]); CE(v[3], v[7]); CE(v[8], v[12]); CE(v[9], v[13]); CE(v[10], v[14]); CE(v[11], v[15]); CE(v[0], v[2]); CE(v[1], v[3]); CE(v[4], v[6]); CE(v[5], v[7]); CE(v[8], v[10]); CE(v[9], v[11]); CE(v[12], v[14]); CE(v[13], v[15]); CE(v[0], v[1]); CE(v[2], v[3]); CE(v[4], v[5]); CE(v[6], v[7]); CE(v[8], v[9]); CE(v[10], v[11]); CE(v[12], v[13]); CE(v[14], v[15]); } while (0)
#define CAND_CHUNK0 do { T[0] = CK(0, 0); T[1] = CK(0, 1); T[2] = CK(0, 2); T[3] = CK(0, 3); T[4] = CK(0, 4); T[5] = CK(0, 5); T[6] = CK(0, 6); T[7] = CK(0, 7); T[8] = CK(0, 8); T[9] = CK(0, 9); T[10] = CK(0, 10); T[11] = CK(0, 11); T[12] = CK(0, 12); T[13] = CK(0, 13); T[14] = CK(0, 14); T[15] = CK(0, 15); } while (0)
#define CAND_CHUNK1 do { X[0] = CK(1, 0); X[1] = CK(1, 1); X[2] = CK(1, 2); X[3] = CK(1, 3); X[4] = CK(1, 4); X[5] = CK(1, 5); X[6] = CK(1, 6); X[7] = CK(1, 7); X[8] = CK(2, 0); X[9] = CK(2, 1); X[10] = CK(2, 2); X[11] = CK(2, 3); X[12] = CK(2, 4); X[13] = CK(3, 0); X[14] = CK(3, 1); X[15] = CK(3, 2); } while (0)
#define CAND_CHUNK2 do { X[0] = CK(3, 3); X[1] = CK(4, 0); X[2] = CK(4, 1); X[3] = CK(4, 2); X[4] = CK(5, 0); X[5] = CK(5, 1); X[6] = CK(6, 0); X[7] = CK(6, 1); X[8] = CK(7, 0); X[9] = CK(7, 1); X[10] = CK(8, 0); X[11] = CK(9, 0); X[12] = CK(10, 0); X[13] = CK(11, 0); X[14] = CK(12, 0); X[15] = CK(13, 0); } while (0)
#define CAND_CHUNK3 do { X[0] = CK(14, 0); X[1] = CK(15, 0); X[2] = (int)0xFF800000; X[3] = (int)0xFF800000; X[4] = (int)0xFF800000; X[5] = (int)0xFF800000; X[6] = (int)0xFF800000; X[7] = (int)0xFF800000; X[8] = (int)0xFF800000; X[9] = (int)0xFF800000; X[10] = (int)0xFF800000; X[11] = (int)0xFF800000; X[12] = (int)0xFF800000; X[13] = (int)0xFF800000; X[14] = (int)0xFF800000; X[15] = (int)0xFF800000; } while (0)

__device__ __forceinline__ int packkey7(float f, int idx) { return (__float_as_int(f) & ~0x7F) | (127 - idx); }
__device__ __forceinline__ float keyval7(int k) { return __int_as_float(k & ~0x7F); }
__device__ __forceinline__ int packkey8(float f, int pos) { return (__float_as_int(f) & ~0xFF) | (255 - pos); }
__device__ __forceinline__ float keyval8(int k) { return __int_as_float(k & ~0xFF); }
typedef int i32x4 __attribute__((ext_vector_type(4)));
#define LD16(dst, ptr) do { const i32x4 _a = *(const i32x4*)(ptr), _b = *(const i32x4*)((ptr) + 4), _c = *(const i32x4*)((ptr) + 8), _d = *(const i32x4*)((ptr) + 12); \
    dst[0] = _a[0]; dst[1] = _a[1]; dst[2] = _a[2]; dst[3] = _a[3]; dst[4] = _b[0]; dst[5] = _b[1]; dst[6] = _b[2]; dst[7] = _b[3];                                \
    dst[8] = _c[0]; dst[9] = _c[1]; dst[10] = _c[2]; dst[11] = _c[3]; dst[12] = _d[0]; dst[13] = _d[1]; dst[14] = _d[2]; dst[15] = _d[3]; } while (0)
#define ST16(ptr, src) do { *(i32x4*)(ptr) = (i32x4){src[0], src[1], src[2], src[3]}; *(i32x4*)((ptr) + 4) = (i32x4){src[4], src[5], src[6], src[7]};           \
    *(i32x4*)((ptr) + 8) = (i32x4){src[8], src[9], src[10], src[11]}; *(i32x4*)((ptr) + 12) = (i32x4){src[12], src[13], src[14], src[15]}; } while (0)
#define MERGE_TOP16(T, X) do { _Pragma("unroll") for (int _i = 0; _i < 16; ++_i) T[_i] = FMX(T[_i], X[15 - _i]); BMERGE16(T); } while (0)
struct EpiTopK {
  int* IDX; float* GATE;
  template <int MFR> struct Pre {};
  template <int MFR> __device__ __forceinline__ void preload(Pre<MFR>&, int, int, int, int, int, int) const {}
  template <int MFR>
  __device__ __forceinline__ void run(const f32x4 (&acc)[MFR][4], const Pre<MFR>&, int row0, int pn, int wr, int wc, int fr, int fq, char* shm, int tid_) const {
    constexpr int LST = 68, BM = 32 * MFR;
    int* lst = (int*)shm;
    const int tid = tid_, lane = tid_ & 63;
#pragma unroll
    for (int m = 0; m < MFR; ++m) {
      int T[16], X[16];
#pragma unroll
      for (int n = 0; n < 4; ++n)
#pragma unroll
        for (int j = 0; j < 4; ++j) T[n * 4 + j] = packkey7(acc[m][n][j], (wc & 1) * 64 + n * 16 + fq * 4 + j);
      SORT16(T);
#pragma unroll
      for (int i = 0; i < 16; ++i) { auto rr = __builtin_amdgcn_permlane16_swap(T[i], T[i], false, false); T[i] = rr[0]; X[i] = rr[1]; }
      MERGE_TOP16(T, X);
#pragma unroll
      for (int i = 0; i < 16; ++i) { auto rr = __builtin_amdgcn_permlane32_swap(T[i], T[i], false, false); T[i] = rr[0]; X[i] = rr[1]; }
      MERGE_TOP16(T, X);
      i32x4 w;
#pragma unroll
      for (int q = 0; q < 4; ++q) {
        const int m1 = -(fq & 1), m2 = -((fq >> 1) & 1);
        const int lo_ = (T[q] & ~m1) | (T[4 + q] & m1), hi_ = (T[8 + q] & ~m1) | (T[12 + q] & m1);
        w[q] = (lo_ & ~m2) | (hi_ & m2);
      }
      *(i32x4*)(lst + (wr * (16 * MFR) + m * 16 + fr) * LST + wc * 16 + fq * 4) = w;
    }
    __syncthreads();
    if (tid < 2 * BM) {
      const int row = tid & (BM - 1), pp = tid / BM;
      int T[16], X[16];
      LD16(T, lst + row * LST + pp * 32);
      LD16(X, lst + row * LST + pp * 32 + 16);
      MERGE_TOP16(T, X);
      ST16(lst + row * LST + pp * 32, T);
    }
    __syncthreads();
    if (tid < BM) {
      const int row = tid;
      int T[16], X[16];
      float a[16], b[16];
      LD16(T, lst + row * LST);
      LD16(X, lst + row * LST + 32);
#pragma unroll
      for (int i = 0; i < 16; ++i) { a[i] = keyval7(T[i]); b[i] = keyval7(X[i]); }
#define CK(i, j) packkey8(a[i] + b[j], (i) * 16 + (j))
      CAND_CHUNK0; SORT16(T);
      CAND_CHUNK1; SORT16(X); MERGE_TOP16(T, X);
      CAND_CHUNK2; SORT16(X); MERGE_TOP16(T, X);
      CAND_CHUNK3; SORT16(X); MERGE_TOP16(T, X);
#undef CK
      const float v0 = keyval8(T[0]);
      float e[16], sum = 0.f;
#pragma unroll
      for (int r = 0; r < 16; ++r) { e[r] = __expf(keyval8(T[r]) - v0); sum += e[r]; }
      const float inv = 1.0f / sum;
      const size_t go = ((size_t)pn * NTOK + (size_t)(row0 + row)) * 16;
#pragma unroll
      for (int r = 0; r < 16; ++r) {
        const int pos = 255 - (T[r] & 0xFF);
        const int ia = 127 - (lst[row * LST + (pos >> 4)] & 0x7F), ib = 127 - (lst[row * LST + 32 + (pos & 15)] & 0x7F);
        X[r] = ia * 128 + ib;
        e[r] *= inv;
      }
      ST16(IDX + go, X);
      *(f32x4*)(GATE + go) = (f32x4){e[0], e[1], e[2], e[3]}; *(f32x4*)(GATE + go + 4) = (f32x4){e[4], e[5], e[6], e[7]};
      *(f32x4*)(GATE + go + 8) = (f32x4){e[8], e[9], e[10], e[11]}; *(f32x4*)(GATE + go + 12) = (f32x4){e[12], e[13], e[14], e[15]};
    }
    __syncthreads();
  }
};

__device__ void transpose_unit(const float* __restrict__ W, bf16_t* __restrict__ Wt, int K, int N, int unit, char* shm, int tid_) {
  float* tl = (float*)shm;
  const int ntn = N / 64;
  const int k0 = (unit / ntn) * 64, n0 = (unit % ntn) * 64;
  const int tid = tid_;
#pragma unroll
  for (int i = 0; i < 8; ++i) {
    const int idx = tid + i * 512, r = idx >> 6, c = idx & 63;
    tl[r * 65 + c] = W[(size_t)(k0 + r) * N + n0 + c];
  }
  __syncthreads();
#pragma unroll
  for (int i = 0; i < 8; ++i) {
    const int idx = tid + i * 512, r = idx >> 6, c = idx & 63;
    Wt[(size_t)(n0 + r) * K + k0 + c] = f2h(tl[c * 65 + r]);
  }
  __syncthreads();
}

__device__ void foldqk_unit(const Params& p, int unit, char* shm, int tid_) {
  const int l = unit >> 8, hp = (unit >> 4) & 15, ct = unit & 15;
  float* kl = (float*)shm;
  float* wl = kl + 128 * 132;
  const float* keys = PIN(p, peer_keys) + ((size_t)(l * 16 + hp) * 128) * 128;
  const float* wq = PIN(p, peer_wq) + (size_t)l * 1024 * 2048;
  const int tid = tid_;
  for (int idx = tid; idx < 128 * 128; idx += 512) { const int k = idx >> 7, d = idx & 127; kl[d * 132 + k] = keys[k * 128 + d]; }
  for (int idx = tid; idx < 64 * 128; idx += 512) { const int c = idx >> 7, d = idx & 127; wl[d * 68 + c] = wq[(size_t)(ct * 64 + c) * 2048 + hp * 128 + d]; }
  __syncthreads();
  const int c0 = (tid & 15) * 4, k0 = (tid >> 4) * 4;
  f32x4 acc[4];
#pragma unroll
  for (int kk = 0; kk < 4; ++kk) acc[kk] = (f32x4){0.f, 0.f, 0.f, 0.f};
#pragma unroll 4
  for (int d = 0; d < 128; ++d) {
    const f32x4 a = *(const f32x4*)(wl + d * 68 + c0), bq = *(const f32x4*)(kl + d * 132 + k0);
#pragma unroll
    for (int kk = 0; kk < 4; ++kk) acc[kk] += a * bq[kk];
  }
  bf16_t* outp = (bf16_t*)(p.ws + OFF_WQK) + (size_t)l * 2048 * 1024;
#pragma unroll
  for (int kk = 0; kk < 4; ++kk) {
    u32x2 w = {pk2h(acc[kk][0], acc[kk][1]), pk2h(acc[kk][2], acc[kk][3])};
    *(u32x2*)(outp + (size_t)(hp * 128 + k0 + kk) * 1024 + ct * 64 + c0) = w;
  }
  __syncthreads();
}
__device__ void foldpool_unit(const Params& p, int unit, char* shm, int tid_) {
  const int j = unit >> 8, g = (unit >> 6) & 3, cit = (unit >> 4) & 3, et = unit & 15;
  float* gl = (float*)shm;
  float* ol = gl + 256 * 68;
  const float* wg = PIN(p, pool_w_grp) + ((size_t)(j * 4 + g) * 256) * 256;
  const float* sc = PIN(p, pool_scale) + (size_t)j * 1024 + g * 256;
  const float* wo = PIN(p, pool_w_out) + ((size_t)j * 1024 + g * 256) * 1024;
  const int tid = tid_;
  for (int idx = tid; idx < 64 * 256; idx += 512) { const int r = idx >> 8, m = idx & 255; gl[m * 68 + r] = wg[(size_t)(cit * 64 + r) * 256 + m] * sc[m]; }
  for (int idx = tid; idx < 256 * 64; idx += 512) { const int m = idx >> 6, e = idx & 63; ol[m * 68 + e] = wo[(size_t)m * 1024 + et * 64 + e]; }
  __syncthreads();
  const int ci0 = (tid & 31) * 2, e0 = (tid >> 5) * 4;
  f32x4 acc0 = {0.f, 0.f, 0.f, 0.f}, acc1 = {0.f, 0.f, 0.f, 0.f};
#pragma unroll 4
  for (int m = 0; m < 256; ++m) {
    const f32x2v a = *(const f32x2v*)(gl + m * 68 + ci0);
    const f32x4 bq = *(const f32x4*)(ol + m * 68 + e0);
    acc0 += bq * a[0]; acc1 += bq * a[1];
  }
  bf16_t* outp = (bf16_t*)(p.ws + OFF_POUT) + (size_t)j * 1024 * 1024;
#pragma unroll
  for (int ee = 0; ee < 4; ++ee)
    *(unsigned*)(outp + (size_t)(et * 64 + e0 + ee) * 1024 + g * 256 + cit * 64 + ci0) = pk2h(acc0[ee], acc1[ee]);
  __syncthreads();
}
__device__ void mod_unit(const Params& p, int unit, char* shm, int tid_) {
  const int l = unit / 48, rem = unit % 48, cgp = rem >> 1, kh = rem & 1;
  float* sv = (float*)shm;
  float* red = sv + 3 * 512;
  const int tid = tid_, lane = tid & 63, ks = __builtin_amdgcn_readfirstlane(tid >> 6);
  for (int idx = tid; idx < 3 * 512; idx += 512) {
    const int w = idx >> 9, k = kh * 512 + (idx & 511);
    const float xv = w < 2 ? PIN(p, c)[w * 1024 + k] : PIN(p, c_ctx)[k];
    sv[idx] = xv / (1.0f + __expf(-xv));
  }
  __syncthreads();
  const float* aw = PIN(p, ada_w) + (size_t)l * 1024 * 6144 + (size_t)(kh * 512 + ks * 64) * 6144 + cgp * 256 + lane * 4;
  f32x4 a0 = {0.f, 0.f, 0.f, 0.f}, a1 = a0, a2 = a0;
#pragma unroll 8
  for (int k = 0; k < 64; ++k) {
    const f32x4 w = *(const f32x4*)(aw + (size_t)k * 6144);
    a0 += w * sv[ks * 64 + k]; a1 += w * sv[512 + ks * 64 + k]; a2 += w * sv[1024 + ks * 64 + k];
  }
  *(f32x4*)(red + (ks * 3 + 0) * 256 + lane * 4) = a0; *(f32x4*)(red + (ks * 3 + 1) * 256 + lane * 4) = a1; *(f32x4*)(red + (ks * 3 + 2) * 256 + lane * 4) = a2;
  __syncthreads();
  for (int idx = tid; idx < 768; idx += 512) {
    const int w = idx >> 8, cc = idx & 255;
    float s = 0.f;
#pragma unroll
    for (int q = 0; q < 8; ++q) s += red[(q * 3 + w) * 256 + cc];
    const int n = cgp * 256 + cc;
    ((float*)(p.ws + OFF_MODP))[((size_t)kh * 12 + l * 3 + w) * 6144 + n] = s;
  }
  __syncthreads();
}

__device__ void phase_prologue_a(const Params& p, char* shm, int tid_) {
  constexpr int U_MOD = 192;
  constexpr int U_TWIN = 2 * 16 * 64, U_TWOUT = 2 * 24 * 16, U_TPIN = 2 * 16 * 16;
  constexpr int U_FQK = 1024, U_FP = 512, U_TAB = 2048, U_MISC = 1;
  constexpr int E0 = U_MOD, E1 = E0 + U_TWIN, E2 = E1 + U_TWOUT, E3 = E2 + U_TPIN, E4 = E3 + U_FQK, E5 = E4 + U_FP, E6 = E5 + U_TAB, E7 = E6 + U_MISC;
  for (int u = lbid(); u < E7; u += gridDim.x) {
    if (u < E0) mod_unit(p, u, shm, tid_);
    else if (u < E1) { const int v = u - E0, j = v / (16 * 64), r = v % (16 * 64);
      transpose_unit(PIN(p, ab_w_in) + (size_t)j * 1024 * 4096, (bf16_t*)(p.ws + OFF_WIN) + (size_t)j * 4096 * 1024, 1024, 4096, r, shm, tid_); }
    else if (u < E2) { const int v = u - E1, j = v / (24 * 16), r = v % (24 * 16);
      transpose_unit(PIN(p, ab_w_out) + (size_t)j * 1536 * 1024, (bf16_t*)(p.ws + OFF_WOUT) + (size_t)j * 1024 * 1536, 1536, 1024, r, shm, tid_); }
    else if (u < E3) { const int v = u - E2, j = v / 256, r = v % 256;
      transpose_unit(PIN(p, pool_w_in) + (size_t)j * 1024 * 1024, (bf16_t*)(p.ws + OFF_PIN) + (size_t)j * 1024 * 1024, 1024, 1024, r, shm, tid_); }
    else if (u < E4) foldqk_unit(p, u - E3, shm, tid_);
    else if (u < E5) foldpool_unit(p, u - E4, shm, tid_);
    else if (u < E6) {
      const int v = u - E5;
      const int tb = v >> 10;
      const float* src = tb ? PIN(p, peer_v) : PIN(p, peer_u);
      unsigned char* dst = (unsigned char*)(p.ws + (tb ? OFF_V8 : OFF_U8));
      const float scl = tb ? 8.0f : 64.0f;
      const int wid = __builtin_amdgcn_readfirstlane(tid_ >> 6), lane = tid_ & 63;
#pragma unroll 4
      for (int i = 0; i < 8; ++i) {
        const int row = (v & 1023) * 64 + i * 8 + wid;
        const int layer = row >> 14, e = row & 16383;
        const float* rp = src + (size_t)row * DM + lane * 16;
        const f32x4 a = *(const f32x4*)rp * scl, b = *(const f32x4*)(rp + 4) * scl, c = *(const f32x4*)(rp + 8) * scl, d = *(const f32x4*)(rp + 12) * scl;
        u32x4 w;
        w[0] = __builtin_amdgcn_cvt_pk_fp8_f32(a[2], a[3], __builtin_amdgcn_cvt_pk_fp8_f32(a[0], a[1], 0, false), true);
        w[1] = __builtin_amdgcn_cvt_pk_fp8_f32(b[2], b[3], __builtin_amdgcn_cvt_pk_fp8_f32(b[0], b[1], 0, false), true);
        w[2] = __builtin_amdgcn_cvt_pk_fp8_f32(c[2], c[3], __builtin_amdgcn_cvt_pk_fp8_f32(c[0], c[1], 0, false), true);
        w[3] = __builtin_amdgcn_cvt_pk_fp8_f32(d[2], d[3], __builtin_amdgcn_cvt_pk_fp8_f32(d[0], d[1], 0, false), true);
        *(u32x4*)(dst + ((size_t)(layer * 8 + (lane >> 3)) * NEXP + e) * 128 + (lane & 7) * 16) = w;
      }
    } else {
      float* rope = (float*)(p.ws + OFF_ROPE);
      for (int idx = tid_; idx < 128 * 16; idx += 512) {
        const int pos = idx >> 4, i = idx & 15;
        const float inv = powf(10000.0f, -(float)i / 16.0f);
        const float ang = (float)pos * inv;
        rope[idx * 2 + 0] = cosf(ang);
        rope[idx * 2 + 1] = sinf(ang);
      }
      if (tid_ < 2) {
        const int j = tid_;
        const float* lv = PIN(p, diff_lam) + (size_t)j * 4 * 64;
        float s1 = 0.f, s2 = 0.f;
        for (int d = 0; d < 64; ++d) { s1 += lv[d] * lv[64 + d]; s2 += lv[128 + d] * lv[192 + d]; }
        const float lam_init = 0.8f - 0.6f * expf(-0.3f * (float)(2 * j));
        float* lam = (float*)(p.ws + OFF_LAM);
        lam[j * 2 + 0] = expf(s1) - expf(s2) + lam_init;
        lam[j * 2 + 1] = lam_init;
      }
    }
  }
}

__device__ void phase_prologue_b(const Params& p, int tid_) {
  const int wid = __builtin_amdgcn_readfirstlane(tid_ >> 6), lane = tid_ & 63;
  {
    const float* mp = (const float*)(p.ws + OFF_MODP);
    float* md = (float*)(p.ws + OFF_MOD);
    for (int idx = lbid() * 512 + tid_; idx < 12 * 6144; idx += gridDim.x * 512) {
      const int l = idx / (3 * 6144), n = idx % 6144;
      md[idx] = mp[idx] + mp[12 * 6144 + idx] + PIN(p, ada_b)[(size_t)l * 6144 + n];
    }
  }
  hstream_t* XS = (hstream_t*)(p.ws + OFF_XSA);
  bf16_t* H = (bf16_t*)(p.ws + OFF_H);
  for (int row = lbid() * 8 + wid; row < NTOK; row += gridDim.x * 8) {
    const float* src = row < NLAT ? PIN(p, x) + (size_t)row * DM : PIN(p, ctx) + (size_t)(row - NLAT) * DM;
    const int who = who_of_row(row);
    const float* mp0 = (const float*)(p.ws + OFF_MODP) + (size_t)who * 6144;
    const float* mp1 = mp0 + 12 * 6144;
#pragma unroll
    for (int i = 0; i < 4; ++i) {
      const int col = i * 256 + lane * 4;
      const f32x4 v = *(const f32x4*)(src + col);
      st4h(XS + (size_t)row * DM + col, v);
      const f32x4 s1 = *(const f32x4*)(mp0 + col) + *(const f32x4*)(mp1 + col) + *(const f32x4*)(PIN(p, ada_b) + col);
      const f32x4 s2 = *(const f32x4*)(mp0 + 1024 + col) + *(const f32x4*)(mp1 + 1024 + col) + *(const f32x4*)(PIN(p, ada_b) + 1024 + col);
      const f32x4 h = v * (s2 + 1.0f) + s1;
      u32x2 w = {pk2h(h[0], h[1]), pk2h(h[2], h[3])};
      *(u32x2*)(H + (size_t)row * DM + col) = w;
    }
  }
}

__device__ void phase_ln(const Params& p, const hstream_t* Zin, hstream_t* XSo, int layer, int lnidx, int nrows, bf16_t* Hout, int mlayer, int msh, int nrows_h, bool final, int tid_) {
  const int wid = __builtin_amdgcn_readfirstlane(tid_ >> 6), lane = tid_ & 63;
  const float* g = PIN(p, ln_g) + (size_t)(layer * 2 + lnidx) * DM;
  const float* bt = PIN(p, ln_b) + (size_t)(layer * 2 + lnidx) * DM;
  for (int row = lbid() * 8 + wid; row < nrows; row += gridDim.x * 8) {
    const int who = who_of_row(row);
    f32x4 v[4];
    float s = 0.f;
#pragma unroll
    for (int i = 0; i < 4; ++i) { v[i] = ld4h(Zin + (size_t)row * DM + i * 256 + lane * 4); s += (v[i][0] + v[i][1]) + (v[i][2] + v[i][3]); }
    const float mu = wave_sum(s, lane) * (1.0f / DM);
    float q = 0.f;
#pragma unroll
    for (int i = 0; i < 4; ++i) { const f32x4 d = v[i] - mu; q += (d[0] * d[0] + d[1] * d[1]) + (d[2] * d[2] + d[3] * d[3]); }
    const float rstd = rsqrtf(wave_sum(q, lane) * (1.0f / DM) + LN_EPS);
#pragma unroll
    for (int i = 0; i < 4; ++i) {
      const int col = i * 256 + lane * 4;
      const f32x4 gg = *(const f32x4*)(g + col), bb = *(const f32x4*)(bt + col);
      const f32x4 xo = (v[i] - mu) * rstd * gg + bb;
      if (final) { *(f32x4*)(p.out + (size_t)row * DM + col) = xo; }
      else {
        st4h(XSo + (size_t)row * DM + col, xo);
        if (row < nrows_h) {
          const f32x4 s1 = *(const f32x4*)(mod_ptr(p, mlayer, who, msh) + col), s2 = *(const f32x4*)(mod_ptr(p, mlayer, who, msh + 1) + col);
          const f32x4 h = xo * (s2 + 1.0f) + s1;
          u32x2 w;
          if (lnidx == 0) w = (u32x2){pk2h(h[0], h[1]), pk2h(h[2], h[3])};
          else w = (u32x2){pk2h(h[0], h[1]), pk2h(h[2], h[3])};
          *(u32x2*)(Hout + (size_t)row * DM + col) = w;
        }
      }
    }
  }
}

typedef short s16x4 __attribute__((ext_vector_type(4)));
typedef float f32x16 __attribute__((ext_vector_type(16)));
#define KSWZ(row, colB) ((row) * 256 + ((colB) ^ (((row) & 7) << 4)))
#define SBAR() __builtin_amdgcn_sched_barrier(0)
constexpr float ATT_SCALE = 0.125f, ATT_THR = 8.f;
#ifndef ATT_SDEPTH
#define ATT_SDEPTH 1
#endif
constexpr int SHM_KV = 64 * 128 * 2;
__device__ __forceinline__ int crow(int r, int hi) { return (r & 3) + 8 * (r >> 2) + 4 * hi; }
__device__ __forceinline__ unsigned cvtpk(float lo, float hi) {
  unsigned r; asm volatile("v_cvt_pk_bf16_f32 %0, %1, %2" : "=v"(r) : "v"(lo), "v"(hi)); return r;
}
__device__ __forceinline__ void qkt(f32x16& p0, f32x16& p1, const char* Ks, const bf16x8* qr, int r32, int hi, int m, float negM) {
#pragma unroll
  for (int r = 0; r < 16; ++r) { p0[r] = negM; p1[r] = negM; }
#pragma unroll
  for (int d0 = 0; d0 < 4; ++d0) {
    const int cb = (m * 64 + d0 * 16 + hi * 8) * 2;
    const bf16x8 b0 = *reinterpret_cast<const bf16x8*>(Ks + KSWZ(r32, cb));
    const bf16x8 b1 = *reinterpret_cast<const bf16x8*>(Ks + KSWZ(32 + r32, cb));
    p0 = __builtin_amdgcn_mfma_f32_32x32x16_bf16(b0, qr[d0], p0, 0, 0, 0);
    p1 = __builtin_amdgcn_mfma_f32_32x32x16_bf16(b1, qr[d0], p1, 0, 0, 0);
  }
}
__device__ __forceinline__ int v_st(int k, int c) { const int kk = (k & ~0xC) | ((k & 4) << 1) | ((k & 8) >> 1); return ((kk >> 3) * 4 + (c >> 5)) * 512 + ((kk & 7) * 32 + (c & 31)) * 2; }
__device__ __forceinline__ int v_rd_base(int lane) { return ((lane & 3) << 3) | (((lane >> 2) & 3) << 6) | (((lane >> 4) & 1) << 5) | (((lane >> 5) & 1) << 8); }
constexpr int v_rd_off(int d0, int ks, int half) { return d0 * 512 + ks * 4096 + half * 2048; }
template <int OFF> __device__ __forceinline__ s16x4 tr_read(int vb) {
  s16x4 r; asm volatile("ds_read_b64_tr_b16 %0, %1 offset:%2" : "=&v"(r) : "v"(vb), "i"(OFF) : "memory"); return r;
}
template <int D0> __device__ __forceinline__ void pv_one(f32x16& od, int vb, bf16x8 pa0, bf16x8 pa1, bf16x8 pa2, bf16x8 pa3) {
  const s16x4 l0 = tr_read<v_rd_off(D0, 0, 0)>(vb), h0 = tr_read<v_rd_off(D0, 0, 1)>(vb), l1 = tr_read<v_rd_off(D0, 1, 0)>(vb), h1 = tr_read<v_rd_off(D0, 1, 1)>(vb);
  const s16x4 l2 = tr_read<v_rd_off(D0, 2, 0)>(vb), h2 = tr_read<v_rd_off(D0, 2, 1)>(vb), l3 = tr_read<v_rd_off(D0, 3, 0)>(vb), h3 = tr_read<v_rd_off(D0, 3, 1)>(vb);
  asm volatile("s_waitcnt lgkmcnt(0)" ::: "memory"); SBAR();
#define PKV(L, H) (bf16x8){L[0], L[1], L[2], L[3], H[0], H[1], H[2], H[3]}
  od = __builtin_amdgcn_mfma_f32_32x32x16_bf16(pa0, PKV(l0, h0), od, 0, 0, 0);
  od = __builtin_amdgcn_mfma_f32_32x32x16_bf16(pa1, PKV(l1, h1), od, 0, 0, 0);
  od = __builtin_amdgcn_mfma_f32_32x32x16_bf16(pa2, PKV(l2, h2), od, 0, 0, 0);
  od = __builtin_amdgcn_mfma_f32_32x32x16_bf16(pa3, PKV(l3, h3), od, 0, 0, 0);
#undef PKV
}
template <int D0> __device__ __forceinline__ void pv_one_t(f32x16& od, int vb, bf16x8 pa0, bf16x8 pa1, bf16x8 pa2, bf16x8 pa3) {
  const s16x4 l0 = tr_read<v_rd_off(D0, 0, 0)>(vb), h0 = tr_read<v_rd_off(D0, 0, 1)>(vb), l1 = tr_read<v_rd_off(D0, 1, 0)>(vb), h1 = tr_read<v_rd_off(D0, 1, 1)>(vb);
  const s16x4 l2 = tr_read<v_rd_off(D0, 2, 0)>(vb), h2 = tr_read<v_rd_off(D0, 2, 1)>(vb), l3 = tr_read<v_rd_off(D0, 3, 0)>(vb), h3 = tr_read<v_rd_off(D0, 3, 1)>(vb);
  asm volatile("s_waitcnt lgkmcnt(0)" ::: "memory"); SBAR();
#define PKV(L, H) (bf16x8){L[0], L[1], L[2], L[3], H[0], H[1], H[2], H[3]}
  od = __builtin_amdgcn_mfma_f32_32x32x16_bf16(PKV(l0, h0), pa0, od, 0, 0, 0);
  od = __builtin_amdgcn_mfma_f32_32x32x16_bf16(PKV(l1, h1), pa1, od, 0, 0, 0);
  od = __builtin_amdgcn_mfma_f32_32x32x16_bf16(PKV(l2, h2), pa2, od, 0, 0, 0);
  od = __builtin_amdgcn_mfma_f32_32x32x16_bf16(PKV(l3, h3), pa3, od, 0, 0, 0);
#undef PKV
}

__device__ __forceinline__ void attn_unit(const bf16_t* __restrict__ Qb, const bf16_t* __restrict__ Kh, const bf16_t* __restrict__ Vh, int seq,
                                          bf16_t* __restrict__ CATp  , const float* __restrict__ ng, float lam, float lam_init,
                                          const unsigned* __restrict__ kmaxp  , char* lds, int tid_) {
  const int tid = tid_, wid = __builtin_amdgcn_readfirstlane(tid >> 6), lane = tid & 63, r32 = lane & 31, hi = lane >> 5;
  const int rg = wid & 3, m = wid >> 2;
  constexpr int SLOT = 2 * SHM_KV;
  float* wsp = (float*)(lds + 4 * SLOT) + wid * 64; float* li_l = wsp;
  float l_reg = 0; f32x16 o[4] = {}; bf16x8 qr[4];
  const bf16_t* Qw = Qb + (size_t)(rg * 32 + r32) * 128 + m * 64 + hi * 8;
#pragma unroll
  for (int d0 = 0; d0 < 4; ++d0) qr[d0] = *reinterpret_cast<const bf16x8*>(Qw + d0 * 16);
  float negM;
  {
    float q2 = 0.f;
#pragma unroll
    for (int d0 = 0; d0 < 4; ++d0)
#pragma unroll
      for (int e = 0; e < 8; ++e) { const float v = bf2f((bf16_t)qr[d0][e]); q2 += v * v; }
    { auto rr = __builtin_amdgcn_permlane32_swap(__float_as_uint(q2), __float_as_uint(q2), false, false); q2 = __uint_as_float(rr[0]) + __uint_as_float(rr[1]); }
    const float k2 = __uint_as_float(kmaxp[m]);
    negM = -1.01f * sqrtf(q2 * k2);
  }
  unsigned vsrc[2], ksrc[2];
#pragma unroll
  for (int j = 0; j < 2; ++j) {
    const int p_ = wid + 8 * j;
    const int g_ = p_ * 64 + lane, sub = g_ >> 5, within = g_ & 31;
    const int kk = (sub >> 2) * 8 + (within >> 2), c_ = (sub & 3) * 32 + (within & 3) * 8;
    const int k_ = (kk & ~0xC) | ((kk & 4) << 1) | ((kk & 8) >> 1);
    vsrc[j] = (unsigned)(k_ * 256 + c_ * 2);
    const int row = p_ * 4 + (lane >> 4), chunk = (lane & 15) ^ (row & 7);
    ksrc[j] = (unsigned)(row * 256 + chunk * 16);
  }
  const int vb0 = (int)(uintptr_t)lds + v_rd_base(lane);
#define SLOAD_DMA(k0, slot) do { \
    const char* _vg = (const char*)(Vh + (size_t)(k0) * 128); const char* _kg = (const char*)(Kh + (size_t)(k0) * 128); char* _b = lds + (slot) * SLOT; \
    __builtin_amdgcn_global_load_lds((const unsigned*)(_vg + vsrc[0]), (unsigned*)(_b + wid * 1024), 16, 0, 0); \
    __builtin_amdgcn_global_load_lds((const unsigned*)(_vg + vsrc[1]), (unsigned*)(_b + (wid + 8) * 1024), 16, 0, 0); \
    __builtin_amdgcn_global_load_lds((const unsigned*)(_kg + ksrc[0]), (unsigned*)(_b + SHM_KV + wid * 1024), 16, 0, 0); \
    __builtin_amdgcn_global_load_lds((const unsigned*)(_kg + ksrc[1]), (unsigned*)(_b + SHM_KV + (wid + 8) * 1024), 16, 0, 0); } while (0)
#define TILE_PUBLISH() do { asm volatile("s_waitcnt vmcnt(0) lgkmcnt(0)" ::: "memory"); __builtin_amdgcn_s_barrier(); asm volatile("" ::: "memory"); } while (0)
#define PKV(L, H) (bf16x8){L[0], L[1], L[2], L[3], H[0], H[1], H[2], H[3]}
#define VRD(D0, KH, vb, f0, f1, f2, f3) do { f0 = tr_read<v_rd_off(D0, 2 * (KH), 0)>(vb); f1 = tr_read<v_rd_off(D0, 2 * (KH), 1)>(vb); \
    f2 = tr_read<v_rd_off(D0, 2 * (KH) + 1, 0)>(vb); f3 = tr_read<v_rd_off(D0, 2 * (KH) + 1, 1)>(vb); } while (0)
#define VMM(D0, qa, qb, f0, f1, f2, f3) do { \
    o[D0] = __builtin_amdgcn_mfma_f32_32x32x16_bf16(qa, PKV(f0, f1), o[D0], 0, 0, 0); \
    o[D0] = __builtin_amdgcn_mfma_f32_32x32x16_bf16(qb, PKV(f2, f3), o[D0], 0, 0, 0); } while (0)
#define LW4() do { asm volatile("s_waitcnt lgkmcnt(4)" ::: "memory"); SBAR(); } while (0)
#define LW0() do { asm volatile("s_waitcnt lgkmcnt(0)" ::: "memory"); SBAR(); } while (0)
#define PV_TILE(vb, q0, q1, q2, q3, C0, C1, C2, C3) do { \
    s16x4 a0, a1, a2, a3; \
    SBAR(); VRD(0, 0, vb, a0, a1, a2, a3); C0; LW0(); VMM(0, q0, q1, a0, a1, a2, a3); SBAR(); \
    VRD(0, 1, vb, a0, a1, a2, a3);     LW0(); VMM(0, q2, q3, a0, a1, a2, a3); SBAR(); \
    VRD(1, 0, vb, a0, a1, a2, a3); C1; LW0(); VMM(1, q0, q1, a0, a1, a2, a3); SBAR(); \
    VRD(1, 1, vb, a0, a1, a2, a3);     LW0(); VMM(1, q2, q3, a0, a1, a2, a3); SBAR(); \
    VRD(2, 0, vb, a0, a1, a2, a3); C2; LW0(); VMM(2, q0, q1, a0, a1, a2, a3); SBAR(); \
    VRD(2, 1, vb, a0, a1, a2, a3);     LW0(); VMM(2, q2, q3, a0, a1, a2, a3); SBAR(); \
    VRD(3, 0, vb, a0, a1, a2, a3); C3; LW0(); VMM(3, q0, q1, a0, a1, a2, a3); SBAR(); \
    VRD(3, 1, vb, a0, a1, a2, a3);     LW0(); VMM(3, q2, q3, a0, a1, a2, a3); SBAR(); } while (0)
#define PK4(P, BASE, OUT) do { unsigned a0 = cvtpk(P[BASE + 0], P[BASE + 1]), a1 = cvtpk(P[BASE + 2], P[BASE + 3]);   \
    unsigned b0 = cvtpk(P[BASE + 4], P[BASE + 5]), b1 = cvtpk(P[BASE + 6], P[BASE + 7]);                              \
    auto r0 = __builtin_amdgcn_permlane32_swap(a0, b0, false, false); auto r1 = __builtin_amdgcn_permlane32_swap(a1, b1, false, false); \
    u32x4 w = {r0[0], r1[0], r0[1], r1[1]}; OUT = *reinterpret_cast<bf16x8*>(&w); } while (0)
#define E1(S0) do { _Pragma("unroll") for (int r = 0; r < 16; ++r) S0[r] = __builtin_amdgcn_exp2f(S0[r]); } while (0)
#define E3(S0, S1) do { float ps = 0; _Pragma("unroll") for (int r = 0; r < 16; ++r) ps += S0[r]; _Pragma("unroll") for (int r = 0; r < 16; ++r) ps += S1[r]; l_reg += ps; } while (0)
#define E4(S0, S1, n0, n1, n2, n3) do { PK4(S0, 0, n0); PK4(S0, 8, n1); PK4(S1, 0, n2); PK4(S1, 8, n3); } while (0)
#define ITER(SN0, SN1, ks, SP0, SP1, vs) do { \
    const int _vb = vb0 + (vs) * SLOT; \
    PV_TILE(_vb, p0, p1, p2, p3, E1(SP0), E1(SP1), E3(SP0, SP1), (void)0); \
    qkt(SN0, SN1, lds + (ks) * SLOT + SHM_KV, qr, r32, hi, m, negM); \
    E4(SP0, SP1, p0, p1, p2, p3); SBAR(); } while (0)
  f32x16 sA0, sA1, sB0, sB1; bf16x8 p0, p1, p2, p3; const int NT = seq / 64;
  SLOAD_DMA(0, 0); TILE_PUBLISH();
  SLOAD_DMA(64, 1);
  qkt(sA0, sA1, lds + SHM_KV, qr, r32, hi, m, negM);
  TILE_PUBLISH();
  if (2 < NT) SLOAD_DMA(2 * 64, 2);
  qkt(sB0, sB1, lds + SLOT + SHM_KV, qr, r32, hi, m, negM);
  E1(sA0); E1(sA1); E3(sA0, sA1); E4(sA0, sA1, p0, p1, p2, p3);
  TILE_PUBLISH();
  for (int i = 2; i < NT; i += 2) {
    SLOAD_DMA((i + 1) * 64, (i + 1) & 3);
    ITER(sA0, sA1, i & 3, sB0, sB1, (i - 2) & 3);
    TILE_PUBLISH();
    if (i + 2 < NT) SLOAD_DMA((i + 2) * 64, (i + 2) & 3);
    ITER(sB0, sB1, (i + 1) & 3, sA0, sA1, (i - 1) & 3);
    TILE_PUBLISH();
  }
  {
    const int _vb = vb0 + ((NT - 2) & 3) * SLOT;
    PV_TILE(_vb, p0, p1, p2, p3, E1(sB0), E1(sB1), E3(sB0, sB1), (void)0);
    E4(sB0, sB1, p0, p1, p2, p3); SBAR();
    const int _vb2 = vb0 + ((NT - 1) & 3) * SLOT;
    PV_TILE(_vb2, p0, p1, p2, p3, (void)0, (void)0, (void)0, (void)0);
  }
#undef SLOAD_DMA
#undef TILE_PUBLISH
#undef PKV
#undef PV_TILE
#undef VRD
#undef VMM
#undef LW4
#undef LW0
#undef PK4
#undef E1
#undef E3
#undef E4
#undef ITER
  int r32e = r32, hie = hi;
  asm volatile("" : "+v"(r32e), "+v"(hie));
  { auto rr = __builtin_amdgcn_permlane32_swap(__float_as_uint(l_reg), __float_as_uint(l_reg), false, false); l_reg = __uint_as_float(rr[0]) + __uint_as_float(rr[1]); }
  if (hie == 0) li_l[r32e] = l_reg;
  asm volatile("s_waitcnt lgkmcnt(0)" ::: "memory");
  float rli[16];
#pragma unroll
  for (int r = 0; r < 16; ++r) rli[r] = __builtin_amdgcn_rcpf(li_l[crow(r, hie)]);
  __syncthreads();
  float* comb = (float*)lds;
  if (m == 1) {
#pragma unroll
    for (int r = 0; r < 16; ++r)
#pragma unroll
      for (int d0 = 0; d0 < 4; ++d0) comb[(rg * 32 + crow(r, hie)) * 128 + d0 * 32 + r32e] = o[d0][r] * rli[r] * lam;
  }
  __syncthreads();
  if (m == 0) {
    float ss[16];
#pragma unroll
    for (int r = 0; r < 16; ++r) {
      float a = 0.f;
#pragma unroll
      for (int d0 = 0; d0 < 4; ++d0) {
        const float v = o[d0][r] * rli[r] - comb[(rg * 32 + crow(r, hie)) * 128 + d0 * 32 + r32e];
        o[d0][r] = v; a += v * v;
      }
      ss[r] = a;
    }
#pragma unroll
    for (int off = 1; off < 32; off <<= 1)
#pragma unroll
      for (int r = 0; r < 16; ++r) ss[r] += shx_f(ss[r], off, lane);
    const float om = 1.0f - lam_init;
    float gq[4];
#pragma unroll
    for (int d0 = 0; d0 < 4; ++d0) gq[d0] = ng[d0 * 32 + r32e] * om;
#pragma unroll
    for (int r = 0; r < 16; ++r) {
      const float rs = rsqrtf(ss[r] * (1.0f / 128.0f) + LN_EPS);
      bf16_t* cp = CATp + (size_t)(rg * 32 + crow(r, hie)) * 1536;
#pragma unroll
      for (int d0 = 0; d0 < 4; ++d0) cp[d0 * 32 + r32e] = f2h(o[d0][r] * rs * gq[d0]);
    }
  }
  __syncthreads();
}

__device__ __forceinline__ void sgu_unit(const Params& p, int chunk, int jl, char* lds, int tid_) {
  const int tid = tid_, wid = __builtin_amdgcn_readfirstlane(tid >> 6), lane = tid & 63, r32 = lane & 31, hi = lane >> 5;
  const int row0 = chunk * 128;
  const bf16_t* GV = (const bf16_t*)(p.ws + OFF_GV);
  const bf16_t* GU = (const bf16_t*)(p.ws + OFF_GU);
  bf16_t* CAT = (bf16_t*)(p.ws + OFF_CAT);
  const float* lg = PIN(p, sgu_ln_g) + (size_t)jl * 512;
  const float* lb = PIN(p, sgu_ln_b) + (size_t)jl * 512;
  {
    const f32x4 g0 = *(const f32x4*)(lg + lane * 8), g1 = *(const f32x4*)(lg + lane * 8 + 4);
    const f32x4 b0 = *(const f32x4*)(lb + lane * 8), b1 = *(const f32x4*)(lb + lane * 8 + 4);
    const int c = lane * 8, g = c >> 7, cg = c & 127;
    for (int q = wid; q < 128; q += 8) {
      const u32x4 w = *(const u32x4*)(GV + (size_t)(row0 + q) * 512 + c);
      float v[8];
#pragma unroll
      for (int i = 0; i < 4; ++i) { v[2 * i] = bflo(w[i]); v[2 * i + 1] = bfhi(w[i]); }
      float s = 0.f;
#pragma unroll
      for (int i = 0; i < 8; ++i) s += v[i];
      const float mu = wave_sum(s, lane) * (1.0f / 512.0f);
      float qq = 0.f;
#pragma unroll
      for (int i = 0; i < 8; ++i) { const float d = v[i] - mu; qq += d * d; }
      const float rstd = rsqrtf(wave_sum(qq, lane) * (1.0f / 512.0f) + LN_EPS);
      u32x4 ow;
      ow[0] = pk2((v[0] - mu) * rstd * g0[0] + b0[0], (v[1] - mu) * rstd * g0[1] + b0[1]);
      ow[1] = pk2((v[2] - mu) * rstd * g0[2] + b0[2], (v[3] - mu) * rstd * g0[3] + b0[3]);
      ow[2] = pk2((v[4] - mu) * rstd * g1[0] + b1[0], (v[5] - mu) * rstd * g1[1] + b1[1]);
      ow[3] = pk2((v[6] - mu) * rstd * g1[2] + b1[2], (v[7] - mu) * rstd * g1[3] + b1[3]);
      *(u32x4*)(lds + (g * 2 + (q >> 6)) * SHM_KV + v_st(q & 63, cg)) = ow;
    }
  }
  __syncthreads();
  const int pg = wid & 3, ch = wid >> 2;
  const int vbase = (int)(uintptr_t)lds + v_rd_base(lane);
  for (int g = 0; g < 4; ++g) {
    const float* Wg = PIN(p, sgu_w) + ((size_t)(jl * 4 + g) * 128) * 128;
    bf16x8 af[8];
#pragma unroll
    for (int ks = 0; ks < 8; ++ks) {
      const float* wp = Wg + (size_t)(pg * 32 + r32) * 128 + ks * 16 + hi * 8;
      const f32x4 a = *(const f32x4*)wp, b = *(const f32x4*)(wp + 4);
      u32x4 w = {pk2(a[0], a[1]), pk2(a[2], a[3]), pk2(b[0], b[1]), pk2(b[2], b[3])};
      af[ks] = *reinterpret_cast<bf16x8*>(&w);
    }
    f32x16 acc[2] = {};
#pragma unroll
    for (int kt = 0; kt < 2; ++kt) {
      const int vb = vbase + (g * 2 + kt) * SHM_KV;
      if (ch == 0) { pv_one_t<0>(acc[0], vb, af[kt * 4 + 0], af[kt * 4 + 1], af[kt * 4 + 2], af[kt * 4 + 3]); pv_one_t<1>(acc[1], vb, af[kt * 4 + 0], af[kt * 4 + 1], af[kt * 4 + 2], af[kt * 4 + 3]); }
      else         { pv_one_t<2>(acc[0], vb, af[kt * 4 + 0], af[kt * 4 + 1], af[kt * 4 + 2], af[kt * 4 + 3]); pv_one_t<3>(acc[1], vb, af[kt * 4 + 0], af[kt * 4 + 1], af[kt * 4 + 2], af[kt * 4 + 3]); }
    }
    const int pp = pg * 32 + r32;
    const float bb = (PIN(p, sgu_b) + (size_t)(jl * 4 + g) * 128)[pp];
    const bf16_t* gup = GU + (size_t)(row0 + pp) * 512 + g * 128 + ch * 64 + 4 * hi;
    bf16_t* cap = CAT + (size_t)(row0 + pp) * 1536 + 1024 + g * 128 + ch * 64 + 4 * hi;
#pragma unroll
    for (int dd = 0; dd < 2; ++dd)
#pragma unroll
      for (int q = 0; q < 4; ++q) {
        const u32x2 uw = *(const u32x2*)(gup + dd * 32 + q * 8);
        const float s0 = acc[dd][4 * q] + bb, s1 = acc[dd][4 * q + 1] + bb, s2 = acc[dd][4 * q + 2] + bb, s3 = acc[dd][4 * q + 3] + bb;
        u32x2 ow = {pk2h(bflo(uw[0]) * s0, bfhi(uw[0]) * s1), pk2h(bflo(uw[1]) * s2, bfhi(uw[1]) * s3)};
        *(u32x2*)(cap + dd * 32 + q * 8) = ow;
      }
  }
  __syncthreads();
}

__device__ void phase_mixer_fast(const Params& p, int layer, char* shm, int tid_) {
  const int jl = layer >> 1;
  const bool ctxq = layer == 0;
  const float lam = ((const float*)(p.ws + OFF_LAM))[jl * 2 + 0];
  const float lam_init = ((const float*)(p.ws + OFF_LAM))[jl * 2 + 1];
  const float* ng = PIN(p, diff_norm_g) + (size_t)jl * 128;
  const bf16_t* Q = (const bf16_t*)(p.ws + OFF_Q);
  const bf16_t* K = (const bf16_t*)(p.ws + OFF_K);
  const bf16_t* V = (const bf16_t*)(p.ws + OFF_V);
  bf16_t* CAT = (bf16_t*)(p.ws + OFF_CAT);
  const int bid = lbid();
  const int NC = ctxq ? 32 : 0;
  const int NS = ctxq ? (NTOK / 128) : (NLAT / 128);
  for (int u = bid; u < 1024 + NC + NS; u += gridDim.x) {
    if (u < 1024 + NC) {
      int bh, pos0, seq, orow;
      if (u < 1024) {
        const int xcd = u & 7, ul = (u >> 8) * 32 + ((u & 255) >> 3), qb = ul & 63;
        bh = xcd * 2 + (ul >> 6);
        pos0 = CTXL + qb * 128; seq = LKV; orow = (bh >> 3) * SEQ + qb * 128;
      } else {
        const int v = u - 1024, qb = v & 1;
        bh = v >> 1;
        pos0 = qb * 128; seq = CTXL; orow = NLAT + (bh >> 3) * CTXL + qb * 128;
      }
      const size_t hb = (size_t)bh * LKV * 128;
      attn_unit(Q + hb + (size_t)pos0 * 128, K + hb, V + hb, seq, CAT + (size_t)orow * 1536 + (bh & 7) * 128, ng, lam, lam_init, (const unsigned*)(p.ws + OFF_BAR + 256) + jl * 32 + bh * 2, shm, tid_);
    } else {
      sgu_unit(p, u - 1024 - NC, jl, shm, tid_);
    }
  }
}

__device__ __forceinline__ void ld8h(const bf16_t* p, float (&v)[8]) {
  const u32x4 w = *(const u32x4*)p;
#pragma unroll
  for (int i = 0; i < 4; ++i) { v[2 * i] = hlo(w[i]); v[2 * i + 1] = hhi(w[i]); }
}
__device__ void phase_pool(const Params& p, int nrows, int tid_) {
  const bf16_t* M1 = (const bf16_t*)(p.ws + OFF_M1);
  bf16_t* M2 = (bf16_t*)(p.ws + OFF_M2);
  const int nitems = (nrows >> 5) * 128;
  for (int it = lbid() * 512 + tid_; it < nitems; it += gridDim.x * 512) {
    const int cg = it & 127, seg = it >> 7;
    const int row0 = seg * 32;
    int base, T;
    if (row0 < NLAT) { base = row0 & ~(SEQ - 1); T = SEQ; } else { base = NLAT + ((row0 - NLAT) & ~255); T = CTXL; }
    const int t0 = row0 - base;
    const int h = 1 << (cg >> 5);
    const bf16_t* colp = M1 + (size_t)base * 1024 + cg * 8;
    float S[8];
#pragma unroll
    for (int i = 0; i < 8; ++i) S[i] = 0.f;
    {
      const int lo = t0 - h < 0 ? 0 : t0 - h, hi = t0 + h > T ? T : t0 + h;
      for (int q = lo; q < hi; ++q) { float v[8]; ld8h(colp + (size_t)q * 1024, v);
#pragma unroll
        for (int i = 0; i < 8; ++i) S[i] += v[i]; }
    }
    for (int t = t0; t < t0 + 32; ++t) {
      const int lo = t - h < 0 ? 0 : t - h, hi = t + h > T ? T : t + h;
      const float inv = 1.0f / (float)(hi - lo);
      float x[8];
      ld8h(colp + (size_t)t * 1024, x);
      u32x4 w;
#pragma unroll
      for (int i = 0; i < 4; ++i) w[i] = pk2h(S[2 * i] * inv - x[2 * i], S[2 * i + 1] * inv - x[2 * i + 1]);
      *(u32x4*)(M2 + (size_t)(base + t) * 1024 + cg * 8) = w;
      if (t + h < T) { float v[8]; ld8h(colp + (size_t)(t + h) * 1024, v);
#pragma unroll
        for (int i = 0; i < 8; ++i) S[i] += v[i]; }
      if (t - h >= 0) { float v[8]; ld8h(colp + (size_t)(t - h) * 1024, v);
#pragma unroll
        for (int i = 0; i < 8; ++i) S[i] -= v[i]; }
    }
  }
}

__device__ __forceinline__ void fp8x16_to_f32(const u32x4 w, float (&f)[16]) {
#pragma unroll
  for (int q = 0; q < 4; ++q) {
    const f32x2v lo = __builtin_amdgcn_cvt_pk_f32_fp8((int)w[q], false), hi = __builtin_amdgcn_cvt_pk_f32_fp8((int)w[q], true);
    f[4 * q] = lo[0]; f[4 * q + 1] = lo[1]; f[4 * q + 2] = hi[0]; f[4 * q + 3] = hi[1];
  }
}
#define PEER_LOAD_IDS_LO(dst, k) do { const int _t = wv + (k) * nwv; const i32x4* _ip = (const i32x4*)(IDX + ((size_t)g * NTOK + _t) * 16); dst##0 = _ip[0]; dst##1 = _ip[1]; } while (0)
#define PEER_LOAD_IDS_HI(dst, k) do { const int _t = wv + (k) * nwv; const i32x4* _ip = (const i32x4*)(IDX + ((size_t)g * NTOK + _t) * 16); dst##2 = _ip[2]; dst##3 = _ip[3]; } while (0)
#define PEER_ROW(TAB, id) (*(const u32x4*)((TAB) + (unsigned)(((id) << 7) | c16)))
#define PEER_GATHER_H0(buf, TAB, id) do { \
    buf[0] = PEER_ROW(TAB, id##0[0]); buf[1] = PEER_ROW(TAB, id##0[1]); buf[2] = PEER_ROW(TAB, id##0[2]); buf[3] = PEER_ROW(TAB, id##0[3]); \
    buf[4] = PEER_ROW(TAB, id##1[0]); buf[5] = PEER_ROW(TAB, id##1[1]); buf[6] = PEER_ROW(TAB, id##1[2]); buf[7] = PEER_ROW(TAB, id##1[3]); } while (0)
#define PEER_GATHER_H1(buf, TAB, id) do { \
    buf[0] = PEER_ROW(TAB, id##2[0]); buf[1] = PEER_ROW(TAB, id##2[1]); buf[2] = PEER_ROW(TAB, id##2[2]); buf[3] = PEER_ROW(TAB, id##2[3]); \
    buf[4] = PEER_ROW(TAB, id##3[0]); buf[5] = PEER_ROW(TAB, id##3[1]); buf[6] = PEER_ROW(TAB, id##3[2]); buf[7] = PEER_ROW(TAB, id##3[3]); } while (0)

__device__ void phase_peer_u(const Params& p, int layer, int nrows, int tid_) {
  const int tid = tid_, wid = __builtin_amdgcn_readfirstlane(tid >> 6), lane = tid & 63, bid = lbid();
  const int s = bid & 7, wv = (bid >> 3) * 8 + wid, nwv = (gridDim.x >> 3) * 8;
  const int g = lane >> 3, c = lane & 7, c16 = c * 16;
  const bool b2 = (lane & 4) != 0, b1 = (lane & 2) != 0, b0 = (lane & 1) != 0;
  const bf16_t* H = (const bf16_t*)(p.ws + OFF_HB) + s * 128 + c * 16;
  const unsigned char* U = (const unsigned char*)(p.ws + OFF_U8) + (size_t)(layer * 8 + s) * NEXP * 128;
  const int* IDX = (const int*)(p.ws + OFF_IDX);
  float* PART = (float*)(p.ws + OFF_PART);
  const int n = wv < nrows ? (nrows - wv + nwv - 1) / nwv : 0;
  if (n == 0) return;
  i32x4 id0, id1, id2, id3;
  u32x4 bufA[8], bufB[8], hn0, hn1;
  f32x2v h2[8];
#define PU_HLOAD(h0, h1, k) do { const int _t = wv + (k) * nwv; h0 = *(const u32x4*)(H + (size_t)_t * DM); h1 = *(const u32x4*)(H + (size_t)_t * DM + 8); } while (0)
#define PU_HCVT() do { _Pragma("unroll") for (int q = 0; q < 4; ++q) { h2[q] = (f32x2v){hlo(hn0[q]), hhi(hn0[q])}; h2[4 + q] = (f32x2v){hlo(hn1[q]), hhi(hn1[q])}; } } while (0)
#define PU_HALF(buf, base) do { \
    _Pragma("unroll") for (int i = 0; i < 8; ++i) { f32x2v a2 = {0.f, 0.f}; \
      _Pragma("unroll") for (int q = 0; q < 4; ++q) { \
        a2 = __builtin_elementwise_fma(h2[2 * q], __builtin_amdgcn_cvt_pk_f32_fp8((int)buf[i][q], false), a2); \
        a2 = __builtin_elementwise_fma(h2[2 * q + 1], __builtin_amdgcn_cvt_pk_f32_fp8((int)buf[i][q], true), a2); } \
      pd[(base) + i] = a2[0] + a2[1]; } } while (0)
  PEER_LOAD_IDS_LO(id, 0); PEER_LOAD_IDS_HI(id, 0);
  PEER_GATHER_H0(bufA, U, id); PU_HLOAD(hn0, hn1, 0);
  { const int k1 = n > 1 ? 1 : 0; PEER_LOAD_IDS_LO(id, k1); }
  PU_HCVT();
  for (int k = 0; k < n; ++k) {
    const int k1 = k + 1 < n ? k + 1 : k, k2 = k + 2 < n ? k + 2 : n - 1;
    PEER_GATHER_H1(bufB, U, id);
    __builtin_amdgcn_sched_barrier(0);
    PEER_LOAD_IDS_HI(id, k1);
    __builtin_amdgcn_sched_barrier(0);
    float pd[16];
    PU_HALF(bufA, 0);
    __builtin_amdgcn_sched_barrier(0);
    PEER_GATHER_H0(bufA, U, id); PU_HLOAD(hn0, hn1, k1);
    __builtin_amdgcn_sched_barrier(0);
    PEER_LOAD_IDS_LO(id, k2);
    __builtin_amdgcn_sched_barrier(0);
    PU_HALF(bufB, 8);
    float r8[8], r4[4], r2[2];
#pragma unroll
    for (int i = 0; i < 8; ++i) { const float keep = b2 ? pd[8 + i] : pd[i], send = b2 ? pd[i] : pd[8 + i]; r8[i] = keep + shx_f(send, 4, lane); }
#pragma unroll
    for (int i = 0; i < 4; ++i) { const float keep = b1 ? r8[4 + i] : r8[i], send = b1 ? r8[i] : r8[4 + i]; r4[i] = keep + shx_f(send, 2, lane); }
#pragma unroll
    for (int i = 0; i < 2; ++i) { const float keep = b0 ? r4[2 + i] : r4[i], send = b0 ? r4[i] : r4[2 + i]; r2[i] = keep + shx_f(send, 1, lane); }
    *(f32x2v*)(PART + ((size_t)(wv + k * nwv) * 8 + s) * 128 + lane * 2) = (f32x2v){r2[0] * (1.0f / 64.0f), r2[1] * (1.0f / 64.0f)};
    PU_HCVT();
    __builtin_amdgcn_sched_barrier(0);
  }
#undef PU_HLOAD
#undef PU_HCVT
#undef PU_HALF
}
__device__ void phase_peer_w(const Params& p, int nrows, int tid_) {
  const int wid = __builtin_amdgcn_readfirstlane(tid_ >> 6), lane = tid_ & 63;
  const float* PART = (const float*)(p.ws + OFF_PART);
  const float* GATE = (const float*)(p.ws + OFF_GATE);
  float* W = (float*)(p.ws + OFF_PW);
  for (int t = lbid() * 8 + wid; t < nrows; t += gridDim.x * 8) {
    f32x2v acc2 = {0.f, 0.f};
#pragma unroll
    for (int q = 0; q < 8; ++q) acc2 += *(const f32x2v*)(PART + ((size_t)t * 8 + q) * 128 + lane * 2);
    const f32x2v gt = *(const f32x2v*)(GATE + ((size_t)(lane >> 3) * NTOK + t) * 16 + (lane & 7) * 2);
    *(f32x2v*)(W + (size_t)t * 128 + lane * 2) = (f32x2v){gt[0] * gelu_tanh(acc2[0]), gt[1] * gelu_tanh(acc2[1])};
  }
}
__device__ void phase_peer_v(const Params& p, int layer, const hstream_t* XSin, hstream_t* Zout, int nrows, int tid_) {
  const int tid = tid_, wid = __builtin_amdgcn_readfirstlane(tid >> 6), lane = tid & 63, bid = lbid();
  const int s = bid & 7, wv = (bid >> 3) * 8 + wid, nwv = (gridDim.x >> 3) * 8;
  const int g = lane >> 3, c = lane & 7, c16 = c * 16;
  const bool b5 = (lane & 32) != 0, b4 = (lane & 16) != 0, b3 = (lane & 8) != 0;
  const unsigned char* Vt = (const unsigned char*)(p.ws + OFF_V8) + (size_t)(layer * 8 + s) * NEXP * 128;
  const int* IDX = (const int*)(p.ws + OFF_IDX);
  const float* W = (const float*)(p.ws + OFF_PW);
  const int col = s * 128 + c * 16 + g * 2;
  const int n = wv < nrows ? (nrows - wv + nwv - 1) / nwv : 0;
  if (n == 0) return;
  i32x4 id0, id1, id2, id3;
  u32x4 bufA[8], bufB[8];
  f32x2v wc2, wn2;
  unsigned xw;
#define PV_HALF(buf, base) do { \
    _Pragma("unroll") for (int i = 0; i < 8; ++i) { \
      const float w = shl_f((i & 1) ? wc2[1] : wc2[0], (lane & 56) + (((base) + i) >> 1)); \
      const f32x2v w2 = {w, w}; \
      _Pragma("unroll") for (int q = 0; q < 4; ++q) { \
        o2[2 * q] = __builtin_elementwise_fma(w2, __builtin_amdgcn_cvt_pk_f32_fp8((int)buf[i][q], false), o2[2 * q]); \
        o2[2 * q + 1] = __builtin_elementwise_fma(w2, __builtin_amdgcn_cvt_pk_f32_fp8((int)buf[i][q], true), o2[2 * q + 1]); } } } while (0)
  PEER_LOAD_IDS_LO(id, 0); PEER_LOAD_IDS_HI(id, 0);
  PEER_GATHER_H0(bufA, Vt, id);
  wc2 = *(const f32x2v*)(W + (size_t)wv * 128 + lane * 2);
  { const int k1 = n > 1 ? 1 : 0; PEER_LOAD_IDS_LO(id, k1); }
  for (int k = 0; k < n; ++k) {
    const int k1 = k + 1 < n ? k + 1 : k, k2 = k + 2 < n ? k + 2 : n - 1;
    const int t = wv + k * nwv;
    PEER_GATHER_H1(bufB, Vt, id);
    __builtin_amdgcn_sched_barrier(0);
    PEER_LOAD_IDS_HI(id, k1);
    xw = *(const unsigned*)(XSin + (size_t)t * DM + col);
    __builtin_amdgcn_sched_barrier(0);
    f32x2v o2[8];
#pragma unroll
    for (int j = 0; j < 8; ++j) o2[j] = (f32x2v){0.f, 0.f};
    PV_HALF(bufA, 0);
    __builtin_amdgcn_sched_barrier(0);
    PEER_GATHER_H0(bufA, Vt, id);
    wn2 = *(const f32x2v*)(W + (size_t)(wv + k1 * nwv) * 128 + lane * 2);
    __builtin_amdgcn_sched_barrier(0);
    PEER_LOAD_IDS_LO(id, k2);
    __builtin_amdgcn_sched_barrier(0);
    PV_HALF(bufB, 8);
    float r8[8], r4[4], r2[2];
#pragma unroll
    for (int i = 0; i < 8; ++i) { const float lo_ = o2[i >> 1][i & 1], hi_ = o2[4 + (i >> 1)][i & 1]; const float keep = b5 ? hi_ : lo_, send = b5 ? lo_ : hi_; r8[i] = keep + shx_f(send, 32, lane); }
#pragma unroll
    for (int i = 0; i < 4; ++i) { const float keep = b4 ? r8[4 + i] : r8[i], send = b4 ? r8[i] : r8[4 + i]; r4[i] = keep + shx_f(send, 16, lane); }
#pragma unroll
    for (int i = 0; i < 2; ++i) { const float keep = b3 ? r4[2 + i] : r4[i], send = b3 ? r4[i] : r4[2 + i]; r2[i] = keep + shx_f(send, 8, lane); }
    const f32x2v g2 = *(const f32x2v*)(mod_ptr(p, layer, who_of_row(t), 5) + col);
    *(unsigned*)(Zout + (size_t)t * DM + col) = pk2h(ALPHA * hlo(xw) + g2[0] * r2[0] * 0.125f, ALPHA * hhi(xw) + g2[1] * r2[1] * 0.125f);
    wc2 = wn2;
    __builtin_amdgcn_sched_barrier(0);
  }
#undef PV_HALF
}

constexpr int NSTEP = 9;
constexpr int NPHASE = 2 + NSTEP * DEPTH;

__device__ void run_phase(const Params& pin, int ph, char* shm, int tid_) {
  Params p = pin;
  { unsigned zoff = 0; asm volatile("" : "+s"(zoff));
    p.ws = pin.ws + zoff; }
  if (ph == 0) { phase_prologue_a(p, shm, tid_); return; }
  if (ph == 1) { phase_prologue_b(p, tid_); return; }
  const int layer = (ph - 2) / NSTEP, step = (ph - 2) % NSTEP;
  const bool even = (layer & 1) == 0;
  const int jl = layer >> 1;
  const bool ctx_out = layer < 2;
  const int nrows = ctx_out ? NTOK : NLAT;
  const int mt_upd = nrows / 256;
  hstream_t* XSA = (hstream_t*)(p.ws + OFF_XSA);
  hstream_t* XSB = (hstream_t*)(p.ws + OFF_XSB);
  hstream_t* Z = (hstream_t*)(p.ws + OFF_Z);
  const bf16_t* H = (const bf16_t*)(p.ws + OFF_H);
  const float* modl = (const float*)(p.ws + OFF_MOD) + (size_t)layer * 3 * 6144;
  if (step == 0) {
    if (even) {
      EpiInProj e{(bf16_t*)(p.ws + OFF_Q), (bf16_t*)(p.ws + OFF_K), (bf16_t*)(p.ws + OFF_V), (bf16_t*)(p.ws + OFF_GU), (bf16_t*)(p.ws + OFF_GV),
                  (const float*)(p.ws + OFF_ROPE), (unsigned*)(p.ws + OFF_BAR + 256) + jl * 32};
      const int mt = (layer <= 2) ? NTOK / 256 : NLAT / 256;
      gemm_phase<true>(H, (const bf16_t*)(p.ws + OFF_WIN) + (size_t)jl * 4096 * 1024, NLAT / 256, (mt * 256) - NLAT, 16, 1024, e, shm, tid_);
    } else {
      EpiBf16Store e{(bf16_t*)(p.ws + OFF_M1), 1024};
      gemm_phase<true>(H, (const bf16_t*)(p.ws + OFF_PIN) + (size_t)jl * 1024 * 1024, NLAT / 256, nrows - NLAT, 4, 1024, e, shm, tid_);
    }
  } else if (step == 1) {
    if (even) phase_mixer_fast(p, layer, shm, tid_);
    else phase_pool(p, nrows, tid_);
  } else if (step == 2) {
    EpiResid e{XSA, Z, modl, 2};
    if (even) gemm_phase<true>((const bf16_t*)(p.ws + OFF_CAT), (const bf16_t*)(p.ws + OFF_WOUT) + (size_t)jl * 1024 * 1536, NLAT / 256, nrows - NLAT, 4, 1536, e, shm, tid_);
    else gemm_phase<true>((const bf16_t*)(p.ws + OFF_M2), (const bf16_t*)(p.ws + OFF_POUT) + (size_t)jl * 1024 * 1024, NLAT / 256, nrows - NLAT, 4, 1024, e, shm, tid_);
  } else if (step == 3) {
    phase_ln(p, Z, XSB, layer, 0, nrows, (bf16_t*)(p.ws + OFF_HB), layer, 3, nrows, false, tid_);
  } else if (step == 4) {
    EpiTopK e{(int*)(p.ws + OFF_IDX), (float*)(p.ws + OFF_GATE)};
    gemm_phase<true>((const bf16_t*)(p.ws + OFF_HB), (const bf16_t*)(p.ws + OFF_WQK) + (size_t)layer * 2048 * 1024, NLAT / 256, nrows - NLAT, 8, 1024, e, shm, tid_);
  } else if (step == 5) {
    phase_peer_u(p, layer, nrows, tid_);
  } else if (step == 6) {
    phase_peer_w(p, nrows, tid_);
  } else if (step == 7) {
    phase_peer_v(p, layer, XSB, Z, nrows, tid_);
  } else {
    const int nl = layer + 1;
    const int nrows_next = (nl <= 2) ? NTOK : NLAT;
    phase_ln(p, Z, XSA, layer, 1, nrows, (bf16_t*)(p.ws + OFF_H), nl, 0, nrows_next < nrows ? nrows_next : nrows, layer == DEPTH - 1, tid_);
  }
}

#define XB_XCNT(j) (64 * (j))
#define XB_XSUB(j) (512 + 64 * (j))
#define XB_XGEN(j) (1024 + 64 * (j))
#define XB_TOP 1536
#define XB_TOPGEN 1600
#define XB_WORDS 1664
__device__ __forceinline__ unsigned xb_ld(unsigned* p) { return __hip_atomic_load(p, __ATOMIC_RELAXED, __HIP_MEMORY_SCOPE_AGENT); }
__device__ __forceinline__ unsigned xb_add(unsigned* p, unsigned v) { return __hip_atomic_fetch_add(p, v, __ATOMIC_RELAXED, __HIP_MEMORY_SCOPE_AGENT); }
__device__ __forceinline__ void grid_barrier(unsigned* bar, int xcc, unsigned nloc, unsigned nx, int tid_) {
  asm volatile("s_waitcnt vmcnt(0) lgkmcnt(0)" ::: "memory");
  __syncthreads();
  if (tid_ == 0) {
    const unsigned old = xb_add(&bar[XB_XSUB(xcc)], 1u);
    const unsigned gen = old / nloc;
    if (old + 1u == (gen + 1u) * nloc) {
      __builtin_amdgcn_fence(__ATOMIC_RELEASE, "agent");
      asm volatile("s_waitcnt vmcnt(0)" ::: "memory");
      const unsigned og = xb_add(&bar[XB_TOP], 1u);
      const unsigned tg = og / nx;
      if (og + 1u == (tg + 1u) * nx) xb_add(&bar[XB_TOPGEN], 1u);
      else while (xb_ld(&bar[XB_TOPGEN]) == tg) __builtin_amdgcn_s_sleep(1);
      __builtin_amdgcn_fence(__ATOMIC_ACQUIRE, "agent");
      xb_add(&bar[XB_XGEN(xcc)], 1u);
      asm volatile("s_waitcnt vmcnt(0)" ::: "memory");
    } else {
      while (xb_ld(&bar[XB_XGEN(xcc)]) == gen) __builtin_amdgcn_s_sleep(1);
      __builtin_amdgcn_fence(__ATOMIC_ACQUIRE, "agent");
      asm volatile("s_waitcnt vmcnt(0)" ::: "memory");
    }
  }
  __syncthreads();
}

__device__ __forceinline__ int phase_cat(int ph) {
  if (ph < 2) return 0;
  const int layer = (ph - 2) / NSTEP, step = (ph - 2) % NSTEP;
  const bool even = (layer & 1) == 0;
  if (step == 0) return even ? 1 : 7;
  if (step == 1) return even ? 2 : 8;
  if (step == 2) return 3;
  if (step == 3) return 4;
  if (step == 4) return 5;
  if (step == 5) return 6;
  if (step == 6) return 12;
  if (step == 7) return 10;
  return 11;
}

__global__ void __launch_bounds__(512) mega(KArgs ka, int ph_lo, int ph_hi) {
  Params p;
  p.in = (const float* const*)__builtin_amdgcn_kernarg_segment_ptr();
  p.out = ka.out; p.ws = ka.ws;
  __shared__ __attribute__((aligned(1024))) char shm[LDS_BYTES];
  cg::grid_group grid = cg::this_grid();
  unsigned* bar = (unsigned*)(p.ws + OFF_BAR + 512);
  int rep = 0;
  const int swid = __builtin_amdgcn_readfirstlane((int)(threadIdx.x >> 6));
  const int my_xcc = (int)(__builtin_amdgcn_s_getreg((3 << 11) | 20) & 0x7);
  if (threadIdx.x == 0) xb_add(&bar[XB_XCNT(my_xcc)], 1u);
  unsigned nloc = 1, nx = 1;
  for (int ph = ph_lo; ph < ph_hi;) {
    run_phase(p, ph, shm, make_tid(swid));
    bool again = false;
#ifdef DUP_CAT
    if (phase_cat(ph) == DUP_CAT && rep == 0) again = true;
#endif
    if (again || ph + 1 < ph_hi) {
      if (ph == ph_lo && !again && rep == 0) {
        grid.sync();
        unsigned cnt = 0, mine = 0;
#pragma unroll
        for (int j = 0; j < 8; ++j) { const unsigned c = xb_ld(&bar[XB_XCNT(j)]); cnt += c > 0u ? 1u : 0u; mine = j == my_xcc ? c : mine; }
        nloc = __builtin_amdgcn_readfirstlane(mine > 0u ? mine : 1u); nx = __builtin_amdgcn_readfirstlane(cnt > 0u ? cnt : 1u);
      } else grid_barrier(bar, my_xcc, nloc, nx, make_tid(swid));
    }
    if (again) rep = 1; else { rep = 0; ++ph; }
  }
}

extern "C" void kernel_launch(void* const* d_in, const int* in_sizes, int n_in, void* d_out, int out_size, void* d_ws, size_t ws_size,
                              hipStream_t stream) {
  static int grid_blocks = 0;
  if (!grid_blocks) {
    int dev = 0, cus = 0, per_cu = 0;
    (void)hipGetDevice(&dev);
    (void)hipDeviceGetAttribute(&cus, hipDeviceAttributeMultiprocessorCount, dev);
    (void)hipOccupancyMaxActiveBlocksPerMultiprocessor(&per_cu, mega, 512, 0);
    if (per_cu > 1) per_cu = 1;
    grid_blocks = cus * per_cu;
    if (ws_size < WS_END) fprintf(stderr, "kernel_launch: workspace too small: %zu < %zu\n", ws_size, (size_t)WS_END);
    if (grid_blocks <= 0) fprintf(stderr, "kernel_launch: occupancy query returned 0\n");
  }
  KArgs p{};
  for (int i = 0; i < 24; ++i) p.in[i] = (const float*)d_in[i];
  p.out = (float*)d_out;
  p.ws = (char*)d_ws;
  (void)hipMemsetAsync((char*)d_ws + OFF_BAR, 0, 512 + 8192, stream);
  int lo = 0, hi = NPHASE;
  void* args[] = {&p, &lo, &hi};
  hipError_t e = hipLaunchCooperativeKernel((void*)mega, dim3(grid_blocks), dim3(512), args, 0, stream);
  if (e != hipSuccess) fprintf(stderr, "cooperative launch failed: %s (grid %d)\n", hipGetErrorString(e), grid_blocks);
}
```

```cpp
#include <hip/hip_runtime.h>
#include <hip/hip_cooperative_groups.h>
#include <cstdio>
#include <cstdint>
namespace cg = cooperative_groups;

typedef unsigned short bf16_t;
typedef short bf16x8 __attribute__((ext_vector_type(8)));
typedef float f32x4 __attribute__((ext_vector_type(4)));
typedef unsigned u32x4 __attribute__((ext_vector_type(4)));
typedef unsigned u32x2 __attribute__((ext_vector_type(2)));
typedef float f32x2v __attribute__((ext_vector_type(2)));
typedef __bf16 bf16x2_t __attribute__((ext_vector_type(2)));

constexpr int DM = 1024, NBATCH = 2, SEQ = 8192, CTXL = 256, DEPTH = 4;
constexpr int NLAT = NBATCH * SEQ;
constexpr int NCTX = NBATCH * CTXL;
constexpr int NTOK = NLAT + NCTX;
constexpr int LKV = CTXL + SEQ;
constexpr int NH = 8;
constexpr int NEXP = 16384;
constexpr float LN_EPS = 1e-5f;
constexpr float ALPHA = 1.6817928305074290f;
constexpr float QSCALE = 0.125f * 1.4426950408889634f;

constexpr size_t al256(size_t x) { return (x + 255) / 256 * 256; }
constexpr size_t SZ_TAB = (size_t)DEPTH * NEXP * DM;
constexpr size_t SZ_QKV = (size_t)NBATCH * NH * LKV * 128 * 2;
constexpr size_t SZ_XS = (size_t)NTOK * DM * 4;
constexpr size_t OFF_U8 = 0;
constexpr size_t OFF_V8 = OFF_U8 + SZ_TAB;
constexpr size_t OFF_Q = OFF_V8 + SZ_TAB;
constexpr size_t OFF_K = OFF_Q + SZ_QKV;
constexpr size_t OFF_V = OFF_K + SZ_QKV;
constexpr size_t OFF_XSA = OFF_V + SZ_QKV;
constexpr size_t OFF_XSB = OFF_XSA + SZ_XS;
constexpr size_t OFF_Z = OFF_XSB + SZ_XS;
constexpr size_t OFF_H = OFF_Z + SZ_XS;
constexpr size_t OFF_HB = OFF_H + (size_t)NTOK * DM * 2;
constexpr size_t OFF_CAT = OFF_HB + (size_t)NTOK * DM * 2;
constexpr size_t OFF_GU = OFF_CAT + (size_t)NTOK * 1536 * 2;
constexpr size_t OFF_GV = OFF_GU + (size_t)NTOK * 512 * 2;
constexpr size_t OFF_M1 = OFF_GV + (size_t)NTOK * 512 * 2;
constexpr size_t OFF_M2 = OFF_M1 + (size_t)NTOK * DM * 2;
constexpr size_t OFF_SC = OFF_M2 + (size_t)NTOK * DM * 2;
constexpr size_t OFF_IDX = OFF_SC;
constexpr size_t OFF_GATE = OFF_IDX + (size_t)NTOK * 128 * 4;
constexpr size_t OFF_WIN = OFF_GATE + (size_t)NTOK * 128 * 4;
constexpr size_t OFF_WOUT = OFF_WIN + (size_t)2 * 4096 * 1024 * 2;
constexpr size_t OFF_PIN = OFF_WOUT + (size_t)2 * 1024 * 1536 * 2;
constexpr size_t OFF_POUT = OFF_PIN + (size_t)2 * 1024 * 1024 * 2;
constexpr size_t OFF_WQK = OFF_POUT + (size_t)2 * 1024 * 1024 * 2;
constexpr size_t OFF_MOD = OFF_WQK + (size_t)4 * 2048 * 1024 * 2;
constexpr size_t OFF_MODP = OFF_MOD + al256((size_t)4 * 3 * 6144 * 4);
constexpr size_t OFF_ROPE = OFF_MODP + al256((size_t)2 * 4 * 3 * 6144 * 4);
constexpr size_t OFF_LAM = OFF_ROPE + al256((size_t)128 * 16 * 2 * 4);
constexpr size_t OFF_PART = OFF_LAM + 256;
constexpr size_t OFF_PW = OFF_PART + (size_t)NTOK * 8 * 128 * 4;
constexpr size_t OFF_BAR = OFF_PW + (size_t)NTOK * 128 * 4;
constexpr size_t WS_END = OFF_BAR + 512 + 8192;

struct KArgs {
  const float* in[24];
  float* out;
  char* ws;
};
struct Params {
  const float* const* in;
  float* out;
  char* ws;
};
enum { IN_x, IN_c, IN_ctx, IN_c_ctx, IN_ada_w, IN_ada_b, IN_ln_g, IN_ln_b, IN_ab_w_in, IN_ab_w_out, IN_diff_lam, IN_diff_norm_g, IN_sgu_ln_g, IN_sgu_ln_b,
       IN_sgu_w, IN_sgu_b, IN_pool_w_in, IN_pool_w_grp, IN_pool_scale, IN_pool_w_out, IN_peer_wq, IN_peer_keys, IN_peer_u, IN_peer_v };
#define AS_GLOBAL(T, ptr) ((T)(__attribute__((address_space(1))) char*)(char*)(ptr))
#define PIN(p, name) AS_GLOBAL(const float*, (p).in[IN_##name])

constexpr int LDS_BYTES = 144 * 1024;

__device__ __forceinline__ int make_tid(int swid) {
  int t;
  asm volatile("v_mbcnt_lo_u32_b32 %0, -1, 0\n\tv_mbcnt_hi_u32_b32 %0, -1, %0" : "=v"(t));
  return (swid << 6) | t;
}
__device__ __forceinline__ int lbid() { int b = blockIdx.x; asm volatile("" : "+s"(b)); return b; }
__device__ __forceinline__ bf16_t f2bf(float f) {
  unsigned u = __float_as_uint(f);
  u += 0x7fffu + ((u >> 16) & 1u);
  return (bf16_t)(u >> 16);
}
__device__ __forceinline__ float bf2f(bf16_t b) { return __uint_as_float(((unsigned)b) << 16); }
__device__ __forceinline__ unsigned pk2(float lo, float hi) { return (unsigned)f2bf(lo) | ((unsigned)f2bf(hi) << 16); }
typedef _Float16 f16x8 __attribute__((ext_vector_type(8)));
typedef _Float16 f16x2 __attribute__((ext_vector_type(2)));
__device__ __forceinline__ unsigned pk2h(float lo, float hi) { const f16x2 v = {(_Float16)lo, (_Float16)hi}; return __builtin_bit_cast(unsigned, v); }
__device__ __forceinline__ float hlo(unsigned w) { return (float)__builtin_bit_cast(f16x2, w)[0]; }
__device__ __forceinline__ float hhi(unsigned w) { return (float)__builtin_bit_cast(f16x2, w)[1]; }
typedef _Float16 hstream_t;
__device__ __forceinline__ f32x4 ld4h(const hstream_t* p) { const u32x2 w = *(const u32x2*)p; return (f32x4){hlo(w[0]), hhi(w[0]), hlo(w[1]), hhi(w[1])}; }
__device__ __forceinline__ void st4h(hstream_t* p, f32x4 v) { *(u32x2*)p = (u32x2){pk2h(v[0], v[1]), pk2h(v[2], v[3])}; }
__device__ __forceinline__ bf16_t f2h(float f) { return __builtin_bit_cast(unsigned short, (_Float16)f); }
__device__ __forceinline__ float h2f(bf16_t b) { return (float)__builtin_bit_cast(_Float16, b); }
__device__ __forceinline__ float bflo(unsigned w) { return __uint_as_float(w << 16); }
__device__ __forceinline__ float bfhi(unsigned w) { return __uint_as_float(w & 0xffff0000u); }
__device__ __forceinline__ float gelu_tanh(float x) {
  const float u = 0.7978845608028654f * (x + 0.044715f * x * x * x);
  return x / (1.0f + __expf(-2.0f * u));
}
__device__ __forceinline__ float dot2bf(unsigned a, unsigned b, float c) {
  return __builtin_amdgcn_fdot2_f32_bf16(__builtin_bit_cast(bf16x2_t, a), __builtin_bit_cast(bf16x2_t, b), c, false);
}
__device__ __forceinline__ float shx_f(float v, int mask, int lane) { return __int_as_float(__builtin_amdgcn_ds_bpermute((lane ^ mask) << 2, __float_as_int(v))); }
__device__ __forceinline__ int shx_i(int v, int mask, int lane) { return __builtin_amdgcn_ds_bpermute((lane ^ mask) << 2, v); }
__device__ __forceinline__ float shl_f(float v, int src) { return __int_as_float(__builtin_amdgcn_ds_bpermute(src << 2, __float_as_int(v))); }
__device__ __forceinline__ float wave_sum(float v, int  ) {
#define DPP_ADD(ctrl, rmask) v += __int_as_float(__builtin_amdgcn_update_dpp(0, __float_as_int(v), ctrl, rmask, 0xf, false))
  DPP_ADD(0xB1, 0xf);
  DPP_ADD(0x4E, 0xf);
  DPP_ADD(0x141, 0xf);
  DPP_ADD(0x140, 0xf);
  DPP_ADD(0x142, 0xa);
  DPP_ADD(0x143, 0xc);
#undef DPP_ADD
  return __int_as_float(__builtin_amdgcn_readlane(__float_as_int(v), 63));
}
__device__ __forceinline__ int who_of_row(int row) { return row < NLAT ? (row >= SEQ ? 1 : 0) : 2; }
__device__ __forceinline__ const float* mod_ptr(const Params& p, int layer, int who, int which) {
  return (const float*)(p.ws + OFF_MOD) + ((size_t)(layer * 3 + who) * 6 + which) * 1024;
}
__device__ __forceinline__ void row_bpos(int row, int& b, int& pos) {
  if (row < NLAT) { b = row >> 13; pos = CTXL + (row & (SEQ - 1)); }
  else { const int r = row - NLAT; b = r >> 8; pos = r & 255; }
}

__device__ __forceinline__ int lds_byte2(int r, int c) {
  int st = (r >> 4) * 2 + (c >> 5), ob = (r & 15) * 64 + (c & 31) * 2;
  return st * 1024 + (ob ^ (((ob >> 9) & 1) << 5));
}
__device__ __forceinline__ void stage_rc2(int b, int& R, int& C) {
  int st = b >> 10, sb = b & 1023, swz = sb ^ (((sb >> 9) & 1) << 5);
  R = (st / 2) * 16 + swz / 64;
  C = (st % 2) * 32 + (swz % 64) / 2;
}
#define WAIT_V0() asm volatile("s_waitcnt vmcnt(0)" ::: "memory")

template <bool F16, int MFR, class Epi>
__device__ __forceinline__ void gemm_tile(const bf16_t* __restrict__ Arow0, const bf16_t* __restrict__ Bcol0, int row0, int pn, int K,
                                          const Epi& epi, char* shm, int tid_) {
  constexpr int BK = 32, TILE_B = 256 * BK * 2, STAGE_B = 2 * TILE_B;
  constexpr int LPS = MFR == 8 ? 4 : 3;
  const int tid = tid_, wid = __builtin_amdgcn_readfirstlane(tid >> 6), lane = tid & 63, wr = wid >> 2, wc = wid & 3, fr = lane & 15, fq = lane >> 4;
  const int sb_ = lane * 16, swz_ = sb_ ^ (((sb_ >> 9) & 1) << 5);
  const int C0 = (swz_ % 64) / 2;
  const int R0b = wid * 16 + swz_ / 64;
  const int R0a = (MFR == 8 ? wid : (wid & 3)) * 16 + swz_ / 64;
  const char* Ab = (const char*)Arow0 + (unsigned)(R0a * K + C0) * 2u;
  const char* Bb = (const char*)Bcol0 + (unsigned)(R0b * K + C0) * 2u;
  const int ob_ = fr * 64 + fq * 16, frag_swz = ob_ ^ (((ob_ >> 9) & 1) << 5);
  const int a_base = wr * (MFR * 1024) + frag_swz, b_base = wc * 4096 + frag_swz;
  const int nt = K / BK;
  f32x4 acc[MFR][4];
#pragma unroll
  for (int m = 0; m < MFR; ++m)
#pragma unroll
    for (int n = 0; n < 4; ++n) acc[m][n] = (f32x4){0.f, 0.f, 0.f, 0.f};
  typename Epi::template Pre<MFR> pre;
  epi.template preload<MFR>(pre, row0, pn, wr, wc, fr, fq);
#define GLDS_STAGE(buf, kt)                                                                                                               \
  do {                                                                                                                                    \
    if (MFR == 8) {                                                                                                                       \
      _Pragma("unroll") for (int i = 0; i < 2; ++i)                                                                                       \
        __builtin_amdgcn_global_load_lds((const unsigned*)(Ab + (size_t)(i * 128) * K * 2 + (kt) * (BK * 2)),                           \
                                         (unsigned*)(shm + (buf) * STAGE_B + wid * 1024 + i * 8192), 16, 0, 0);                           \
    } else {                                                                                                                              \
      __builtin_amdgcn_global_load_lds((const unsigned*)(Ab + (kt) * (BK * 2)), (unsigned*)(shm + (buf) * STAGE_B + (wid & 3) * 1024), 16, 0, 0); \
    }                                                                                                                                     \
    _Pragma("unroll") for (int i = 0; i < 2; ++i)                                                                                         \
      __builtin_amdgcn_global_load_lds((const unsigned*)(Bb + (size_t)(i * 128) * K * 2 + (kt) * (BK * 2)),                             \
                                       (unsigned*)(shm + (buf) * STAGE_B + TILE_B + wid * 1024 + i * 8192), 16, 0, 0);                    \
  } while (0)
#define RAW_BARRIER() do { asm volatile("s_waitcnt lgkmcnt(0)" ::: "memory"); __builtin_amdgcn_s_barrier(); } while (0)
#define WAIT_2STAGES() do { if (LPS == 4) asm volatile("s_waitcnt vmcnt(8)" ::: "memory"); else asm volatile("s_waitcnt vmcnt(6)" ::: "memory"); } while (0)
#define WAIT_1STAGE() do { if (LPS == 4) asm volatile("s_waitcnt vmcnt(4)" ::: "memory"); else asm volatile("s_waitcnt vmcnt(3)" ::: "memory"); } while (0)
  GLDS_STAGE(0, 0); GLDS_STAGE(1, 1); GLDS_STAGE(2, 2);
  WAIT_2STAGES();
  RAW_BARRIER();
  for (int t = 0; t < nt; ++t) {
    if (t + 3 < nt) GLDS_STAGE((t + 3) & 3, t + 3);
    const char* sa = shm + (t & 3) * STAGE_B;
    const char* sb = sa + TILE_B;
    {
      bf16x8 At[MFR], Bf[4];
#pragma unroll
      for (int m = 0; m < MFR; ++m) At[m] = *(const bf16x8*)(sa + a_base + m * 1024);
#pragma unroll
      for (int n = 0; n < 4; ++n) Bf[n] = *(const bf16x8*)(sb + b_base + n * 1024);
#pragma unroll
      for (int m = 0; m < MFR; ++m)
#pragma unroll
        for (int n = 0; n < 4; ++n) {
          if (F16) acc[m][n] = __builtin_amdgcn_mfma_f32_16x16x32_f16(__builtin_bit_cast(f16x8, Bf[n]), __builtin_bit_cast(f16x8, At[m]), acc[m][n], 0, 0, 0);
          else acc[m][n] = __builtin_amdgcn_mfma_f32_16x16x32_bf16(Bf[n], At[m], acc[m][n], 0, 0, 0);
        }
    }
    if (t + 3 < nt) WAIT_2STAGES();
    else if (t + 2 < nt) WAIT_1STAGE();
    else asm volatile("s_waitcnt vmcnt(0)" ::: "memory");
    RAW_BARRIER();
  }
#undef GLDS_STAGE
#undef RAW_BARRIER
#undef WAIT_2STAGES
#undef WAIT_1STAGE
  epi.template run<MFR>(acc, pre, row0, pn, wr, wc, fr, fq, shm, tid_);
}

template <bool F16 = false, class Epi>
__device__ __forceinline__ void gemm_phase(const bf16_t* __restrict__ A, const bf16_t* __restrict__ Bt, int mt_big, int small_rows, int ntiles, int K,
                                           const Epi& epi, char* shm, int tid_) {
  const int nu_big = ((mt_big + 7) >> 3) * ntiles * 8, nu_small = (small_rows >> 6) * ntiles;
  int u = lbid();
  for (; u < nu_big; u += gridDim.x) {
    const int xcd = u & 7, v = u >> 3;
    const int pn = v % ntiles, pm = (v / ntiles) * 8 + xcd;
    if (pm >= mt_big) continue;
    gemm_tile<F16, 8>(A + (size_t)pm * 256 * K, Bt + (size_t)pn * 256 * K, pm * 256, pn, K, epi, shm, tid_);
  }
  for (; u < nu_big + nu_small; u += gridDim.x) {
    const int w = u - nu_big, pn = w % ntiles, row0 = mt_big * 256 + (w / ntiles) * 64;
    gemm_tile<F16, 2>(A + (size_t)row0 * K, Bt + (size_t)pn * 256 * K, row0, pn, K, epi, shm, tid_);
  }
}

struct EpiInProj {
  bf16_t *Q, *K, *V, *GU, *GV;
  const float* rope;
  unsigned* KMAX;
  template <int MFR> struct Pre {};
  template <int MFR> __device__ __forceinline__ void preload(Pre<MFR>&, int, int, int, int, int, int) const {}
  template <int MFR>
  __device__ __forceinline__ void run(const f32x4 (&acc)[MFR][4], const Pre<MFR>&, int row0, int pn, int wr, int wc, int fr, int fq, char*, int) const {
    const int region = pn >> 2;
    const int lane = fq * 16 + fr;
    float kn2 = 0.f, kmax2 = 0.f;
#pragma unroll
    for (int m = 0; m < MFR; ++m) {
      const int row = row0 + wr * (16 * MFR) + m * 16 + fr;
      int b, pos;
      row_bpos(row, b, pos);
      if (region <= 1) {
        bf16_t* dst = region == 0 ? Q : K;
        const int head = (pn & 3) * 2 + (wc >> 1), msub = wc & 1;
        bf16_t* rp = dst + ((size_t)(b * NH + head) * LKV + pos) * 128 + msub * 64;
        const bool lat = row < NLAT;
        const int t = row & (SEQ - 1);
        const int prow = t >> 6, pcol = t & 63;
#pragma unroll
        for (int n = 0; n < 2; ++n) {
          float oa[4], ob[4];
          if (n == 0) kn2 = 0.f;
          const int pp = (n == 0) ? prow : pcol;
          const f32x4 r0 = lat ? *(const f32x4*)(rope + (pp * 16 + fq * 4) * 2) : (f32x4){1.f, 0.f, 1.f, 0.f};
          const f32x4 r1 = lat ? *(const f32x4*)(rope + (pp * 16 + fq * 4) * 2 + 4) : (f32x4){1.f, 0.f, 1.f, 0.f};
          const float csv[4] = {r0[0], r0[2], r1[0], r1[2]}, snv[4] = {r0[1], r0[3], r1[1], r1[3]};
#pragma unroll
          for (int j = 0; j < 4; ++j) {
            const float a = acc[m][n][j], bb = acc[m][n + 2][j];
            oa[j] = a * csv[j] - bb * snv[j];
            ob[j] = a * snv[j] + bb * csv[j];
          }
          if (region == 0) {
#pragma unroll
            for (int j = 0; j < 4; ++j) { oa[j] *= QSCALE; ob[j] *= QSCALE; }
          } else {
#pragma unroll
            for (int j = 0; j < 4; ++j) kn2 += oa[j] * oa[j] + ob[j] * ob[j];
          }
          u32x2 wa = {pk2(oa[0], oa[1]), pk2(oa[2], oa[3])};
          u32x2 wb = {pk2(ob[0], ob[1]), pk2(ob[2], ob[3])};
          *(u32x2*)(rp + n * 16 + fq * 4) = wa;
          *(u32x2*)(rp + 32 + n * 16 + fq * 4) = wb;
        }
        if (region == 1) {
          kn2 += shx_f(kn2, 16, lane); kn2 += shx_f(kn2, 32, lane);
          kmax2 = fmaxf(kmax2, kn2);
        }
      } else if (region == 2) {
        const int head = (pn & 3) * 2 + (wc >> 1);
        bf16_t* rp = V + ((size_t)(b * NH + head) * LKV + pos) * 128 + (wc & 1) * 64;
#pragma unroll
        for (int n = 0; n < 4; ++n) {
          u32x2 w = {pk2(acc[m][n][0], acc[m][n][1]), pk2(acc[m][n][2], acc[m][n][3])};
          *(u32x2*)(rp + n * 16 + fq * 4) = w;
        }
      } else {
        const int isv = (pn >> 1) & 1;
        bf16_t* rp = (isv ? GV : GU) + (size_t)row * 512 + (pn & 1) * 256 + wc * 64;
#pragma unroll
        for (int n = 0; n < 4; ++n) {
          u32x2 w = {pk2(gelu_tanh(acc[m][n][0]), gelu_tanh(acc[m][n][1])), pk2(gelu_tanh(acc[m][n][2]), gelu_tanh(acc[m][n][3]))};
          *(u32x2*)(rp + n * 16 + fq * 4) = w;
        }
      }
      asm volatile("" ::: "memory");
    }
    if (region == 1) {
#pragma unroll
      for (int o = 1; o < 16; o <<= 1) kmax2 = fmaxf(kmax2, shx_f(kmax2, o, lane));
      if (lane == 0) {
        const int b = row0 < NLAT ? (row0 >> 13) : ((row0 - NLAT) >> 8);
        const int head = (pn & 3) * 2 + (wc >> 1), msub = wc & 1;
        atomicMax(KMAX + (b * NH + head) * 2 + msub, __float_as_uint(kmax2));
      }
    }
  }
};
struct EpiResid {
  const hstream_t* XS; hstream_t* Z; const float* modbase;
  int which;
  template <int MFR> struct Pre { u32x2 xs[MFR][4]; };
  template <int MFR> __device__ __forceinline__ void preload(Pre<MFR>& pre, int row0, int pn, int wr, int wc, int fr, int fq) const {
#pragma unroll
    for (int n = 0; n < 4; ++n)
#pragma unroll
      for (int m = 0; m < MFR; ++m)
        pre.xs[m][n] = *(const u32x2*)(XS + (size_t)(row0 + wr * (16 * MFR) + m * 16 + fr) * DM + pn * 256 + wc * 64 + n * 16 + fq * 4);
  }
  template <int MFR>
  __device__ __forceinline__ void run(const f32x4 (&acc)[MFR][4], const Pre<MFR>& pre, int row0, int pn, int wr, int wc, int fr, int fq, char*, int) const {
    const int who = row0 < SEQ ? 0 : (row0 < NLAT ? 1 : 2);
    const float* g = modbase + ((size_t)who * 6 + which) * 1024;
#pragma unroll
    for (int n = 0; n < 4; ++n) {
      const int col = pn * 256 + wc * 64 + n * 16 + fq * 4;
      const f32x4 gv = *(const f32x4*)(g + col);
#pragma unroll
      for (int m = 0; m < MFR; ++m) {
        const size_t off = (size_t)(row0 + wr * (16 * MFR) + m * 16 + fr) * DM + col;
        const u32x2 w = pre.xs[m][n];
        const f32x4 xs = {hlo(w[0]), hhi(w[0]), hlo(w[1]), hhi(w[1])};
        st4h(Z + off, xs * ALPHA + gv * acc[m][n]);
      }
    }
  }
};
struct EpiBf16Store {
  bf16_t* O; int ld;
  template <int MFR> struct Pre {};
  template <int MFR> __device__ __forceinline__ void preload(Pre<MFR>&, int, int, int, int, int, int) const {}
  template <int MFR>
  __device__ __forceinline__ void run(const f32x4 (&acc)[MFR][4], const Pre<MFR>&, int row0, int pn, int wr, int wc, int fr, int fq, char*, int) const {
#pragma unroll
    for (int m = 0; m < MFR; ++m) {
      bf16_t* rp = O + (size_t)(row0 + wr * (16 * MFR) + m * 16 + fr) * ld + pn * 256 + wc * 64;
#pragma unroll
      for (int n = 0; n < 4; ++n) {
        u32x2 w = {pk2h(acc[m][n][0], acc[m][n][1]), pk2h(acc[m][n][2], acc[m][n][3])};
        *(u32x2*)(rp + n * 16 + fq * 4) = w;
      }
    }
  }
};
#define FMX(a, b) __float_as_int(__builtin_fmaxf(__int_as_float(a), __int_as_float(b)))
#define FMN(a, b) __float_as_int(__builtin_fminf(__int_as_float(a), __int_as_float(b)))
#define CE(a, b) do { const int _h = FMX(a, b), _l = FMN(a, b); a = _h; b = _l; } while (0)
#define SORT16(v) do { CE(v[0], v[1]); CE(v[2], v[3]); CE(v[0], v[2]); CE(v[1], v[3]); CE(v[1], v[2]); CE(v[4], v[5]); CE(v[6], v[7]); CE(v[4], v[6]); CE(v[5], v[7]); CE(v[5], v[6]); CE(v[0], v[4]); CE(v[2], v[6]); CE(v[2], v[4]); CE(v[1], v[5]); CE(v[3], v[7]); CE(v[3], v[5]); CE(v[1], v[2]); CE(v[3], v[4]); CE(v[5], v[6]); CE(v[8], v[9]); CE(v[10], v[11]); CE(v[8], v[10]); CE(v[9], v[11]); CE(v[9], v[10]); CE(v[12], v[13]); CE(v[14], v[15]); CE(v[12], v[14]); CE(v[13], v[15]); CE(v[13], v[14]); CE(v[8], v[12]); CE(v[10], v[14]); CE(v[10], v[12]); CE(v[9], v[13]); CE(v[11], v[15]); CE(v[11], v[13]); CE(v[9], v[10]); CE(v[11], v[12]); CE(v[13], v[14]); CE(v[0], v[8]); CE(v[4], v[12]); CE(v[4], v[8]); CE(v[2], v[10]); CE(v[6], v[14]); CE(v[6], v[10]); CE(v[2], v[4]); CE(v[6], v[8]); CE(v[10], v[12]); CE(v[1], v[9]); CE(v[5], v[13]); CE(v[5], v[9]); CE(v[3], v[11]); CE(v[7], v[15]); CE(v[7], v[11]); CE(v[3], v[5]); CE(v[7], v[9]); CE(v[11], v[13]); CE(v[1], v[2]); CE(v[3], v[4]); CE(v[5], v[6]); CE(v[7], v[8]); CE(v[9], v[10]); CE(v[11], v[12]); CE(v[13], v[14]); } while (0)
#define BMERGE16(v) do { CE(v[0], v[8]); CE(v[1], v[9]); CE(v[2], v[10]); CE(v[3], v[11]); CE(v[4], v[12]); CE(v[5], v[13]); CE(v[6], v[14]); CE(v[7], v[15]); CE(v[0], v[4]); CE(v[1], v[5]); CE(v[2], v[6]); CE(v[3], v[7]); CE(v[8], v[12]); CE(v[9], v[13]); CE(v[10], v[14]); CE(v[11], v[15]); CE(v[0], v[2]); CE(v[1], v[3]); CE(v[4], v[6]); CE(v[5], v[7]); CE(v[8], v[10]); CE(v[9], v[11]); CE(v[12], v[14]); CE(v[13], v[15]); CE(v[0], v[1]); CE(v[2], v[3]); CE(v[4], v[5]); CE(v[6], v[7]); CE(v[8], v[9]); CE(v[10], v[11]); CE(v[12], v[13]); CE(v[14], v[15]); } while (0)
#define CAND_CHUNK0 do { T[0] = CK(0, 0); T[1] = CK(0, 1); T[2] = CK(0, 2); T[3] = CK(0, 3); T[4] = CK(0, 4); T[5] = CK(0, 5); T[6] = CK(0, 6); T[7] = CK(0, 7); T[8] = CK(0, 8); T[9] = CK(0, 9); T[10] = CK(0, 10); T[11] = CK(0, 11); T[12] = CK(0, 12); T[13] = CK(0, 13); T[14] = CK(0, 14); T[15] = CK(0, 15); } while (0)
#define CAND_CHUNK1 do { X[0] = CK(1, 0); X[1] = CK(1, 1); X[2] = CK(1, 2); X[3] = CK(1, 3); X[4] = CK(1, 4); X[5] = CK(1, 5); X[6] = CK(1, 6); X[7] = CK(1, 7); X[8] = CK(2, 0); X[9] = CK(2, 1); X[10] = CK(2, 2); X[11] = CK(2, 3); X[12] = CK(2, 4); X[13] = CK(3, 0); X[14] = CK(3, 1); X[15] = CK(3, 2); } while (0)
#define CAND_CHUNK2 do { X[0] = CK(3, 3); X[1] = CK(4, 0); X[2] = CK(4, 1); X[3] = CK(4, 2); X[4] = CK(5, 0); X[5] = CK(5, 1); X[6] = CK(6, 0); X[7] = CK(6, 1); X[8] = CK(7, 0); X[9] = CK(7, 1); X[10] = CK(8, 0); X[11] = CK(9, 0); X[12] = CK(10, 0); X[13] = CK(11, 0); X[14] = CK(12, 0); X[15] = CK(13, 0); } while (0)
#define CAND_CHUNK3 do { X[0] = CK(14, 0); X[1] = CK(15, 0); X[2] = (int)0xFF800000; X[3] = (int)0xFF800000; X[4] = (int)0xFF800000; X[5] = (int)0xFF800000; X[6] = (int)0xFF800000; X[7] = (int)0xFF800000; X[8] = (int)0xFF800000; X[9] = (int)0xFF800000; X[10] = (int)0xFF800000; X[11] = (int)0xFF800000; X[12] = (int)0xFF800000; X[13] = (int)0xFF800000; X[14] = (int)0xFF800000; X[15] = (int)0xFF800000; } while (0)

__device__ __forceinline__ int packkey7(float f, int idx) { return (__float_as_int(f) & ~0x7F) | (127 - idx); }
__device__ __forceinline__ float keyval7(int k) { return __int_as_float(k & ~0x7F); }
__device__ __forceinline__ int packkey8(float f, int pos) { return (__float_as_int(f) & ~0xFF) | (255 - pos); }
__device__ __forceinline__ float keyval8(int k) { return __int_as_float(k & ~0xFF); }
typedef int i32x4 __attribute__((ext_vector_type(4)));
#define LD16(dst, ptr) do { const i32x4 _a = *(const i32x4*)(ptr), _b = *(const i32x4*)((ptr) + 4), _c = *(const i32x4*)((ptr) + 8), _d = *(const i32x4*)((ptr) + 12); \
    dst[0] = _a[0]; dst[1] = _a[1]; dst[2] = _a[2]; dst[3] = _a[3]; dst[4] = _b[0]; dst[5] = _b[1]; dst[6] = _b[2]; dst[7] = _b[3];                                \
    dst[8] = _c[0]; dst[9] = _c[1]; dst[10] = _c[2]; dst[11] = _c[3]; dst[12] = _d[0]; dst[13] = _d[1]; dst[14] = _d[2]; dst[15] = _d[3]; } while (0)
#define ST16(ptr, src) do { *(i32x4*)(ptr) = (i32x4){src[0], src[1], src[2], src[3]}; *(i32x4*)((ptr) + 4) = (i32x4){src[4], src[5], src[6], src[7]};           \
    *(i32x4*)((ptr) + 8) = (i32x4){src[8], src[9], src[10], src[11]}; *(i32x4*)((ptr) + 12) = (i32x4){src[12], src[13], src[14], src[15]}; } while (0)
#define MERGE_TOP16(T, X) do { _Pragma("unroll") for (int _i = 0; _i < 16; ++_i) T[_i] = FMX(T[_i], X[15 - _i]); BMERGE16(T); } while (0)
struct EpiTopK {
  int* IDX; float* GATE;
  template <int MFR> struct Pre {};
  template <int MFR> __device__ __forceinline__ void preload(Pre<MFR>&, int, int, int, int, int, int) const {}
  template <int MFR>
  __device__ __forceinline__ void run(const f32x4 (&acc)[MFR][4], const Pre<MFR>&, int row0, int pn, int wr, int wc, int fr, int fq, char* shm, int tid_) const {
    constexpr int LST = 68, BM = 32 * MFR;
    int* lst = (int*)shm;
    const int tid = tid_, lane = tid_ & 63;
#pragma unroll
    for (int m = 0; m < MFR; ++m) {
      int T[16], X[16];
#pragma unroll
      for (int n = 0; n < 4; ++n)
#pragma unroll
        for (int j = 0; j < 4; ++j) T[n * 4 + j] = packkey7(acc[m][n][j], (wc & 1) * 64 + n * 16 + fq * 4 + j);
      SORT16(T);
#pragma unroll
      for (int i = 0; i < 16; ++i) { auto rr = __builtin_amdgcn_permlane16_swap(T[i], T[i], false, false); T[i] = rr[0]; X[i] = rr[1]; }
      MERGE_TOP16(T, X);
#pragma unroll
      for (int i = 0; i < 16; ++i) { auto rr = __builtin_amdgcn_permlane32_swap(T[i], T[i], false, false); T[i] = rr[0]; X[i] = rr[1]; }
      MERGE_TOP16(T, X);
      i32x4 w;
#pragma unroll
      for (int q = 0; q < 4; ++q) {
        const int m1 = -(fq & 1), m2 = -((fq >> 1) & 1);
        const int lo_ = (T[q] & ~m1) | (T[4 + q] & m1), hi_ = (T[8 + q] & ~m1) | (T[12 + q] & m1);
        w[q] = (lo_ & ~m2) | (hi_ & m2);
      }
      *(i32x4*)(lst + (wr * (16 * MFR) + m * 16 + fr) * LST + wc * 16 + fq * 4) = w;
    }
    __syncthreads();
    if (tid < 2 * BM) {
      const int row = tid & (BM - 1), pp = tid / BM;
      int T[16], X[16];
      LD16(T, lst + row * LST + pp * 32);
      LD16(X, lst + row * LST + pp * 32 + 16);
      MERGE_TOP16(T, X);
      ST16(lst + row * LST + pp * 32, T);
    }
    __syncthreads();
    if (tid < BM) {
      const int row = tid;
      int T[16], X[16];
      float a[16], b[16];
      LD16(T, lst + row * LST);
      LD16(X, lst + row * LST + 32);
#pragma unroll
      for (int i = 0; i < 16; ++i) { a[i] = keyval7(T[i]); b[i] = keyval7(X[i]); }
#define CK(i, j) packkey8(a[i] + b[j], (i) * 16 + (j))
      CAND_CHUNK0; SORT16(T);
      CAND_CHUNK1; SORT16(X); MERGE_TOP16(T, X);
      CAND_CHUNK2; SORT16(X); MERGE_TOP16(T, X);
      CAND_CHUNK3; SORT16(X); MERGE_TOP16(T, X);
#undef CK
      const float v0 = keyval8(T[0]);
      float e[16], sum = 0.f;
#pragma unroll
      for (int r = 0; r < 16; ++r) { e[r] = __expf(keyval8(T[r]) - v0); sum += e[r]; }
      const float inv = 1.0f / sum;
      const size_t go = ((size_t)pn * NTOK + (size_t)(row0 + row)) * 16;
#pragma unroll
      for (int r = 0; r < 16; ++r) {
        const int pos = 255 - (T[r] & 0xFF);
        const int ia = 127 - (lst[row * LST + (pos >> 4)] & 0x7F), ib = 127 - (lst[row * LST + 32 + (pos & 15)] & 0x7F);
        X[r] = ia * 128 + ib;
        e[r] *= inv;
      }
      ST16(IDX + go, X);
      *(f32x4*)(GATE + go) = (f32x4){e[0], e[1], e[2], e[3]}; *(f32x4*)(GATE + go + 4) = (f32x4){e[4], e[5], e[6], e[7]};
      *(f32x4*)(GATE + go + 8) = (f32x4){e[8], e[9], e[10], e[11]}; *(f32x4*)(GATE + go + 12) = (f32x4){e[12], e[13], e[14], e[15]};
    }
    __syncthreads();
  }
};

__device__ void transpose_unit(const float* __restrict__ W, bf16_t* __restrict__ Wt, int K, int N, int unit, char* shm, int tid_) {
  float* tl = (float*)shm;
  const int ntn = N / 64;
  const int k0 = (unit / ntn) * 64, n0 = (unit % ntn) * 64;
  const int tid = tid_;
#pragma unroll
  for (int i = 0; i < 8; ++i) {
    const int idx = tid + i * 512, r = idx >> 6, c = idx & 63;
    tl[r * 65 + c] = W[(size_t)(k0 + r) * N + n0 + c];
  }
  __syncthreads();
#pragma unroll
  for (int i = 0; i < 8; ++i) {
    const int idx = tid + i * 512, r = idx >> 6, c = idx & 63;
    Wt[(size_t)(n0 + r) * K + k0 + c] = f2h(tl[c * 65 + r]);
  }
  __syncthreads();
}

__device__ void foldqk_unit(const Params& p, int unit, char* shm, int tid_) {
  const int l = unit >> 8, hp = (unit >> 4) & 15, ct = unit & 15;
  float* kl = (float*)shm;
  float* wl = kl + 128 * 132;
  const float* keys = PIN(p, peer_keys) + ((size_t)(l * 16 + hp) * 128) * 128;
  const float* wq = PIN(p, peer_wq) + (size_t)l * 1024 * 2048;
  const int tid = tid_;
  for (int idx = tid; idx < 128 * 128; idx += 512) { const int k = idx >> 7, d = idx & 127; kl[d * 132 + k] = keys[k * 128 + d]; }
  for (int idx = tid; idx < 64 * 128; idx += 512) { const int c = idx >> 7, d = idx & 127; wl[d * 68 + c] = wq[(size_t)(ct * 64 + c) * 2048 + hp * 128 + d]; }
  __syncthreads();
  const int c0 = (tid & 15) * 4, k0 = (tid >> 4) * 4;
  f32x4 acc[4];
#pragma unroll
  for (int kk = 0; kk < 4; ++kk) acc[kk] = (f32x4){0.f, 0.f, 0.f, 0.f};
#pragma unroll 4
  for (int d = 0; d < 128; ++d) {
    const f32x4 a = *(const f32x4*)(wl + d * 68 + c0), bq = *(const f32x4*)(kl + d * 132 + k0);
#pragma unroll
    for (int kk = 0; kk < 4; ++kk) acc[kk] += a * bq[kk];
  }
  bf16_t* outp = (bf16_t*)(p.ws + OFF_WQK) + (size_t)l * 2048 * 1024;
#pragma unroll
  for (int kk = 0; kk < 4; ++kk) {
    u32x2 w = {pk2h(acc[kk][0], acc[kk][1]), pk2h(acc[kk][2], acc[kk][3])};
    *(u32x2*)(outp + (size_t)(hp * 128 + k0 + kk) * 1024 + ct * 64 + c0) = w;
  }
  __syncthreads();
}
__device__ void foldpool_unit(const Params& p, int unit, char* shm, int tid_) {
  const int j = unit >> 8, g = (unit >> 6) & 3, cit = (unit >> 4) & 3, et = unit & 15;
  float* gl = (float*)shm;
  float* ol = gl + 256 * 68;
  const float* wg = PIN(p, pool_w_grp) + ((size_t)(j * 4 + g) * 256) * 256;
  const float* sc = PIN(p, pool_scale) + (size_t)j * 1024 + g * 256;
  const float* wo = PIN(p, pool_w_out) + ((size_t)j * 1024 + g * 256) * 1024;
  const int tid = tid_;
  for (int idx = tid; idx < 64 * 256; idx += 512) { const int r = idx >> 8, m = idx & 255; gl[m * 68 + r] = wg[(size_t)(cit * 64 + r) * 256 + m] * sc[m]; }
  for (int idx = tid; idx < 256 * 64; idx += 512) { const int m = idx >> 6, e = idx & 63; ol[m * 68 + e] = wo[(size_t)m * 1024 + et * 64 + e]; }
  __syncthreads();
  const int ci0 = (tid & 31) * 2, e0 = (tid >> 5) * 4;
  f32x4 acc0 = {0.f, 0.f, 0.f, 0.f}, acc1 = {0.f, 0.f, 0.f, 0.f};
#pragma unroll 4
  for (int m = 0; m < 256; ++m) {
    const f32x2v a = *(const f32x2v*)(gl + m * 68 + ci0);
    const f32x4 bq = *(const f32x4*)(ol + m * 68 + e0);
    acc0 += bq * a[0]; acc1 += bq * a[1];
  }
  bf16_t* outp = (bf16_t*)(p.ws + OFF_POUT) + (size_t)j * 1024 * 1024;
#pragma unroll
  for (int ee = 0; ee < 4; ++ee)
    *(unsigned*)(outp + (size_t)(et * 64 + e0 + ee) * 1024 + g * 256 + cit * 64 + ci0) = pk2h(acc0[ee], acc1[ee]);
  __syncthreads();
}
__device__ void mod_unit(const Params& p, int unit, char* shm, int tid_) {
  const int l = unit / 48, rem = unit % 48, cgp = rem >> 1, kh = rem & 1;
  float* sv = (float*)shm;
  float* red = sv + 3 * 512;
  const int tid = tid_, lane = tid & 63, ks = __builtin_amdgcn_readfirstlane(tid >> 6);
  for (int idx = tid; idx < 3 * 512; idx += 512) {
    const int w = idx >> 9, k = kh * 512 + (idx & 511);
    const float xv = w < 2 ? PIN(p, c)[w * 1024 + k] : PIN(p, c_ctx)[k];
    sv[idx] = xv / (1.0f + __expf(-xv));
  }
  __syncthreads();
  const float* aw = PIN(p, ada_w) + (size_t)l * 1024 * 6144 + (size_t)(kh * 512 + ks * 64) * 6144 + cgp * 256 + lane * 4;
  f32x4 a0 = {0.f, 0.f, 0.f, 0.f}, a1 = a0, a2 = a0;
#pragma unroll 8
  for (int k = 0; k < 64; ++k) {
    const f32x4 w = *(const f32x4*)(aw + (size_t)k * 6144);
    a0 += w * sv[ks * 64 + k]; a1 += w * sv[512 + ks * 64 + k]; a2 += w * sv[1024 + ks * 64 + k];
  }
  *(f32x4*)(red + (ks * 3 + 0) * 256 + lane * 4) = a0; *(f32x4*)(red + (ks * 3 + 1) * 256 + lane * 4) = a1; *(f32x4*)(red + (ks * 3 + 2) * 256 + lane * 4) = a2;
  __syncthreads();
  for (int idx = tid; idx < 768; idx += 512) {
    const int w = idx >> 8, cc = idx & 255;
    float s = 0.f;
#pragma unroll
    for (int q = 0; q < 8; ++q) s += red[(q * 3 + w) * 256 + cc];
    const int n = cgp * 256 + cc;
    ((float*)(p.ws + OFF_MODP))[((size_t)kh * 12 + l * 3 + w) * 6144 + n] = s;
  }
  __syncthreads();
}

__device__ void phase_prologue_a(const Params& p, char* shm, int tid_) {
  constexpr int U_MOD = 192;
  constexpr int U_TWIN = 2 * 16 * 64, U_TWOUT = 2 * 24 * 16, U_TPIN = 2 * 16 * 16;
  constexpr int U_FQK = 1024, U_FP = 512, U_TAB = 2048, U_MISC = 1;
  constexpr int E0 = U_MOD, E1 = E0 + U_TWIN, E2 = E1 + U_TWOUT, E3 = E2 + U_TPIN, E4 = E3 + U_FQK, E5 = E4 + U_FP, E6 = E5 + U_TAB, E7 = E6 + U_MISC;
  for (int u = lbid(); u < E7; u += gridDim.x) {
    if (u < E0) mod_unit(p, u, shm, tid_);
    else if (u < E1) { const int v = u - E0, j = v / (16 * 64), r = v % (16 * 64);
      transpose_unit(PIN(p, ab_w_in) + (size_t)j * 1024 * 4096, (bf16_t*)(p.ws + OFF_WIN) + (size_t)j * 4096 * 1024, 1024, 4096, r, shm, tid_); }
    else if (u < E2) { const int v = u - E1, j = v / (24 * 16), r = v % (24 * 16);
      transpose_unit(PIN(p, ab_w_out) + (size_t)j * 1536 * 1024, (bf16_t*)(p.ws + OFF_WOUT) + (size_t)j * 1024 * 1536, 1536, 1024, r, shm, tid_); }
    else if (u < E3) { const int v = u - E2, j = v / 256, r = v % 256;
      transpose_unit(PIN(p, pool_w_in) + (size_t)j * 1024 * 1024, (bf16_t*)(p.ws + OFF_PIN) + (size_t)j * 1024 * 1024, 1024, 1024, r, shm, tid_); }
    else if (u < E4) foldqk_unit(p, u - E3, shm, tid_);
    else if (u < E5) foldpool_unit(p, u - E4, shm, tid_);
    else if (u < E6) {
      const int v = u - E5;
      const int tb = v >> 10;
      const float* src = tb ? PIN(p, peer_v) : PIN(p, peer_u);
      unsigned char* dst = (unsigned char*)(p.ws + (tb ? OFF_V8 : OFF_U8));
      const float scl = tb ? 8.0f : 64.0f;
      const int wid = __builtin_amdgcn_readfirstlane(tid_ >> 6), lane = tid_ & 63;
#pragma unroll 4
      for (int i = 0; i < 8; ++i) {
        const int row = (v & 1023) * 64 + i * 8 + wid;
        const int layer = row >> 14, e = row & 16383;
        const float* rp = src + (size_t)row * DM + lane * 16;
        const f32x4 a = *(const f32x4*)rp * scl, b = *(const f32x4*)(rp + 4) * scl, c = *(const f32x4*)(rp + 8) * scl, d = *(const f32x4*)(rp + 12) * scl;
        u32x4 w;
        w[0] = __builtin_amdgcn_cvt_pk_fp8_f32(a[2], a[3], __builtin_amdgcn_cvt_pk_fp8_f32(a[0], a[1], 0, false), true);
        w[1] = __builtin_amdgcn_cvt_pk_fp8_f32(b[2], b[3], __builtin_amdgcn_cvt_pk_fp8_f32(b[0], b[1], 0, false), true);
        w[2] = __builtin_amdgcn_cvt_pk_fp8_f32(c[2], c[3], __builtin_amdgcn_cvt_pk_fp8_f32(c[0], c[1], 0, false), true);
        w[3] = __builtin_amdgcn_cvt_pk_fp8_f32(d[2], d[3], __builtin_amdgcn_cvt_pk_fp8_f32(d[0], d[1], 0, false), true);
        *(u32x4*)(dst + ((size_t)(layer * 8 + (lane >> 3)) * NEXP + e) * 128 + (lane & 7) * 16) = w;
      }
    } else {
      float* rope = (float*)(p.ws + OFF_ROPE);
      for (int idx = tid_; idx < 128 * 16; idx += 512) {
        const int pos = idx >> 4, i = idx & 15;
        const float inv = powf(10000.0f, -(float)i / 16.0f);
        const float ang = (float)pos * inv;
        rope[idx * 2 + 0] = cosf(ang);
        rope[idx * 2 + 1] = sinf(ang);
      }
      if (tid_ < 2) {
        const int j = tid_;
        const float* lv = PIN(p, diff_lam) + (size_t)j * 4 * 64;
        float s1 = 0.f, s2 = 0.f;
        for (int d = 0; d < 64; ++d) { s1 += lv[d] * lv[64 + d]; s2 += lv[128 + d] * lv[192 + d]; }
        const float lam_init = 0.8f - 0.6f * expf(-0.3f * (float)(2 * j));
        float* lam = (float*)(p.ws + OFF_LAM);
        lam[j * 2 + 0] = expf(s1) - expf(s2) + lam_init;
        lam[j * 2 + 1] = lam_init;
      }
    }
  }
}

__device__ void phase_prologue_b(const Params& p, int tid_) {
  const int wid = __builtin_amdgcn_readfirstlane(tid_ >> 6), lane = tid_ & 63;
  {
    const float* mp = (const float*)(p.ws + OFF_MODP);
    float* md = (float*)(p.ws + OFF_MOD);
    for (int idx = lbid() * 512 + tid_; idx < 12 * 6144; idx += gridDim.x * 512) {
      const int l = idx / (3 * 6144), n = idx % 6144;
      md[idx] = mp[idx] + mp[12 * 6144 + idx] + PIN(p, ada_b)[(size_t)l * 6144 + n];
    }
  }
  hstream_t* XS = (hstream_t*)(p.ws + OFF_XSA);
  bf16_t* H = (bf16_t*)(p.ws + OFF_H);
  for (int row = lbid() * 8 + wid; row < NTOK; row += gridDim.x * 8) {
    const float* src = row < NLAT ? PIN(p, x) + (size_t)row * DM : PIN(p, ctx) + (size_t)(row - NLAT) * DM;
    const int who = who_of_row(row);
    const float* mp0 = (const float*)(p.ws + OFF_MODP) + (size_t)who * 6144;
    const float* mp1 = mp0 + 12 * 6144;
#pragma unroll
    for (int i = 0; i < 4; ++i) {
      const int col = i * 256 + lane * 4;
      const f32x4 v = *(const f32x4*)(src + col);
      st4h(XS + (size_t)row * DM + col, v);
      const f32x4 s1 = *(const f32x4*)(mp0 + col) + *(const f32x4*)(mp1 + col) + *(const f32x4*)(PIN(p, ada_b) + col);
      const f32x4 s2 = *(const f32x4*)(mp0 + 1024 + col) + *(const f32x4*)(mp1 + 1024 + col) + *(const f32x4*)(PIN(p, ada_b) + 1024 + col);
      const f32x4 h = v * (s2 + 1.0f) + s1;
      u32x2 w = {pk2h(h[0], h[1]), pk2h(h[2], h[3])};
      *(u32x2*)(H + (size_t)row * DM + col) = w;
    }
  }
}

__device__ void phase_ln(const Params& p, const hstream_t* Zin, hstream_t* XSo, int layer, int lnidx, int nrows, bf16_t* Hout, int mlayer, int msh, int nrows_h, bool final, int tid_) {
  const int wid = __builtin_amdgcn_readfirstlane(tid_ >> 6), lane = tid_ & 63;
  const float* g = PIN(p, ln_g) + (size_t)(layer * 2 + lnidx) * DM;
  const float* bt = PIN(p, ln_b) + (size_t)(layer * 2 + lnidx) * DM;
  for (int row = lbid() * 8 + wid; row < nrows; row += gridDim.x * 8) {
    const int who = who_of_row(row);
    f32x4 v[4];
    float s = 0.f;
#pragma unroll
    for (int i = 0; i < 4; ++i) { v[i] = ld4h(Zin + (size_t)row * DM + i * 256 + lane * 4); s += (v[i][0] + v[i][1]) + (v[i][2] + v[i][3]); }
    const float mu = wave_sum(s, lane) * (1.0f / DM);
    float q = 0.f;
#pragma unroll
    for (int i = 0; i < 4; ++i) { const f32x4 d = v[i] - mu; q += (d[0] * d[0] + d[1] * d[1]) + (d[2] * d[2] + d[3] * d[3]); }
    const float rstd = rsqrtf(wave_sum(q, lane) * (1.0f / DM) + LN_EPS);
#pragma unroll
    for (int i = 0; i < 4; ++i) {
      const int col = i * 256 + lane * 4;
      const f32x4 gg = *(const f32x4*)(g + col), bb = *(const f32x4*)(bt + col);
      const f32x4 xo = (v[i] - mu) * rstd * gg + bb;
      if (final) { *(f32x4*)(p.out + (size_t)row * DM + col) = xo; }
      else {
        st4h(XSo + (size_t)row * DM + col, xo);
        if (row < nrows_h) {
          const f32x4 s1 = *(const f32x4*)(mod_ptr(p, mlayer, who, msh) + col), s2 = *(const f32x4*)(mod_ptr(p, mlayer, who, msh + 1) + col);
          const f32x4 h = xo * (s2 + 1.0f) + s1;
          u32x2 w;
          if (lnidx == 0) w = (u32x2){pk2h(h[0], h[1]), pk2h(h[2], h[3])};
          else w = (u32x2){pk2h(h[0], h[1]), pk2h(h[2], h[3])};
          *(u32x2*)(Hout + (size_t)row * DM + col) = w;
        }
      }
    }
  }
}

typedef short s16x4 __attribute__((ext_vector_type(4)));
typedef float f32x16 __attribute__((ext_vector_type(16)));
#define KSWZ(row, colB) ((row) * 256 + ((colB) ^ (((row) & 7) << 4)))
#define SBAR() __builtin_amdgcn_sched_barrier(0)
constexpr float ATT_SCALE = 0.125f, ATT_THR = 8.f;
#ifndef ATT_SDEPTH
#define ATT_SDEPTH 1
#endif
constexpr int SHM_KV = 64 * 128 * 2;
__device__ __forceinline__ int crow(int r, int hi) { return (r & 3) + 8 * (r >> 2) + 4 * hi; }
__device__ __forceinline__ unsigned cvtpk(float lo, float hi) {
  unsigned r; asm volatile("v_cvt_pk_bf16_f32 %0, %1, %2" : "=v"(r) : "v"(lo), "v"(hi)); return r;
}
__device__ __forceinline__ void qkt(f32x16& p0, f32x16& p1, const char* Ks, const bf16x8* qr, int r32, int hi, int m, float negM) {
#pragma unroll
  for (int r = 0; r < 16; ++r) { p0[r] = negM; p1[r] = negM; }
#pragma unroll
  for (int d0 = 0; d0 < 4; ++d0) {
    const int cb = (m * 64 + d0 * 16 + hi * 8) * 2;
    const bf16x8 b0 = *reinterpret_cast<const bf16x8*>(Ks + KSWZ(r32, cb));
    const bf16x8 b1 = *reinterpret_cast<const bf16x8*>(Ks + KSWZ(32 + r32, cb));
    p0 = __builtin_amdgcn_mfma_f32_32x32x16_bf16(b0, qr[d0], p0, 0, 0, 0);
    p1 = __builtin_amdgcn_mfma_f32_32x32x16_bf16(b1, qr[d0], p1, 0, 0, 0);
  }
}
__device__ __forceinline__ int v_st(int k, int c) { const int kk = (k & ~0xC) | ((k & 4) << 1) | ((k & 8) >> 1); return ((kk >> 3) * 4 + (c >> 5)) * 512 + ((kk & 7) * 32 + (c & 31)) * 2; }
__device__ __forceinline__ int v_rd_base(int lane) { return ((lane & 3) << 3) | (((lane >> 2) & 3) << 6) | (((lane >> 4) & 1) << 5) | (((lane >> 5) & 1) << 8); }
constexpr int v_rd_off(int d0, int ks, int half) { return d0 * 512 + ks * 4096 + half * 2048; }
template <int OFF> __device__ __forceinline__ s16x4 tr_read(int vb) {
  s16x4 r; asm volatile("ds_read_b64_tr_b16 %0, %1 offset:%2" : "=&v"(r) : "v"(vb), "i"(OFF) : "memory"); return r;
}
template <int D0> __device__ __forceinline__ void pv_one(f32x16& od, int vb, bf16x8 pa0, bf16x8 pa1, bf16x8 pa2, bf16x8 pa3) {
  const s16x4 l0 = tr_read<v_rd_off(D0, 0, 0)>(vb), h0 = tr_read<v_rd_off(D0, 0, 1)>(vb), l1 = tr_read<v_rd_off(D0, 1, 0)>(vb), h1 = tr_read<v_rd_off(D0, 1, 1)>(vb);
  const s16x4 l2 = tr_read<v_rd_off(D0, 2, 0)>(vb), h2 = tr_read<v_rd_off(D0, 2, 1)>(vb), l3 = tr_read<v_rd_off(D0, 3, 0)>(vb), h3 = tr_read<v_rd_off(D0, 3, 1)>(vb);
  asm volatile("s_waitcnt lgkmcnt(0)" ::: "memory"); SBAR();
#define PKV(L, H) (bf16x8){L[0], L[1], L[2], L[3], H[0], H[1], H[2], H[3]}
  od = __builtin_amdgcn_mfma_f32_32x32x16_bf16(pa0, PKV(l0, h0), od, 0, 0, 0);
  od = __builtin_amdgcn_mfma_f32_32x32x16_bf16(pa1, PKV(l1, h1), od, 0, 0, 0);
  od = __builtin_amdgcn_mfma_f32_32x32x16_bf16(pa2, PKV(l2, h2), od, 0, 0, 0);
  od = __builtin_amdgcn_mfma_f32_32x32x16_bf16(pa3, PKV(l3, h3), od, 0, 0, 0);
#undef PKV
}
template <int D0> __device__ __forceinline__ void pv_one_t(f32x16& od, int vb, bf16x8 pa0, bf16x8 pa1, bf16x8 pa2, bf16x8 pa3) {
  const s16x4 l0 = tr_read<v_rd_off(D0, 0, 0)>(vb), h0 = tr_read<v_rd_off(D0, 0, 1)>(vb), l1 = tr_read<v_rd_off(D0, 1, 0)>(vb), h1 = tr_read<v_rd_off(D0, 1, 1)>(vb);
  const s16x4 l2 = tr_read<v_rd_off(D0, 2, 0)>(vb), h2 = tr_read<v_rd_off(D0, 2, 1)>(vb), l3 = tr_read<v_rd_off(D0, 3, 0)>(vb), h3 = tr_read<v_rd_off(D0, 3, 1)>(vb);
  asm volatile("s_waitcnt lgkmcnt(0)" ::: "memory"); SBAR();
#define PKV(L, H) (bf16x8){L[0], L[1], L[2], L[3], H[0], H[1], H[2], H[3]}
  od = __builtin_amdgcn_mfma_f32_32x32x16_bf16(PKV(l0, h0), pa0, od, 0, 0, 0);
  od = __builtin_amdgcn_mfma_f32_32x32x16_bf16(PKV(l1, h1), pa1, od, 0, 0, 0);
  od = __builtin_amdgcn_mfma_f32_32x32x16_bf16(PKV(l2, h2), pa2, od, 0, 0, 0);
  od = __builtin_amdgcn_mfma_f32_32x32x16_bf16(PKV(l3, h3), pa3, od, 0, 0, 0);
#undef PKV
}

__device__ __forceinline__ void attn_unit(const bf16_t* __restrict__ Qb, const bf16_t* __restrict__ Kh, const bf16_t* __restrict__ Vh, int seq,
                                          bf16_t* __restrict__ CATp  , const float* __restrict__ ng, float lam, float lam_init,
                                          const unsigned* __restrict__ kmaxp  , char* lds, int tid_) {
  const int tid = tid_, wid = __builtin_amdgcn_readfirstlane(tid >> 6), lane = tid & 63, r32 = lane & 31, hi = lane >> 5;
  const int rg = wid & 3, m = wid >> 2;
  constexpr int SLOT = 2 * SHM_KV;
  float* wsp = (float*)(lds + 4 * SLOT) + wid * 64; float* li_l = wsp;
  float l_reg = 0; f32x16 o[4] = {}; bf16x8 qr[4];
  const bf16_t* Qw = Qb + (size_t)(rg * 32 + r32) * 128 + m * 64 + hi * 8;
#pragma unroll
  for (int d0 = 0; d0 < 4; ++d0) qr[d0] = *reinterpret_cast<const bf16x8*>(Qw + d0 * 16);
  float negM;
  {
    float q2 = 0.f;
#pragma unroll
    for (int d0 = 0; d0 < 4; ++d0)
#pragma unroll
      for (int e = 0; e < 8; ++e) { const float v = bf2f((bf16_t)qr[d0][e]); q2 += v * v; }
    { auto rr = __builtin_amdgcn_permlane32_swap(__float_as_uint(q2), __float_as_uint(q2), false, false); q2 = __uint_as_float(rr[0]) + __uint_as_float(rr[1]); }
    const float k2 = __uint_as_float(kmaxp[m]);
    negM = -1.01f * sqrtf(q2 * k2);
  }
  unsigned vsrc[2], ksrc[2];
#pragma unroll
  for (int j = 0; j < 2; ++j) {
    const int p_ = wid + 8 * j;
    const int g_ = p_ * 64 + lane, sub = g_ >> 5, within = g_ & 31;
    const int kk = (sub >> 2) * 8 + (within >> 2), c_ = (sub & 3) * 32 + (within & 3) * 8;
    const int k_ = (kk & ~0xC) | ((kk & 4) << 1) | ((kk & 8) >> 1);
    vsrc[j] = (unsigned)(k_ * 256 + c_ * 2);
    const int row = p_ * 4 + (lane >> 4), chunk = (lane & 15) ^ (row & 7);
    ksrc[j] = (unsigned)(row * 256 + chunk * 16);
  }
  const int vb0 = (int)(uintptr_t)lds + v_rd_base(lane);
#define SLOAD_DMA(k0, slot) do { \
    const char* _vg = (const char*)(Vh + (size_t)(k0) * 128); const char* _kg = (const char*)(Kh + (size_t)(k0) * 128); char* _b = lds + (slot) * SLOT; \
    __builtin_amdgcn_global_load_lds((const unsigned*)(_vg + vsrc[0]), (unsigned*)(_b + wid * 1024), 16, 0, 0); \
    __builtin_amdgcn_global_load_lds((const unsigned*)(_vg + vsrc[1]), (unsigned*)(_b + (wid + 8) * 1024), 16, 0, 0); \
    __builtin_amdgcn_global_load_lds((const unsigned*)(_kg + ksrc[0]), (unsigned*)(_b + SHM_KV + wid * 1024), 16, 0, 0); \
    __builtin_amdgcn_global_load_lds((const unsigned*)(_kg + ksrc[1]), (unsigned*)(_b + SHM_KV + (wid + 8) * 1024), 16, 0, 0); } while (0)
#define TILE_PUBLISH() do { asm volatile("s_waitcnt vmcnt(0) lgkmcnt(0)" ::: "memory"); __builtin_amdgcn_s_barrier(); asm volatile("" ::: "memory"); } while (0)
#define PKV(L, H) (bf16x8){L[0], L[1], L[2], L[3], H[0], H[1], H[2], H[3]}
#define VRD(D0, KH, vb, f0, f1, f2, f3) do { f0 = tr_read<v_rd_off(D0, 2 * (KH), 0)>(vb); f1 = tr_read<v_rd_off(D0, 2 * (KH), 1)>(vb); \
    f2 = tr_read<v_rd_off(D0, 2 * (KH) + 1, 0)>(vb); f3 = tr_read<v_rd_off(D0, 2 * (KH) + 1, 1)>(vb); } while (0)
#define VMM(D0, qa, qb, f0, f1, f2, f3) do { \
    o[D0] = __builtin_amdgcn_mfma_f32_32x32x16_bf16(qa, PKV(f0, f1), o[D0], 0, 0, 0); \
    o[D0] = __builtin_amdgcn_mfma_f32_32x32x16_bf16(qb, PKV(f2, f3), o[D0], 0, 0, 0); } while (0)
#define LW4() do { asm volatile("s_waitcnt lgkmcnt(4)" ::: "memory"); SBAR(); } while (0)
#define LW0() do { asm volatile("s_waitcnt lgkmcnt(0)" ::: "memory"); SBAR(); } while (0)
#define PV_TILE(vb, q0, q1, q2, q3, C0, C1, C2, C3) do { \
    s16x4 a0, a1, a2, a3; \
    SBAR(); VRD(0, 0, vb, a0, a1, a2, a3); C0; LW0(); VMM(0, q0, q1, a0, a1, a2, a3); SBAR(); \
    VRD(0, 1, vb, a0, a1, a2, a3);     LW0(); VMM(0, q2, q3, a0, a1, a2, a3); SBAR(); \
    VRD(1, 0, vb, a0, a1, a2, a3); C1; LW0(); VMM(1, q0, q1, a0, a1, a2, a3); SBAR(); \
    VRD(1, 1, vb, a0, a1, a2, a3);     LW0(); VMM(1, q2, q3, a0, a1, a2, a3); SBAR(); \
    VRD(2, 0, vb, a0, a1, a2, a3); C2; LW0(); VMM(2, q0, q1, a0, a1, a2, a3); SBAR(); \
    VRD(2, 1, vb, a0, a1, a2, a3);     LW0(); VMM(2, q2, q3, a0, a1, a2, a3); SBAR(); \
    VRD(3, 0, vb, a0, a1, a2, a3); C3; LW0(); VMM(3, q0, q1, a0, a1, a2, a3); SBAR(); \
    VRD(3, 1, vb, a0, a1, a2, a3);     LW0(); VMM(3, q2, q3, a0, a1, a2, a3); SBAR(); } while (0)
#define PK4(P, BASE, OUT) do { unsigned a0 = cvtpk(P[BASE + 0], P[BASE + 1]), a1 = cvtpk(P[BASE + 2], P[BASE + 3]);   \
    unsigned b0 = cvtpk(P[BASE + 4], P[BASE + 5]), b1 = cvtpk(P[BASE + 6], P[BASE + 7]);                              \
    auto r0 = __builtin_amdgcn_permlane32_swap(a0, b0, false, false); auto r1 = __builtin_amdgcn_permlane32_swap(a1, b1, false, false); \
    u32x4 w = {r0[0], r1[0], r0[1], r1[1]}; OUT = *reinterpret_cast<bf16x8*>(&w); } while (0)
#define E1(S0) do { _Pragma("unroll") for (int r = 0; r < 16; ++r) S0[r] = __builtin_amdgcn_exp2f(S0[r]); } while (0)
#define E3(S0, S1) do { float ps = 0; _Pragma("unroll") for (int r = 0; r < 16; ++r) ps += S0[r]; _Pragma("unroll") for (int r = 0; r < 16; ++r) ps += S1[r]; l_reg += ps; } while (0)
#define E4(S0, S1, n0, n1, n2, n3) do { PK4(S0, 0, n0); PK4(S0, 8, n1); PK4(S1, 0, n2); PK4(S1, 8, n3); } while (0)
#define ITER(SN0, SN1, ks, SP0, SP1, vs) do { \
    const int _vb = vb0 + (vs) * SLOT; \
    PV_TILE(_vb, p0, p1, p2, p3, E1(SP0), E1(SP1), E3(SP0, SP1), (void)0); \
    qkt(SN0, SN1, lds + (ks) * SLOT + SHM_KV, qr, r32, hi, m, negM); \
    E4(SP0, SP1, p0, p1, p2, p3); SBAR(); } while (0)
  f32x16 sA0, sA1, sB0, sB1; bf16x8 p0, p1, p2, p3; const int NT = seq / 64;
  SLOAD_DMA(0, 0); TILE_PUBLISH();
  SLOAD_DMA(64, 1);
  qkt(sA0, sA1, lds + SHM_KV, qr, r32, hi, m, negM);
  TILE_PUBLISH();
  if (2 < NT) SLOAD_DMA(2 * 64, 2);
  qkt(sB0, sB1, lds + SLOT + SHM_KV, qr, r32, hi, m, negM);
  E1(sA0); E1(sA1); E3(sA0, sA1); E4(sA0, sA1, p0, p1, p2, p3);
  TILE_PUBLISH();
  for (int i = 2; i < NT; i += 2) {
    SLOAD_DMA((i + 1) * 64, (i + 1) & 3);
    ITER(sA0, sA1, i & 3, sB0, sB1, (i - 2) & 3);
    TILE_PUBLISH();
    if (i + 2 < NT) SLOAD_DMA((i + 2) * 64, (i + 2) & 3);
    ITER(sB0, sB1, (i + 1) & 3, sA0, sA1, (i - 1) & 3);
    TILE_PUBLISH();
  }
  {
    const int _vb = vb0 + ((NT - 2) & 3) * SLOT;
    PV_TILE(_vb, p0, p1, p2, p3, E1(sB0), E1(sB1), E3(sB0, sB1), (void)0);
    E4(sB0, sB1, p0, p1, p2, p3); SBAR();
    const int _vb2 = vb0 + ((NT - 1) & 3) * SLOT;
    PV_TILE(_vb2, p0, p1, p2, p3, (void)0, (void)0, (void)0, (void)0);
  }
#undef SLOAD_DMA
#undef TILE_PUBLISH
#undef PKV
#undef PV_TILE
#undef VRD
#undef VMM
#undef LW4
#undef LW0
#undef PK4
#undef E1
#undef E3
#undef E4
#undef ITER
  int r32e = r32, hie = hi;
  asm volatile("" : "+v"(r32e), "+v"(hie));
  { auto rr = __builtin_amdgcn_permlane32_swap(__float_as_uint(l_reg), __float_as_uint(l_reg), false, false); l_reg = __uint_as_float(rr[0]) + __uint_as_float(rr[1]); }
  if (hie == 0) li_l[r32e] = l_reg;
  asm volatile("s_waitcnt lgkmcnt(0)" ::: "memory");
  float rli[16];
#pragma unroll
  for (int r = 0; r < 16; ++r) rli[r] = __builtin_amdgcn_rcpf(li_l[crow(r, hie)]);
  __syncthreads();
  float* comb = (float*)lds;
  if (m == 1) {
#pragma unroll
    for (int r = 0; r < 16; ++r)
#pragma unroll
      for (int d0 = 0; d0 < 4; ++d0) comb[(rg * 32 + crow(r, hie)) * 128 + d0 * 32 + r32e] = o[d0][r] * rli[r] * lam;
  }
  __syncthreads();
  if (m == 0) {
    float ss[16];
#pragma unroll
    for (int r = 0; r < 16; ++r) {
      float a = 0.f;
#pragma unroll
      for (int d0 = 0; d0 < 4; ++d0) {
        const float v = o[d0][r] * rli[r] - comb[(rg * 32 + crow(r, hie)) * 128 + d0 * 32 + r32e];
        o[d0][r] = v; a += v * v;
      }
      ss[r] = a;
    }
#pragma unroll
    for (int off = 1; off < 32; off <<= 1)
#pragma unroll
      for (int r = 0; r < 16; ++r) ss[r] += shx_f(ss[r], off, lane);
    const float om = 1.0f - lam_init;
    float gq[4];
#pragma unroll
    for (int d0 = 0; d0 < 4; ++d0) gq[d0] = ng[d0 * 32 + r32e] * om;
#pragma unroll
    for (int r = 0; r < 16; ++r) {
      const float rs = rsqrtf(ss[r] * (1.0f / 128.0f) + LN_EPS);
      bf16_t* cp = CATp + (size_t)(rg * 32 + crow(r, hie)) * 1536;
#pragma unroll
      for (int d0 = 0; d0 < 4; ++d0) cp[d0 * 32 + r32e] = f2h(o[d0][r] * rs * gq[d0]);
    }
  }
  __syncthreads();
}

__device__ __forceinline__ void sgu_unit(const Params& p, int chunk, int jl, char* lds, int tid_) {
  const int tid = tid_, wid = __builtin_amdgcn_readfirstlane(tid >> 6), lane = tid & 63, r32 = lane & 31, hi = lane >> 5;
  const int row0 = chunk * 128;
  const bf16_t* GV = (const bf16_t*)(p.ws + OFF_GV);
  const bf16_t* GU = (const bf16_t*)(p.ws + OFF_GU);
  bf16_t* CAT = (bf16_t*)(p.ws + OFF_CAT);
  const float* lg = PIN(p, sgu_ln_g) + (size_t)jl * 512;
  const float* lb = PIN(p, sgu_ln_b) + (size_t)jl * 512;
  {
    const f32x4 g0 = *(const f32x4*)(lg + lane * 8), g1 = *(const f32x4*)(lg + lane * 8 + 4);
    const f32x4 b0 = *(const f32x4*)(lb + lane * 8), b1 = *(const f32x4*)(lb + lane * 8 + 4);
    const int c = lane * 8, g = c >> 7, cg = c & 127;
    for (int q = wid; q < 128; q += 8) {
      const u32x4 w = *(const u32x4*)(GV + (size_t)(row0 + q) * 512 + c);
      float v[8];
#pragma unroll
      for (int i = 0; i < 4; ++i) { v[2 * i] = bflo(w[i]); v[2 * i + 1] = bfhi(w[i]); }
      float s = 0.f;
#pragma unroll
      for (int i = 0; i < 8; ++i) s += v[i];
      const float mu = wave_sum(s, lane) * (1.0f / 512.0f);
      float qq = 0.f;
#pragma unroll
      for (int i = 0; i < 8; ++i) { const float d = v[i] - mu; qq += d * d; }
      const float rstd = rsqrtf(wave_sum(qq, lane) * (1.0f / 512.0f) + LN_EPS);
      u32x4 ow;
      ow[0] = pk2((v[0] - mu) * rstd * g0[0] + b0[0], (v[1] - mu) * rstd * g0[1] + b0[1]);
      ow[1] = pk2((v[2] - mu) * rstd * g0[2] + b0[2], (v[3] - mu) * rstd * g0[3] + b0[3]);
      ow[2] = pk2((v[4] - mu) * rstd * g1[0] + b1[0], (v[5] - mu) * rstd * g1[1] + b1[1]);
      ow[3] = pk2((v[6] - mu) * rstd * g1[2] + b1[2], (v[7] - mu) * rstd * g1[3] + b1[3]);
      *(u32x4*)(lds + (g * 2 + (q >> 6)) * SHM_KV + v_st(q & 63, cg)) = ow;
    }
  }
  __syncthreads();
  const int pg = wid & 3, ch = wid >> 2;
  const int vbase = (int)(uintptr_t)lds + v_rd_base(lane);
  for (int g = 0; g < 4; ++g) {
    const float* Wg = PIN(p, sgu_w) + ((size_t)(jl * 4 + g) * 128) * 128;
    bf16x8 af[8];
#pragma unroll
    for (int ks = 0; ks < 8; ++ks) {
      const float* wp = Wg + (size_t)(pg * 32 + r32) * 128 + ks * 16 + hi * 8;
      const f32x4 a = *(const f32x4*)wp, b = *(const f32x4*)(wp + 4);
      u32x4 w = {pk2(a[0], a[1]), pk2(a[2], a[3]), pk2(b[0], b[1]), pk2(b[2], b[3])};
      af[ks] = *reinterpret_cast<bf16x8*>(&w);
    }
    f32x16 acc[2] = {};
#pragma unroll
    for (int kt = 0; kt < 2; ++kt) {
      const int vb = vbase + (g * 2 + kt) * SHM_KV;
      if (ch == 0) { pv_one_t<0>(acc[0], vb, af[kt * 4 + 0], af[kt * 4 + 1], af[kt * 4 + 2], af[kt * 4 + 3]); pv_one_t<1>(acc[1], vb, af[kt * 4 + 0], af[kt * 4 + 1], af[kt * 4 + 2], af[kt * 4 + 3]); }
      else         { pv_one_t<2>(acc[0], vb, af[kt * 4 + 0], af[kt * 4 + 1], af[kt * 4 + 2], af[kt * 4 + 3]); pv_one_t<3>(acc[1], vb, af[kt * 4 + 0], af[kt * 4 + 1], af[kt * 4 + 2], af[kt * 4 + 3]); }
    }
    const int pp = pg * 32 + r32;
    const float bb = (PIN(p, sgu_b) + (size_t)(jl * 4 + g) * 128)[pp];
    const bf16_t* gup = GU + (size_t)(row0 + pp) * 512 + g * 128 + ch * 64 + 4 * hi;
    bf16_t* cap = CAT + (size_t)(row0 + pp) * 1536 + 1024 + g * 128 + ch * 64 + 4 * hi;
#pragma unroll
    for (int dd = 0; dd < 2; ++dd)
#pragma unroll
      for (int q = 0; q < 4; ++q) {
        const u32x2 uw = *(const u32x2*)(gup + dd * 32 + q * 8);
        const float s0 = acc[dd][4 * q] + bb, s1 = acc[dd][4 * q + 1] + bb, s2 = acc[dd][4 * q + 2] + bb, s3 = acc[dd][4 * q + 3] + bb;
        u32x2 ow = {pk2h(bflo(uw[0]) * s0, bfhi(uw[0]) * s1), pk2h(bflo(uw[1]) * s2, bfhi(uw[1]) * s3)};
        *(u32x2*)(cap + dd * 32 + q * 8) = ow;
      }
  }
  __syncthreads();
}

__device__ void phase_mixer_fast(const Params& p, int layer, char* shm, int tid_) {
  const int jl = layer >> 1;
  const bool ctxq = layer == 0;
  const float lam = ((const float*)(p.ws + OFF_LAM))[jl * 2 + 0];
  const float lam_init = ((const float*)(p.ws + OFF_LAM))[jl * 2 + 1];
  const float* ng = PIN(p, diff_norm_g) + (size_t)jl * 128;
  const bf16_t* Q = (const bf16_t*)(p.ws + OFF_Q);
  const bf16_t* K = (const bf16_t*)(p.ws + OFF_K);
  const bf16_t* V = (const bf16_t*)(p.ws + OFF_V);
  bf16_t* CAT = (bf16_t*)(p.ws + OFF_CAT);
  const int bid = lbid();
  const int NC = ctxq ? 32 : 0;
  const int NS = ctxq ? (NTOK / 128) : (NLAT / 128);
  for (int u = bid; u < 1024 + NC + NS; u += gridDim.x) {
    if (u < 1024 + NC) {
      int bh, pos0, seq, orow;
      if (u < 1024) {
        const int xcd = u & 7, ul = (u >> 8) * 32 + ((u & 255) >> 3), qb = ul & 63;
        bh = xcd * 2 + (ul >> 6);
        pos0 = CTXL + qb * 128; seq = LKV; orow = (bh >> 3) * SEQ + qb * 128;
      } else {
        const int v = u - 1024, qb = v & 1;
        bh = v >> 1;
        pos0 = qb * 128; seq = CTXL; orow = NLAT + (bh >> 3) * CTXL + qb * 128;
      }
      const size_t hb = (size_t)bh * LKV * 128;
      attn_unit(Q + hb + (size_t)pos0 * 128, K + hb, V + hb, seq, CAT + (size_t)orow * 1536 + (bh & 7) * 128, ng, lam, lam_init, (const unsigned*)(p.ws + OFF_BAR + 256) + jl * 32 + bh * 2, shm, tid_);
    } else {
      sgu_unit(p, u - 1024 - NC, jl, shm, tid_);
    }
  }
}

__device__ __forceinline__ void ld8h(const bf16_t* p, float (&v)[8]) {
  const u32x4 w = *(const u32x4*)p;
#pragma unroll
  for (int i = 0; i < 4; ++i) { v[2 * i] = hlo(w[i]); v[2 * i + 1] = hhi(w[i]); }
}
__device__ void phase_pool(const Params& p, int nrows, int tid_) {
  const bf16_t* M1 = (const bf16_t*)(p.ws + OFF_M1);
  bf16_t* M2 = (bf16_t*)(p.ws + OFF_M2);
  const int nitems = (nrows >> 5) * 128;
  for (int it = lbid() * 512 + tid_; it < nitems; it += gridDim.x * 512) {
    const int cg = it & 127, seg = it >> 7;
    const int row0 = seg * 32;
    int base, T;
    if (row0 < NLAT) { base = row0 & ~(SEQ - 1); T = SEQ; } else { base = NLAT + ((row0 - NLAT) & ~255); T = CTXL; }
    const int t0 = row0 - base;
    const int h = 1 << (cg >> 5);
    const bf16_t* colp = M1 + (size_t)base * 1024 + cg * 8;
    float S[8];
#pragma unroll
    for (int i = 0; i < 8; ++i) S[i] = 0.f;
    {
      const int lo = t0 - h < 0 ? 0 : t0 - h, hi = t0 + h > T ? T : t0 + h;
      for (int q = lo; q < hi; ++q) { float v[8]; ld8h(colp + (size_t)q * 1024, v);
#pragma unroll
        for (int i = 0; i < 8; ++i) S[i] += v[i]; }
    }
    for (int t = t0; t < t0 + 32; ++t) {
      const int lo = t - h < 0 ? 0 : t - h, hi = t + h > T ? T : t + h;
      const float inv = 1.0f / (float)(hi - lo);
      float x[8];
      ld8h(colp + (size_t)t * 1024, x);
      u32x4 w;
#pragma unroll
      for (int i = 0; i < 4; ++i) w[i] = pk2h(S[2 * i] * inv - x[2 * i], S[2 * i + 1] * inv - x[2 * i + 1]);
      *(u32x4*)(M2 + (size_t)(base + t) * 1024 + cg * 8) = w;
      if (t + h < T) { float v[8]; ld8h(colp + (size_t)(t + h) * 1024, v);
#pragma unroll
        for (int i = 0; i < 8; ++i) S[i] += v[i]; }
      if (t - h >= 0) { float v[8]; ld8h(colp + (size_t)(t - h) * 1024, v);
#pragma unroll
        for (int i = 0; i < 8; ++i) S[i] -= v[i]; }
    }
  }
}

__device__ __forceinline__ void fp8x16_to_f32(const u32x4 w, float (&f)[16]) {
#pragma unroll
  for (int q = 0; q < 4; ++q) {
    const f32x2v lo = __builtin_amdgcn_cvt_pk_f32_fp8((int)w[q], false), hi = __builtin_amdgcn_cvt_pk_f32_fp8((int)w[q], true);
    f[4 * q] = lo[0]; f[4 * q + 1] = lo[1]; f[4 * q + 2] = hi[0]; f[4 * q + 3] = hi[1];
  }
}
__device__ __forceinline__ float hadd2(f32x2v v) { float r; asm("v_add_f32 %0, %1, %2" : "=v"(r) : "v"(v[0]), "v"(v[1])); return r; }
#define PEER_LOAD_IDS_LO(dst, k) do { const int _t = wv + (k) * nwv; const i32x4* _ip = (const i32x4*)(IDX + ((size_t)g * NTOK + _t) * 16); dst##0 = _ip[0]; dst##1 = _ip[1]; } while (0)
#define PEER_LOAD_IDS_HI(dst, k) do { const int _t = wv + (k) * nwv; const i32x4* _ip = (const i32x4*)(IDX + ((size_t)g * NTOK + _t) * 16); dst##2 = _ip[2]; dst##3 = _ip[3]; } while (0)
#define PEER_ROW(TAB, id) (*(const u32x4*)((TAB) + (unsigned)(((id) << 7) | c16)))
#define PEER_GATHER_H0(buf, TAB, id) do { \
    buf[0] = PEER_ROW(TAB, id##0[0]); buf[1] = PEER_ROW(TAB, id##0[1]); buf[2] = PEER_ROW(TAB, id##0[2]); buf[3] = PEER_ROW(TAB, id##0[3]); \
    buf[4] = PEER_ROW(TAB, id##1[0]); buf[5] = PEER_ROW(TAB, id##1[1]); buf[6] = PEER_ROW(TAB, id##1[2]); buf[7] = PEER_ROW(TAB, id##1[3]); } while (0)
#define PEER_GATHER_H1(buf, TAB, id) do { \
    buf[0] = PEER_ROW(TAB, id##2[0]); buf[1] = PEER_ROW(TAB, id##2[1]); buf[2] = PEER_ROW(TAB, id##2[2]); buf[3] = PEER_ROW(TAB, id##2[3]); \
    buf[4] = PEER_ROW(TAB, id##3[0]); buf[5] = PEER_ROW(TAB, id##3[1]); buf[6] = PEER_ROW(TAB, id##3[2]); buf[7] = PEER_ROW(TAB, id##3[3]); } while (0)

__device__ void phase_peer_u(const Params& p, int layer, int nrows, int tid_) {
  const int tid = tid_, wid = __builtin_amdgcn_readfirstlane(tid >> 6), lane = tid & 63, bid = lbid();
  const int s = bid & 7, wv = (bid >> 3) * 8 + wid, nwv = (gridDim.x >> 3) * 8;
  const int g = lane >> 3, c = lane & 7, c16 = c * 16;
  const bool b2 = (lane & 4) != 0, b1 = (lane & 2) != 0, b0 = (lane & 1) != 0;
  const bf16_t* H = (const bf16_t*)(p.ws + OFF_HB) + s * 128 + c * 16;
  const unsigned char* U = (const unsigned char*)(p.ws + OFF_U8) + (size_t)(layer * 8 + s) * NEXP * 128;
  const int* IDX = (const int*)(p.ws + OFF_IDX);
  float* PART = (float*)(p.ws + OFF_PART);
  const int n = wv < nrows ? (nrows - wv + nwv - 1) / nwv : 0;
  if (n == 0) return;
  i32x4 id0, id1, id2, id3;
  u32x4 bufA[8], bufB[8], hn0, hn1;
  f32x2v h2[8];
#define PU_HLOAD(h0, h1, k) do { const int _t = wv + (k) * nwv; h0 = *(const u32x4*)(H + (size_t)_t * DM); h1 = *(const u32x4*)(H + (size_t)_t * DM + 8); } while (0)
#define PU_HCVT() do { _Pragma("unroll") for (int q = 0; q < 4; ++q) { h2[q] = (f32x2v){hlo(hn0[q]), hhi(hn0[q])}; h2[4 + q] = (f32x2v){hlo(hn1[q]), hhi(hn1[q])}; } } while (0)
#define PU_HALF(buf, base) do { \
    _Pragma("unroll") for (int i = 0; i < 8; i += 2) { f32x2v a0 = {0.f, 0.f}, a1 = a0, b0v = a0, b1v = a0;     \
      _Pragma("unroll") for (int q = 0; q < 4; ++q) { \
        a0 = __builtin_elementwise_fma(h2[2 * q], __builtin_amdgcn_cvt_pk_f32_fp8((int)buf[i][q], false), a0); \
        b0v = __builtin_elementwise_fma(h2[2 * q], __builtin_amdgcn_cvt_pk_f32_fp8((int)buf[i + 1][q], false), b0v); \
        a1 = __builtin_elementwise_fma(h2[2 * q + 1], __builtin_amdgcn_cvt_pk_f32_fp8((int)buf[i][q], true), a1); \
        b1v = __builtin_elementwise_fma(h2[2 * q + 1], __builtin_amdgcn_cvt_pk_f32_fp8((int)buf[i + 1][q], true), b1v); } \
      a0 += a1; b0v += b1v; pd[(base) + i] = hadd2(a0); pd[(base) + i + 1] = hadd2(b0v); } } while (0)
  PEER_LOAD_IDS_LO(id, 0); PEER_LOAD_IDS_HI(id, 0);
  PEER_GATHER_H0(bufA, U, id); PU_HLOAD(hn0, hn1, 0);
  { const int k1 = n > 1 ? 1 : 0; PEER_LOAD_IDS_LO(id, k1); }
  PU_HCVT();
  for (int k = 0; k < n; ++k) {
    const int k1 = k + 1 < n ? k + 1 : k, k2 = k + 2 < n ? k + 2 : n - 1;
    PEER_GATHER_H1(bufB, U, id);
    __builtin_amdgcn_sched_barrier(0);
    PEER_LOAD_IDS_HI(id, k1);
    __builtin_amdgcn_sched_barrier(0);
    float pd[16];
    PU_HALF(bufA, 0);
    __builtin_amdgcn_sched_barrier(0);
    PEER_GATHER_H0(bufA, U, id); PU_HLOAD(hn0, hn1, k1);
    __builtin_amdgcn_sched_barrier(0);
    PEER_LOAD_IDS_LO(id, k2);
    __builtin_amdgcn_sched_barrier(0);
    PU_HALF(bufB, 8);
    float r8[8], r4[4], r2[2];
#pragma unroll
    for (int i = 0; i < 8; ++i) { const float keep = b2 ? pd[8 + i] : pd[i], send = b2 ? pd[i] : pd[8 + i]; r8[i] = keep + shx_f(send, 4, lane); }
#pragma unroll
    for (int i = 0; i < 4; ++i) { const float keep = b1 ? r8[4 + i] : r8[i], send = b1 ? r8[i] : r8[4 + i]; r4[i] = keep + shx_f(send, 2, lane); }
#pragma unroll
    for (int i = 0; i < 2; ++i) { const float keep = b0 ? r4[2 + i] : r4[i], send = b0 ? r4[i] : r4[2 + i]; r2[i] = keep + shx_f(send, 1, lane); }
    *(f32x2v*)(PART + ((size_t)(wv + k * nwv) * 8 + s) * 128 + lane * 2) = (f32x2v){r2[0] * (1.0f / 64.0f), r2[1] * (1.0f / 64.0f)};
    PU_HCVT();
    __builtin_amdgcn_sched_barrier(0);
  }
#undef PU_HLOAD
#undef PU_HCVT
#undef PU_HALF
}
__device__ void phase_peer_w(const Params& p, int nrows, int tid_) {
  const int wid = __builtin_amdgcn_readfirstlane(tid_ >> 6), lane = tid_ & 63;
  const float* PART = (const float*)(p.ws + OFF_PART);
  const float* GATE = (const float*)(p.ws + OFF_GATE);
  float* W = (float*)(p.ws + OFF_PW);
  for (int t = lbid() * 8 + wid; t < nrows; t += gridDim.x * 8) {
    f32x2v acc2 = {0.f, 0.f};
#pragma unroll
    for (int q = 0; q < 8; ++q) acc2 += *(const f32x2v*)(PART + ((size_t)t * 8 + q) * 128 + lane * 2);
    const f32x2v gt = *(const f32x2v*)(GATE + ((size_t)(lane >> 3) * NTOK + t) * 16 + (lane & 7) * 2);
    *(f32x2v*)(W + (size_t)t * 128 + lane * 2) = (f32x2v){gt[0] * gelu_tanh(acc2[0]), gt[1] * gelu_tanh(acc2[1])};
  }
}
__device__ void phase_peer_v(const Params& p, int layer, const hstream_t* XSin, hstream_t* Zout, int nrows, int tid_) {
  const int tid = tid_, wid = __builtin_amdgcn_readfirstlane(tid >> 6), lane = tid & 63, bid = lbid();
  const int s = bid & 7, wv = (bid >> 3) * 8 + wid, nwv = (gridDim.x >> 3) * 8;
  const int g = lane >> 3, c = lane & 7, c16 = c * 16;
  const bool b5 = (lane & 32) != 0, b4 = (lane & 16) != 0, b3 = (lane & 8) != 0;
  const unsigned char* Vt = (const unsigned char*)(p.ws + OFF_V8) + (size_t)(layer * 8 + s) * NEXP * 128;
  const int* IDX = (const int*)(p.ws + OFF_IDX);
  const float* W = (const float*)(p.ws + OFF_PW);
  const int col = s * 128 + c * 16 + g * 2;
  const int n = wv < nrows ? (nrows - wv + nwv - 1) / nwv : 0;
  if (n == 0) return;
  i32x4 id0, id1, id2, id3;
  u32x4 bufA[8], bufB[8];
  f32x2v wc2, wn2;
  unsigned xw;
#define PV_HALF(buf, base) do { \
    _Pragma("unroll") for (int i = 0; i < 8; ++i) { \
      const float w = shl_f((i & 1) ? wc2[1] : wc2[0], (lane & 56) + (((base) + i) >> 1)); \
      const f32x2v w2 = {w, w}; \
      _Pragma("unroll") for (int q = 0; q < 4; ++q) { \
        o2[2 * q] = __builtin_elementwise_fma(w2, __builtin_amdgcn_cvt_pk_f32_fp8((int)buf[i][q], false), o2[2 * q]); \
        o2[2 * q + 1] = __builtin_elementwise_fma(w2, __builtin_amdgcn_cvt_pk_f32_fp8((int)buf[i][q], true), o2[2 * q + 1]); } } } while (0)
  PEER_LOAD_IDS_LO(id, 0); PEER_LOAD_IDS_HI(id, 0);
  PEER_GATHER_H0(bufA, Vt, id);
  wc2 = *(const f32x2v*)(W + (size_t)wv * 128 + lane * 2);
  { const int k1 = n > 1 ? 1 : 0; PEER_LOAD_IDS_LO(id, k1); }
  for (int k = 0; k < n; ++k) {
    const int k1 = k + 1 < n ? k + 1 : k, k2 = k + 2 < n ? k + 2 : n - 1;
    const int t = wv + k * nwv;
    PEER_GATHER_H1(bufB, Vt, id);
    __builtin_amdgcn_sched_barrier(0);
    PEER_LOAD_IDS_HI(id, k1);
    xw = *(const unsigned*)(XSin + (size_t)t * DM + col);
    __builtin_amdgcn_sched_barrier(0);
    f32x2v o2[8];
#pragma unroll
    for (int j = 0; j < 8; ++j) o2[j] = (f32x2v){0.f, 0.f};
    PV_HALF(bufA, 0);
    __builtin_amdgcn_sched_barrier(0);
    PEER_GATHER_H0(bufA, Vt, id);
    wn2 = *(const f32x2v*)(W + (size_t)(wv + k1 * nwv) * 128 + lane * 2);
    __builtin_amdgcn_sched_barrier(0);
    PEER_LOAD_IDS_LO(id, k2);
    __builtin_amdgcn_sched_barrier(0);
    PV_HALF(bufB, 8);
    float r8[8], r4[4], r2[2];
#pragma unroll
    for (int i = 0; i < 8; ++i) { const float lo_ = o2[i >> 1][i & 1], hi_ = o2[4 + (i >> 1)][i & 1]; const float keep = b5 ? hi_ : lo_, send = b5 ? lo_ : hi_; r8[i] = keep + shx_f(send, 32, lane); }
#pragma unroll
    for (int i = 0; i < 4; ++i) { const float keep = b4 ? r8[4 + i] : r8[i], send = b4 ? r8[i] : r8[4 + i]; r4[i] = keep + shx_f(send, 16, lane); }
#pragma unroll
    for (int i = 0; i < 2; ++i) { const float keep = b3 ? r4[2 + i] : r4[i], send = b3 ? r4[i] : r4[2 + i]; r2[i] = keep + shx_f(send, 8, lane); }
    const f32x2v g2 = *(const f32x2v*)(mod_ptr(p, layer, who_of_row(t), 5) + col);
    *(unsigned*)(Zout + (size_t)t * DM + col) = pk2h(ALPHA * hlo(xw) + g2[0] * r2[0] * 0.125f, ALPHA * hhi(xw) + g2[1] * r2[1] * 0.125f);
    wc2 = wn2;
    __builtin_amdgcn_sched_barrier(0);
  }
#undef PV_HALF
}

constexpr int NSTEP = 9;
constexpr int NPHASE = 2 + NSTEP * DEPTH;

__device__ void run_phase(const Params& pin, int ph, char* shm, int tid_) {
  Params p = pin;
  { unsigned zoff = 0; asm volatile("" : "+s"(zoff));
    p.ws = pin.ws + zoff; }
  if (ph == 0) { phase_prologue_a(p, shm, tid_); return; }
  if (ph == 1) { phase_prologue_b(p, tid_); return; }
  const int layer = (ph - 2) / NSTEP, step = (ph - 2) % NSTEP;
  const bool even = (layer & 1) == 0;
  const int jl = layer >> 1;
  const bool ctx_out = layer < 2;
  const int nrows = ctx_out ? NTOK : NLAT;
  const int mt_upd = nrows / 256;
  hstream_t* XSA = (hstream_t*)(p.ws + OFF_XSA);
  hstream_t* XSB = (hstream_t*)(p.ws + OFF_XSB);
  hstream_t* Z = (hstream_t*)(p.ws + OFF_Z);
  const bf16_t* H = (const bf16_t*)(p.ws + OFF_H);
  const float* modl = (const float*)(p.ws + OFF_MOD) + (size_t)layer * 3 * 6144;
  if (step == 0) {
    if (even) {
      EpiInProj e{(bf16_t*)(p.ws + OFF_Q), (bf16_t*)(p.ws + OFF_K), (bf16_t*)(p.ws + OFF_V), (bf16_t*)(p.ws + OFF_GU), (bf16_t*)(p.ws + OFF_GV),
                  (const float*)(p.ws + OFF_ROPE), (unsigned*)(p.ws + OFF_BAR + 256) + jl * 32};
      const int mt = (layer <= 2) ? NTOK / 256 : NLAT / 256;
      gemm_phase<true>(H, (const bf16_t*)(p.ws + OFF_WIN) + (size_t)jl * 4096 * 1024, NLAT / 256, (mt * 256) - NLAT, 16, 1024, e, shm, tid_);
    } else {
      EpiBf16Store e{(bf16_t*)(p.ws + OFF_M1), 1024};
      gemm_phase<true>(H, (const bf16_t*)(p.ws + OFF_PIN) + (size_t)jl * 1024 * 1024, NLAT / 256, nrows - NLAT, 4, 1024, e, shm, tid_);
    }
  } else if (step == 1) {
    if (even) phase_mixer_fast(p, layer, shm, tid_);
    else phase_pool(p, nrows, tid_);
  } else if (step == 2) {
    EpiResid e{XSA, Z, modl, 2};
    if (even) gemm_phase<true>((const bf16_t*)(p.ws + OFF_CAT), (const bf16_t*)(p.ws + OFF_WOUT) + (size_t)jl * 1024 * 1536, NLAT / 256, nrows - NLAT, 4, 1536, e, shm, tid_);
    else gemm_phase<true>((const bf16_t*)(p.ws + OFF_M2), (const bf16_t*)(p.ws + OFF_POUT) + (size_t)jl * 1024 * 1024, NLAT / 256, nrows - NLAT, 4, 1024, e, shm, tid_);
  } else if (step == 3) {
    phase_ln(p, Z, XSB, layer, 0, nrows, (bf16_t*)(p.ws + OFF_HB), layer, 3, nrows, false, tid_);
  } else if (step == 4) {
    EpiTopK e{(int*)(p.ws + OFF_IDX), (float*)(p.ws + OFF_GATE)};
    gemm_phase<true>((const bf16_t*)(p.ws + OFF_HB), (const bf16_t*)(p.ws + OFF_WQK) + (size_t)layer * 2048 * 1024, NLAT / 256, nrows - NLAT, 8, 1024, e, shm, tid_);
  } else if (step == 5) {
    phase_peer_u(p, layer, nrows, tid_);
  } else if (step == 6) {
    phase_peer_w(p, nrows, tid_);
  } else if (step == 7) {
    phase_peer_v(p, layer, XSB, Z, nrows, tid_);
  } else {
    const int nl = layer + 1;
    const int nrows_next = (nl <= 2) ? NTOK : NLAT;
    phase_ln(p, Z, XSA, layer, 1, nrows, (bf16_t*)(p.ws + OFF_H), nl, 0, nrows_next < nrows ? nrows_next : nrows, layer == DEPTH - 1, tid_);
  }
}

#define XB_XCNT(j) (64 * (j))
#define XB_XSUB(j) (512 + 64 * (j))
#define XB_XGEN(j) (1024 + 64 * (j))
#define XB_TOP 1536
#define XB_TOPGEN 1600
#define XB_WORDS 1664
__device__ __forceinline__ unsigned xb_ld(unsigned* p) { return __hip_atomic_load(p, __ATOMIC_RELAXED, __HIP_MEMORY_SCOPE_AGENT); }
__device__ __forceinline__ unsigned xb_add(unsigned* p, unsigned v) { return __hip_atomic_fetch_add(p, v, __ATOMIC_RELAXED, __HIP_MEMORY_SCOPE_AGENT); }
__device__ __forceinline__ void grid_barrier(unsigned* bar, int xcc, unsigned nloc, unsigned nx, int tid_) {
  asm volatile("s_waitcnt vmcnt(0) lgkmcnt(0)" ::: "memory");
  __syncthreads();
  if (tid_ == 0) {
    const unsigned old = xb_add(&bar[XB_XSUB(xcc)], 1u);
    const unsigned gen = old / nloc;
    if (old + 1u == (gen + 1u) * nloc) {
      __builtin_amdgcn_fence(__ATOMIC_RELEASE, "agent");
      asm volatile("s_waitcnt vmcnt(0)" ::: "memory");
      const unsigned og = xb_add(&bar[XB_TOP], 1u);
      const unsigned tg = og / nx;
      if (og + 1u == (tg + 1u) * nx) xb_add(&bar[XB_TOPGEN], 1u);
      else while (xb_ld(&bar[XB_TOPGEN]) == tg) __builtin_amdgcn_s_sleep(1);
      __builtin_amdgcn_fence(__ATOMIC_ACQUIRE, "agent");
      xb_add(&bar[XB_XGEN(xcc)], 1u);
      asm volatile("s_waitcnt vmcnt(0)" ::: "memory");
    } else {
      while (xb_ld(&bar[XB_XGEN(xcc)]) == gen) __builtin_amdgcn_s_sleep(1);
      __builtin_amdgcn_fence(__ATOMIC_ACQUIRE, "agent");
      asm volatile("s_waitcnt vmcnt(0)" ::: "memory");
    }
  }
  __syncthreads();
}

__device__ __forceinline__ int phase_cat(int ph) {
  if (ph < 2) return 0;
  const int layer = (ph - 2) / NSTEP, step = (ph - 2) % NSTEP;
  const bool even = (layer & 1) == 0;
  if (step == 0) return even ? 1 : 7;
  if (step == 1) return even ? 2 : 8;
  if (step == 2) return 3;
  if (step == 3) return 4;
  if (step == 4) return 5;
  if (step == 5) return 6;
  if (step == 6) return 12;
  if (step == 7) return 10;
  return 11;
}

__global__ void __launch_bounds__(512) mega(KArgs ka, int ph_lo, int ph_hi) {
  Params p;
  p.in = (const float* const*)__builtin_amdgcn_kernarg_segment_ptr();
  p.out = ka.out; p.ws = ka.ws;
  __shared__ __attribute__((aligned(1024))) char shm[LDS_BYTES];
  cg::grid_group grid = cg::this_grid();
  unsigned* bar = (unsigned*)(p.ws + OFF_BAR + 512);
  int rep = 0;
  const int swid = __builtin_amdgcn_readfirstlane((int)(threadIdx.x >> 6));
  const int my_xcc = (int)(__builtin_amdgcn_s_getreg((3 << 11) | 20) & 0x7);
  if (threadIdx.x == 0) xb_add(&bar[XB_XCNT(my_xcc)], 1u);
  unsigned nloc = 1, nx = 1;
  for (int ph = ph_lo; ph < ph_hi;) {
    run_phase(p, ph, shm, make_tid(swid));
    bool again = false;
#ifdef DUP_CAT
    if (phase_cat(ph) == DUP_CAT && rep == 0) again = true;
#endif
    if (again || ph + 1 < ph_hi) {
      if (ph == ph_lo && !again && rep == 0) {
        grid.sync();
        unsigned cnt = 0, mine = 0;
#pragma unroll
        for (int j = 0; j < 8; ++j) { const unsigned c = xb_ld(&bar[XB_XCNT(j)]); cnt += c > 0u ? 1u : 0u; mine = j == my_xcc ? c : mine; }
        nloc = __builtin_amdgcn_readfirstlane(mine > 0u ? mine : 1u); nx = __builtin_amdgcn_readfirstlane(cnt > 0u ? cnt : 1u);
      } else grid_barrier(bar, my_xcc, nloc, nx, make_tid(swid));
    }
    if (again) rep = 1; else { rep = 0; ++ph; }
  }
}

extern "C" void kernel_launch(void* const* d_in, const int* in_sizes, int n_in, void* d_out, int out_size, void* d_ws, size_t ws_size,
                              hipStream_t stream) {
  static int grid_blocks = 0;
  if (!grid_blocks) {
    int dev = 0, cus = 0, per_cu = 0;
    (void)hipGetDevice(&dev);
    (void)hipDeviceGetAttribute(&cus, hipDeviceAttributeMultiprocessorCount, dev);
    (void)hipOccupancyMaxActiveBlocksPerMultiprocessor(&per_cu, mega, 512, 0);
    if (per_cu > 1) per_cu = 1;
    grid_blocks = cus * per_cu;
    if (ws_size < WS_END) fprintf(stderr, "kernel_launch: workspace too small: %zu < %zu\n", ws_size, (size_t)WS_END);
    if (grid_blocks <= 0) fprintf(stderr, "kernel_launch: occupancy query returned 0\n");
  }
  KArgs p{};
  for (int i = 0; i < 24; ++i) p.in[i] = (const float*)d_in[i];
  p.out = (float*)d_out;
  p.ws = (char*)d_ws;
  (void)hipMemsetAsync((char*)d_ws + OFF_BAR, 0, 512 + 8192, stream);
  int lo = 0, hi = NPHASE;
  void* args[] = {&p, &lo, &hi};
  hipError_t e = hipLaunchCooperativeKernel((void*)mega, dim3(grid_blocks), dim3(512), args, 0, stream);
  if (e != hipSuccess) fprintf(stderr, "cooperative launch failed: %s (grid %d)\n", hipGetErrorString(e), grid_blocks);
}
```

```cpp
#include <hip/hip_runtime.h>
#include <hip/hip_cooperative_groups.h>
#include <cstdio>
#include <cstdint>
namespace cg = cooperative_groups;

typedef unsigned short bf16_t;
typedef short bf16x8 __attribute__((ext_vector_type(8)));
typedef float f32x4 __attribute__((ext_vector_type(4)));
typedef unsigned u32x4 __attribute__((ext_vector_type(4)));
typedef unsigned u32x2 __attribute__((ext_vector_type(2)));
typedef float f32x2v __attribute__((ext_vector_type(2)));
typedef __bf16 bf16x2_t __attribute__((ext_vector_type(2)));

constexpr int DM = 1024, NBATCH = 2, SEQ = 8192, CTXL = 256, DEPTH = 4;
constexpr int NLAT = NBATCH * SEQ;
constexpr int NCTX = NBATCH * CTXL;
constexpr int NTOK = NLAT + NCTX;
constexpr int LKV = CTXL + SEQ;
constexpr int NH = 8;
constexpr int NEXP = 16384;
constexpr float LN_EPS = 1e-5f;
constexpr float ALPHA = 1.6817928305074290f;
constexpr float QSCALE = 0.125f * 1.4426950408889634f;

constexpr size_t al256(size_t x) { return (x + 255) / 256 * 256; }
constexpr size_t SZ_TAB = (size_t)DEPTH * NEXP * DM;
constexpr size_t SZ_QKV = (size_t)NBATCH * NH * LKV * 128 * 2;
constexpr size_t SZ_XS = (size_t)NTOK * DM * 4;
constexpr size_t OFF_U8 = 0;
constexpr size_t OFF_V8 = OFF_U8 + SZ_TAB;
constexpr size_t OFF_Q = OFF_V8 + SZ_TAB;
constexpr size_t OFF_K = OFF_Q + SZ_QKV;
constexpr size_t OFF_V = OFF_K + SZ_QKV;
constexpr size_t OFF_XSA = OFF_V + SZ_QKV;
constexpr size_t OFF_XSB = OFF_XSA + SZ_XS;
constexpr size_t OFF_Z = OFF_XSB + SZ_XS;
constexpr size_t OFF_H = OFF_Z + SZ_XS;
constexpr size_t OFF_HB = OFF_H + (size_t)NTOK * DM * 2;
constexpr size_t OFF_CAT = OFF_HB + (size_t)NTOK * DM * 2;
constexpr size_t OFF_GU = OFF_CAT + (size_t)NTOK * 1536 * 2;
constexpr size_t OFF_GV = OFF_GU + (size_t)NTOK * 512 * 2;
constexpr size_t OFF_M1 = OFF_GV + (size_t)NTOK * 512 * 2;
constexpr size_t OFF_M2 = OFF_M1 + (size_t)NTOK * DM * 2;
constexpr size_t OFF_SC = OFF_M2 + (size_t)NTOK * DM * 2;
constexpr size_t OFF_IDX = OFF_SC;
constexpr size_t OFF_GATE = OFF_IDX + (size_t)NTOK * 128 * 4;
constexpr size_t OFF_WIN = OFF_GATE + (size_t)NTOK * 128 * 4;
constexpr size_t OFF_WOUT = OFF_WIN + (size_t)2 * 4096 * 1024 * 2;
constexpr size_t OFF_PIN = OFF_WOUT + (size_t)2 * 1024 * 1536 * 2;
constexpr size_t OFF_POUT = OFF_PIN + (size_t)2 * 1024 * 1024 * 2;
constexpr size_t OFF_WQK = OFF_POUT + (size_t)2 * 1024 * 1024 * 2;
constexpr size_t OFF_MOD = OFF_WQK + (size_t)4 * 2048 * 1024 * 2;
constexpr size_t OFF_MODP = OFF_MOD + al256((size_t)4 * 3 * 6144 * 4);
constexpr size_t OFF_ROPE = OFF_MODP + al256((size_t)2 * 4 * 3 * 6144 * 4);
constexpr size_t OFF_LAM = OFF_ROPE + al256((size_t)128 * 16 * 2 * 4);
constexpr size_t OFF_PART = OFF_LAM + 256;
constexpr size_t OFF_PW = OFF_PART + (size_t)NTOK * 8 * 128 * 4;
constexpr size_t OFF_BAR = OFF_PW + (size_t)NTOK * 128 * 4;
constexpr size_t WS_END = OFF_BAR + 512 + 8192;

struct KArgs {
  const float* in[24];
  float* out;
  char* ws;
};
struct Params {
  const float* const* in;
  float* out;
  char* ws;
};
enum { IN_x, IN_c, IN_ctx, IN_c_ctx, IN_ada_w, IN_ada_b, IN_ln_g, IN_ln_b, IN_ab_w_in, IN_ab_w_out, IN_diff_lam, IN_diff_norm_g, IN_sgu_ln_g, IN_sgu_ln_b,
       IN_sgu_w, IN_sgu_b, IN_pool_w_in, IN_pool_w_grp, IN_pool_scale, IN_pool_w_out, IN_peer_wq, IN_peer_keys, IN_peer_u, IN_peer_v };
#define AS_GLOBAL(T, ptr) ((T)(__attribute__((address_space(1))) char*)(char*)(ptr))
#define PIN(p, name) AS_GLOBAL(const float*, (p).in[IN_##name])

constexpr int LDS_BYTES = 144 * 1024;

__device__ __forceinline__ int make_tid(int swid) {
  int t;
  asm volatile("v_mbcnt_lo_u32_b32 %0, -1, 0\n\tv_mbcnt_hi_u32_b32 %0, -1, %0" : "=v"(t));
  return (swid << 6) | t;
}
__device__ __forceinline__ int lbid() { int b = blockIdx.x; asm volatile("" : "+s"(b)); return b; }
__device__ __forceinline__ bf16_t f2bf(float f) {
  unsigned u = __float_as_uint(f);
  u += 0x7fffu + ((u >> 16) & 1u);
  return (bf16_t)(u >> 16);
}
__device__ __forceinline__ float bf2f(bf16_t b) { return __uint_as_float(((unsigned)b) << 16); }
__device__ __forceinline__ unsigned pk2(float lo, float hi) { return (unsigned)f2bf(lo) | ((unsigned)f2bf(hi) << 16); }
typedef _Float16 f16x8 __attribute__((ext_vector_type(8)));
typedef _Float16 f16x2 __attribute__((ext_vector_type(2)));
__device__ __forceinline__ unsigned pk2h(float lo, float hi) { const f16x2 v = {(_Float16)lo, (_Float16)hi}; return __builtin_bit_cast(unsigned, v); }
__device__ __forceinline__ float hlo(unsigned w) { return (float)__builtin_bit_cast(f16x2, w)[0]; }
__device__ __forceinline__ float hhi(unsigned w) { return (float)__builtin_bit_cast(f16x2, w)[1]; }
typedef _Float16 hstream_t;
__device__ __forceinline__ f32x4 ld4h(const hstream_t* p) { const u32x2 w = *(const u32x2*)p; return (f32x4){hlo(w[0]), hhi(w[0]), hlo(w[1]), hhi(w[1])}; }
__device__ __forceinline__ void st4h(hstream_t* p, f32x4 v) { *(u32x2*)p = (u32x2){pk2h(v[0], v[1]), pk2h(v[2], v[3])}; }
__device__ __forceinline__ bf16_t f2h(float f) { return __builtin_bit_cast(unsigned short, (_Float16)f); }
__device__ __forceinline__ float h2f(bf16_t b) { return (float)__builtin_bit_cast(_Float16, b); }
__device__ __forceinline__ float bflo(unsigned w) { return __uint_as_float(w << 16); }
__device__ __forceinline__ float bfhi(unsigned w) { return __uint_as_float(w & 0xffff0000u); }
__device__ __forceinline__ float gelu_tanh(float x) {
  const float u = 0.7978845608028654f * (x + 0.044715f * x * x * x);
  return x / (1.0f + __expf(-2.0f * u));
}
__device__ __forceinline__ float dot2bf(unsigned a, unsigned b, float c) {
  return __builtin_amdgcn_fdot2_f32_bf16(__builtin_bit_cast(bf16x2_t, a), __builtin_bit_cast(bf16x2_t, b), c, false);
}
__device__ __forceinline__ float shx_f(float v, int mask, int lane) { return __int_as_float(__builtin_amdgcn_ds_bpermute((lane ^ mask) << 2, __float_as_int(v))); }
__device__ __forceinline__ int shx_i(int v, int mask, int lane) { return __builtin_amdgcn_ds_bpermute((lane ^ mask) << 2, v); }
__device__ __forceinline__ float shl_f(float v, int src) { return __int_as_float(__builtin_amdgcn_ds_bpermute(src << 2, __float_as_int(v))); }
__device__ __forceinline__ float wave_sum(float v, int  ) {
#define DPP_ADD(ctrl, rmask) v += __int_as_float(__builtin_amdgcn_update_dpp(0, __float_as_int(v), ctrl, rmask, 0xf, false))
  DPP_ADD(0xB1, 0xf);
  DPP_ADD(0x4E, 0xf);
  DPP_ADD(0x141, 0xf);
  DPP_ADD(0x140, 0xf);
  DPP_ADD(0x142, 0xa);
  DPP_ADD(0x143, 0xc);
#undef DPP_ADD
  return __int_as_float(__builtin_amdgcn_readlane(__float_as_int(v), 63));
}
__device__ __forceinline__ int who_of_row(int row) { return row < NLAT ? (row >= SEQ ? 1 : 0) : 2; }
__device__ __forceinline__ const float* mod_ptr(const Params& p, int layer, int who, int which) {
  return (const float*)(p.ws + OFF_MOD) + ((size_t)(layer * 3 + who) * 6 + which) * 1024;
}
__device__ __forceinline__ void row_bpos(int row, int& b, int& pos) {
  if (row < NLAT) { b = row >> 13; pos = CTXL + (row & (SEQ - 1)); }
  else { const int r = row - NLAT; b = r >> 8; pos = r & 255; }
}

__device__ __forceinline__ int lds_byte2(int r, int c) {
  int st = (r >> 4) * 2 + (c >> 5), ob = (r & 15) * 64 + (c & 31) * 2;
  return st * 1024 + (ob ^ (((ob >> 9) & 1) << 5));
}
__device__ __forceinline__ void stage_rc2(int b, int& R, int& C) {
  int st = b >> 10, sb = b & 1023, swz = sb ^ (((sb >> 9) & 1) << 5);
  R = (st / 2) * 16 + swz / 64;
  C = (st % 2) * 32 + (swz % 64) / 2;
}
#define WAIT_V0() asm volatile("s_waitcnt vmcnt(0)" ::: "memory")

template <bool F16, int MFR, class Epi>
__device__ __forceinline__ void gemm_tile(const bf16_t* __restrict__ Arow0, const bf16_t* __restrict__ Bcol0, int row0, int pn, int K,
                                          const Epi& epi, char* shm, int tid_) {
  constexpr int BK = 32, TILE_B = 256 * BK * 2, STAGE_B = 2 * TILE_B;
  constexpr int LPS = MFR == 8 ? 4 : 3;
  const int tid = tid_, wid = __builtin_amdgcn_readfirstlane(tid >> 6), lane = tid & 63, wr = wid >> 2, wc = wid & 3, fr = lane & 15, fq = lane >> 4;
  const int sb_ = lane * 16, swz_ = sb_ ^ (((sb_ >> 9) & 1) << 5);
  const int C0 = (swz_ % 64) / 2;
  const int R0b = wid * 16 + swz_ / 64;
  const int R0a = (MFR == 8 ? wid : (wid & 3)) * 16 + swz_ / 64;
  const char* Ab = (const char*)Arow0 + (unsigned)(R0a * K + C0) * 2u;
  const char* Bb = (const char*)Bcol0 + (unsigned)(R0b * K + C0) * 2u;
  const int ob_ = fr * 64 + fq * 16, frag_swz = ob_ ^ (((ob_ >> 9) & 1) << 5);
  const int a_base = wr * (MFR * 1024) + frag_swz, b_base = wc * 4096 + frag_swz;
  const int nt = K / BK;
  f32x4 acc[MFR][4];
#pragma unroll
  for (int m = 0; m < MFR; ++m)
#pragma unroll
    for (int n = 0; n < 4; ++n) acc[m][n] = (f32x4){0.f, 0.f, 0.f, 0.f};
  typename Epi::template Pre<MFR> pre;
  epi.template preload<MFR>(pre, row0, pn, wr, wc, fr, fq);
#define GLDS_STAGE(buf, kt)                                                                                                               \
  do {                                                                                                                                    \
    if (MFR == 8) {                                                                                                                       \
      _Pragma("unroll") for (int i = 0; i < 2; ++i)                                                                                       \
        __builtin_amdgcn_global_load_lds((const unsigned*)(Ab + (size_t)(i * 128) * K * 2 + (kt) * (BK * 2)),                           \
                                         (unsigned*)(shm + (buf) * STAGE_B + wid * 1024 + i * 8192), 16, 0, 0);                           \
    } else {                                                                                                                              \
      __builtin_amdgcn_global_load_lds((const unsigned*)(Ab + (kt) * (BK * 2)), (unsigned*)(shm + (buf) * STAGE_B + (wid & 3) * 1024), 16, 0, 0); \
    }                                                                                                                                     \
    _Pragma("unroll") for (int i = 0; i < 2; ++i)                                                                                         \
      __builtin_amdgcn_global_load_lds((const unsigned*)(Bb + (size_t)(i * 128) * K * 2 + (kt) * (BK * 2)),                             \
                                       (unsigned*)(shm + (buf) * STAGE_B + TILE_B + wid * 1024 + i * 8192), 16, 0, 0);                    \
  } while (0)
#define RAW_BARRIER() do { asm volatile("s_waitcnt lgkmcnt(0)" ::: "memory"); __builtin_amdgcn_s_barrier(); } while (0)
#define WAIT_2STAGES() do { if (LPS == 4) asm volatile("s_waitcnt vmcnt(8)" ::: "memory"); else asm volatile("s_waitcnt vmcnt(6)" ::: "memory"); } while (0)
#define WAIT_1STAGE() do { if (LPS == 4) asm volatile("s_waitcnt vmcnt(4)" ::: "memory"); else asm volatile("s_waitcnt vmcnt(3)" ::: "memory"); } while (0)
  GLDS_STAGE(0, 0); GLDS_STAGE(1, 1); GLDS_STAGE(2, 2);
  WAIT_2STAGES();
  RAW_BARRIER();
  for (int t = 0; t < nt; ++t) {
    if (t + 3 < nt) GLDS_STAGE((t + 3) & 3, t + 3);
    const char* sa = shm + (t & 3) * STAGE_B;
    const char* sb = sa + TILE_B;
    {
      bf16x8 At[MFR], Bf[4];
#pragma unroll
      for (int m = 0; m < MFR; ++m) At[m] = *(const bf16x8*)(sa + a_base + m * 1024);
#pragma unroll
      for (int n = 0; n < 4; ++n) Bf[n] = *(const bf16x8*)(sb + b_base + n * 1024);
#pragma unroll
      for (int m = 0; m < MFR; ++m)
#pragma unroll
        for (int n = 0; n < 4; ++n) {
          if (F16) acc[m][n] = __builtin_amdgcn_mfma_f32_16x16x32_f16(__builtin_bit_cast(f16x8, Bf[n]), __builtin_bit_cast(f16x8, At[m]), acc[m][n], 0, 0, 0);
          else acc[m][n] = __builtin_amdgcn_mfma_f32_16x16x32_bf16(Bf[n], At[m], acc[m][n], 0, 0, 0);
        }
    }
    if (t + 3 < nt) WAIT_2STAGES();
    else if (t + 2 < nt) WAIT_1STAGE();
    else asm volatile("s_waitcnt vmcnt(0)" ::: "memory");
    RAW_BARRIER();
  }
#undef GLDS_STAGE
#undef RAW_BARRIER
#undef WAIT_2STAGES
#undef WAIT_1STAGE
  epi.template run<MFR>(acc, pre, row0, pn, wr, wc, fr, fq, shm, tid_);
}

template <bool F16 = false, class Epi>
__device__ __forceinline__ void gemm_phase(const bf16_t* __restrict__ A, const bf16_t* __restrict__ Bt, int mt_big, int small_rows, int ntiles, int K,
                                           const Epi& epi, char* shm, int tid_) {
  const int nu_big = ((mt_big + 7) >> 3) * ntiles * 8, nu_small = (small_rows >> 6) * ntiles;
  int u = lbid();
  for (; u < nu_big; u += gridDim.x) {
    const int xcd = u & 7, v = u >> 3;
    const int pn = v % ntiles, pm = (v / ntiles) * 8 + xcd;
    if (pm >= mt_big) continue;
    gemm_tile<F16, 8>(A + (size_t)pm * 256 * K, Bt + (size_t)pn * 256 * K, pm * 256, pn, K, epi, shm, tid_);
  }
  for (; u < nu_big + nu_small; u += gridDim.x) {
    const int w = u - nu_big, pn = w % ntiles, row0 = mt_big * 256 + (w / ntiles) * 64;
    gemm_tile<F16, 2>(A + (size_t)row0 * K, Bt + (size_t)pn * 256 * K, row0, pn, K, epi, shm, tid_);
  }
}

struct EpiInProj {
  bf16_t *Q, *K, *V, *GU, *GV;
  const float* rope;
  unsigned* KMAX;
  template <int MFR> struct Pre {};
  template <int MFR> __device__ __forceinline__ void preload(Pre<MFR>&, int, int, int, int, int, int) const {}
  template <int MFR>
  __device__ __forceinline__ void run(const f32x4 (&acc)[MFR][4], const Pre<MFR>&, int row0, int pn, int wr, int wc, int fr, int fq, char*, int) const {
    const int region = pn >> 2;
    const int lane = fq * 16 + fr;
    float kn2 = 0.f, kmax2 = 0.f;
#pragma unroll
    for (int m = 0; m < MFR; ++m) {
      const int row = row0 + wr * (16 * MFR) + m * 16 + fr;
      int b, pos;
      row_bpos(row, b, pos);
      if (region <= 1) {
        bf16_t* dst = region == 0 ? Q : K;
        const int head = (pn & 3) * 2 + (wc >> 1), msub = wc & 1;
        bf16_t* rp = dst + ((size_t)(b * NH + head) * LKV + pos) * 128 + msub * 64;
        const bool lat = row < NLAT;
        const int t = row & (SEQ - 1);
        const int prow = t >> 6, pcol = t & 63;
#pragma unroll
        for (int n = 0; n < 2; ++n) {
          float oa[4], ob[4];
          if (n == 0) kn2 = 0.f;
          const int pp = (n == 0) ? prow : pcol;
          const f32x4 r0 = lat ? *(const f32x4*)(rope + (pp * 16 + fq * 4) * 2) : (f32x4){1.f, 0.f, 1.f, 0.f};
          const f32x4 r1 = lat ? *(const f32x4*)(rope + (pp * 16 + fq * 4) * 2 + 4) : (f32x4){1.f, 0.f, 1.f, 0.f};
          const float csv[4] = {r0[0], r0[2], r1[0], r1[2]}, snv[4] = {r0[1], r0[3], r1[1], r1[3]};
#pragma unroll
          for (int j = 0; j < 4; ++j) {
            const float a = acc[m][n][j], bb = acc[m][n + 2][j];
            oa[j] = a * csv[j] - bb * snv[j];
            ob[j] = a * snv[j] + bb * csv[j];
          }
          if (region == 0) {
#pragma unroll
            for (int j = 0; j < 4; ++j) { oa[j] *= QSCALE; ob[j] *= QSCALE; }
          } else {
#pragma unroll
            for (int j = 0; j < 4; ++j) kn2 += oa[j] * oa[j] + ob[j] * ob[j];
          }
          u32x2 wa = {pk2(oa[0], oa[1]), pk2(oa[2], oa[3])};
          u32x2 wb = {pk2(ob[0], ob[1]), pk2(ob[2], ob[3])};
          *(u32x2*)(rp + n * 16 + fq * 4) = wa;
          *(u32x2*)(rp + 32 + n * 16 + fq * 4) = wb;
        }
        if (region == 1) {
          kn2 += shx_f(kn2, 16, lane); kn2 += shx_f(kn2, 32, lane);
          kmax2 = fmaxf(kmax2, kn2);
        }
      } else if (region == 2) {
        const int head = (pn & 3) * 2 + (wc >> 1);
        bf16_t* rp = V + ((size_t)(b * NH + head) * LKV + pos) * 128 + (wc & 1) * 64;
#pragma unroll
        for (int n = 0; n < 4; ++n) {
          u32x2 w = {pk2(acc[m][n][0], acc[m][n][1]), pk2(acc[m][n][2], acc[m][n][3])};
          *(u32x2*)(rp + n * 16 + fq * 4) = w;
        }
      } else {
        const int isv = (pn >> 1) & 1;
        bf16_t* rp = (isv ? GV : GU) + (size_t)row * 512 + (pn & 1) * 256 + wc * 64;
#pragma unroll
        for (int n = 0; n < 4; ++n) {
          u32x2 w = {pk2(gelu_tanh(acc[m][n][0]), gelu_tanh(acc[m][n][1])), pk2(gelu_tanh(acc[m][n][2]), gelu_tanh(acc[m][n][3]))};
          *(u32x2*)(rp + n * 16 + fq * 4) = w;
        }
      }
      asm volatile("" ::: "memory");
    }
    if (region == 1) {
#pragma unroll
      for (int o = 1; o < 16; o <<= 1) kmax2 = fmaxf(kmax2, shx_f(kmax2, o, lane));
      if (lane == 0) {
        const int b = row0 < NLAT ? (row0 >> 13) : ((row0 - NLAT) >> 8);
        const int head = (pn & 3) * 2 + (wc >> 1), msub = wc & 1;
        atomicMax(KMAX + (b * NH + head) * 2 + msub, __float_as_uint(kmax2));
      }
    }
  }
};
struct EpiResid {
  const hstream_t* XS; hstream_t* Z; const float* modbase;
  int which;
  template <int MFR> struct Pre { u32x2 xs[MFR][4]; };
  template <int MFR> __device__ __forceinline__ void preload(Pre<MFR>& pre, int row0, int pn, int wr, int wc, int fr, int fq) const {
#pragma unroll
    for (int n = 0; n < 4; ++n)
#pragma unroll
      for (int m = 0; m < MFR; ++m)
        pre.xs[m][n] = *(const u32x2*)(XS + (size_t)(row0 + wr * (16 * MFR) + m * 16 + fr) * DM + pn * 256 + wc * 64 + n * 16 + fq * 4);
  }
  template <int MFR>
  __device__ __forceinline__ void run(const f32x4 (&acc)[MFR][4], const Pre<MFR>& pre, int row0, int pn, int wr, int wc, int fr, int fq, char*, int) const {
    const int who = row0 < SEQ ? 0 : (row0 < NLAT ? 1 : 2);
    const float* g = modbase + ((size_t)who * 6 + which) * 1024;
#pragma unroll
    for (int n = 0; n < 4; ++n) {
      const int col = pn * 256 + wc * 64 + n * 16 + fq * 4;
      const f32x4 gv = *(const f32x4*)(g + col);
#pragma unroll
      for (int m = 0; m < MFR; ++m) {
        const size_t off = (size_t)(row0 + wr * (16 * MFR) + m * 16 + fr) * DM + col;
        const u32x2 w = pre.xs[m][n];
        const f32x4 xs = {hlo(w[0]), hhi(w[0]), hlo(w[1]), hhi(w[1])};
        st4h(Z + off, xs * ALPHA + gv * acc[m][n]);
      }
    }
  }
};
struct EpiBf16Store {
  bf16_t* O; int ld;
  template <int MFR> struct Pre {};
  template <int MFR> __device__ __forceinline__ void preload(Pre<MFR>&, int, int, int, int, int, int) const {}
  template <int MFR>
  __device__ __forceinline__ void run(const f32x4 (&acc)[MFR][4], const Pre<MFR>&, int row0, int pn, int wr, int wc, int fr, int fq, char*, int) const {
#pragma unroll
    for (int m = 0; m < MFR; ++m) {
      bf16_t* rp = O + (size_t)(row0 + wr * (16 * MFR) + m * 16 + fr) * ld + pn * 256 + wc * 64;
#pragma unroll
      for (int n = 0; n < 4; ++n) {
        u32x2 w = {pk2h(acc[m][n][0], acc[m][n][1]), pk2h(acc[m][n][2], acc[m][n][3])};
        *(u32x2*)(rp + n * 16 + fq * 4) = w;
      }
    }
  }
};
#define FMX(a, b) __float_as_int(__builtin_fmaxf(__int_as_float(a), __int_as_float(b)))
#define FMN(a, b) __float_as_int(__builtin_fminf(__int_as_float(a), __int_as_float(b)))
#define CE(a, b) do { const int _h = FMX(a, b), _l = FMN(a, b); a = _h; b = _l; } while (0)
#define SORT16(v) do { CE(v[0], v[1]); CE(v[2], v[3]); CE(v[0], v[2]); CE(v[1], v[3]); CE(v[1], v[2]); CE(v[4], v[5]); CE(v[6], v[7]); CE(v[4], v[6]); CE(v[5], v[7]); CE(v[5], v[6]); CE(v[0], v[4]); CE(v[2], v[6]); CE(v[2], v[4]); CE(v[1], v[5]); CE(v[3], v[7]); CE(v[3], v[5]); CE(v[1], v[2]); CE(v[3], v[4]); CE(v[5], v[6]); CE(v[8], v[9]); CE(v[10], v[11]); CE(v[8], v[10]); CE(v[9], v[11]); CE(v[9], v[10]); CE(v[12], v[13]); CE(v[14], v[15]); CE(v[12], v[14]); CE(v[13], v[15]); CE(v[13], v[14]); CE(v[8], v[12]); CE(v[10], v[14]); CE(v[10], v[12]); CE(v[9], v[13]); CE(v[11], v[15]); CE(v[11], v[13]); CE(v[9], v[10]); CE(v[11], v[12]); CE(v[13], v[14]); CE(v[0], v[8]); CE(v[4], v[12]); CE(v[4], v[8]); CE(v[2], v[10]); CE(v[6], v[14]); CE(v[6], v[10]); CE(v[2], v[4]); CE(v[6], v[8]); CE(v[10], v[12]); CE(v[1], v[9]); CE(v[5], v[13]); CE(v[5], v[9]); CE(v[3], v[11]); CE(v[7], v[15]); CE(v[7], v[11]); CE(v[3], v[5]); CE(v[7], v[9]); CE(v[11], v[13]); CE(v[1], v[2]); CE(v[3], v[4]); CE(v[5], v[6]); CE(v[7], v[8]); CE(v[9], v[10]); CE(v[11], v[12]); CE(v[13], v[14]); } while (0)
#define BMERGE16(v) do { CE(v[0], v[8]); CE(v[1], v[9]); CE(v[2], v[10]); CE(v[3], v[11]); CE(v[4], v[12]); CE(v[5], v[13]); CE(v[6], v[14]); CE(v[7], v[15]); CE(v[0], v[4]); CE(v[1], v[5]); CE(v[2], v[6]); CE(v[3], v[7]); CE(v[8], v[12]); CE(v[9], v[13]); CE(v[10], v[14]); CE(v[11], v[15]); CE(v[0], v[2]); CE(v[1], v[3]); CE(v[4], v[6]); CE(v[5], v[7]); CE(v[8], v[10]); CE(v[9], v[11]); CE(v[12], v[14]); CE(v[13], v[15]); CE(v[0], v[1]); CE(v[2], v[3]); CE(v[4], v[5]); CE(v[6], v[7]); CE(v[8], v[9]); CE(v[10], v[11]); CE(v[12], v[13]); CE(v[14], v[15]); } while (0)
#define CAND_CHUNK0 do { T[0] = CK(0, 0); T[1] = CK(0, 1); T[2] = CK(0, 2); T[3] = CK(0, 3); T[4] = CK(0, 4); T[5] = CK(0, 5); T[6] = CK(0, 6); T[7] = CK(0, 7); T[8] = CK(0, 8); T[9] = CK(0, 9); T[10] = CK(0, 10); T[11] = CK(0, 11); T[12] = CK(0, 12); T[13] = CK(0, 13); T[14] = CK(0, 14); T[15] = CK(0, 15); } while (0)
#define CAND_CHUNK1 do { X[0] = CK(1, 0); X[1] = CK(1, 1); X[2] = CK(1, 2); X[3] = CK(1, 3); X[4] = CK(1, 4); X[5] = CK(1, 5); X[6] = CK(1, 6); X[7] = CK(1, 7); X[8] = CK(2, 0); X[9] = CK(2, 1); X[10] = CK(2, 2); X[11] = CK(2, 3); X[12] = CK(2, 4); X[13] = CK(3, 0); X[14] = CK(3, 1); X[15] = CK(3, 2); } while (0)
#define CAND_CHUNK2 do { X[0] = CK(3, 3); X[1] = CK(4, 0); X[2] = CK(4, 1); X[3] = CK(4, 2); X[4] = CK(5, 0); X[5] = CK(5, 1); X[6] = CK(6, 0); X[7] = CK(6, 1); X[8] = CK(7, 0); X[9] = CK(7, 1); X[10] = CK(8, 0); X[11] = CK(9, 0); X[12] = CK(10, 0); X[13] = CK(11, 0); X[14] = CK(12, 0); X[15] = CK(13, 0); } while (0)
#define CAND_CHUNK3 do { X[0] = CK(14, 0); X[1] = CK(15, 0); X[2] = (int)0xFF800000; X[3] = (int)0xFF800000; X[4] = (int)0xFF800000; X[5] = (int)0xFF800000; X[6] = (int)0xFF800000; X[7] = (int)0xFF800000; X[8] = (int)0xFF800000; X[9] = (int)0xFF800000; X[10] = (int)0xFF800000; X[11] = (int)0xFF800000; X[12] = (int)0xFF800000; X[13] = (int)0xFF800000; X[14] = (int)0xFF800000; X[15] = (int)0xFF800000; } while (0)

__device__ __forceinline__ int packkey7(float f, int idx) { return (__float_as_int(f) & ~0x7F) | (127 - idx); }
__device__ __forceinline__ float keyval7(int k) { return __int_as_float(k & ~0x7F); }
__device__ __forceinline__ int packkey8(float f, int pos) { return (__float_as_int(f) & ~0xFF) | (255 - pos); }
__device__ __forceinline__ float keyval8(int k) { return __int_as_float(k & ~0xFF); }
typedef int i32x4 __attribute__((ext_vector_type(4)));
#define LD16(dst, ptr) do { const i32x4 _a = *(const i32x4*)(ptr), _b = *(const i32x4*)((ptr) + 4), _c = *(const i32x4*)((ptr) + 8), _d = *(const i32x4*)((ptr) + 12); \
    dst[0] = _a[0]; dst[1] = _a[1]; dst[2] = _a[2]; dst[3] = _a[3]; dst[4] = _b[0]; dst[5] = _b[1]; dst[6] = _b[2]; dst[7] = _b[3];                                \
    dst[8] = _c[0]; dst[9] = _c[1]; dst[10] = _c[2]; dst[11] = _c[3]; dst[12] = _d[0]; dst[13] = _d[1]; dst[14] = _d[2]; dst[15] = _d[3]; } while (0)
#define ST16(ptr, src) do { *(i32x4*)(ptr) = (i32x4){src[0], src[1], src[2], src[3]}; *(i32x4*)((ptr) + 4) = (i32x4){src[4], src[5], src[6], src[7]};           \
    *(i32x4*)((ptr) + 8) = (i32x4){src[8], src[9], src[10], src[11]}; *(i32x4*)((ptr) + 12) = (i32x4){src[12], src[13], src[14], src[15]}; } while (0)
#define MERGE_TOP16(T, X) do { _Pragma("unroll") for (int _i = 0; _i < 16; ++_i) T[_i] = FMX(T[_i], X[15 - _i]); BMERGE16(T); } while (0)
struct EpiTopK {
  int* IDX; float* GATE;
  template <int MFR> struct Pre {};
  template <int MFR> __device__ __forceinline__ void preload(Pre<MFR>&, int, int, int, int, int, int) const {}
  template <int MFR>
  __device__ __forceinline__ void run(const f32x4 (&acc)[MFR][4], const Pre<MFR>&, int row0, int pn, int wr, int wc, int fr, int fq, char* shm, int tid_) const {
    constexpr int LST = 68, BM = 32 * MFR;
    int* lst = (int*)shm;
    const int tid = tid_, lane = tid_ & 63;
#pragma unroll
    for (int m = 0; m < MFR; ++m) {
      int T[16], X[16];
#pragma unroll
      for (int n = 0; n < 4; ++n)
#pragma unroll
        for (int j = 0; j < 4; ++j) T[n * 4 + j] = packkey7(acc[m][n][j], (wc & 1) * 64 + n * 16 + fq * 4 + j);
      SORT16(T);
#pragma unroll
      for (int i = 0; i < 16; ++i) { auto rr = __builtin_amdgcn_permlane16_swap(T[i], T[i], false, false); T[i] = rr[0]; X[i] = rr[1]; }
      MERGE_TOP16(T, X);
#pragma unroll
      for (int i = 0; i < 16; ++i) { auto rr = __builtin_amdgcn_permlane32_swap(T[i], T[i], false, false); T[i] = rr[0]; X[i] = rr[1]; }
      MERGE_TOP16(T, X);
      i32x4 w;
#pragma unroll
      for (int q = 0; q < 4; ++q) {
        const int m1 = -(fq & 1), m2 = -((fq >> 1) & 1);
        const int lo_ = (T[q] & ~m1) | (T[4 + q] & m1), hi_ = (T[8 + q] & ~m1) | (T[12 + q] & m1);
        w[q] = (lo_ & ~m2) | (hi_ & m2);
      }
      *(i32x4*)(lst + (wr * (16 * MFR) + m * 16 + fr) * LST + wc * 16 + fq * 4) = w;
    }
    __syncthreads();
    if (tid < 2 * BM) {
      const int row = tid & (BM - 1), pp = tid / BM;
      int T[16], X[16];
      LD16(T, lst + row * LST + pp * 32);
      LD16(X, lst + row * LST + pp * 32 + 16);
      MERGE_TOP16(T, X);
      ST16(lst + row * LST + pp * 32, T);
    }
    __syncthreads();
    if (tid < BM) {
      const int row = tid;
      int T[16], X[16];
      float a[16], b[16];
      LD16(T, lst + row * LST);
      LD16(X, lst + row * LST + 32);
#pragma unroll
      for (int i = 0; i < 16; ++i) { a[i] = keyval7(T[i]); b[i] = keyval7(X[i]); }
#define CK(i, j) packkey8(a[i] + b[j], (i) * 16 + (j))
      CAND_CHUNK0; SORT16(T);
      CAND_CHUNK1; SORT16(X); MERGE_TOP16(T, X);
      CAND_CHUNK2; SORT16(X); MERGE_TOP16(T, X);
      CAND_CHUNK3; SORT16(X); MERGE_TOP16(T, X);
#undef CK
      const float v0 = keyval8(T[0]);
      float e[16], sum = 0.f;
#pragma unroll
      for (int r = 0; r < 16; ++r) { e[r] = __expf(keyval8(T[r]) - v0); sum += e[r]; }
      const float inv = 1.0f / sum;
      const size_t go = ((size_t)pn * NTOK + (size_t)(row0 + row)) * 16;
#pragma unroll
      for (int r = 0; r < 16; ++r) {
        const int pos = 255 - (T[r] & 0xFF);
        const int ia = 127 - (lst[row * LST + (pos >> 4)] & 0x7F), ib = 127 - (lst[row * LST + 32 + (pos & 15)] & 0x7F);
        X[r] = ia * 128 + ib;
        e[r] *= inv;
      }
      ST16(IDX + go, X);
      *(f32x4*)(GATE + go) = (f32x4){e[0], e[1], e[2], e[3]}; *(f32x4*)(GATE + go + 4) = (f32x4){e[4], e[5], e[6], e[7]};
      *(f32x4*)(GATE + go + 8) = (f32x4){e[8], e[9], e[10], e[11]}; *(f32x4*)(GATE + go + 12) = (f32x4){e[12], e[13], e[14], e[15]};
    }
    __syncthreads();
  }
};

__device__ void transpose_unit(const float* __restrict__ W, bf16_t* __restrict__ Wt, int K, int N, int unit, char* shm, int tid_) {
  float* tl = (float*)shm;
  const int ntn = N / 64;
  const int k0 = (unit / ntn) * 64, n0 = (unit % ntn) * 64;
  const int tid = tid_;
#pragma unroll
  for (int i = 0; i < 8; ++i) {
    const int idx = tid + i * 512, r = idx >> 6, c = idx & 63;
    tl[r * 65 + c] = W[(size_t)(k0 + r) * N + n0 + c];
  }
  __syncthreads();
#pragma unroll
  for (int i = 0; i < 8; ++i) {
    const int idx = tid + i * 512, r = idx >> 6, c = idx & 63;
    Wt[(size_t)(n0 + r) * K + k0 + c] = f2h(tl[c * 65 + r]);
  }
  __syncthreads();
}

__device__ void foldqk_unit(const Params& p, int unit, char* shm, int tid_) {
  const int l = unit >> 8, hp = (unit >> 4) & 15, ct = unit & 15;
  float* kl = (float*)shm;
  float* wl = kl + 128 * 132;
  const float* keys = PIN(p, peer_keys) + ((size_t)(l * 16 + hp) * 128) * 128;
  const float* wq = PIN(p, peer_wq) + (size_t)l * 1024 * 2048;
  const int tid = tid_;
  for (int idx = tid; idx < 128 * 128; idx += 512) { const int k = idx >> 7, d = idx & 127; kl[d * 132 + k] = keys[k * 128 + d]; }
  for (int idx = tid; idx < 64 * 128; idx += 512) { const int c = idx >> 7, d = idx & 127; wl[d * 68 + c] = wq[(size_t)(ct * 64 + c) * 2048 + hp * 128 + d]; }
  __syncthreads();
  const int c0 = (tid & 15) * 4, k0 = (tid >> 4) * 4;
  f32x4 acc[4];
#pragma unroll
  for (int kk = 0; kk < 4; ++kk) acc[kk] = (f32x4){0.f, 0.f, 0.f, 0.f};
#pragma unroll 4
  for (int d = 0; d < 128; ++d) {
    const f32x4 a = *(const f32x4*)(wl + d * 68 + c0), bq = *(const f32x4*)(kl + d * 132 + k0);
#pragma unroll
    for (int kk = 0; kk < 4; ++kk) acc[kk] += a * bq[kk];
  }
  bf16_t* outp = (bf16_t*)(p.ws + OFF_WQK) + (size_t)l * 2048 * 1024;
#pragma unroll
  for (int kk = 0; kk < 4; ++kk) {
    u32x2 w = {pk2h(acc[kk][0], acc[kk][1]), pk2h(acc[kk][2], acc[kk][3])};
    *(u32x2*)(outp + (size_t)(hp * 128 + k0 + kk) * 1024 + ct * 64 + c0) = w;
  }
  __syncthreads();
}
__device__ void foldpool_unit(const Params& p, int unit, char* shm, int tid_) {
  const int j = unit >> 8, g = (unit >> 6) & 3, cit = (unit >> 4) & 3, et = unit & 15;
  float* gl = (float*)shm;
  float* ol = gl + 256 * 68;
  const float* wg = PIN(p, pool_w_grp) + ((size_t)(j * 4 + g) * 256) * 256;
  const float* sc = PIN(p, pool_scale) + (size_t)j * 1024 + g * 256;
  const float* wo = PIN(p, pool_w_out) + ((size_t)j * 1024 + g * 256) * 1024;
  const int tid = tid_;
  for (int idx = tid; idx < 64 * 256; idx += 512) { const int r = idx >> 8, m = idx & 255; gl[m * 68 + r] = wg[(size_t)(cit * 64 + r) * 256 + m] * sc[m]; }
  for (int idx = tid; idx < 256 * 64; idx += 512) { const int m = idx >> 6, e = idx & 63; ol[m * 68 + e] = wo[(size_t)m * 1024 + et * 64 + e]; }
  __syncthreads();
  const int ci0 = (tid & 31) * 2, e0 = (tid >> 5) * 4;
  f32x4 acc0 = {0.f, 0.f, 0.f, 0.f}, acc1 = {0.f, 0.f, 0.f, 0.f};
#pragma unroll 4
  for (int m = 0; m < 256; ++m) {
    const f32x2v a = *(const f32x2v*)(gl + m * 68 + ci0);
    const f32x4 bq = *(const f32x4*)(ol + m * 68 + e0);
    acc0 += bq * a[0]; acc1 += bq * a[1];
  }
  bf16_t* outp = (bf16_t*)(p.ws + OFF_POUT) + (size_t)j * 1024 * 1024;
#pragma unroll
  for (int ee = 0; ee < 4; ++ee)
    *(unsigned*)(outp + (size_t)(et * 64 + e0 + ee) * 1024 + g * 256 + cit * 64 + ci0) = pk2h(acc0[ee], acc1[ee]);
  __syncthreads();
}
__device__ void mod_unit(const Params& p, int unit, char* shm, int tid_) {
  const int l = unit / 48, rem = unit % 48, cgp = rem >> 1, kh = rem & 1;
  float* sv = (float*)shm;
  float* red = sv + 3 * 512;
  const int tid = tid_, lane = tid & 63, ks = __builtin_amdgcn_readfirstlane(tid >> 6);
  for (int idx = tid; idx < 3 * 512; idx += 512) {
    const int w = idx >> 9, k = kh * 512 + (idx & 511);
    const float xv = w < 2 ? PIN(p, c)[w * 1024 + k] : PIN(p, c_ctx)[k];
    sv[idx] = xv / (1.0f + __expf(-xv));
  }
  __syncthreads();
  const float* aw = PIN(p, ada_w) + (size_t)l * 1024 * 6144 + (size_t)(kh * 512 + ks * 64) * 6144 + cgp * 256 + lane * 4;
  f32x4 a0 = {0.f, 0.f, 0.f, 0.f}, a1 = a0, a2 = a0;
#pragma unroll 8
  for (int k = 0; k < 64; ++k) {
    const f32x4 w = *(const f32x4*)(aw + (size_t)k * 6144);
    a0 += w * sv[ks * 64 + k]; a1 += w * sv[512 + ks * 64 + k]; a2 += w * sv[1024 + ks * 64 + k];
  }
  *(f32x4*)(red + (ks * 3 + 0) * 256 + lane * 4) = a0; *(f32x4*)(red + (ks * 3 + 1) * 256 + lane * 4) = a1; *(f32x4*)(red + (ks * 3 + 2) * 256 + lane * 4) = a2;
  __syncthreads();
  for (int idx = tid; idx < 768; idx += 512) {
    const int w = idx >> 8, cc = idx & 255;
    float s = 0.f;
#pragma unroll
    for (int q = 0; q < 8; ++q) s += red[(q * 3 + w) * 256 + cc];
    const int n = cgp * 256 + cc;
    ((float*)(p.ws + OFF_MODP))[((size_t)kh * 12 + l * 3 + w) * 6144 + n] = s;
  }
  __syncthreads();
}

__device__ void phase_prologue_a(const Params& p, char* shm, int tid_) {
  constexpr int U_MOD = 192;
  constexpr int U_TWIN = 2 * 16 * 64, U_TWOUT = 2 * 24 * 16, U_TPIN = 2 * 16 * 16;
  constexpr int U_FQK = 1024, U_FP = 512, U_TAB = 2048, U_MISC = 1;
  constexpr int E0 = U_MOD, E1 = E0 + U_TWIN, E2 = E1 + U_TWOUT, E3 = E2 + U_TPIN, E4 = E3 + U_FQK, E5 = E4 + U_FP, E6 = E5 + U_TAB, E7 = E6 + U_MISC;
  const int bid_ = lbid(), G_ = gridDim.x;
  const bool tab_first = ((bid_ >> 3) & 1) != 0;
  const int nr_ = (E7 + G_ - 1) / G_;
  for (int j = 0; j < 2 * nr_; ++j) {
    const int u = bid_ + (j < nr_ ? j : j - nr_) * G_;
    if (u >= E7 || (u >= E5 && u < E6) != ((j < nr_) == tab_first)) continue;
    if (u < E0) mod_unit(p, u, shm, tid_);
    else if (u < E1) { const int v = u - E0, j = v / (16 * 64), r = v % (16 * 64);
      transpose_unit(PIN(p, ab_w_in) + (size_t)j * 1024 * 4096, (bf16_t*)(p.ws + OFF_WIN) + (size_t)j * 4096 * 1024, 1024, 4096, r, shm, tid_); }
    else if (u < E2) { const int v = u - E1, j = v / (24 * 16), r = v % (24 * 16);
      transpose_unit(PIN(p, ab_w_out) + (size_t)j * 1536 * 1024, (bf16_t*)(p.ws + OFF_WOUT) + (size_t)j * 1024 * 1536, 1536, 1024, r, shm, tid_); }
    else if (u < E3) { const int v = u - E2, j = v / 256, r = v % 256;
      transpose_unit(PIN(p, pool_w_in) + (size_t)j * 1024 * 1024, (bf16_t*)(p.ws + OFF_PIN) + (size_t)j * 1024 * 1024, 1024, 1024, r, shm, tid_); }
    else if (u < E4) foldqk_unit(p, u - E3, shm, tid_);
    else if (u < E5) foldpool_unit(p, u - E4, shm, tid_);
    else if (u < E6) {
      const int v = u - E5;
      const int tb = v >> 10;
      const float* src = tb ? PIN(p, peer_v) : PIN(p, peer_u);
      unsigned char* dst = (unsigned char*)(p.ws + (tb ? OFF_V8 : OFF_U8));
      const float scl = tb ? 8.0f : 64.0f;
      const int wid = __builtin_amdgcn_readfirstlane(tid_ >> 6), lane = tid_ & 63;
#pragma unroll 4
      for (int i = 0; i < 8; ++i) {
        const int row = (v & 1023) * 64 + i * 8 + wid;
        const int layer = row >> 14, e = row & 16383;
        const float* rp = src + (size_t)row * DM + lane * 16;
        const f32x4 a = *(const f32x4*)rp * scl, b = *(const f32x4*)(rp + 4) * scl, c = *(const f32x4*)(rp + 8) * scl, d = *(const f32x4*)(rp + 12) * scl;
        u32x4 w;
        w[0] = __builtin_amdgcn_cvt_pk_fp8_f32(a[2], a[3], __builtin_amdgcn_cvt_pk_fp8_f32(a[0], a[1], 0, false), true);
        w[1] = __builtin_amdgcn_cvt_pk_fp8_f32(b[2], b[3], __builtin_amdgcn_cvt_pk_fp8_f32(b[0], b[1], 0, false), true);
        w[2] = __builtin_amdgcn_cvt_pk_fp8_f32(c[2], c[3], __builtin_amdgcn_cvt_pk_fp8_f32(c[0], c[1], 0, false), true);
        w[3] = __builtin_amdgcn_cvt_pk_fp8_f32(d[2], d[3], __builtin_amdgcn_cvt_pk_fp8_f32(d[0], d[1], 0, false), true);
        *(u32x4*)(dst + ((size_t)(layer * 8 + (lane >> 3)) * NEXP + e) * 128 + (lane & 7) * 16) = w;
      }
    } else {
      float* rope = (float*)(p.ws + OFF_ROPE);
      for (int idx = tid_; idx < 128 * 16; idx += 512) {
        const int pos = idx >> 4, i = idx & 15;
        const float inv = powf(10000.0f, -(float)i / 16.0f);
        const float ang = (float)pos * inv;
        rope[idx * 2 + 0] = cosf(ang);
        rope[idx * 2 + 1] = sinf(ang);
      }
      if (tid_ < 2) {
        const int j = tid_;
        const float* lv = PIN(p, diff_lam) + (size_t)j * 4 * 64;
        float s1 = 0.f, s2 = 0.f;
        for (int d = 0; d < 64; ++d) { s1 += lv[d] * lv[64 + d]; s2 += lv[128 + d] * lv[192 + d]; }
        const float lam_init = 0.8f - 0.6f * expf(-0.3f * (float)(2 * j));
        float* lam = (float*)(p.ws + OFF_LAM);
        lam[j * 2 + 0] = expf(s1) - expf(s2) + lam_init;
        lam[j * 2 + 1] = lam_init;
      }
    }
  }
}

__device__ void phase_prologue_b(const Params& p, int tid_) {
  const int wid = __builtin_amdgcn_readfirstlane(tid_ >> 6), lane = tid_ & 63;
  {
    const float* mp = (const float*)(p.ws + OFF_MODP);
    float* md = (float*)(p.ws + OFF_MOD);
    for (int idx = lbid() * 512 + tid_; idx < 12 * 6144; idx += gridDim.x * 512) {
      const int l = idx / (3 * 6144), n = idx % 6144;
      md[idx] = mp[idx] + mp[12 * 6144 + idx] + PIN(p, ada_b)[(size_t)l * 6144 + n];
    }
  }
  hstream_t* XS = (hstream_t*)(p.ws + OFF_XSA);
  bf16_t* H = (bf16_t*)(p.ws + OFF_H);
  for (int row = lbid() * 8 + wid; row < NTOK; row += gridDim.x * 8) {
    const float* src = row < NLAT ? PIN(p, x) + (size_t)row * DM : PIN(p, ctx) + (size_t)(row - NLAT) * DM;
    const int who = who_of_row(row);
    const float* mp0 = (const float*)(p.ws + OFF_MODP) + (size_t)who * 6144;
    const float* mp1 = mp0 + 12 * 6144;
#pragma unroll
    for (int i = 0; i < 4; ++i) {
      const int col = i * 256 + lane * 4;
      const f32x4 v = *(const f32x4*)(src + col);
      st4h(XS + (size_t)row * DM + col, v);
      const f32x4 s1 = *(const f32x4*)(mp0 + col) + *(const f32x4*)(mp1 + col) + *(const f32x4*)(PIN(p, ada_b) + col);
      const f32x4 s2 = *(const f32x4*)(mp0 + 1024 + col) + *(const f32x4*)(mp1 + 1024 + col) + *(const f32x4*)(PIN(p, ada_b) + 1024 + col);
      const f32x4 h = v * (s2 + 1.0f) + s1;
      u32x2 w = {pk2h(h[0], h[1]), pk2h(h[2], h[3])};
      *(u32x2*)(H + (size_t)row * DM + col) = w;
    }
  }
}

__device__ void phase_ln(const Params& p, const hstream_t* Zin, hstream_t* XSo, int layer, int lnidx, int nrows, bf16_t* Hout, int mlayer, int msh, int nrows_h, bool final, int tid_) {
  const int wid = __builtin_amdgcn_readfirstlane(tid_ >> 6), lane = tid_ & 63;
  const float* g = PIN(p, ln_g) + (size_t)(layer * 2 + lnidx) * DM;
  const float* bt = PIN(p, ln_b) + (size_t)(layer * 2 + lnidx) * DM;
  for (int row = lbid() * 8 + wid; row < nrows; row += gridDim.x * 8) {
    const int who = who_of_row(row);
    f32x4 v[4];
    float s = 0.f;
#pragma unroll
    for (int i = 0; i < 4; ++i) { v[i] = ld4h(Zin + (size_t)row * DM + i * 256 + lane * 4); s += (v[i][0] + v[i][1]) + (v[i][2] + v[i][3]); }
    const float mu = wave_sum(s, lane) * (1.0f / DM);
    float q = 0.f;
#pragma unroll
    for (int i = 0; i < 4; ++i) { const f32x4 d = v[i] - mu; q += (d[0] * d[0] + d[1] * d[1]) + (d[2] * d[2] + d[3] * d[3]); }
    const float rstd = rsqrtf(wave_sum(q, lane) * (1.0f / DM) + LN_EPS);
#pragma unroll
    for (int i = 0; i < 4; ++i) {
      const int col = i * 256 + lane * 4;
      const f32x4 gg = *(const f32x4*)(g + col), bb = *(const f32x4*)(bt + col);
      const f32x4 xo = (v[i] - mu) * rstd * gg + bb;
      if (final) { *(f32x4*)(p.out + (size_t)row * DM + col) = xo; }
      else {
        st4h(XSo + (size_t)row * DM + col, xo);
        if (row < nrows_h) {
          const f32x4 s1 = *(const f32x4*)(mod_ptr(p, mlayer, who, msh) + col), s2 = *(const f32x4*)(mod_ptr(p, mlayer, who, msh + 1) + col);
          const f32x4 h = xo * (s2 + 1.0f) + s1;
          u32x2 w;
          if (lnidx == 0) w = (u32x2){pk2h(h[0], h[1]), pk2h(h[2], h[3])};
          else w = (u32x2){pk2h(h[0], h[1]), pk2h(h[2], h[3])};
          *(u32x2*)(Hout + (size_t)row * DM + col) = w;
        }
      }
    }
  }
}

typedef short s16x4 __attribute__((ext_vector_type(4)));
typedef float f32x16 __attribute__((ext_vector_type(16)));
#define KSWZ(row, colB) ((row) * 256 + ((colB) ^ (((row) & 7) << 4)))
#define SBAR() __builtin_amdgcn_sched_barrier(0)
constexpr float ATT_SCALE = 0.125f, ATT_THR = 8.f;
#ifndef ATT_SDEPTH
#define ATT_SDEPTH 1
#endif
constexpr int SHM_KV = 64 * 128 * 2;
__device__ __forceinline__ int crow(int r, int hi) { return (r & 3) + 8 * (r >> 2) + 4 * hi; }
__device__ __forceinline__ unsigned cvtpk(float lo, float hi) {
  unsigned r; asm volatile("v_cvt_pk_bf16_f32 %0, %1, %2" : "=v"(r) : "v"(lo), "v"(hi)); return r;
}
__device__ __forceinline__ void qkt(f32x16& p0, f32x16& p1, const char* Ks, const bf16x8* qr, int r32, int hi, int m, float negM) {
#pragma unroll
  for (int r = 0; r < 16; ++r) { p0[r] = negM; p1[r] = negM; }
#pragma unroll
  for (int d0 = 0; d0 < 4; ++d0) {
    const int cb = (m * 64 + d0 * 16 + hi * 8) * 2;
    const bf16x8 b0 = *reinterpret_cast<const bf16x8*>(Ks + KSWZ(r32, cb));
    const bf16x8 b1 = *reinterpret_cast<const bf16x8*>(Ks + KSWZ(32 + r32, cb));
    p0 = __builtin_amdgcn_mfma_f32_32x32x16_bf16(b0, qr[d0], p0, 0, 0, 0);
    p1 = __builtin_amdgcn_mfma_f32_32x32x16_bf16(b1, qr[d0], p1, 0, 0, 0);
  }
}
__device__ __forceinline__ int v_st(int k, int c) { const int kk = (k & ~0xC) | ((k & 4) << 1) | ((k & 8) >> 1); return ((kk >> 3) * 4 + (c >> 5)) * 512 + ((kk & 7) * 32 + (c & 31)) * 2; }
__device__ __forceinline__ int v_rd_base(int lane) { return ((lane & 3) << 3) | (((lane >> 2) & 3) << 6) | (((lane >> 4) & 1) << 5) | (((lane >> 5) & 1) << 8); }
constexpr int v_rd_off(int d0, int ks, int half) { return d0 * 512 + ks * 4096 + half * 2048; }
template <int OFF> __device__ __forceinline__ s16x4 tr_read(int vb) {
  s16x4 r; asm volatile("ds_read_b64_tr_b16 %0, %1 offset:%2" : "=&v"(r) : "v"(vb), "i"(OFF) : "memory"); return r;
}
template <int D0> __device__ __forceinline__ void pv_one(f32x16& od, int vb, bf16x8 pa0, bf16x8 pa1, bf16x8 pa2, bf16x8 pa3) {
  const s16x4 l0 = tr_read<v_rd_off(D0, 0, 0)>(vb), h0 = tr_read<v_rd_off(D0, 0, 1)>(vb), l1 = tr_read<v_rd_off(D0, 1, 0)>(vb), h1 = tr_read<v_rd_off(D0, 1, 1)>(vb);
  const s16x4 l2 = tr_read<v_rd_off(D0, 2, 0)>(vb), h2 = tr_read<v_rd_off(D0, 2, 1)>(vb), l3 = tr_read<v_rd_off(D0, 3, 0)>(vb), h3 = tr_read<v_rd_off(D0, 3, 1)>(vb);
  asm volatile("s_waitcnt lgkmcnt(0)" ::: "memory"); SBAR();
#define PKV(L, H) (bf16x8){L[0], L[1], L[2], L[3], H[0], H[1], H[2], H[3]}
  od = __builtin_amdgcn_mfma_f32_32x32x16_bf16(pa0, PKV(l0, h0), od, 0, 0, 0);
  od = __builtin_amdgcn_mfma_f32_32x32x16_bf16(pa1, PKV(l1, h1), od, 0, 0, 0);
  od = __builtin_amdgcn_mfma_f32_32x32x16_bf16(pa2, PKV(l2, h2), od, 0, 0, 0);
  od = __builtin_amdgcn_mfma_f32_32x32x16_bf16(pa3, PKV(l3, h3), od, 0, 0, 0);
#undef PKV
}
template <int D0> __device__ __forceinline__ void pv_one_t(f32x16& od, int vb, bf16x8 pa0, bf16x8 pa1, bf16x8 pa2, bf16x8 pa3) {
  const s16x4 l0 = tr_read<v_rd_off(D0, 0, 0)>(vb), h0 = tr_read<v_rd_off(D0, 0, 1)>(vb), l1 = tr_read<v_rd_off(D0, 1, 0)>(vb), h1 = tr_read<v_rd_off(D0, 1, 1)>(vb);
  const s16x4 l2 = tr_read<v_rd_off(D0, 2, 0)>(vb), h2 = tr_read<v_rd_off(D0, 2, 1)>(vb), l3 = tr_read<v_rd_off(D0, 3, 0)>(vb), h3 = tr_read<v_rd_off(D0, 3, 1)>(vb);
  asm volatile("s_waitcnt lgkmcnt(0)" ::: "memory"); SBAR();
#define PKV(L, H) (bf16x8){L[0], L[1], L[2], L[3], H[0], H[1], H[2], H[3]}
  od = __builtin_amdgcn_mfma_f32_32x32x16_bf16(PKV(l0, h0), pa0, od, 0, 0, 0);
  od = __builtin_amdgcn_mfma_f32_32x32x16_bf16(PKV(l1, h1), pa1, od, 0, 0, 0);
  od = __builtin_amdgcn_mfma_f32_32x32x16_bf16(PKV(l2, h2), pa2, od, 0, 0, 0);
  od = __builtin_amdgcn_mfma_f32_32x32x16_bf16(PKV(l3, h3), pa3, od, 0, 0, 0);
#undef PKV
}

__device__ __forceinline__ void attn_unit(const bf16_t* __restrict__ Qb, const bf16_t* __restrict__ Kh, const bf16_t* __restrict__ Vh, int seq,
                                          bf16_t* __restrict__ CATp  , const float* __restrict__ ng, float lam, float lam_init,
                                          const unsigned* __restrict__ kmaxp  , char* lds, int tid_) {
  const int tid = tid_, wid = __builtin_amdgcn_readfirstlane(tid >> 6), lane = tid & 63, r32 = lane & 31, hi = lane >> 5;
  const int rg = wid & 3, m = wid >> 2;
  constexpr int SLOT = 2 * SHM_KV;
  float* wsp = (float*)(lds + 4 * SLOT) + wid * 64; float* li_l = wsp;
  float l_reg = 0; f32x16 o[4] = {}; bf16x8 qr[4];
  const bf16_t* Qw = Qb + (size_t)(rg * 32 + r32) * 128 + m * 64 + hi * 8;
#pragma unroll
  for (int d0 = 0; d0 < 4; ++d0) qr[d0] = *reinterpret_cast<const bf16x8*>(Qw + d0 * 16);
  float negM;
  {
    float q2 = 0.f;
#pragma unroll
    for (int d0 = 0; d0 < 4; ++d0)
#pragma unroll
      for (int e = 0; e < 8; ++e) { const float v = bf2f((bf16_t)qr[d0][e]); q2 += v * v; }
    { auto rr = __builtin_amdgcn_permlane32_swap(__float_as_uint(q2), __float_as_uint(q2), false, false); q2 = __uint_as_float(rr[0]) + __uint_as_float(rr[1]); }
    const float k2 = __uint_as_float(kmaxp[m]);
    negM = -1.01f * sqrtf(q2 * k2);
  }
  unsigned vsrc[2], ksrc[2];
#pragma unroll
  for (int j = 0; j < 2; ++j) {
    const int p_ = wid + 8 * j;
    const int g_ = p_ * 64 + lane, sub = g_ >> 5, within = g_ & 31;
    const int kk = (sub >> 2) * 8 + (within >> 2), c_ = (sub & 3) * 32 + (within & 3) * 8;
    const int k_ = (kk & ~0xC) | ((kk & 4) << 1) | ((kk & 8) >> 1);
    vsrc[j] = (unsigned)(k_ * 256 + c_ * 2);
    const int row = p_ * 4 + (lane >> 4), chunk = (lane & 15) ^ (row & 7);
    ksrc[j] = (unsigned)(row * 256 + chunk * 16);
  }
  const int vb0 = (int)(uintptr_t)lds + v_rd_base(lane);
#define SLOAD_DMA(k0, slot) do { \
    const char* _vg = (const char*)(Vh + (size_t)(k0) * 128); const char* _kg = (const char*)(Kh + (size_t)(k0) * 128); char* _b = lds + (slot) * SLOT; \
    __builtin_amdgcn_global_load_lds((const unsigned*)(_vg + vsrc[0]), (unsigned*)(_b + wid * 1024), 16, 0, 0); \
    __builtin_amdgcn_global_load_lds((const unsigned*)(_vg + vsrc[1]), (unsigned*)(_b + (wid + 8) * 1024), 16, 0, 0); \
    __builtin_amdgcn_global_load_lds((const unsigned*)(_kg + ksrc[0]), (unsigned*)(_b + SHM_KV + wid * 1024), 16, 0, 0); \
    __builtin_amdgcn_global_load_lds((const unsigned*)(_kg + ksrc[1]), (unsigned*)(_b + SHM_KV + (wid + 8) * 1024), 16, 0, 0); } while (0)
#define TILE_PUBLISH() do { asm volatile("s_waitcnt vmcnt(0) lgkmcnt(0)" ::: "memory"); __builtin_amdgcn_s_barrier(); asm volatile("" ::: "memory"); } while (0)
#define PKV(L, H) (bf16x8){L[0], L[1], L[2], L[3], H[0], H[1], H[2], H[3]}
#define VRD(D0, KH, vb, f0, f1, f2, f3) do { f0 = tr_read<v_rd_off(D0, 2 * (KH), 0)>(vb); f1 = tr_read<v_rd_off(D0, 2 * (KH), 1)>(vb); \
    f2 = tr_read<v_rd_off(D0, 2 * (KH) + 1, 0)>(vb); f3 = tr_read<v_rd_off(D0, 2 * (KH) + 1, 1)>(vb); } while (0)
#define VMM(D0, qa, qb, f0, f1, f2, f3) do { \
    o[D0] = __builtin_amdgcn_mfma_f32_32x32x16_bf16(qa, PKV(f0, f1), o[D0], 0, 0, 0); \
    o[D0] = __builtin_amdgcn_mfma_f32_32x32x16_bf16(qb, PKV(f2, f3), o[D0], 0, 0, 0); } while (0)
#define LW4() do { asm volatile("s_waitcnt lgkmcnt(4)" ::: "memory"); SBAR(); } while (0)
#define LW0() do { asm volatile("s_waitcnt lgkmcnt(0)" ::: "memory"); SBAR(); } while (0)
#define PV_TILE(vb, q0, q1, q2, q3, C0, C1, C2, C3) do { \
    s16x4 a0, a1, a2, a3; \
    SBAR(); VRD(0, 0, vb, a0, a1, a2, a3); C0; LW0(); VMM(0, q0, q1, a0, a1, a2, a3); SBAR(); \
    VRD(0, 1, vb, a0, a1, a2, a3);     LW0(); VMM(0, q2, q3, a0, a1, a2, a3); SBAR(); \
    VRD(1, 0, vb, a0, a1, a2, a3); C1; LW0(); VMM(1, q0, q1, a0, a1, a2, a3); SBAR(); \
    VRD(1, 1, vb, a0, a1, a2, a3);     LW0(); VMM(1, q2, q3, a0, a1, a2, a3); SBAR(); \
    VRD(2, 0, vb, a0, a1, a2, a3); C2; LW0(); VMM(2, q0, q1, a0, a1, a2, a3); SBAR(); \
    VRD(2, 1, vb, a0, a1, a2, a3);     LW0(); VMM(2, q2, q3, a0, a1, a2, a3); SBAR(); \
    VRD(3, 0, vb, a0, a1, a2, a3); C3; LW0(); VMM(3, q0, q1, a0, a1, a2, a3); SBAR(); \
    VRD(3, 1, vb, a0, a1, a2, a3);     LW0(); VMM(3, q2, q3, a0, a1, a2, a3); SBAR(); } while (0)
#define PK4(P, BASE, OUT) do { unsigned a0 = cvtpk(P[BASE + 0], P[BASE + 1]), a1 = cvtpk(P[BASE + 2], P[BASE + 3]);   \
    unsigned b0 = cvtpk(P[BASE + 4], P[BASE + 5]), b1 = cvtpk(P[BASE + 6], P[BASE + 7]);                              \
    auto r0 = __builtin_amdgcn_permlane32_swap(a0, b0, false, false); auto r1 = __builtin_amdgcn_permlane32_swap(a1, b1, false, false); \
    u32x4 w = {r0[0], r1[0], r0[1], r1[1]}; OUT = *reinterpret_cast<bf16x8*>(&w); } while (0)
#define E1(S0) do { _Pragma("unroll") for (int r = 0; r < 16; ++r) S0[r] = __builtin_amdgcn_exp2f(S0[r]); } while (0)
#define E3(S0, S1) do { float ps = 0; _Pragma("unroll") for (int r = 0; r < 16; ++r) ps += S0[r]; _Pragma("unroll") for (int r = 0; r < 16; ++r) ps += S1[r]; l_reg += ps; } while (0)
#define E4(S0, S1, n0, n1, n2, n3) do { PK4(S0, 0, n0); PK4(S0, 8, n1); PK4(S1, 0, n2); PK4(S1, 8, n3); } while (0)
#define ITER(SN0, SN1, ks, SP0, SP1, vs) do { \
    const int _vb = vb0 + (vs) * SLOT; \
    PV_TILE(_vb, p0, p1, p2, p3, E1(SP0), E1(SP1), E3(SP0, SP1), (void)0); \
    qkt(SN0, SN1, lds + (ks) * SLOT + SHM_KV, qr, r32, hi, m, negM); \
    E4(SP0, SP1, p0, p1, p2, p3); SBAR(); } while (0)
  f32x16 sA0, sA1, sB0, sB1; bf16x8 p0, p1, p2, p3; const int NT = seq / 64;
  SLOAD_DMA(0, 0); TILE_PUBLISH();
  SLOAD_DMA(64, 1);
  qkt(sA0, sA1, lds + SHM_KV, qr, r32, hi, m, negM);
  TILE_PUBLISH();
  if (2 < NT) SLOAD_DMA(2 * 64, 2);
  qkt(sB0, sB1, lds + SLOT + SHM_KV, qr, r32, hi, m, negM);
  E1(sA0); E1(sA1); E3(sA0, sA1); E4(sA0, sA1, p0, p1, p2, p3);
  TILE_PUBLISH();
  for (int i = 2; i < NT; i += 2) {
    SLOAD_DMA((i + 1) * 64, (i + 1) & 3);
    ITER(sA0, sA1, i & 3, sB0, sB1, (i - 2) & 3);
    TILE_PUBLISH();
    if (i + 2 < NT) SLOAD_DMA((i + 2) * 64, (i + 2) & 3);
    ITER(sB0, sB1, (i + 1) & 3, sA0, sA1, (i - 1) & 3);
    TILE_PUBLISH();
  }
  {
    const int _vb = vb0 + ((NT - 2) & 3) * SLOT;
    PV_TILE(_vb, p0, p1, p2, p3, E1(sB0), E1(sB1), E3(sB0, sB1), (void)0);
    E4(sB0, sB1, p0, p1, p2, p3); SBAR();
    const int _vb2 = vb0 + ((NT - 1) & 3) * SLOT;
    PV_TILE(_vb2, p0, p1, p2, p3, (void)0, (void)0, (void)0, (void)0);
  }
#undef SLOAD_DMA
#undef TILE_PUBLISH
#undef PKV
#undef PV_TILE
#undef VRD
#undef VMM
#undef LW4
#undef LW0
#undef PK4
#undef E1
#undef E3
#undef E4
#undef ITER
  int r32e = r32, hie = hi;
  asm volatile("" : "+v"(r32e), "+v"(hie));
  { auto rr = __builtin_amdgcn_permlane32_swap(__float_as_uint(l_reg), __float_as_uint(l_reg), false, false); l_reg = __uint_as_float(rr[0]) + __uint_as_float(rr[1]); }
  if (hie == 0) li_l[r32e] = l_reg;
  asm volatile("s_waitcnt lgkmcnt(0)" ::: "memory");
  float rli[16];
#pragma unroll
  for (int r = 0; r < 16; ++r) rli[r] = __builtin_amdgcn_rcpf(li_l[crow(r, hie)]);
  __syncthreads();
  float* comb = (float*)lds;
  if (m == 1) {
#pragma unroll
    for (int r = 0; r < 16; ++r)
#pragma unroll
      for (int d0 = 0; d0 < 4; ++d0) comb[(rg * 32 + crow(r, hie)) * 128 + d0 * 32 + r32e] = o[d0][r] * rli[r] * lam;
  }
  __syncthreads();
  if (m == 0) {
    float ss[16];
#pragma unroll
    for (int r = 0; r < 16; ++r) {
      float a = 0.f;
#pragma unroll
      for (int d0 = 0; d0 < 4; ++d0) {
        const float v = o[d0][r] * rli[r] - comb[(rg * 32 + crow(r, hie)) * 128 + d0 * 32 + r32e];
        o[d0][r] = v; a += v * v;
      }
      ss[r] = a;
    }
#pragma unroll
    for (int off = 1; off < 32; off <<= 1)
#pragma unroll
      for (int r = 0; r < 16; ++r) ss[r] += shx_f(ss[r], off, lane);
    const float om = 1.0f - lam_init;
    float gq[4];
#pragma unroll
    for (int d0 = 0; d0 < 4; ++d0) gq[d0] = ng[d0 * 32 + r32e] * om;
#pragma unroll
    for (int r = 0; r < 16; ++r) {
      const float rs = rsqrtf(ss[r] * (1.0f / 128.0f) + LN_EPS);
      bf16_t* cp = CATp + (size_t)(rg * 32 + crow(r, hie)) * 1536;
#pragma unroll
      for (int d0 = 0; d0 < 4; ++d0) cp[d0 * 32 + r32e] = f2h(o[d0][r] * rs * gq[d0]);
    }
  }
  __syncthreads();
}

__device__ __forceinline__ void sgu_unit(const Params& p, int chunk, int jl, char* lds, int tid_) {
  const int tid = tid_, wid = __builtin_amdgcn_readfirstlane(tid >> 6), lane = tid & 63, r32 = lane & 31, hi = lane >> 5;
  const int row0 = chunk * 128;
  const bf16_t* GV = (const bf16_t*)(p.ws + OFF_GV);
  const bf16_t* GU = (const bf16_t*)(p.ws + OFF_GU);
  bf16_t* CAT = (bf16_t*)(p.ws + OFF_CAT);
  const float* lg = PIN(p, sgu_ln_g) + (size_t)jl * 512;
  const float* lb = PIN(p, sgu_ln_b) + (size_t)jl * 512;
  {
    const f32x4 g0 = *(const f32x4*)(lg + lane * 8), g1 = *(const f32x4*)(lg + lane * 8 + 4);
    const f32x4 b0 = *(const f32x4*)(lb + lane * 8), b1 = *(const f32x4*)(lb + lane * 8 + 4);
    const int c = lane * 8, g = c >> 7, cg = c & 127;
    for (int q = wid; q < 128; q += 8) {
      const u32x4 w = *(const u32x4*)(GV + (size_t)(row0 + q) * 512 + c);
      float v[8];
#pragma unroll
      for (int i = 0; i < 4; ++i) { v[2 * i] = bflo(w[i]); v[2 * i + 1] = bfhi(w[i]); }
      float s = 0.f;
#pragma unroll
      for (int i = 0; i < 8; ++i) s += v[i];
      const float mu = wave_sum(s, lane) * (1.0f / 512.0f);
      float qq = 0.f;
#pragma unroll
      for (int i = 0; i < 8; ++i) { const float d = v[i] - mu; qq += d * d; }
      const float rstd = rsqrtf(wave_sum(qq, lane) * (1.0f / 512.0f) + LN_EPS);
      u32x4 ow;
      ow[0] = pk2((v[0] - mu) * rstd * g0[0] + b0[0], (v[1] - mu) * rstd * g0[1] + b0[1]);
      ow[1] = pk2((v[2] - mu) * rstd * g0[2] + b0[2], (v[3] - mu) * rstd * g0[3] + b0[3]);
      ow[2] = pk2((v[4] - mu) * rstd * g1[0] + b1[0], (v[5] - mu) * rstd * g1[1] + b1[1]);
      ow[3] = pk2((v[6] - mu) * rstd * g1[2] + b1[2], (v[7] - mu) * rstd * g1[3] + b1[3]);
      *(u32x4*)(lds + (g * 2 + (q >> 6)) * SHM_KV + v_st(q & 63, cg)) = ow;
    }
  }
  __syncthreads();
  const int pg = wid & 3, ch = wid >> 2;
  const int vbase = (int)(uintptr_t)lds + v_rd_base(lane);
  for (int g = 0; g < 4; ++g) {
    const float* Wg = PIN(p, sgu_w) + ((size_t)(jl * 4 + g) * 128) * 128;
    bf16x8 af[8];
#pragma unroll
    for (int ks = 0; ks < 8; ++ks) {
      const float* wp = Wg + (size_t)(pg * 32 + r32) * 128 + ks * 16 + hi * 8;
      const f32x4 a = *(const f32x4*)wp, b = *(const f32x4*)(wp + 4);
      u32x4 w = {pk2(a[0], a[1]), pk2(a[2], a[3]), pk2(b[0], b[1]), pk2(b[2], b[3])};
      af[ks] = *reinterpret_cast<bf16x8*>(&w);
    }
    f32x16 acc[2] = {};
#pragma unroll
    for (int kt = 0; kt < 2; ++kt) {
      const int vb = vbase + (g * 2 + kt) * SHM_KV;
      if (ch == 0) { pv_one_t<0>(acc[0], vb, af[kt * 4 + 0], af[kt * 4 + 1], af[kt * 4 + 2], af[kt * 4 + 3]); pv_one_t<1>(acc[1], vb, af[kt * 4 + 0], af[kt * 4 + 1], af[kt * 4 + 2], af[kt * 4 + 3]); }
      else         { pv_one_t<2>(acc[0], vb, af[kt * 4 + 0], af[kt * 4 + 1], af[kt * 4 + 2], af[kt * 4 + 3]); pv_one_t<3>(acc[1], vb, af[kt * 4 + 0], af[kt * 4 + 1], af[kt * 4 + 2], af[kt * 4 + 3]); }
    }
    const int pp = pg * 32 + r32;
    const float bb = (PIN(p, sgu_b) + (size_t)(jl * 4 + g) * 128)[pp];
    const bf16_t* gup = GU + (size_t)(row0 + pp) * 512 + g * 128 + ch * 64 + 4 * hi;
    bf16_t* cap = CAT + (size_t)(row0 + pp) * 1536 + 1024 + g * 128 + ch * 64 + 4 * hi;
#pragma unroll
    for (int dd = 0; dd < 2; ++dd)
#pragma unroll
      for (int q = 0; q < 4; ++q) {
        const u32x2 uw = *(const u32x2*)(gup + dd * 32 + q * 8);
        const float s0 = acc[dd][4 * q] + bb, s1 = acc[dd][4 * q + 1] + bb, s2 = acc[dd][4 * q + 2] + bb, s3 = acc[dd][4 * q + 3] + bb;
        u32x2 ow = {pk2h(bflo(uw[0]) * s0, bfhi(uw[0]) * s1), pk2h(bflo(uw[1]) * s2, bfhi(uw[1]) * s3)};
        *(u32x2*)(cap + dd * 32 + q * 8) = ow;
      }
  }
  __syncthreads();
}

__device__ void phase_mixer_fast(const Params& p, int layer, char* shm, int tid_) {
  const int jl = layer >> 1;
  const bool ctxq = layer == 0;
  const float lam = ((const float*)(p.ws + OFF_LAM))[jl * 2 + 0];
  const float lam_init = ((const float*)(p.ws + OFF_LAM))[jl * 2 + 1];
  const float* ng = PIN(p, diff_norm_g) + (size_t)jl * 128;
  const bf16_t* Q = (const bf16_t*)(p.ws + OFF_Q);
  const bf16_t* K = (const bf16_t*)(p.ws + OFF_K);
  const bf16_t* V = (const bf16_t*)(p.ws + OFF_V);
  bf16_t* CAT = (bf16_t*)(p.ws + OFF_CAT);
  const int bid = lbid();
  const int NC = ctxq ? 32 : 0;
  const int NS = ctxq ? (NTOK / 128) : (NLAT / 128);
  for (int u = bid; u < 1024 + NC + NS; u += gridDim.x) {
    if (u < 1024 + NC) {
      int bh, pos0, seq, orow;
      if (u < 1024) {
        const int xcd = u & 7, ul = (u >> 8) * 32 + ((u & 255) >> 3), qb = ul & 63;
        bh = xcd * 2 + (ul >> 6);
        pos0 = CTXL + qb * 128; seq = LKV; orow = (bh >> 3) * SEQ + qb * 128;
      } else {
        const int v = u - 1024, qb = v & 1;
        bh = v >> 1;
        pos0 = qb * 128; seq = CTXL; orow = NLAT + (bh >> 3) * CTXL + qb * 128;
      }
      const size_t hb = (size_t)bh * LKV * 128;
      attn_unit(Q + hb + (size_t)pos0 * 128, K + hb, V + hb, seq, CAT + (size_t)orow * 1536 + (bh & 7) * 128, ng, lam, lam_init, (const unsigned*)(p.ws + OFF_BAR + 256) + jl * 32 + bh * 2, shm, tid_);
    } else {
      sgu_unit(p, u - 1024 - NC, jl, shm, tid_);
    }
  }
}

__device__ __forceinline__ void ld8h(const bf16_t* p, float (&v)[8]) {
  const u32x4 w = *(const u32x4*)p;
#pragma unroll
  for (int i = 0; i < 4; ++i) { v[2 * i] = hlo(w[i]); v[2 * i + 1] = hhi(w[i]); }
}
__device__ void phase_pool(const Params& p, int nrows, int tid_) {
  const bf16_t* M1 = (const bf16_t*)(p.ws + OFF_M1);
  bf16_t* M2 = (bf16_t*)(p.ws + OFF_M2);
  const int nitems = (nrows >> 5) * 128;
  for (int it = lbid() * 512 + tid_; it < nitems; it += gridDim.x * 512) {
    const int cg = it & 127, seg = it >> 7;
    const int row0 = seg * 32;
    int base, T;
    if (row0 < NLAT) { base = row0 & ~(SEQ - 1); T = SEQ; } else { base = NLAT + ((row0 - NLAT) & ~255); T = CTXL; }
    const int t0 = row0 - base;
    const int h = 1 << (cg >> 5);
    const bf16_t* colp = M1 + (size_t)base * 1024 + cg * 8;
    float S[8];
#pragma unroll
    for (int i = 0; i < 8; ++i) S[i] = 0.f;
    {
      const int lo = t0 - h < 0 ? 0 : t0 - h, hi = t0 + h > T ? T : t0 + h;
      for (int q = lo; q < hi; ++q) { float v[8]; ld8h(colp + (size_t)q * 1024, v);
#pragma unroll
        for (int i = 0; i < 8; ++i) S[i] += v[i]; }
    }
    for (int t = t0; t < t0 + 32; ++t) {
      const int lo = t - h < 0 ? 0 : t - h, hi = t + h > T ? T : t + h;
      const float inv = 1.0f / (float)(hi - lo);
      float x[8];
      ld8h(colp + (size_t)t * 1024, x);
      u32x4 w;
#pragma unroll
      for (int i = 0; i < 4; ++i) w[i] = pk2h(S[2 * i] * inv - x[2 * i], S[2 * i + 1] * inv - x[2 * i + 1]);
      *(u32x4*)(M2 + (size_t)(base + t) * 1024 + cg * 8) = w;
      if (t + h < T) { float v[8]; ld8h(colp + (size_t)(t + h) * 1024, v);
#pragma unroll
        for (int i = 0; i < 8; ++i) S[i] += v[i]; }
      if (t - h >= 0) { float v[8]; ld8h(colp + (size_t)(t - h) * 1024, v);
#pragma unroll
        for (int i = 0; i < 8; ++i) S[i] -= v[i]; }
    }
  }
}

__device__ __forceinline__ void fp8x16_to_f32(const u32x4 w, float (&f)[16]) {
#pragma unroll
  for (int q = 0; q < 4; ++q) {
    const f32x2v lo = __builtin_amdgcn_cvt_pk_f32_fp8((int)w[q], false), hi = __builtin_amdgcn_cvt_pk_f32_fp8((int)w[q], true);
    f[4 * q] = lo[0]; f[4 * q + 1] = lo[1]; f[4 * q + 2] = hi[0]; f[4 * q + 3] = hi[1];
  }
}
__device__ __forceinline__ float hadd2(f32x2v v) { float r; asm("v_add_f32 %0, %1, %2" : "=v"(r) : "v"(v[0]), "v"(v[1])); return r; }
#define PEER_LOAD_IDS_LO(dst, k) do { const int _t = wv + (k) * nwv; const i32x4* _ip = (const i32x4*)(IDX + ((size_t)g * NTOK + _t) * 16); dst##0 = _ip[0]; dst##1 = _ip[1]; } while (0)
#define PEER_LOAD_IDS_HI(dst, k) do { const int _t = wv + (k) * nwv; const i32x4* _ip = (const i32x4*)(IDX + ((size_t)g * NTOK + _t) * 16); dst##2 = _ip[2]; dst##3 = _ip[3]; } while (0)
#define PEER_ROW(TAB, id) (*(const u32x4*)((TAB) + (unsigned)(((id) << 7) | c16)))
#define PEER_GATHER_H0(buf, TAB, id) do { \
    buf[0] = PEER_ROW(TAB, id##0[0]); buf[1] = PEER_ROW(TAB, id##0[1]); buf[2] = PEER_ROW(TAB, id##0[2]); buf[3] = PEER_ROW(TAB, id##0[3]); \
    buf[4] = PEER_ROW(TAB, id##1[0]); buf[5] = PEER_ROW(TAB, id##1[1]); buf[6] = PEER_ROW(TAB, id##1[2]); buf[7] = PEER_ROW(TAB, id##1[3]); } while (0)
#define PEER_GATHER_H1(buf, TAB, id) do { \
    buf[0] = PEER_ROW(TAB, id##2[0]); buf[1] = PEER_ROW(TAB, id##2[1]); buf[2] = PEER_ROW(TAB, id##2[2]); buf[3] = PEER_ROW(TAB, id##2[3]); \
    buf[4] = PEER_ROW(TAB, id##3[0]); buf[5] = PEER_ROW(TAB, id##3[1]); buf[6] = PEER_ROW(TAB, id##3[2]); buf[7] = PEER_ROW(TAB, id##3[3]); } while (0)

__device__ void phase_peer_u(const Params& p, int layer, int nrows, int tid_) {
  const int tid = tid_, wid = __builtin_amdgcn_readfirstlane(tid >> 6), lane = tid & 63, bid = lbid();
  const int s = bid & 7, wv = (bid >> 3) * 8 + wid, nwv = (gridDim.x >> 3) * 8;
  const int g = lane >> 3, c = lane & 7, c16 = c * 16;
  const bool b2 = (lane & 4) != 0, b1 = (lane & 2) != 0, b0 = (lane & 1) != 0;
  const bf16_t* H = (const bf16_t*)(p.ws + OFF_HB) + s * 128 + c * 16;
  const unsigned char* U = (const unsigned char*)(p.ws + OFF_U8) + (size_t)(layer * 8 + s) * NEXP * 128;
  const int* IDX = (const int*)(p.ws + OFF_IDX);
  float* PART = (float*)(p.ws + OFF_PART);
  const int n = wv < nrows ? (nrows - wv + nwv - 1) / nwv : 0;
  if (n == 0) return;
  i32x4 id0, id1, id2, id3;
  u32x4 bufA[8], bufB[8], hn0, hn1;
  f32x2v h2[8];
#define PU_HLOAD(h0, h1, k) do { const int _t = wv + (k) * nwv; h0 = *(const u32x4*)(H + (size_t)_t * DM); h1 = *(const u32x4*)(H + (size_t)_t * DM + 8); } while (0)
#define PU_HCVT() do { _Pragma("unroll") for (int q = 0; q < 4; ++q) { h2[q] = (f32x2v){hlo(hn0[q]), hhi(hn0[q])}; h2[4 + q] = (f32x2v){hlo(hn1[q]), hhi(hn1[q])}; } } while (0)
#define PU_HALF(buf, base) do { \
    _Pragma("unroll") for (int i = 0; i < 8; i += 2) { f32x2v a0 = {0.f, 0.f}, a1 = a0, b0v = a0, b1v = a0;     \
      _Pragma("unroll") for (int q = 0; q < 4; ++q) { \
        a0 = __builtin_elementwise_fma(h2[2 * q], __builtin_amdgcn_cvt_pk_f32_fp8((int)buf[i][q], false), a0); \
        b0v = __builtin_elementwise_fma(h2[2 * q], __builtin_amdgcn_cvt_pk_f32_fp8((int)buf[i + 1][q], false), b0v); \
        a1 = __builtin_elementwise_fma(h2[2 * q + 1], __builtin_amdgcn_cvt_pk_f32_fp8((int)buf[i][q], true), a1); \
        b1v = __builtin_elementwise_fma(h2[2 * q + 1], __builtin_amdgcn_cvt_pk_f32_fp8((int)buf[i + 1][q], true), b1v); } \
      a0 += a1; b0v += b1v; pd[(base) + i] = hadd2(a0); pd[(base) + i + 1] = hadd2(b0v); } } while (0)
  PEER_LOAD_IDS_LO(id, 0); PEER_LOAD_IDS_HI(id, 0);
  PEER_GATHER_H0(bufA, U, id); PU_HLOAD(hn0, hn1, 0);
  { const int k1 = n > 1 ? 1 : 0; PEER_LOAD_IDS_LO(id, k1); }
  PU_HCVT();
  for (int k = 0; k < n; ++k) {
    const int k1 = k + 1 < n ? k + 1 : k, k2 = k + 2 < n ? k + 2 : n - 1;
    PEER_GATHER_H1(bufB, U, id);
    __builtin_amdgcn_sched_barrier(0);
    PEER_LOAD_IDS_HI(id, k1);
    __builtin_amdgcn_sched_barrier(0);
    float pd[16];
    PU_HALF(bufA, 0);
    __builtin_amdgcn_sched_barrier(0);
    PEER_GATHER_H0(bufA, U, id); PU_HLOAD(hn0, hn1, k1);
    __builtin_amdgcn_sched_barrier(0);
    PEER_LOAD_IDS_LO(id, k2);
    __builtin_amdgcn_sched_barrier(0);
    PU_HALF(bufB, 8);
    float r8[8], r4[4], r2[2];
#pragma unroll
    for (int i = 0; i < 8; ++i) { const float keep = b2 ? pd[8 + i] : pd[i], send = b2 ? pd[i] : pd[8 + i]; r8[i] = keep + shx_f(send, 4, lane); }
#pragma unroll
    for (int i = 0; i < 4; ++i) { const float keep = b1 ? r8[4 + i] : r8[i], send = b1 ? r8[i] : r8[4 + i]; r4[i] = keep + shx_f(send, 2, lane); }
#pragma unroll
    for (int i = 0; i < 2; ++i) { const float keep = b0 ? r4[2 + i] : r4[i], send = b0 ? r4[i] : r4[2 + i]; r2[i] = keep + shx_f(send, 1, lane); }
    *(f32x2v*)(PART + ((size_t)(wv + k * nwv) * 8 + s) * 128 + lane * 2) = (f32x2v){r2[0] * (1.0f / 64.0f), r2[1] * (1.0f / 64.0f)};
    PU_HCVT();
    __builtin_amdgcn_sched_barrier(0);
  }
#undef PU_HLOAD
#undef PU_HCVT
#undef PU_HALF
}
__device__ void phase_peer_w(const Params& p, int nrows, int tid_) {
  const int wid = __builtin_amdgcn_readfirstlane(tid_ >> 6), lane = tid_ & 63;
  const float* PART = (const float*)(p.ws + OFF_PART);
  const float* GATE = (const float*)(p.ws + OFF_GATE);
  float* W = (float*)(p.ws + OFF_PW);
  for (int t = lbid() * 8 + wid; t < nrows; t += gridDim.x * 8) {
    f32x2v acc2 = {0.f, 0.f};
#pragma unroll
    for (int q = 0; q < 8; ++q) acc2 += *(const f32x2v*)(PART + ((size_t)t * 8 + q) * 128 + lane * 2);
    const f32x2v gt = *(const f32x2v*)(GATE + ((size_t)(lane >> 3) * NTOK + t) * 16 + (lane & 7) * 2);
    *(f32x2v*)(W + (size_t)t * 128 + lane * 2) = (f32x2v){gt[0] * gelu_tanh(acc2[0]), gt[1] * gelu_tanh(acc2[1])};
  }
}
__device__ void phase_peer_v(const Params& p, int layer, const hstream_t* XSin, hstream_t* Zout, int nrows, int tid_) {
  const int tid = tid_, wid = __builtin_amdgcn_readfirstlane(tid >> 6), lane = tid & 63, bid = lbid();
  const int s = bid & 7, wv = (bid >> 3) * 8 + wid, nwv = (gridDim.x >> 3) * 8;
  const int g = lane >> 3, c = lane & 7, c16 = c * 16;
  const bool b5 = (lane & 32) != 0, b4 = (lane & 16) != 0, b3 = (lane & 8) != 0;
  const unsigned char* Vt = (const unsigned char*)(p.ws + OFF_V8) + (size_t)(layer * 8 + s) * NEXP * 128;
  const int* IDX = (const int*)(p.ws + OFF_IDX);
  const float* W = (const float*)(p.ws + OFF_PW);
  const int col = s * 128 + c * 16 + g * 2;
  const int n = wv < nrows ? (nrows - wv + nwv - 1) / nwv : 0;
  if (n == 0) return;
  i32x4 id0, id1, id2, id3;
  u32x4 bufA[8], bufB[8];
  f32x2v wc2, wn2;
  unsigned xw;
#define PV_HALF(buf, base) do { \
    _Pragma("unroll") for (int i = 0; i < 8; ++i) { \
      const float w = shl_f((i & 1) ? wc2[1] : wc2[0], (lane & 56) + (((base) + i) >> 1)); \
      const f32x2v w2 = {w, w}; \
      _Pragma("unroll") for (int q = 0; q < 4; ++q) { \
        o2[2 * q] = __builtin_elementwise_fma(w2, __builtin_amdgcn_cvt_pk_f32_fp8((int)buf[i][q], false), o2[2 * q]); \
        o2[2 * q + 1] = __builtin_elementwise_fma(w2, __builtin_amdgcn_cvt_pk_f32_fp8((int)buf[i][q], true), o2[2 * q + 1]); } } } while (0)
  PEER_LOAD_IDS_LO(id, 0); PEER_LOAD_IDS_HI(id, 0);
  PEER_GATHER_H0(bufA, Vt, id);
  wc2 = *(const f32x2v*)(W + (size_t)wv * 128 + lane * 2);
  { const int k1 = n > 1 ? 1 : 0; PEER_LOAD_IDS_LO(id, k1); }
  for (int k = 0; k < n; ++k) {
    const int k1 = k + 1 < n ? k + 1 : k, k2 = k + 2 < n ? k + 2 : n - 1;
    const int t = wv + k * nwv;
    PEER_GATHER_H1(bufB, Vt, id);
    __builtin_amdgcn_sched_barrier(0);
    PEER_LOAD_IDS_HI(id, k1);
    xw = *(const unsigned*)(XSin + (size_t)t * DM + col);
    __builtin_amdgcn_sched_barrier(0);
    f32x2v o2[8];
#pragma unroll
    for (int j = 0; j < 8; ++j) o2[j] = (f32x2v){0.f, 0.f};
    PV_HALF(bufA, 0);
    __builtin_amdgcn_sched_barrier(0);
    PEER_GATHER_H0(bufA, Vt, id);
    wn2 = *(const f32x2v*)(W + (size_t)(wv + k1 * nwv) * 128 + lane * 2);
    __builtin_amdgcn_sched_barrier(0);
    PEER_LOAD_IDS_LO(id, k2);
    __builtin_amdgcn_sched_barrier(0);
    PV_HALF(bufB, 8);
    float r8[8], r4[4], r2[2];
#pragma unroll
    for (int i = 0; i < 8; ++i) { const float lo_ = o2[i >> 1][i & 1], hi_ = o2[4 + (i >> 1)][i & 1]; const float keep = b5 ? hi_ : lo_, send = b5 ? lo_ : hi_; r8[i] = keep + shx_f(send, 32, lane); }
#pragma unroll
    for (int i = 0; i < 4; ++i) { const float keep = b4 ? r8[4 + i] : r8[i], send = b4 ? r8[i] : r8[4 + i]; r4[i] = keep + shx_f(send, 16, lane); }
#pragma unroll
    for (int i = 0; i < 2; ++i) { const float keep = b3 ? r4[2 + i] : r4[i], send = b3 ? r4[i] : r4[2 + i]; r2[i] = keep + shx_f(send, 8, lane); }
    const f32x2v g2 = *(const f32x2v*)(mod_ptr(p, layer, who_of_row(t), 5) + col);
    *(unsigned*)(Zout + (size_t)t * DM + col) = pk2h(ALPHA * hlo(xw) + g2[0] * r2[0] * 0.125f, ALPHA * hhi(xw) + g2[1] * r2[1] * 0.125f);
    wc2 = wn2;
    __builtin_amdgcn_sched_barrier(0);
  }
#undef PV_HALF
}

constexpr int NSTEP = 9;
constexpr int NPHASE = 2 + NSTEP * DEPTH;

__device__ void run_phase(const Params& pin, int ph, char* shm, int tid_) {
  Params p = pin;
  { unsigned zoff = 0; asm volatile("" : "+s"(zoff));
    p.ws = pin.ws + zoff; }
  if (ph == 0) { phase_prologue_a(p, shm, tid_); return; }
  if (ph == 1) { phase_prologue_b(p, tid_); return; }
  const int layer = (ph - 2) / NSTEP, step = (ph - 2) % NSTEP;
  const bool even = (layer & 1) == 0;
  const int jl = layer >> 1;
  const bool ctx_out = layer < 2;
  const int nrows = ctx_out ? NTOK : NLAT;
  const int mt_upd = nrows / 256;
  hstream_t* XSA = (hstream_t*)(p.ws + OFF_XSA);
  hstream_t* XSB = (hstream_t*)(p.ws + OFF_XSB);
  hstream_t* Z = (hstream_t*)(p.ws + OFF_Z);
  const bf16_t* H = (const bf16_t*)(p.ws + OFF_H);
  const float* modl = (const float*)(p.ws + OFF_MOD) + (size_t)layer * 3 * 6144;
  if (step == 0) {
    if (even) {
      EpiInProj e{(bf16_t*)(p.ws + OFF_Q), (bf16_t*)(p.ws + OFF_K), (bf16_t*)(p.ws + OFF_V), (bf16_t*)(p.ws + OFF_GU), (bf16_t*)(p.ws + OFF_GV),
                  (const float*)(p.ws + OFF_ROPE), (unsigned*)(p.ws + OFF_BAR + 256) + jl * 32};
      const int mt = (layer <= 2) ? NTOK / 256 : NLAT / 256;
      gemm_phase<true>(H, (const bf16_t*)(p.ws + OFF_WIN) + (size_t)jl * 4096 * 1024, NLAT / 256, (mt * 256) - NLAT, 16, 1024, e, shm, tid_);
    } else {
      EpiBf16Store e{(bf16_t*)(p.ws + OFF_M1), 1024};
      gemm_phase<true>(H, (const bf16_t*)(p.ws + OFF_PIN) + (size_t)jl * 1024 * 1024, NLAT / 256, nrows - NLAT, 4, 1024, e, shm, tid_);
    }
  } else if (step == 1) {
    if (even) phase_mixer_fast(p, layer, shm, tid_);
    else phase_pool(p, nrows, tid_);
  } else if (step == 2) {
    EpiResid e{XSA, Z, modl, 2};
    if (even) gemm_phase<true>((const bf16_t*)(p.ws + OFF_CAT), (const bf16_t*)(p.ws + OFF_WOUT) + (size_t)jl * 1024 * 1536, NLAT / 256, nrows - NLAT, 4, 1536, e, shm, tid_);
    else gemm_phase<true>((const bf16_t*)(p.ws + OFF_M2), (const bf16_t*)(p.ws + OFF_POUT) + (size_t)jl * 1024 * 1024, NLAT / 256, nrows - NLAT, 4, 1024, e, shm, tid_);
  } else if (step == 3) {
    phase_ln(p, Z, XSB, layer, 0, nrows, (bf16_t*)(p.ws + OFF_HB), layer, 3, nrows, false, tid_);
  } else if (step == 4) {
    EpiTopK e{(int*)(p.ws + OFF_IDX), (float*)(p.ws + OFF_GATE)};
    gemm_phase<true>((const bf16_t*)(p.ws + OFF_HB), (const bf16_t*)(p.ws + OFF_WQK) + (size_t)layer * 2048 * 1024, NLAT / 256, nrows - NLAT, 8, 1024, e, shm, tid_);
  } else if (step == 5) {
    phase_peer_u(p, layer, nrows, tid_);
  } else if (step == 6) {
    phase_peer_w(p, nrows, tid_);
  } else if (step == 7) {
    phase_peer_v(p, layer, XSB, Z, nrows, tid_);
  } else {
    const int nl = layer + 1;
    const int nrows_next = (nl <= 2) ? NTOK : NLAT;
    phase_ln(p, Z, XSA, layer, 1, nrows, (bf16_t*)(p.ws + OFF_H), nl, 0, nrows_next < nrows ? nrows_next : nrows, layer == DEPTH - 1, tid_);
  }
}

#define XB_XCNT(j) (64 * (j))
#define XB_XSUB(j) (512 + 64 * (j))
#define XB_XGEN(j) (1024 + 64 * (j))
#define XB_TOP 1536
#define XB_TOPGEN 1600
#define XB_WORDS 1664
__device__ __forceinline__ unsigned xb_ld(unsigned* p) { return __hip_atomic_load(p, __ATOMIC_RELAXED, __HIP_MEMORY_SCOPE_AGENT); }
__device__ __forceinline__ unsigned xb_add(unsigned* p, unsigned v) { return __hip_atomic_fetch_add(p, v, __ATOMIC_RELAXED, __HIP_MEMORY_SCOPE_AGENT); }
__device__ __forceinline__ void grid_barrier(unsigned* bar, int xcc, unsigned nloc, unsigned nx, int tid_) {
  asm volatile("s_waitcnt vmcnt(0) lgkmcnt(0)" ::: "memory");
  __syncthreads();
  if (tid_ == 0) {
    const unsigned old = xb_add(&bar[XB_XSUB(xcc)], 1u);
    const unsigned gen = old / nloc;
    if (old + 1u == (gen + 1u) * nloc) {
      __builtin_amdgcn_fence(__ATOMIC_RELEASE, "agent");
      asm volatile("s_waitcnt vmcnt(0)" ::: "memory");
      const unsigned og = xb_add(&bar[XB_TOP], 1u);
      const unsigned tg = og / nx;
      if (og + 1u == (tg + 1u) * nx) xb_add(&bar[XB_TOPGEN], 1u);
      else while (xb_ld(&bar[XB_TOPGEN]) == tg) __builtin_amdgcn_s_sleep(1);
      __builtin_amdgcn_fence(__ATOMIC_ACQUIRE, "agent");
      xb_add(&bar[XB_XGEN(xcc)], 1u);
      asm volatile("s_waitcnt vmcnt(0)" ::: "memory");
    } else {
      while (xb_ld(&bar[XB_XGEN(xcc)]) == gen) __builtin_amdgcn_s_sleep(1);
      __builtin_amdgcn_fence(__ATOMIC_ACQUIRE, "agent");
      asm volatile("s_waitcnt vmcnt(0)" ::: "memory");
    }
  }
  __syncthreads();
}

__device__ __forceinline__ int phase_cat(int ph) {
  if (ph < 2) return 0;
  const int layer = (ph - 2) / NSTEP, step = (ph - 2) % NSTEP;
  const bool even = (layer & 1) == 0;
  if (step == 0) return even ? 1 : 7;
  if (step == 1) return even ? 2 : 8;
  if (step == 2) return 3;
  if (step == 3) return 4;
  if (step == 4) return 5;
  if (step == 5) return 6;
  if (step == 6) return 12;
  if (step == 7) return 10;
  return 11;
}

__global__ void __launch_bounds__(512) mega(KArgs ka, int ph_lo, int ph_hi) {
  Params p;
  p.in = (const float* const*)__builtin_amdgcn_kernarg_segment_ptr();
  p.out = ka.out; p.ws = ka.ws;
  __shared__ __attribute__((aligned(1024))) char shm[LDS_BYTES];
  cg::grid_group grid = cg::this_grid();
  unsigned* bar = (unsigned*)(p.ws + OFF_BAR + 512);
  int rep = 0;
  const int swid = __builtin_amdgcn_readfirstlane((int)(threadIdx.x >> 6));
  const int my_xcc = (int)(__builtin_amdgcn_s_getreg((3 << 11) | 20) & 0x7);
  if (threadIdx.x == 0) xb_add(&bar[XB_XCNT(my_xcc)], 1u);
  unsigned nloc = 1, nx = 1;
  for (int ph = ph_lo; ph < ph_hi;) {
    run_phase(p, ph, shm, make_tid(swid));
    bool again = false;
#ifdef DUP_CAT
    if (phase_cat(ph) == DUP_CAT && rep == 0) again = true;
#endif
    if (again || ph + 1 < ph_hi) {
      if (ph == ph_lo && !again && rep == 0) {
        grid.sync();
        unsigned cnt = 0, mine = 0;
#pragma unroll
        for (int j = 0; j < 8; ++j) { const unsigned c = xb_ld(&bar[XB_XCNT(j)]); cnt += c > 0u ? 1u : 0u; mine = j == my_xcc ? c : mine; }
        nloc = __builtin_amdgcn_readfirstlane(mine > 0u ? mine : 1u); nx = __builtin_amdgcn_readfirstlane(cnt > 0u ? cnt : 1u);
      } else grid_barrier(bar, my_xcc, nloc, nx, make_tid(swid));
    }
    if (again) rep = 1; else { rep = 0; ++ph; }
  }
}

extern "C" void kernel_launch(void* const* d_in, const int* in_sizes, int n_in, void* d_out, int out_size, void* d_ws, size_t ws_size,
                              hipStream_t stream) {
  static int grid_blocks = 0;
  if (!grid_blocks) {
    int dev = 0, cus = 0, per_cu = 0;
    (void)hipGetDevice(&dev);
    (void)hipDeviceGetAttribute(&cus, hipDeviceAttributeMultiprocessorCount, dev);
    (void)hipOccupancyMaxActiveBlocksPerMultiprocessor(&per_cu, mega, 512, 0);
    if (per_cu > 1) per_cu = 1;
    grid_blocks = cus * per_cu;
    if (ws_size < WS_END) fprintf(stderr, "kernel_launch: workspace too small: %zu < %zu\n", ws_size, (size_t)WS_END);
    if (grid_blocks <= 0) fprintf(stderr, "kernel_launch: occupancy query returned 0\n");
  }
  KArgs p{};
  for (int i = 0; i < 24; ++i) p.in[i] = (const float*)d_in[i];
  p.out = (float*)d_out;
  p.ws = (char*)d_ws;
  (void)hipMemsetAsync((char*)d_ws + OFF_BAR, 0, 512 + 8192, stream);
  int lo = 0, hi = NPHASE;
  void* args[] = {&p, &lo, &hi};
  hipError_t e = hipLaunchCooperativeKernel((void*)mega, dim3(grid_blocks), dim3(512), args, 0, stream);
  if (e != hipSuccess) fprintf(stderr, "cooperative launch failed: %s (grid %d)\n", hipGetErrorString(e), grid_blocks);
}
```

```cpp
#include <hip/hip_runtime.h>
#include <hip/hip_cooperative_groups.h>
#include <cstdio>
#include <cstdint>
namespace cg = cooperative_groups;

typedef unsigned short bf16_t;
typedef short bf16x8 __attribute__((ext_vector_type(8)));
typedef float f32x4 __attribute__((ext_vector_type(4)));
typedef unsigned u32x4 __attribute__((ext_vector_type(4)));
typedef unsigned u32x2 __attribute__((ext_vector_type(2)));
typedef float f32x2v __attribute__((ext_vector_type(2)));
typedef int i32x4 __attribute__((ext_vector_type(4)));
typedef __bf16 bf16x2_t __attribute__((ext_vector_type(2)));

constexpr int DM = 1024, NBATCH = 2, SEQ = 8192, CTXL = 256, DEPTH = 4;
constexpr int NLAT = NBATCH * SEQ;
constexpr int NCTX = NBATCH * CTXL;
constexpr int NTOK = NLAT + NCTX;
constexpr int LKV = CTXL + SEQ;
constexpr int NH = 8;
constexpr int NEXP = 16384;
constexpr float LN_EPS = 1e-5f;
constexpr float ALPHA = 1.6817928305074290f;
constexpr float QSCALE = 0.125f * 1.4426950408889634f;

constexpr size_t al256(size_t x) { return (x + 255) / 256 * 256; }
constexpr size_t SZ_TAB = (size_t)DEPTH * NEXP * DM;
constexpr size_t SZ_QKV = (size_t)NBATCH * NH * LKV * 128 * 2;
constexpr size_t SZ_XS = (size_t)NTOK * DM * 4;
constexpr size_t OFF_U8 = 0;
constexpr size_t OFF_V8 = OFF_U8 + SZ_TAB;
constexpr size_t OFF_Q = OFF_V8 + SZ_TAB;
constexpr size_t OFF_K = OFF_Q + SZ_QKV;
constexpr size_t OFF_V = OFF_K + SZ_QKV;
constexpr size_t OFF_XSA = OFF_V + SZ_QKV;
constexpr size_t OFF_XSB = OFF_XSA + SZ_XS;
constexpr size_t OFF_Z = OFF_XSB + SZ_XS;
constexpr size_t OFF_H = OFF_Z + SZ_XS;
constexpr size_t OFF_HB = OFF_H + (size_t)NTOK * DM * 2;
constexpr size_t OFF_CAT = OFF_HB + (size_t)NTOK * DM * 2;
constexpr size_t OFF_GU = OFF_CAT + (size_t)NTOK * 1536 * 2;
constexpr size_t OFF_GV = OFF_GU + (size_t)NTOK * 512 * 2;
constexpr size_t OFF_M1 = OFF_GV + (size_t)NTOK * 512 * 2;
constexpr size_t OFF_M2 = OFF_M1 + (size_t)NTOK * DM * 2;
constexpr size_t OFF_SC = OFF_M2 + (size_t)NTOK * DM * 2;
constexpr size_t OFF_IDX = OFF_SC;
constexpr size_t OFF_GATE = OFF_IDX + (size_t)NTOK * 128 * 4;
constexpr size_t OFF_WIN = OFF_GATE + (size_t)NTOK * 128 * 4;
constexpr size_t OFF_WOUT = OFF_WIN + (size_t)2 * 4096 * 1024 * 2;
constexpr size_t OFF_PIN = OFF_WOUT + (size_t)2 * 1024 * 1536 * 2;
constexpr size_t OFF_POUT = OFF_PIN + (size_t)2 * 1024 * 1024 * 2;
constexpr size_t OFF_WQK = OFF_POUT + (size_t)2 * 1024 * 1024 * 2;
constexpr size_t OFF_MOD = OFF_WQK + (size_t)4 * 2048 * 1024 * 2;
constexpr size_t OFF_MODP = OFF_MOD + al256((size_t)4 * 3 * 6144 * 4);
constexpr size_t OFF_ROPE = OFF_MODP + al256((size_t)2 * 4 * 3 * 6144 * 4);
constexpr size_t OFF_LAM = OFF_ROPE + al256((size_t)128 * 16 * 2 * 4);
constexpr size_t OFF_PART = OFF_LAM + 256;
constexpr size_t OFF_PW = OFF_PART + (size_t)NTOK * 8 * 128 * 4;
constexpr size_t OFF_H8 = OFF_PW + (size_t)NTOK * 128 * 4;
constexpr size_t OFF_HSC = OFF_H8 + (size_t)NTOK * DM;
constexpr size_t OFF_USC = OFF_HSC + al256((size_t)NTOK * 4);
constexpr size_t OFF_VSC = OFF_USC + (size_t)DEPTH * NEXP * 4;
constexpr size_t OFF_W8 = OFF_VSC + (size_t)DEPTH * NEXP * 4;
constexpr size_t OFF_WSC = OFF_W8 + (size_t)NTOK * 128;
constexpr size_t OFF_IDX16 = OFF_WSC + al256((size_t)NTOK * 4);
constexpr size_t OFF_WQK8 = OFF_IDX16 + (size_t)NTOK * 128 * 2;
constexpr size_t OFF_WQSC = OFF_WQK8 + (size_t)DEPTH * 2048 * 1024;
constexpr size_t OFF_PIN8 = OFF_WQSC + (size_t)DEPTH * 2048 * 4;
constexpr size_t OFF_PINSC = OFF_PIN8 + (size_t)2 * 1024 * 1024;
constexpr size_t OFF_WIN8 = OFF_PINSC + (size_t)2 * 1024 * 4;
constexpr size_t OFF_WINSC = OFF_WIN8 + (size_t)2 * 4096 * 1024;
constexpr size_t OFF_BAR = OFF_WINSC + (size_t)2 * 4096 * 4;
constexpr size_t WS_END = OFF_BAR + 512 + 8192;

struct KArgs {
  const float* in[24];
  float* out;
  char* ws;
};
struct Params {
  const float* const* in;
  float* out;
  char* ws;
};
enum { IN_x, IN_c, IN_ctx, IN_c_ctx, IN_ada_w, IN_ada_b, IN_ln_g, IN_ln_b, IN_ab_w_in, IN_ab_w_out, IN_diff_lam, IN_diff_norm_g, IN_sgu_ln_g, IN_sgu_ln_b,
       IN_sgu_w, IN_sgu_b, IN_pool_w_in, IN_pool_w_grp, IN_pool_scale, IN_pool_w_out, IN_peer_wq, IN_peer_keys, IN_peer_u, IN_peer_v };
#define AS_GLOBAL(T, ptr) ((T)(__attribute__((address_space(1))) char*)(char*)(ptr))
#define PIN(p, name) AS_GLOBAL(const float*, (p).in[IN_##name])

constexpr int LDS_BYTES = 144 * 1024;

__device__ __forceinline__ int make_tid(int swid) {
  int t;
  asm volatile("v_mbcnt_lo_u32_b32 %0, -1, 0\n\tv_mbcnt_hi_u32_b32 %0, -1, %0" : "=v"(t));
  return (swid << 6) | t;
}
__device__ __forceinline__ int lbid() { int b = blockIdx.x; asm volatile("" : "+s"(b)); return b; }
__device__ __forceinline__ bf16_t f2bf(float f) {
  unsigned u = __float_as_uint(f);
  u += 0x7fffu + ((u >> 16) & 1u);
  return (bf16_t)(u >> 16);
}
__device__ __forceinline__ float bf2f(bf16_t b) { return __uint_as_float(((unsigned)b) << 16); }
__device__ __forceinline__ unsigned pk2(float lo, float hi) { return (unsigned)f2bf(lo) | ((unsigned)f2bf(hi) << 16); }
typedef _Float16 f16x8 __attribute__((ext_vector_type(8)));
typedef _Float16 f16x2 __attribute__((ext_vector_type(2)));
__device__ __forceinline__ unsigned pk2h(float lo, float hi) { const f16x2 v = {(_Float16)lo, (_Float16)hi}; return __builtin_bit_cast(unsigned, v); }
__device__ __forceinline__ float hlo(unsigned w) { return (float)__builtin_bit_cast(f16x2, w)[0]; }
__device__ __forceinline__ float hhi(unsigned w) { return (float)__builtin_bit_cast(f16x2, w)[1]; }
typedef _Float16 hstream_t;
__device__ __forceinline__ f32x4 ld4h(const hstream_t* p) { const u32x2 w = *(const u32x2*)p; return (f32x4){hlo(w[0]), hhi(w[0]), hlo(w[1]), hhi(w[1])}; }
__device__ __forceinline__ void st4h(hstream_t* p, f32x4 v) { *(u32x2*)p = (u32x2){pk2h(v[0], v[1]), pk2h(v[2], v[3])}; }
__device__ __forceinline__ bf16_t f2h(float f) { return __builtin_bit_cast(unsigned short, (_Float16)f); }
__device__ __forceinline__ float h2f(bf16_t b) { return (float)__builtin_bit_cast(_Float16, b); }
__device__ __forceinline__ float bflo(unsigned w) { return __uint_as_float(w << 16); }
__device__ __forceinline__ float bfhi(unsigned w) { return __uint_as_float(w & 0xffff0000u); }
__device__ __forceinline__ float gelu_tanh(float x) {
  const float u = 0.7978845608028654f * (x + 0.044715f * x * x * x);
  return x / (1.0f + __expf(-2.0f * u));
}
__device__ __forceinline__ float dot2bf(unsigned a, unsigned b, float c) {
  return __builtin_amdgcn_fdot2_f32_bf16(__builtin_bit_cast(bf16x2_t, a), __builtin_bit_cast(bf16x2_t, b), c, false);
}
__device__ __forceinline__ float shx_f(float v, int mask, int lane) { return __int_as_float(__builtin_amdgcn_ds_bpermute((lane ^ mask) << 2, __float_as_int(v))); }
__device__ __forceinline__ int shx_i(int v, int mask, int lane) { return __builtin_amdgcn_ds_bpermute((lane ^ mask) << 2, v); }
__device__ __forceinline__ float shl_f(float v, int src) { return __int_as_float(__builtin_amdgcn_ds_bpermute(src << 2, __float_as_int(v))); }
__device__ __forceinline__ float wave_sum(float v, int  ) {
#define DPP_ADD(ctrl, rmask) v += __int_as_float(__builtin_amdgcn_update_dpp(0, __float_as_int(v), ctrl, rmask, 0xf, false))
  DPP_ADD(0xB1, 0xf);
  DPP_ADD(0x4E, 0xf);
  DPP_ADD(0x141, 0xf);
  DPP_ADD(0x140, 0xf);
  DPP_ADD(0x142, 0xa);
  DPP_ADD(0x143, 0xc);
#undef DPP_ADD
  return __int_as_float(__builtin_amdgcn_readlane(__float_as_int(v), 63));
}
__device__ __forceinline__ float wave_max(float v) {
#define DPP_MAX(ctrl, rmask) v = fmaxf(v, __int_as_float(__builtin_amdgcn_update_dpp(0, __float_as_int(v), ctrl, rmask, 0xf, false)))
  DPP_MAX(0xB1, 0xf); DPP_MAX(0x4E, 0xf); DPP_MAX(0x141, 0xf); DPP_MAX(0x140, 0xf); DPP_MAX(0x142, 0xa); DPP_MAX(0x143, 0xc);
#undef DPP_MAX
  return __int_as_float(__builtin_amdgcn_readlane(__float_as_int(v), 63));
}
__device__ __forceinline__ unsigned pack_i8x4(f32x4 v) {
  const int a = __float2int_rn(v[0]), b = __float2int_rn(v[1]), c = __float2int_rn(v[2]), d = __float2int_rn(v[3]);
  return (unsigned)(a & 255) | ((unsigned)(b & 255) << 8) | ((unsigned)(c & 255) << 16) | ((unsigned)d << 24);
}
__device__ __forceinline__ int who_of_row(int row) { return row < NLAT ? (row >= SEQ ? 1 : 0) : 2; }
__device__ __forceinline__ const float* mod_ptr(const Params& p, int layer, int who, int which) {
  return (const float*)(p.ws + OFF_MOD) + ((size_t)(layer * 3 + who) * 6 + which) * 1024;
}
__device__ __forceinline__ void row_bpos(int row, int& b, int& pos) {
  if (row < NLAT) { b = row >> 13; pos = CTXL + (row & (SEQ - 1)); }
  else { const int r = row - NLAT; b = r >> 8; pos = r & 255; }
}

__device__ __forceinline__ int lds_byte2(int r, int c) {
  int st = (r >> 4) * 2 + (c >> 5), ob = (r & 15) * 64 + (c & 31) * 2;
  return st * 1024 + (ob ^ (((ob >> 9) & 1) << 5));
}
__device__ __forceinline__ void stage_rc2(int b, int& R, int& C) {
  int st = b >> 10, sb = b & 1023, swz = sb ^ (((sb >> 9) & 1) << 5);
  R = (st / 2) * 16 + swz / 64;
  C = (st % 2) * 32 + (swz % 64) / 2;
}
#define WAIT_V0() asm volatile("s_waitcnt vmcnt(0)" ::: "memory")

template <int MODE, int MFR, class Epi>
__device__ __forceinline__ void gemm_tile(const bf16_t* __restrict__ Arow0, const bf16_t* __restrict__ Bcol0, int row0, int pn, int K,
                                          const Epi& epi, char* shm, int tid_) {
  constexpr int BK = 32, TILE_B = 256 * BK * 2, STAGE_B = 2 * TILE_B;
  constexpr int LPS = MFR == 8 ? 4 : 3;
  const int tid = tid_, wid = __builtin_amdgcn_readfirstlane(tid >> 6), lane = tid & 63, wr = wid >> 2, wc = wid & 3, fr = lane & 15, fq = lane >> 4;
  const int sb_ = lane * 16, swz_ = sb_ ^ (((sb_ >> 9) & 1) << 5);
  const int C0 = (swz_ % 64) / 2;
  const int R0b = wid * 16 + swz_ / 64;
  const int R0a = (MFR == 8 ? wid : (wid & 3)) * 16 + swz_ / 64;
  const char* Ab = (const char*)Arow0 + (unsigned)(R0a * K + C0) * 2u;
  const int R0bp = Epi::perm(pn) ? ((R0b & ~63) | (((R0b & 15) >> 2) << 4) | (((R0b >> 4) & 3) << 2) | (R0b & 3)) : R0b;
  const char* Bb = (const char*)Bcol0 + (unsigned)(R0bp * K + C0) * 2u;
  const int ob_ = fr * 64 + fq * 16, frag_swz = ob_ ^ (((ob_ >> 9) & 1) << 5);
  const int a_base = wr * (MFR * 1024) + frag_swz, b_base = wc * 4096 + frag_swz;
  const int nt = K / BK;
  f32x4 acc[MFR][4];
#pragma unroll
  for (int m = 0; m < MFR; ++m)
#pragma unroll
    for (int n = 0; n < 4; ++n) acc[m][n] = (f32x4){0.f, 0.f, 0.f, 0.f};
  typename Epi::template Pre<MFR> pre;
  epi.template preload<MFR>(pre, row0, pn, wr, wc, fr, fq);
#define GLDS_STAGE(buf, kt)                                                                                                               \
  do {                                                                                                                                    \
    if (MFR == 8) {                                                                                                                       \
      _Pragma("unroll") for (int i = 0; i < 2; ++i)                                                                                       \
        __builtin_amdgcn_global_load_lds((const unsigned*)(Ab + (size_t)(i * 128) * K * 2 + (kt) * (BK * 2)),                           \
                                         (unsigned*)(shm + (buf) * STAGE_B + wid * 1024 + i * 8192), 16, 0, 0);                           \
    } else {                                                                                                                              \
      __builtin_amdgcn_global_load_lds((const unsigned*)(Ab + (kt) * (BK * 2)), (unsigned*)(shm + (buf) * STAGE_B + (wid & 3) * 1024), 16, 0, 0); \
    }                                                                                                                                     \
    _Pragma("unroll") for (int i = 0; i < 2; ++i)                                                                                         \
      __builtin_amdgcn_global_load_lds((const unsigned*)(Bb + (size_t)(i * 128) * K * 2 + (kt) * (BK * 2)),                             \
                                       (unsigned*)(shm + (buf) * STAGE_B + TILE_B + wid * 1024 + i * 8192), 16, 0, 0);                    \
  } while (0)
#define RAW_BARRIER() do { asm volatile("s_waitcnt lgkmcnt(0)" ::: "memory"); __builtin_amdgcn_s_barrier(); } while (0)
#define WAIT_2STAGES() do { if (LPS == 4) asm volatile("s_waitcnt vmcnt(8)" ::: "memory"); else asm volatile("s_waitcnt vmcnt(6)" ::: "memory"); } while (0)
#define WAIT_1STAGE() do { if (LPS == 4) asm volatile("s_waitcnt vmcnt(4)" ::: "memory"); else asm volatile("s_waitcnt vmcnt(3)" ::: "memory"); } while (0)
  GLDS_STAGE(0, 0); GLDS_STAGE(1, 1); GLDS_STAGE(2, 2);
  WAIT_2STAGES();
  RAW_BARRIER();
  for (int t = 0; t < nt; ++t) {
    if (t + 3 < nt) GLDS_STAGE((t + 3) & 3, t + 3);
    const char* sa = shm + (t & 3) * STAGE_B;
    const char* sb = sa + TILE_B;
    {
      bf16x8 At[MFR], Bf[4];
#pragma unroll
      for (int m = 0; m < MFR; ++m) At[m] = *(const bf16x8*)(sa + a_base + m * 1024);
#pragma unroll
      for (int n = 0; n < 4; ++n) Bf[n] = *(const bf16x8*)(sb + b_base + n * 1024);
#pragma unroll
      for (int m = 0; m < MFR; ++m)
#pragma unroll
        for (int n = 0; n < 4; ++n) {
          if (MODE == 1) acc[m][n] = __builtin_amdgcn_mfma_f32_16x16x32_f16(__builtin_bit_cast(f16x8, Bf[n]), __builtin_bit_cast(f16x8, At[m]), acc[m][n], 0, 0, 0);
          else if (MODE == 2) acc[m][n] = __builtin_bit_cast(f32x4, __builtin_amdgcn_mfma_i32_16x16x64_i8(__builtin_bit_cast(i32x4, Bf[n]), __builtin_bit_cast(i32x4, At[m]),
                                                                                                         __builtin_bit_cast(i32x4, acc[m][n]), 0, 0, 0));
          else acc[m][n] = __builtin_amdgcn_mfma_f32_16x16x32_bf16(Bf[n], At[m], acc[m][n], 0, 0, 0);
        }
    }
    if (t + 3 < nt) WAIT_2STAGES();
    else if (t + 2 < nt) WAIT_1STAGE();
    else asm volatile("s_waitcnt vmcnt(0)" ::: "memory");
    RAW_BARRIER();
  }
#undef GLDS_STAGE
#undef RAW_BARRIER
#undef WAIT_2STAGES
#undef WAIT_1STAGE
  if (MODE == 2) {
#pragma unroll
    for (int m = 0; m < MFR; ++m)
#pragma unroll
      for (int n = 0; n < 4; ++n)
#pragma unroll
        for (int j = 0; j < 4; ++j) acc[m][n][j] = (float)__float_as_int(acc[m][n][j]);
  }
  epi.template run<MFR>(acc, pre, row0, pn, wr, wc, fr, fq, shm, tid_);
}

template <int MODE = 0, class Epi>
__device__ __forceinline__ void gemm_phase(const bf16_t* __restrict__ A, const bf16_t* __restrict__ Bt, int mt_big, int small_rows, int ntiles, int K,
                                           const Epi& epi, char* shm, int tid_) {
  const int nu_big = ((mt_big + 7) >> 3) * ntiles * 8, nu_small = (small_rows >> 6) * ntiles;
  int u = lbid();
  for (; u < nu_big; u += gridDim.x) {
    const int xcd = u & 7, v = u >> 3;
    const int pn = v % ntiles, pm = (v / ntiles) * 8 + xcd;
    if (pm >= mt_big) continue;
    gemm_tile<MODE, 8>(A + (size_t)pm * 256 * K, Bt + (size_t)pn * 256 * K, pm * 256, pn, K, epi, shm, tid_);
  }
  for (; u < nu_big + nu_small; u += gridDim.x) {
    const int w = u - nu_big, pn = w % ntiles, row0 = mt_big * 256 + (w / ntiles) * 64;
    gemm_tile<MODE, 2>(A + (size_t)row0 * K, Bt + (size_t)pn * 256 * K, row0, pn, K, epi, shm, tid_);
  }
}

struct EpiInProj {
  static __device__ __forceinline__ bool perm(int) { return false; }
  bf16_t *Q, *K;
  const float* rs; const float* cs;
  const float* rope;
  unsigned* KMAX;
  template <int MFR> struct Pre {};
  template <int MFR> __device__ __forceinline__ void preload(Pre<MFR>&, int, int, int, int, int, int) const {}
  template <int MFR>
  __device__ __forceinline__ void run(const f32x4 (&acc)[MFR][4], const Pre<MFR>&, int row0, int pn, int wr, int wc, int fr, int fq, char*, int) const {
    const int region = pn >> 2;
    const int lane = fq * 16 + fr;
    float kn2 = 0.f, kmax2 = 0.f;
    f32x4 csl[4];
#pragma unroll
    for (int n = 0; n < 4; ++n) csl[n] = *(const f32x4*)(cs + pn * 256 + wc * 64 + n * 16 + fq * 4);
#pragma unroll
    for (int m = 0; m < MFR; ++m) {
      const int row = row0 + wr * (16 * MFR) + m * 16 + fr;
      int b, pos;
      row_bpos(row, b, pos);
      const float rsm = rs[row];
      if (region <= 1) {
        bf16_t* dst = region == 0 ? Q : K;
        const int head = (pn & 3) * 2 + (wc >> 1), msub = wc & 1;
        bf16_t* rp = dst + ((size_t)(b * NH + head) * LKV + pos) * 128 + msub * 64;
        const bool lat = row < NLAT;
        const int t = row & (SEQ - 1);
        const int prow = t >> 6, pcol = t & 63;
#pragma unroll
        for (int n = 0; n < 2; ++n) {
          float oa[4], ob[4];
          if (n == 0) kn2 = 0.f;
          const int pp = (n == 0) ? prow : pcol;
          const f32x4 r0 = lat ? *(const f32x4*)(rope + (pp * 16 + fq * 4) * 2) : (f32x4){1.f, 0.f, 1.f, 0.f};
          const f32x4 r1 = lat ? *(const f32x4*)(rope + (pp * 16 + fq * 4) * 2 + 4) : (f32x4){1.f, 0.f, 1.f, 0.f};
          const float csv[4] = {r0[0], r0[2], r1[0], r1[2]}, snv[4] = {r0[1], r0[3], r1[1], r1[3]};
#pragma unroll
          for (int j = 0; j < 4; ++j) {
            const float a = acc[m][n][j] * (rsm * csl[n][j]), bb = acc[m][n + 2][j] * (rsm * csl[n + 2][j]);
            oa[j] = a * csv[j] - bb * snv[j];
            ob[j] = a * snv[j] + bb * csv[j];
          }
          if (region == 0) {
#pragma unroll
            for (int j = 0; j < 4; ++j) { oa[j] *= QSCALE; ob[j] *= QSCALE; }
          } else {
#pragma unroll
            for (int j = 0; j < 4; ++j) kn2 += oa[j] * oa[j] + ob[j] * ob[j];
          }
          u32x2 wa = {pk2(oa[0], oa[1]), pk2(oa[2], oa[3])};
          u32x2 wb = {pk2(ob[0], ob[1]), pk2(ob[2], ob[3])};
          *(u32x2*)(rp + n * 16 + fq * 4) = wa;
          *(u32x2*)(rp + 32 + n * 16 + fq * 4) = wb;
        }
        if (region == 1) {
          kn2 += shx_f(kn2, 16, lane); kn2 += shx_f(kn2, 32, lane);
          kmax2 = fmaxf(kmax2, kn2);
        }
      }
      asm volatile("" ::: "memory");
    }
    if (region == 1) {
#pragma unroll
      for (int o = 1; o < 16; o <<= 1) kmax2 = fmaxf(kmax2, shx_f(kmax2, o, lane));
      if (lane == 0) {
        const int b = row0 < NLAT ? (row0 >> 13) : ((row0 - NLAT) >> 8);
        const int head = (pn & 3) * 2 + (wc >> 1), msub = wc & 1;
        atomicMax(KMAX + (b * NH + head) * 2 + msub, __float_as_uint(kmax2));
      }
    }
  }
};
struct EpiInProjVG {
  static __device__ __forceinline__ bool perm(int) { return true; }
  bf16_t *V, *GU, *GV;
  const float* rs; const float* cs;
  template <int MFR> struct Pre {};
  template <int MFR> __device__ __forceinline__ void preload(Pre<MFR>&, int, int, int, int, int, int) const {}
  template <int MFR>
  __device__ __forceinline__ void run(const f32x4 (&acc)[MFR][4], const Pre<MFR>&, int row0, int pn, int wr, int wc, int fr, int fq, char*, int) const {
    const int region = pn >> 2;
    f32x4 csv[4];
#pragma unroll
    for (int n = 0; n < 4; ++n) csv[n] = *(const f32x4*)(cs + (pn - 8) * 256 + wc * 64 + fq * 16 + n * 4);
#pragma unroll
    for (int m = 0; m < MFR; ++m) {
      const int row = row0 + wr * (16 * MFR) + m * 16 + fr;
      const float r_ = rs[row];
      f32x4 a_[4];
#pragma unroll
      for (int n = 0; n < 4; ++n) a_[n] = acc[m][n] * (csv[n] * r_);
      bf16_t* rp;
      if (region == 2) {
        int b, pos;
        row_bpos(row, b, pos);
        const int head = (pn & 3) * 2 + (wc >> 1);
        rp = V + ((size_t)(b * NH + head) * LKV + pos) * 128 + (wc & 1) * 64 + fq * 16;
      } else {
        const int isv = (pn >> 1) & 1;
        rp = (isv ? GV : GU) + (size_t)row * 512 + (pn & 1) * 256 + wc * 64 + fq * 16;
#pragma unroll
        for (int n = 0; n < 4; ++n)
#pragma unroll
          for (int j = 0; j < 4; ++j) a_[n][j] = gelu_tanh(a_[n][j]);
      }
      const u32x4 w0 = {pk2(a_[0][0], a_[0][1]), pk2(a_[0][2], a_[0][3]), pk2(a_[1][0], a_[1][1]), pk2(a_[1][2], a_[1][3])};
      const u32x4 w1 = {pk2(a_[2][0], a_[2][1]), pk2(a_[2][2], a_[2][3]), pk2(a_[3][0], a_[3][1]), pk2(a_[3][2], a_[3][3])};
      *(u32x4*)rp = w0; *(u32x4*)(rp + 8) = w1;
      asm volatile("" ::: "memory");
    }
  }
};
struct EpiResid {
  static __device__ __forceinline__ bool perm(int) { return true; }
  const hstream_t* XS; hstream_t* Z; const float* modbase;
  int which;
  template <int MFR> struct Pre { u32x4 xs[MFR][2]; };
  template <int MFR> __device__ __forceinline__ void preload(Pre<MFR>& pre, int row0, int pn, int wr, int wc, int fr, int fq) const {
#pragma unroll
    for (int m = 0; m < MFR; ++m) {
      const hstream_t* rp = XS + (size_t)(row0 + wr * (16 * MFR) + m * 16 + fr) * DM + pn * 256 + wc * 64 + fq * 16;
      pre.xs[m][0] = *(const u32x4*)rp; pre.xs[m][1] = *(const u32x4*)(rp + 8);
    }
  }
  template <int MFR>
  __device__ __forceinline__ void run(const f32x4 (&acc)[MFR][4], const Pre<MFR>& pre, int row0, int pn, int wr, int wc, int fr, int fq, char*, int) const {
    const int who = row0 < SEQ ? 0 : (row0 < NLAT ? 1 : 2);
    const int col = pn * 256 + wc * 64 + fq * 16;
    const float* g = modbase + ((size_t)who * 6 + which) * 1024 + col;
    f32x4 gv[4];
#pragma unroll
    for (int n = 0; n < 4; ++n) gv[n] = *(const f32x4*)(g + n * 4);
#pragma unroll
    for (int m = 0; m < MFR; ++m) {
      hstream_t* zp = Z + (size_t)(row0 + wr * (16 * MFR) + m * 16 + fr) * DM + col;
      u32x4 o[2];
#pragma unroll
      for (int n = 0; n < 4; ++n) {
        const unsigned w0 = pre.xs[m][n >> 1][(n & 1) * 2], w1 = pre.xs[m][n >> 1][(n & 1) * 2 + 1];
        const f32x4 xs = {hlo(w0), hhi(w0), hlo(w1), hhi(w1)};
        const f32x4 r = xs * ALPHA + gv[n] * acc[m][n];
        o[n >> 1][(n & 1) * 2] = pk2h(r[0], r[1]); o[n >> 1][(n & 1) * 2 + 1] = pk2h(r[2], r[3]);
      }
      *(u32x4*)zp = o[0]; *(u32x4*)(zp + 8) = o[1];
    }
  }
};
struct EpiBf16Store {
  static __device__ __forceinline__ bool perm(int) { return true; }
  bf16_t* O; int ld; const float* rs; const float* cs;
  template <int MFR> struct Pre {};
  template <int MFR> __device__ __forceinline__ void preload(Pre<MFR>&, int, int, int, int, int, int) const {}
  template <int MFR>
  __device__ __forceinline__ void run(const f32x4 (&acc)[MFR][4], const Pre<MFR>&, int row0, int pn, int wr, int wc, int fr, int fq, char*, int) const {
    f32x4 csv[4];
#pragma unroll
    for (int n = 0; n < 4; ++n) csv[n] = *(const f32x4*)(cs + pn * 256 + wc * 64 + fq * 16 + n * 4);
#pragma unroll
    for (int m = 0; m < MFR; ++m) {
      const int row = row0 + wr * (16 * MFR) + m * 16 + fr;
      bf16_t* rp = O + (size_t)row * ld + pn * 256 + wc * 64 + fq * 16;
      const float r_ = rs[row];
      f32x4 a_[4];
#pragma unroll
      for (int n = 0; n < 4; ++n) a_[n] = acc[m][n] * (csv[n] * r_);
      const u32x4 w0 = {pk2h(a_[0][0], a_[0][1]), pk2h(a_[0][2], a_[0][3]), pk2h(a_[1][0], a_[1][1]), pk2h(a_[1][2], a_[1][3])};
      const u32x4 w1 = {pk2h(a_[2][0], a_[2][1]), pk2h(a_[2][2], a_[2][3]), pk2h(a_[3][0], a_[3][1]), pk2h(a_[3][2], a_[3][3])};
      *(u32x4*)rp = w0; *(u32x4*)(rp + 8) = w1;
    }
  }
};
#define FMX(a, b) __float_as_int(__builtin_fmaxf(__int_as_float(a), __int_as_float(b)))
#define FMN(a, b) __float_as_int(__builtin_fminf(__int_as_float(a), __int_as_float(b)))
#define CE(a, b) do { const int _h = FMX(a, b), _l = FMN(a, b); a = _h; b = _l; } while (0)
#define SORT16(v) do { CE(v[0], v[1]); CE(v[2], v[3]); CE(v[0], v[2]); CE(v[1], v[3]); CE(v[1], v[2]); CE(v[4], v[5]); CE(v[6], v[7]); CE(v[4], v[6]); CE(v[5], v[7]); CE(v[5], v[6]); CE(v[0], v[4]); CE(v[2], v[6]); CE(v[2], v[4]); CE(v[1], v[5]); CE(v[3], v[7]); CE(v[3], v[5]); CE(v[1], v[2]); CE(v[3], v[4]); CE(v[5], v[6]); CE(v[8], v[9]); CE(v[10], v[11]); CE(v[8], v[10]); CE(v[9], v[11]); CE(v[9], v[10]); CE(v[12], v[13]); CE(v[14], v[15]); CE(v[12], v[14]); CE(v[13], v[15]); CE(v[13], v[14]); CE(v[8], v[12]); CE(v[10], v[14]); CE(v[10], v[12]); CE(v[9], v[13]); CE(v[11], v[15]); CE(v[11], v[13]); CE(v[9], v[10]); CE(v[11], v[12]); CE(v[13], v[14]); CE(v[0], v[8]); CE(v[4], v[12]); CE(v[4], v[8]); CE(v[2], v[10]); CE(v[6], v[14]); CE(v[6], v[10]); CE(v[2], v[4]); CE(v[6], v[8]); CE(v[10], v[12]); CE(v[1], v[9]); CE(v[5], v[13]); CE(v[5], v[9]); CE(v[3], v[11]); CE(v[7], v[15]); CE(v[7], v[11]); CE(v[3], v[5]); CE(v[7], v[9]); CE(v[11], v[13]); CE(v[1], v[2]); CE(v[3], v[4]); CE(v[5], v[6]); CE(v[7], v[8]); CE(v[9], v[10]); CE(v[11], v[12]); CE(v[13], v[14]); } while (0)
#define BMERGE16(v) do { CE(v[0], v[8]); CE(v[1], v[9]); CE(v[2], v[10]); CE(v[3], v[11]); CE(v[4], v[12]); CE(v[5], v[13]); CE(v[6], v[14]); CE(v[7], v[15]); CE(v[0], v[4]); CE(v[1], v[5]); CE(v[2], v[6]); CE(v[3], v[7]); CE(v[8], v[12]); CE(v[9], v[13]); CE(v[10], v[14]); CE(v[11], v[15]); CE(v[0], v[2]); CE(v[1], v[3]); CE(v[4], v[6]); CE(v[5], v[7]); CE(v[8], v[10]); CE(v[9], v[11]); CE(v[12], v[14]); CE(v[13], v[15]); CE(v[0], v[1]); CE(v[2], v[3]); CE(v[4], v[5]); CE(v[6], v[7]); CE(v[8], v[9]); CE(v[10], v[11]); CE(v[12], v[13]); CE(v[14], v[15]); } while (0)
#define CAND_CHUNK0 do { T[0] = CK(0, 0); T[1] = CK(0, 1); T[2] = CK(0, 2); T[3] = CK(0, 3); T[4] = CK(0, 4); T[5] = CK(0, 5); T[6] = CK(0, 6); T[7] = CK(0, 7); T[8] = CK(0, 8); T[9] = CK(0, 9); T[10] = CK(0, 10); T[11] = CK(0, 11); T[12] = CK(0, 12); T[13] = CK(0, 13); T[14] = CK(0, 14); T[15] = CK(0, 15); } while (0)
#define CAND_CHUNK1 do { X[0] = CK(1, 0); X[1] = CK(1, 1); X[2] = CK(1, 2); X[3] = CK(1, 3); X[4] = CK(1, 4); X[5] = CK(1, 5); X[6] = CK(1, 6); X[7] = CK(1, 7); X[8] = CK(2, 0); X[9] = CK(2, 1); X[10] = CK(2, 2); X[11] = CK(2, 3); X[12] = CK(2, 4); X[13] = CK(3, 0); X[14] = CK(3, 1); X[15] = CK(3, 2); } while (0)
#define CAND_CHUNK2 do { X[0] = CK(3, 3); X[1] = CK(4, 0); X[2] = CK(4, 1); X[3] = CK(4, 2); X[4] = CK(5, 0); X[5] = CK(5, 1); X[6] = CK(6, 0); X[7] = CK(6, 1); X[8] = CK(7, 0); X[9] = CK(7, 1); X[10] = CK(8, 0); X[11] = CK(9, 0); X[12] = CK(10, 0); X[13] = CK(11, 0); X[14] = CK(12, 0); X[15] = CK(13, 0); } while (0)
#define CAND_CHUNK3 do { X[0] = CK(14, 0); X[1] = CK(15, 0); X[2] = (int)0xFF800000; X[3] = (int)0xFF800000; X[4] = (int)0xFF800000; X[5] = (int)0xFF800000; X[6] = (int)0xFF800000; X[7] = (int)0xFF800000; X[8] = (int)0xFF800000; X[9] = (int)0xFF800000; X[10] = (int)0xFF800000; X[11] = (int)0xFF800000; X[12] = (int)0xFF800000; X[13] = (int)0xFF800000; X[14] = (int)0xFF800000; X[15] = (int)0xFF800000; } while (0)

__device__ __forceinline__ int packkey7(float f, int idx) { return (__float_as_int(f) & ~0x7F) | (127 - idx); }
__device__ __forceinline__ float keyval7(int k) { return __int_as_float(k & ~0x7F); }
__device__ __forceinline__ int packkey8(float f, int pos) { return (__float_as_int(f) & ~0xFF) | (255 - pos); }
__device__ __forceinline__ float keyval8(int k) { return __int_as_float(k & ~0xFF); }
#define LD16(dst, ptr) do { const i32x4 _a = *(const i32x4*)(ptr), _b = *(const i32x4*)((ptr) + 4), _c = *(const i32x4*)((ptr) + 8), _d = *(const i32x4*)((ptr) + 12); \
    dst[0] = _a[0]; dst[1] = _a[1]; dst[2] = _a[2]; dst[3] = _a[3]; dst[4] = _b[0]; dst[5] = _b[1]; dst[6] = _b[2]; dst[7] = _b[3];                                \
    dst[8] = _c[0]; dst[9] = _c[1]; dst[10] = _c[2]; dst[11] = _c[3]; dst[12] = _d[0]; dst[13] = _d[1]; dst[14] = _d[2]; dst[15] = _d[3]; } while (0)
#define ST16(ptr, src) do { *(i32x4*)(ptr) = (i32x4){src[0], src[1], src[2], src[3]}; *(i32x4*)((ptr) + 4) = (i32x4){src[4], src[5], src[6], src[7]};           \
    *(i32x4*)((ptr) + 8) = (i32x4){src[8], src[9], src[10], src[11]}; *(i32x4*)((ptr) + 12) = (i32x4){src[12], src[13], src[14], src[15]}; } while (0)
#define MERGE_TOP16(T, X) do { _Pragma("unroll") for (int _i = 0; _i < 16; ++_i) T[_i] = FMX(T[_i], X[15 - _i]); BMERGE16(T); } while (0)
struct EpiTopK {
  static __device__ __forceinline__ bool perm(int) { return false; }
  int* IDX; float* GATE; unsigned* IDX16;
  const float* rs; const float* cs;
  template <int MFR> struct Pre {};
  template <int MFR> __device__ __forceinline__ void preload(Pre<MFR>&, int, int, int, int, int, int) const {}
  template <int MFR>
  __device__ __forceinline__ void run(const f32x4 (&acc)[MFR][4], const Pre<MFR>&, int row0, int pn, int wr, int wc, int fr, int fq, char* shm, int tid_) const {
    constexpr int LST = 68, BM = 32 * MFR;
    int* lst = (int*)shm;
    const int tid = tid_, lane = tid_ & 63;
    float csl[16];
#pragma unroll
    for (int n = 0; n < 4; ++n) { const f32x4 c4 = *(const f32x4*)(cs + pn * 256 + wc * 64 + n * 16 + fq * 4); csl[n * 4] = c4[0]; csl[n * 4 + 1] = c4[1]; csl[n * 4 + 2] = c4[2]; csl[n * 4 + 3] = c4[3]; }
#pragma unroll
    for (int m = 0; m < MFR; ++m) {
      int T[16], X[16];
      const float hsr = rs[row0 + wr * (16 * MFR) + m * 16 + fr];
#pragma unroll
      for (int n = 0; n < 4; ++n)
#pragma unroll
        for (int j = 0; j < 4; ++j) T[n * 4 + j] = packkey7(acc[m][n][j] * (hsr * csl[n * 4 + j]), (wc & 1) * 64 + n * 16 + fq * 4 + j);
      SORT16(T);
#pragma unroll
      for (int i = 0; i < 16; ++i) { auto rr = __builtin_amdgcn_permlane16_swap(T[i], T[i], false, false); T[i] = rr[0]; X[i] = rr[1]; }
      MERGE_TOP16(T, X);
#pragma unroll
      for (int i = 0; i < 16; ++i) { auto rr = __builtin_amdgcn_permlane32_swap(T[i], T[i], false, false); T[i] = rr[0]; X[i] = rr[1]; }
      MERGE_TOP16(T, X);
      i32x4 w;
#pragma unroll
      for (int q = 0; q < 4; ++q) {
        const int m1 = -(fq & 1), m2 = -((fq >> 1) & 1);
        const int lo_ = (T[q] & ~m1) | (T[4 + q] & m1), hi_ = (T[8 + q] & ~m1) | (T[12 + q] & m1);
        w[q] = (lo_ & ~m2) | (hi_ & m2);
      }
      *(i32x4*)(lst + (wr * (16 * MFR) + m * 16 + fr) * LST + wc * 16 + fq * 4) = w;
    }
    __syncthreads();
    if (tid < 2 * BM) {
      const int row = tid & (BM - 1), pp = tid / BM;
      int T[16], X[16];
      LD16(T, lst + row * LST + pp * 32);
      LD16(X, lst + row * LST + pp * 32 + 16);
      MERGE_TOP16(T, X);
      ST16(lst + row * LST + pp * 32, T);
    }
    __syncthreads();
    if (tid < BM) {
      const int row = tid;
      int T[16], X[16];
      float a[16], b[16];
      LD16(T, lst + row * LST);
      LD16(X, lst + row * LST + 32);
#pragma unroll
      for (int i = 0; i < 16; ++i) { a[i] = keyval7(T[i]); b[i] = keyval7(X[i]); }
#define CK(i, j) packkey8(a[i] + b[j], (i) * 16 + (j))
      CAND_CHUNK0; SORT16(T);
      CAND_CHUNK1; SORT16(X); MERGE_TOP16(T, X);
      CAND_CHUNK2; SORT16(X); MERGE_TOP16(T, X);
      CAND_CHUNK3; SORT16(X); MERGE_TOP16(T, X);
#undef CK
      const float v0 = keyval8(T[0]);
      float e[16], sum = 0.f;
#pragma unroll
      for (int r = 0; r < 16; ++r) { e[r] = __expf(keyval8(T[r]) - v0); sum += e[r]; }
      const float inv = 1.0f / sum;
      const size_t go = ((size_t)pn * NTOK + (size_t)(row0 + row)) * 16;
#pragma unroll
      for (int r = 0; r < 16; ++r) {
        const int pos = 255 - (T[r] & 0xFF);
        const int ia = 127 - (lst[row * LST + (pos >> 4)] & 0x7F), ib = 127 - (lst[row * LST + 32 + (pos & 15)] & 0x7F);
        X[r] = ia * 128 + ib;
        e[r] *= inv;
      }
      ST16(IDX + go, X);
      {
        const i32x4 h0 = {X[0] | (X[1] << 16), X[2] | (X[3] << 16), X[4] | (X[5] << 16), X[6] | (X[7] << 16)};
        const i32x4 h1 = {X[8] | (X[9] << 16), X[10] | (X[11] << 16), X[12] | (X[13] << 16), X[14] | (X[15] << 16)};
        *(i32x4*)(IDX16 + go / 2) = h0; *(i32x4*)(IDX16 + go / 2 + 4) = h1;
      }
      *(f32x4*)(GATE + go) = (f32x4){e[0], e[1], e[2], e[3]}; *(f32x4*)(GATE + go + 4) = (f32x4){e[4], e[5], e[6], e[7]};
      *(f32x4*)(GATE + go + 8) = (f32x4){e[8], e[9], e[10], e[11]}; *(f32x4*)(GATE + go + 12) = (f32x4){e[12], e[13], e[14], e[15]};
    }
    __syncthreads();
  }
};

__device__ void transpose_unit(const float* __restrict__ W, bf16_t* __restrict__ Wt, int K, int N, int unit, char* shm, int tid_) {
  float* tl = (float*)shm;
  const int ntn = N / 256;
  const int k0 = (unit / ntn) * 64, n0 = (unit % ntn) * 256;
  const int tid = tid_;
#pragma unroll 8
  for (int i = 0; i < 32; ++i) {
    const int idx = tid + i * 512, r = idx >> 8, c = idx & 255;
    tl[r * 257 + c] = W[(size_t)(k0 + r) * N + n0 + c];
  }
  __syncthreads();
#pragma unroll 8
  for (int i = 0; i < 32; ++i) {
    const int idx = tid + i * 512, r = idx >> 6, c = idx & 63;
    Wt[(size_t)(n0 + r) * K + k0 + c] = f2h(tl[c * 257 + r]);
  }
  __syncthreads();
}

__device__ void foldqk_unit(const Params& p, int unit, char* shm, int tid_) {
  const int l = unit >> 8, hp = (unit >> 4) & 15, ct = unit & 15;
  float* kl = (float*)shm;
  float* wl = kl + 128 * 132;
  const float* keys = PIN(p, peer_keys) + ((size_t)(l * 16 + hp) * 128) * 128;
  const float* wq = PIN(p, peer_wq) + (size_t)l * 1024 * 2048;
  const int tid = tid_;
  for (int idx = tid; idx < 128 * 128; idx += 512) { const int k = idx >> 7, d = idx & 127; kl[d * 132 + k] = keys[k * 128 + d]; }
  for (int idx = tid; idx < 64 * 128; idx += 512) { const int c = idx >> 7, d = idx & 127; wl[d * 68 + c] = wq[(size_t)(ct * 64 + c) * 2048 + hp * 128 + d]; }
  __syncthreads();
  const int wid = __builtin_amdgcn_readfirstlane(tid >> 6), ln = tid & 15, lq = (tid & 63) >> 4;
  const int tc = wid & 3, tk0 = (wid >> 2) * 4;
  f32x4 acc[4];
#pragma unroll
  for (int t = 0; t < 4; ++t) acc[t] = (f32x4){0.f, 0.f, 0.f, 0.f};
#pragma unroll 4
  for (int st = 0; st < 32; ++st) {
    const float a = wl[(4 * st + lq) * 68 + 16 * tc + ln];
#pragma unroll
    for (int t = 0; t < 4; ++t) acc[t] = __builtin_amdgcn_mfma_f32_16x16x4f32(a, kl[(4 * st + lq) * 132 + 16 * (tk0 + t) + ln], acc[t], 0, 0, 0);
  }
  bf16_t* outp = (bf16_t*)(p.ws + OFF_WQK) + (size_t)l * 2048 * 1024;
#pragma unroll
  for (int t = 0; t < 4; ++t) {
    u32x2 w = {pk2h(acc[t][0], acc[t][1]), pk2h(acc[t][2], acc[t][3])};
    *(u32x2*)(outp + (size_t)(hp * 128 + 16 * (tk0 + t) + ln) * 1024 + ct * 64 + 16 * tc + 4 * lq) = w;
  }
  __syncthreads();
}
__device__ void foldpool_unit(const Params& p, int unit, char* shm, int tid_) {
  const int j = unit >> 8, g = (unit >> 6) & 3, cit = (unit >> 4) & 3, et = unit & 15;
  float* gl = (float*)shm;
  float* ol = gl + 256 * 68;
  const float* wg = PIN(p, pool_w_grp) + ((size_t)(j * 4 + g) * 256) * 256;
  const float* sc = PIN(p, pool_scale) + (size_t)j * 1024 + g * 256;
  const float* wo = PIN(p, pool_w_out) + ((size_t)j * 1024 + g * 256) * 1024;
  const int tid = tid_;
  for (int idx = tid; idx < 64 * 256; idx += 512) { const int r = idx >> 8, m = idx & 255; gl[m * 68 + r] = wg[(size_t)(cit * 64 + r) * 256 + m] * sc[m]; }
  for (int idx = tid; idx < 256 * 64; idx += 512) { const int m = idx >> 6, e = idx & 63; ol[m * 68 + e] = wo[(size_t)m * 1024 + et * 64 + e]; }
  __syncthreads();
  const int wid = __builtin_amdgcn_readfirstlane(tid >> 6), ln = tid & 15, lq = (tid & 63) >> 4;
  const int tci = wid & 3, te0 = (wid >> 2) * 2;
  f32x4 acc[2] = {{0.f, 0.f, 0.f, 0.f}, {0.f, 0.f, 0.f, 0.f}};
#pragma unroll 4
  for (int st = 0; st < 64; ++st) {
    const float a = gl[(4 * st + lq) * 68 + 16 * tci + ln];
#pragma unroll
    for (int t = 0; t < 2; ++t) acc[t] = __builtin_amdgcn_mfma_f32_16x16x4f32(a, ol[(4 * st + lq) * 68 + 16 * (te0 + t) + ln], acc[t], 0, 0, 0);
  }
  bf16_t* outp = (bf16_t*)(p.ws + OFF_POUT) + (size_t)j * 1024 * 1024;
#pragma unroll
  for (int t = 0; t < 2; ++t) {
    u32x2 w = {pk2h(acc[t][0], acc[t][1]), pk2h(acc[t][2], acc[t][3])};
    *(u32x2*)(outp + (size_t)(et * 64 + 16 * (te0 + t) + ln) * 1024 + g * 256 + cit * 64 + 16 * tci + 4 * lq) = w;
  }
  __syncthreads();
}
__device__ void mod_unit(const Params& p, int unit, char* shm, int tid_) {
  const int l = unit / 48, rem = unit % 48, cgp = rem >> 1, kh = rem & 1;
  float* sv = (float*)shm;
  float* red = sv + 3 * 512;
  const int tid = tid_, lane = tid & 63, ks = __builtin_amdgcn_readfirstlane(tid >> 6);
  for (int idx = tid; idx < 3 * 512; idx += 512) {
    const int w = idx >> 9, k = kh * 512 + (idx & 511);
    const float xv = w < 2 ? PIN(p, c)[w * 1024 + k] : PIN(p, c_ctx)[k];
    sv[idx] = xv / (1.0f + __expf(-xv));
  }
  __syncthreads();
  const float* aw = PIN(p, ada_w) + (size_t)l * 1024 * 6144 + (size_t)(kh * 512 + ks * 64) * 6144 + cgp * 256 + lane * 4;
  f32x4 a0 = {0.f, 0.f, 0.f, 0.f}, a1 = a0, a2 = a0;
#pragma unroll 8
  for (int k = 0; k < 64; ++k) {
    const f32x4 w = *(const f32x4*)(aw + (size_t)k * 6144);
    a0 += w * sv[ks * 64 + k]; a1 += w * sv[512 + ks * 64 + k]; a2 += w * sv[1024 + ks * 64 + k];
  }
  *(f32x4*)(red + (ks * 3 + 0) * 256 + lane * 4) = a0; *(f32x4*)(red + (ks * 3 + 1) * 256 + lane * 4) = a1; *(f32x4*)(red + (ks * 3 + 2) * 256 + lane * 4) = a2;
  __syncthreads();
  for (int idx = tid; idx < 768; idx += 512) {
    const int w = idx >> 8, cc = idx & 255;
    float s = 0.f;
#pragma unroll
    for (int q = 0; q < 8; ++q) s += red[(q * 3 + w) * 256 + cc];
    const int n = cgp * 256 + cc;
    ((float*)(p.ws + OFF_MODP))[((size_t)kh * 12 + l * 3 + w) * 6144 + n] = s;
  }
  __syncthreads();
}

__device__ void phase_prologue_a(const Params& p, char* shm, int tid_) {
  constexpr int U_MOD = 192;
  constexpr int U_TWIN = 2 * 16 * 16, U_TWOUT = 2 * 24 * 4, U_TPIN = 2 * 16 * 4;
  constexpr int U_FQK = 1024, U_FP = 512, U_TAB = 2048, U_MISC = 1;
  constexpr int E0 = U_MOD, E1 = E0 + U_TWIN, E2 = E1 + U_TWOUT, E3 = E2 + U_TPIN, E4 = E3 + U_FQK, E5 = E4 + U_FP, E6 = E5 + U_TAB, E7 = E6 + U_MISC;
  const int bid_ = lbid(), G_ = gridDim.x;
  const bool tab_first = ((bid_ >> 3) & 1) != 0;
  const int nr_ = (E7 + G_ - 1) / G_;
  for (int j = 0; j < 2 * nr_; ++j) {
    const int u = bid_ + (j < nr_ ? j : j - nr_) * G_;
    if (u >= E7 || (u >= E5 && u < E6) != ((j < nr_) == tab_first)) continue;
    if (u < E0) mod_unit(p, u, shm, tid_);
    else if (u < E1) { const int v = u - E0, j = v / (16 * 16), r = v % (16 * 16);
      transpose_unit(PIN(p, ab_w_in) + (size_t)j * 1024 * 4096, (bf16_t*)(p.ws + OFF_WIN) + (size_t)j * 4096 * 1024, 1024, 4096, r, shm, tid_); }
    else if (u < E2) { const int v = u - E1, j = v / (24 * 4), r = v % (24 * 4);
      transpose_unit(PIN(p, ab_w_out) + (size_t)j * 1536 * 1024, (bf16_t*)(p.ws + OFF_WOUT) + (size_t)j * 1024 * 1536, 1536, 1024, r, shm, tid_); }
    else if (u < E3) { const int v = u - E2, j = v / 64, r = v % 64;
      transpose_unit(PIN(p, pool_w_in) + (size_t)j * 1024 * 1024, (bf16_t*)(p.ws + OFF_PIN) + (size_t)j * 1024 * 1024, 1024, 1024, r, shm, tid_); }
    else if (u < E4) foldqk_unit(p, u - E3, shm, tid_);
    else if (u < E5) foldpool_unit(p, u - E4, shm, tid_);
    else if (u < E6) {
      const int v = u - E5;
      const int tb = v >> 10;
      const float* src = tb ? PIN(p, peer_v) : PIN(p, peer_u);
      unsigned char* dst = (unsigned char*)(p.ws + (tb ? OFF_V8 : OFF_U8));
      const int wid = __builtin_amdgcn_readfirstlane(tid_ >> 6), lane = tid_ & 63;
#pragma unroll 4
      for (int i = 0; i < 8; ++i) {
        const int row = (v & 1023) * 64 + i * 8 + wid;
        const int layer = row >> 14, e = row & 16383;
        const float* rp = src + (size_t)row * DM + lane * 16;
        f32x4 a = *(const f32x4*)rp, b = *(const f32x4*)(rp + 4), c = *(const f32x4*)(rp + 8), d = *(const f32x4*)(rp + 12);
        u32x4 w;
        {
          float mx = 0.f;
#pragma unroll
          for (int j = 0; j < 4; ++j) mx = fmaxf(mx, fmaxf(fmaxf(fabsf(a[j]), fabsf(b[j])), fmaxf(fabsf(c[j]), fabsf(d[j]))));
          mx = wave_max(mx);
          const float inv = mx > 0.f ? 127.0f / mx : 0.f;
          if (lane == 0) ((float*)(p.ws + (tb ? OFF_VSC : OFF_USC)))[row] = mx * (1.0f / 127.0f);
          w[0] = pack_i8x4(a * inv); w[1] = pack_i8x4(b * inv); w[2] = pack_i8x4(c * inv); w[3] = pack_i8x4(d * inv);
        }
        *(u32x4*)(dst + ((size_t)(layer * 8 + (lane >> 3)) * NEXP + e) * 128 + (lane & 7) * 16) = w;
      }
    } else {
      float* rope = (float*)(p.ws + OFF_ROPE);
      for (int idx = tid_; idx < 128 * 16; idx += 512) {
        const int pos = idx >> 4, i = idx & 15;
        const float inv = powf(10000.0f, -(float)i / 16.0f);
        const float ang = (float)pos * inv;
        rope[idx * 2 + 0] = cosf(ang);
        rope[idx * 2 + 1] = sinf(ang);
      }
      if (tid_ < 2) {
        const int j = tid_;
        const float* lv = PIN(p, diff_lam) + (size_t)j * 4 * 64;
        float s1 = 0.f, s2 = 0.f;
        for (int d = 0; d < 64; ++d) { s1 += lv[d] * lv[64 + d]; s2 += lv[128 + d] * lv[192 + d]; }
        const float lam_init = 0.8f - 0.6f * expf(-0.3f * (float)(2 * j));
        float* lam = (float*)(p.ws + OFF_LAM);
        lam[j * 2 + 0] = expf(s1) - expf(s2) + lam_init;
        lam[j * 2 + 1] = lam_init;
      }
    }
  }
}

__device__ void phase_prologue_b(const Params& p, int tid_) {
  const int wid = __builtin_amdgcn_readfirstlane(tid_ >> 6), lane = tid_ & 63;
  {
    const float* mp = (const float*)(p.ws + OFF_MODP);
    float* md = (float*)(p.ws + OFF_MOD);
    for (int idx = lbid() * 512 + tid_; idx < 12 * 6144; idx += gridDim.x * 512) {
      const int l = idx / (3 * 6144), n = idx % 6144;
      md[idx] = mp[idx] + mp[12 * 6144 + idx] + PIN(p, ada_b)[(size_t)l * 6144 + n];
    }
  }
  {
    const bf16_t* wq = (const bf16_t*)(p.ws + OFF_WQK);
    unsigned char* w8 = (unsigned char*)(p.ws + OFF_WQK8);
    float* wsc = (float*)(p.ws + OFF_WQSC);
    for (int r = lbid() * 8 + wid; r < DEPTH * 2048; r += gridDim.x * 8) {
      const u32x4 a = *(const u32x4*)(wq + (size_t)r * 1024 + lane * 16), b = *(const u32x4*)(wq + (size_t)r * 1024 + lane * 16 + 8);
      float v[16];
#pragma unroll
      for (int i = 0; i < 4; ++i) { v[2 * i] = hlo(a[i]); v[2 * i + 1] = hhi(a[i]); v[8 + 2 * i] = hlo(b[i]); v[8 + 2 * i + 1] = hhi(b[i]); }
      float mx = 0.f;
#pragma unroll
      for (int i = 0; i < 16; ++i) mx = fmaxf(mx, fabsf(v[i]));
      mx = wave_max(mx);
      const float inv = mx > 0.f ? 127.0f / mx : 0.f;
      u32x4 o;
#pragma unroll
      for (int i = 0; i < 4; ++i) o[i] = pack_i8x4((f32x4){v[4 * i], v[4 * i + 1], v[4 * i + 2], v[4 * i + 3]} * inv);
      *(u32x4*)(w8 + (size_t)r * 1024 + lane * 16) = o;
      if (lane == 0) wsc[r] = mx * (1.0f / 127.0f);
    }
  }
  {
    const bf16_t* wq = (const bf16_t*)(p.ws + OFF_WIN);
    unsigned char* w8 = (unsigned char*)(p.ws + OFF_WIN8);
    float* wsc = (float*)(p.ws + OFF_WINSC);
    for (int r = lbid() * 8 + wid; r < 2 * 4096; r += gridDim.x * 8) {
      const size_t src = (size_t)r * 1024 + lane * 16;
      const u32x4 a = *(const u32x4*)(wq + src), b = *(const u32x4*)(wq + src + 8);
      float v[16];
#pragma unroll
      for (int i = 0; i < 4; ++i) { v[2 * i] = hlo(a[i]); v[2 * i + 1] = hhi(a[i]); v[8 + 2 * i] = hlo(b[i]); v[8 + 2 * i + 1] = hhi(b[i]); }
      float mx = 0.f;
#pragma unroll
      for (int i = 0; i < 16; ++i) mx = fmaxf(mx, fabsf(v[i]));
      mx = wave_max(mx);
      const float inv = mx > 0.f ? 127.0f / mx : 0.f;
      u32x4 o;
#pragma unroll
      for (int i = 0; i < 4; ++i) o[i] = pack_i8x4((f32x4){v[4 * i], v[4 * i + 1], v[4 * i + 2], v[4 * i + 3]} * inv);
      *(u32x4*)(w8 + (size_t)r * 1024 + lane * 16) = o;
      if (lane == 0) wsc[r] = mx * (1.0f / 127.0f);
    }
  }
  {
    const bf16_t* wq = (const bf16_t*)(p.ws + OFF_PIN);
    unsigned char* w8 = (unsigned char*)(p.ws + OFF_PIN8);
    float* wsc = (float*)(p.ws + OFF_PINSC);
    for (int r = lbid() * 8 + wid; r < 2 * 1024; r += gridDim.x * 8) {
      const u32x4 a = *(const u32x4*)(wq + (size_t)r * 1024 + lane * 16), b = *(const u32x4*)(wq + (size_t)r * 1024 + lane * 16 + 8);
      float v[16];
#pragma unroll
      for (int i = 0; i < 4; ++i) { v[2 * i] = hlo(a[i]); v[2 * i + 1] = hhi(a[i]); v[8 + 2 * i] = hlo(b[i]); v[8 + 2 * i + 1] = hhi(b[i]); }
      float mx = 0.f;
#pragma unroll
      for (int i = 0; i < 16; ++i) mx = fmaxf(mx, fabsf(v[i]));
      mx = wave_max(mx);
      const float inv = mx > 0.f ? 127.0f / mx : 0.f;
      u32x4 o;
#pragma unroll
      for (int i = 0; i < 4; ++i) o[i] = pack_i8x4((f32x4){v[4 * i], v[4 * i + 1], v[4 * i + 2], v[4 * i + 3]} * inv);
      *(u32x4*)(w8 + (size_t)r * 1024 + lane * 16) = o;
      if (lane == 0) wsc[r] = mx * (1.0f / 127.0f);
    }
  }
  hstream_t* XS = (hstream_t*)(p.ws + OFF_XSA);
  for (int row = lbid() * 8 + wid; row < NTOK; row += gridDim.x * 8) {
    const float* src = row < NLAT ? PIN(p, x) + (size_t)row * DM : PIN(p, ctx) + (size_t)(row - NLAT) * DM;
    const int who = who_of_row(row);
    const float* mp0 = (const float*)(p.ws + OFF_MODP) + (size_t)who * 6144;
    const float* mp1 = mp0 + 12 * 6144;
    f32x4 hq[4];
    float hmx = 0.f;
#pragma unroll
    for (int i = 0; i < 4; ++i) {
      const int col = i * 256 + lane * 4;
      const f32x4 v = *(const f32x4*)(src + col);
      st4h(XS + (size_t)row * DM + col, v);
      const f32x4 s1 = *(const f32x4*)(mp0 + col) + *(const f32x4*)(mp1 + col) + *(const f32x4*)(PIN(p, ada_b) + col);
      const f32x4 s2 = *(const f32x4*)(mp0 + 1024 + col) + *(const f32x4*)(mp1 + 1024 + col) + *(const f32x4*)(PIN(p, ada_b) + 1024 + col);
      const f32x4 h = v * (s2 + 1.0f) + s1;
      hq[i] = h; hmx = fmaxf(hmx, fmaxf(fmaxf(fabsf(h[0]), fabsf(h[1])), fmaxf(fabsf(h[2]), fabsf(h[3]))));
    }
    {
      const float mx = wave_max(hmx), inv = mx > 0.f ? 127.0f / mx : 0.f;
      unsigned char* h8 = (unsigned char*)(p.ws + OFF_H8) + (size_t)row * DM + lane * 4;
#pragma unroll
      for (int i = 0; i < 4; ++i) *(unsigned*)(h8 + i * 256) = pack_i8x4(hq[i] * inv);
      if (lane == 0) ((float*)(p.ws + OFF_HSC))[row] = mx * (1.0f / 127.0f);
    }
  }
}

__device__ void phase_ln(const Params& p, const hstream_t* Zin, hstream_t* XSo, int layer, int lnidx, int nrows, bf16_t* Hout, int mlayer, int msh, int nrows_h, bool final, bool wi8, int tid_) {
  const int wid = __builtin_amdgcn_readfirstlane(tid_ >> 6), lane = tid_ & 63;
  const float* g = PIN(p, ln_g) + (size_t)(layer * 2 + lnidx) * DM;
  const float* bt = PIN(p, ln_b) + (size_t)(layer * 2 + lnidx) * DM;
  for (int row = lbid() * 8 + wid; row < nrows; row += gridDim.x * 8) {
    const int who = who_of_row(row);
    f32x4 v[4];
    float s = 0.f;
#pragma unroll
    for (int i = 0; i < 4; ++i) { v[i] = ld4h(Zin + (size_t)row * DM + i * 256 + lane * 4); s += (v[i][0] + v[i][1]) + (v[i][2] + v[i][3]); }
    const float mu = wave_sum(s, lane) * (1.0f / DM);
    float q = 0.f;
#pragma unroll
    for (int i = 0; i < 4; ++i) { const f32x4 d = v[i] - mu; q += (d[0] * d[0] + d[1] * d[1]) + (d[2] * d[2] + d[3] * d[3]); }
    const float rstd = rsqrtf(wave_sum(q, lane) * (1.0f / DM) + LN_EPS);
    f32x4 hq[4];
    float hmx = 0.f;
#pragma unroll
    for (int i = 0; i < 4; ++i) {
      const int col = i * 256 + lane * 4;
      const f32x4 gg = *(const f32x4*)(g + col), bb = *(const f32x4*)(bt + col);
      const f32x4 xo = (v[i] - mu) * rstd * gg + bb;
      if (final) { *(f32x4*)(p.out + (size_t)row * DM + col) = xo; }
      else {
        st4h(XSo + (size_t)row * DM + col, xo);
        if (row < nrows_h) {
          const f32x4 s1 = *(const f32x4*)(mod_ptr(p, mlayer, who, msh) + col), s2 = *(const f32x4*)(mod_ptr(p, mlayer, who, msh + 1) + col);
          const f32x4 h = xo * (s2 + 1.0f) + s1;
          const u32x2 w = {pk2h(h[0], h[1]), pk2h(h[2], h[3])};
          if (Hout != nullptr) *(u32x2*)(Hout + (size_t)row * DM + col) = w;
          hq[i] = h; hmx = fmaxf(hmx, fmaxf(fmaxf(fabsf(h[0]), fabsf(h[1])), fmaxf(fabsf(h[2]), fabsf(h[3]))));
        }
      }
    }
    if (wi8 && !final && row < nrows_h) {
      const float mx = wave_max(hmx), inv = mx > 0.f ? 127.0f / mx : 0.f;
      unsigned char* h8 = (unsigned char*)(p.ws + OFF_H8) + (size_t)row * DM + lane * 4;
#pragma unroll
      for (int i = 0; i < 4; ++i) *(unsigned*)(h8 + i * 256) = pack_i8x4(hq[i] * inv);
      if (lane == 0) ((float*)(p.ws + OFF_HSC))[row] = mx * (1.0f / 127.0f);
    }
  }
}

typedef short s16x4 __attribute__((ext_vector_type(4)));
typedef float f32x16 __attribute__((ext_vector_type(16)));
#define KSWZ(row, colB) ((row) * 256 + ((colB) ^ (((row) & 7) << 4)))
#define SBAR() __builtin_amdgcn_sched_barrier(0)
constexpr float ATT_SCALE = 0.125f, ATT_THR = 8.f;
#ifndef ATT_SDEPTH
#define ATT_SDEPTH 1
#endif
constexpr int SHM_KV = 64 * 128 * 2;
__device__ __forceinline__ int crow(int r, int hi) { return (r & 3) + 8 * (r >> 2) + 4 * hi; }
__device__ __forceinline__ unsigned cvtpk(float lo, float hi) {
  unsigned r; asm volatile("v_cvt_pk_bf16_f32 %0, %1, %2" : "=v"(r) : "v"(lo), "v"(hi)); return r;
}
__device__ __forceinline__ void qkt(f32x16& p0, f32x16& p1, const char* Ks, const bf16x8* qr, int r32, int hi, int m, float negM) {
#pragma unroll
  for (int r = 0; r < 16; ++r) { p0[r] = negM; p1[r] = negM; }
#pragma unroll
  for (int d0 = 0; d0 < 4; ++d0) {
    const int cb = (m * 64 + d0 * 16 + hi * 8) * 2;
    const bf16x8 b0 = *reinterpret_cast<const bf16x8*>(Ks + KSWZ(r32, cb));
    const bf16x8 b1 = *reinterpret_cast<const bf16x8*>(Ks + KSWZ(32 + r32, cb));
    p0 = __builtin_amdgcn_mfma_f32_32x32x16_bf16(b0, qr[d0], p0, 0, 0, 0);
    p1 = __builtin_amdgcn_mfma_f32_32x32x16_bf16(b1, qr[d0], p1, 0, 0, 0);
  }
}
__device__ __forceinline__ int v_st(int k, int c) { const int kk = (k & ~0xC) | ((k & 4) << 1) | ((k & 8) >> 1); return ((kk >> 3) * 4 + (c >> 5)) * 512 + ((kk & 7) * 32 + (c & 31)) * 2; }
__device__ __forceinline__ int v_rd_base(int lane) { return ((lane & 3) << 3) | (((lane >> 2) & 3) << 6) | (((lane >> 4) & 1) << 5) | (((lane >> 5) & 1) << 8); }
constexpr int v_rd_off(int d0, int ks, int half) { return d0 * 512 + ks * 4096 + half * 2048; }
template <int OFF> __device__ __forceinline__ s16x4 tr_read(int vb) {
  s16x4 r; asm volatile("ds_read_b64_tr_b16 %0, %1 offset:%2" : "=&v"(r) : "v"(vb), "i"(OFF) : "memory"); return r;
}
template <int D0> __device__ __forceinline__ void pv_one(f32x16& od, int vb, bf16x8 pa0, bf16x8 pa1, bf16x8 pa2, bf16x8 pa3) {
  const s16x4 l0 = tr_read<v_rd_off(D0, 0, 0)>(vb), h0 = tr_read<v_rd_off(D0, 0, 1)>(vb), l1 = tr_read<v_rd_off(D0, 1, 0)>(vb), h1 = tr_read<v_rd_off(D0, 1, 1)>(vb);
  const s16x4 l2 = tr_read<v_rd_off(D0, 2, 0)>(vb), h2 = tr_read<v_rd_off(D0, 2, 1)>(vb), l3 = tr_read<v_rd_off(D0, 3, 0)>(vb), h3 = tr_read<v_rd_off(D0, 3, 1)>(vb);
  asm volatile("s_waitcnt lgkmcnt(0)" ::: "memory"); SBAR();
#define PKV(L, H) (bf16x8){L[0], L[1], L[2], L[3], H[0], H[1], H[2], H[3]}
  od = __builtin_amdgcn_mfma_f32_32x32x16_bf16(pa0, PKV(l0, h0), od, 0, 0, 0);
  od = __builtin_amdgcn_mfma_f32_32x32x16_bf16(pa1, PKV(l1, h1), od, 0, 0, 0);
  od = __builtin_amdgcn_mfma_f32_32x32x16_bf16(pa2, PKV(l2, h2), od, 0, 0, 0);
  od = __builtin_amdgcn_mfma_f32_32x32x16_bf16(pa3, PKV(l3, h3), od, 0, 0, 0);
#undef PKV
}
template <int D0> __device__ __forceinline__ void pv_one_t(f32x16& od, int vb, bf16x8 pa0, bf16x8 pa1, bf16x8 pa2, bf16x8 pa3) {
  const s16x4 l0 = tr_read<v_rd_off(D0, 0, 0)>(vb), h0 = tr_read<v_rd_off(D0, 0, 1)>(vb), l1 = tr_read<v_rd_off(D0, 1, 0)>(vb), h1 = tr_read<v_rd_off(D0, 1, 1)>(vb);
  const s16x4 l2 = tr_read<v_rd_off(D0, 2, 0)>(vb), h2 = tr_read<v_rd_off(D0, 2, 1)>(vb), l3 = tr_read<v_rd_off(D0, 3, 0)>(vb), h3 = tr_read<v_rd_off(D0, 3, 1)>(vb);
  asm volatile("s_waitcnt lgkmcnt(0)" ::: "memory"); SBAR();
#define PKV(L, H) (bf16x8){L[0], L[1], L[2], L[3], H[0], H[1], H[2], H[3]}
  od = __builtin_amdgcn_mfma_f32_32x32x16_bf16(PKV(l0, h0), pa0, od, 0, 0, 0);
  od = __builtin_amdgcn_mfma_f32_32x32x16_bf16(PKV(l1, h1), pa1, od, 0, 0, 0);
  od = __builtin_amdgcn_mfma_f32_32x32x16_bf16(PKV(l2, h2), pa2, od, 0, 0, 0);
  od = __builtin_amdgcn_mfma_f32_32x32x16_bf16(PKV(l3, h3), pa3, od, 0, 0, 0);
#undef PKV
}

__device__ __forceinline__ void attn_unit(const bf16_t* __restrict__ Qb, const bf16_t* __restrict__ Kh, const bf16_t* __restrict__ Vh, int seq,
                                          bf16_t* __restrict__ CATp  , const float* __restrict__ ng, float lam, float lam_init,
                                          const unsigned* __restrict__ kmaxp  , char* lds, int tid_) {
  const int tid = tid_, wid = __builtin_amdgcn_readfirstlane(tid >> 6), lane = tid & 63, r32 = lane & 31, hi = lane >> 5;
  const int rg = wid & 3, m = wid >> 2;
  constexpr int SLOT = 2 * SHM_KV;
  float* wsp = (float*)(lds + 4 * SLOT) + wid * 64; float* li_l = wsp;
  float l_reg = 0; f32x16 o[4] = {}; bf16x8 qr[4];
  const bf16_t* Qw = Qb + (size_t)(rg * 32 + r32) * 128 + m * 64 + hi * 8;
#pragma unroll
  for (int d0 = 0; d0 < 4; ++d0) qr[d0] = *reinterpret_cast<const bf16x8*>(Qw + d0 * 16);
  float negM;
  {
    float q2 = 0.f;
#pragma unroll
    for (int d0 = 0; d0 < 4; ++d0)
#pragma unroll
      for (int e = 0; e < 8; ++e) { const float v = bf2f((bf16_t)qr[d0][e]); q2 += v * v; }
    { auto rr = __builtin_amdgcn_permlane32_swap(__float_as_uint(q2), __float_as_uint(q2), false, false); q2 = __uint_as_float(rr[0]) + __uint_as_float(rr[1]); }
    const float k2 = __uint_as_float(kmaxp[m]);
    negM = -1.01f * sqrtf(q2 * k2);
  }
  unsigned vsrc[2], ksrc[2];
#pragma unroll
  for (int j = 0; j < 2; ++j) {
    const int p_ = wid + 8 * j;
    const int g_ = p_ * 64 + lane, sub = g_ >> 5, within = g_ & 31;
    const int kk = (sub >> 2) * 8 + (within >> 2), c_ = (sub & 3) * 32 + (within & 3) * 8;
    const int k_ = (kk & ~0xC) | ((kk & 4) << 1) | ((kk & 8) >> 1);
    vsrc[j] = (unsigned)(k_ * 256 + c_ * 2);
    const int row = p_ * 4 + (lane >> 4), chunk = (lane & 15) ^ (row & 7);
    ksrc[j] = (unsigned)(row * 256 + chunk * 16);
  }
  const int vb0 = (int)(uintptr_t)lds + v_rd_base(lane);
#define SLOAD_DMA(k0, slot) do { \
    const char* _vg = (const char*)(Vh + (size_t)(k0) * 128); const char* _kg = (const char*)(Kh + (size_t)(k0) * 128); char* _b = lds + (slot) * SLOT; \
    __builtin_amdgcn_global_load_lds((const unsigned*)(_vg + vsrc[0]), (unsigned*)(_b + wid * 1024), 16, 0, 0); \
    __builtin_amdgcn_global_load_lds((const unsigned*)(_vg + vsrc[1]), (unsigned*)(_b + (wid + 8) * 1024), 16, 0, 0); \
    __builtin_amdgcn_global_load_lds((const unsigned*)(_kg + ksrc[0]), (unsigned*)(_b + SHM_KV + wid * 1024), 16, 0, 0); \
    __builtin_amdgcn_global_load_lds((const unsigned*)(_kg + ksrc[1]), (unsigned*)(_b + SHM_KV + (wid + 8) * 1024), 16, 0, 0); } while (0)
#define TILE_PUBLISH() do { asm volatile("s_waitcnt vmcnt(0) lgkmcnt(0)" ::: "memory"); __builtin_amdgcn_s_barrier(); asm volatile("" ::: "memory"); } while (0)
#define PKV(L, H) (bf16x8){L[0], L[1], L[2], L[3], H[0], H[1], H[2], H[3]}
#define VRD(D0, KH, vb, f0, f1, f2, f3) do { f0 = tr_read<v_rd_off(D0, 2 * (KH), 0)>(vb); f1 = tr_read<v_rd_off(D0, 2 * (KH), 1)>(vb); \
    f2 = tr_read<v_rd_off(D0, 2 * (KH) + 1, 0)>(vb); f3 = tr_read<v_rd_off(D0, 2 * (KH) + 1, 1)>(vb); } while (0)
#define VMM(D0, qa, qb, f0, f1, f2, f3) do { \
    o[D0] = __builtin_amdgcn_mfma_f32_32x32x16_bf16(qa, PKV(f0, f1), o[D0], 0, 0, 0); \
    o[D0] = __builtin_amdgcn_mfma_f32_32x32x16_bf16(qb, PKV(f2, f3), o[D0], 0, 0, 0); } while (0)
#define LW4() do { asm volatile("s_waitcnt lgkmcnt(4)" ::: "memory"); SBAR(); } while (0)
#define LW0() do { asm volatile("s_waitcnt lgkmcnt(0)" ::: "memory"); SBAR(); } while (0)
#define PV_TILE(vb, q0, q1, q2, q3, C0, C1, C2, C3) do { \
    s16x4 a0, a1, a2, a3; \
    SBAR(); VRD(0, 0, vb, a0, a1, a2, a3); C0; LW0(); VMM(0, q0, q1, a0, a1, a2, a3); SBAR(); \
    VRD(0, 1, vb, a0, a1, a2, a3);     LW0(); VMM(0, q2, q3, a0, a1, a2, a3); SBAR(); \
    VRD(1, 0, vb, a0, a1, a2, a3); C1; LW0(); VMM(1, q0, q1, a0, a1, a2, a3); SBAR(); \
    VRD(1, 1, vb, a0, a1, a2, a3);     LW0(); VMM(1, q2, q3, a0, a1, a2, a3); SBAR(); \
    VRD(2, 0, vb, a0, a1, a2, a3); C2; LW0(); VMM(2, q0, q1, a0, a1, a2, a3); SBAR(); \
    VRD(2, 1, vb, a0, a1, a2, a3);     LW0(); VMM(2, q2, q3, a0, a1, a2, a3); SBAR(); \
    VRD(3, 0, vb, a0, a1, a2, a3); C3; LW0(); VMM(3, q0, q1, a0, a1, a2, a3); SBAR(); \
    VRD(3, 1, vb, a0, a1, a2, a3);     LW0(); VMM(3, q2, q3, a0, a1, a2, a3); SBAR(); } while (0)
#define PK4(P, BASE, OUT) do { unsigned a0 = cvtpk(P[BASE + 0], P[BASE + 1]), a1 = cvtpk(P[BASE + 2], P[BASE + 3]);   \
    unsigned b0 = cvtpk(P[BASE + 4], P[BASE + 5]), b1 = cvtpk(P[BASE + 6], P[BASE + 7]);                              \
    auto r0 = __builtin_amdgcn_permlane32_swap(a0, b0, false, false); auto r1 = __builtin_amdgcn_permlane32_swap(a1, b1, false, false); \
    u32x4 w = {r0[0], r1[0], r0[1], r1[1]}; OUT = *reinterpret_cast<bf16x8*>(&w); } while (0)
#define E1(S0) do { _Pragma("unroll") for (int r = 0; r < 16; ++r) S0[r] = __builtin_amdgcn_exp2f(S0[r]); } while (0)
#define E3(S0, S1) do { float ps = 0; _Pragma("unroll") for (int r = 0; r < 16; ++r) ps += S0[r]; _Pragma("unroll") for (int r = 0; r < 16; ++r) ps += S1[r]; l_reg += ps; } while (0)
#define E4(S0, S1, n0, n1, n2, n3) do { PK4(S0, 0, n0); PK4(S0, 8, n1); PK4(S1, 0, n2); PK4(S1, 8, n3); } while (0)
#define ITER(SN0, SN1, ks, SP0, SP1, vs) do { \
    const int _vb = vb0 + (vs) * SLOT; \
    PV_TILE(_vb, p0, p1, p2, p3, E1(SP0), E1(SP1), E3(SP0, SP1), (void)0); \
    qkt(SN0, SN1, lds + (ks) * SLOT + SHM_KV, qr, r32, hi, m, negM); \
    E4(SP0, SP1, p0, p1, p2, p3); SBAR(); } while (0)
  f32x16 sA0, sA1, sB0, sB1; bf16x8 p0, p1, p2, p3; const int NT = seq / 64;
  SLOAD_DMA(0, 0); TILE_PUBLISH();
  SLOAD_DMA(64, 1);
  qkt(sA0, sA1, lds + SHM_KV, qr, r32, hi, m, negM);
  TILE_PUBLISH();
  if (2 < NT) SLOAD_DMA(2 * 64, 2);
  qkt(sB0, sB1, lds + SLOT + SHM_KV, qr, r32, hi, m, negM);
  E1(sA0); E1(sA1); E3(sA0, sA1); E4(sA0, sA1, p0, p1, p2, p3);
  TILE_PUBLISH();
  for (int i = 2; i < NT; i += 2) {
    SLOAD_DMA((i + 1) * 64, (i + 1) & 3);
    ITER(sA0, sA1, i & 3, sB0, sB1, (i - 2) & 3);
    TILE_PUBLISH();
    if (i + 2 < NT) SLOAD_DMA((i + 2) * 64, (i + 2) & 3);
    ITER(sB0, sB1, (i + 1) & 3, sA0, sA1, (i - 1) & 3);
    TILE_PUBLISH();
  }
  {
    const int _vb = vb0 + ((NT - 2) & 3) * SLOT;
    PV_TILE(_vb, p0, p1, p2, p3, E1(sB0), E1(sB1), E3(sB0, sB1), (void)0);
    E4(sB0, sB1, p0, p1, p2, p3); SBAR();
    const int _vb2 = vb0 + ((NT - 1) & 3) * SLOT;
    PV_TILE(_vb2, p0, p1, p2, p3, (void)0, (void)0, (void)0, (void)0);
  }
#undef SLOAD_DMA
#undef TILE_PUBLISH
#undef PKV
#undef PV_TILE
#undef VRD
#undef VMM
#undef LW4
#undef LW0
#undef PK4
#undef E1
#undef E3
#undef E4
#undef ITER
  int r32e = r32, hie = hi;
  asm volatile("" : "+v"(r32e), "+v"(hie));
  { auto rr = __builtin_amdgcn_permlane32_swap(__float_as_uint(l_reg), __float_as_uint(l_reg), false, false); l_reg = __uint_as_float(rr[0]) + __uint_as_float(rr[1]); }
  if (hie == 0) li_l[r32e] = l_reg;
  asm volatile("s_waitcnt lgkmcnt(0)" ::: "memory");
  float rli[16];
#pragma unroll
  for (int r = 0; r < 16; ++r) rli[r] = __builtin_amdgcn_rcpf(li_l[crow(r, hie)]);
  __syncthreads();
  constexpr int CST = 132;
  float* cbuf = (float*)lds + (m ? 128 * CST : 0);
  {
    const float sc = m ? lam : 1.0f;
#pragma unroll
    for (int r = 0; r < 16; ++r) {
      const float f = rli[r] * sc;
#pragma unroll
      for (int d0 = 0; d0 < 4; ++d0) cbuf[(rg * 32 + crow(r, hie)) * CST + d0 * 32 + r32e] = o[d0][r] * f;
    }
  }
  __syncthreads();
  {
    int tide = tid;
    asm volatile("" : "+v"(tide));
    const int row = tide >> 2, q = tide & 3;
    const float* pa = (const float*)lds + row * CST + q * 32;
    const float* pb = pa + 128 * CST;
    f32x4 v[8];
    float a = 0.f;
#pragma unroll
    for (int j = 0; j < 8; ++j) {
      v[j] = *(const f32x4*)(pa + 4 * j) - *(const f32x4*)(pb + 4 * j);
      a += (v[j][0] * v[j][0] + v[j][1] * v[j][1]) + (v[j][2] * v[j][2] + v[j][3] * v[j][3]);
    }
    a += __int_as_float(__builtin_amdgcn_update_dpp(0, __float_as_int(a), 0xB1, 0xf, 0xf, true));
    a += __int_as_float(__builtin_amdgcn_update_dpp(0, __float_as_int(a), 0x4E, 0xf, 0xf, true));
    const float rs = rsqrtf(a * (1.0f / 128.0f) + LN_EPS) * (1.0f - lam_init);
    bf16_t* cp = CATp + (size_t)row * 1536 + q * 32;
#pragma unroll
    for (int j = 0; j < 4; ++j) {
      const f32x4 g0 = *(const f32x4*)(ng + q * 32 + 8 * j), g1 = *(const f32x4*)(ng + q * 32 + 8 * j + 4);
      const f32x4 x0 = v[2 * j] * g0 * rs, x1 = v[2 * j + 1] * g1 * rs;
      *(u32x4*)(cp + 8 * j) = (u32x4){pk2h(x0[0], x0[1]), pk2h(x0[2], x0[3]), pk2h(x1[0], x1[1]), pk2h(x1[2], x1[3])};
    }
  }
  __syncthreads();
}

__device__ __forceinline__ void sgu_unit(const Params& p, int chunk, int jl, char* lds, int tid_) {
  const int tid = tid_, wid = __builtin_amdgcn_readfirstlane(tid >> 6), lane = tid & 63, r32 = lane & 31, hi = lane >> 5;
  const int row0 = chunk * 128;
  const bf16_t* GV = (const bf16_t*)(p.ws + OFF_GV);
  const bf16_t* GU = (const bf16_t*)(p.ws + OFF_GU);
  bf16_t* CAT = (bf16_t*)(p.ws + OFF_CAT);
  const float* lg = PIN(p, sgu_ln_g) + (size_t)jl * 512;
  const float* lb = PIN(p, sgu_ln_b) + (size_t)jl * 512;
  {
    const f32x4 g0 = *(const f32x4*)(lg + lane * 8), g1 = *(const f32x4*)(lg + lane * 8 + 4);
    const f32x4 b0 = *(const f32x4*)(lb + lane * 8), b1 = *(const f32x4*)(lb + lane * 8 + 4);
    const int c = lane * 8, g = c >> 7, cg = c & 127;
    for (int q = wid; q < 128; q += 8) {
      const u32x4 w = *(const u32x4*)(GV + (size_t)(row0 + q) * 512 + c);
      float v[8];
#pragma unroll
      for (int i = 0; i < 4; ++i) { v[2 * i] = bflo(w[i]); v[2 * i + 1] = bfhi(w[i]); }
      float s = 0.f;
#pragma unroll
      for (int i = 0; i < 8; ++i) s += v[i];
      const float mu = wave_sum(s, lane) * (1.0f / 512.0f);
      float qq = 0.f;
#pragma unroll
      for (int i = 0; i < 8; ++i) { const float d = v[i] - mu; qq += d * d; }
      const float rstd = rsqrtf(wave_sum(qq, lane) * (1.0f / 512.0f) + LN_EPS);
      u32x4 ow;
      ow[0] = pk2((v[0] - mu) * rstd * g0[0] + b0[0], (v[1] - mu) * rstd * g0[1] + b0[1]);
      ow[1] = pk2((v[2] - mu) * rstd * g0[2] + b0[2], (v[3] - mu) * rstd * g0[3] + b0[3]);
      ow[2] = pk2((v[4] - mu) * rstd * g1[0] + b1[0], (v[5] - mu) * rstd * g1[1] + b1[1]);
      ow[3] = pk2((v[6] - mu) * rstd * g1[2] + b1[2], (v[7] - mu) * rstd * g1[3] + b1[3]);
      *(u32x4*)(lds + (g * 2 + (q >> 6)) * SHM_KV + v_st(q & 63, cg)) = ow;
    }
  }
  __syncthreads();
  const int pg = wid & 3, ch = wid >> 2;
  const int vbase = (int)(uintptr_t)lds + v_rd_base(lane);
  for (int g = 0; g < 4; ++g) {
    const float* Wg = PIN(p, sgu_w) + ((size_t)(jl * 4 + g) * 128) * 128;
    bf16x8 af[8];
#pragma unroll
    for (int ks = 0; ks < 8; ++ks) {
      const float* wp = Wg + (size_t)(pg * 32 + r32) * 128 + ks * 16 + hi * 8;
      const f32x4 a = *(const f32x4*)wp, b = *(const f32x4*)(wp + 4);
      u32x4 w = {pk2(a[0], a[1]), pk2(a[2], a[3]), pk2(b[0], b[1]), pk2(b[2], b[3])};
      af[ks] = *reinterpret_cast<bf16x8*>(&w);
    }
    f32x16 acc[2] = {};
#pragma unroll
    for (int kt = 0; kt < 2; ++kt) {
      const int vb = vbase + (g * 2 + kt) * SHM_KV;
      if (ch == 0) { pv_one_t<0>(acc[0], vb, af[kt * 4 + 0], af[kt * 4 + 1], af[kt * 4 + 2], af[kt * 4 + 3]); pv_one_t<1>(acc[1], vb, af[kt * 4 + 0], af[kt * 4 + 1], af[kt * 4 + 2], af[kt * 4 + 3]); }
      else         { pv_one_t<2>(acc[0], vb, af[kt * 4 + 0], af[kt * 4 + 1], af[kt * 4 + 2], af[kt * 4 + 3]); pv_one_t<3>(acc[1], vb, af[kt * 4 + 0], af[kt * 4 + 1], af[kt * 4 + 2], af[kt * 4 + 3]); }
    }
    const int pp = pg * 32 + r32;
    const float bb = (PIN(p, sgu_b) + (size_t)(jl * 4 + g) * 128)[pp];
    const bf16_t* gup = GU + (size_t)(row0 + pp) * 512 + g * 128 + ch * 64 + 4 * hi;
    bf16_t* cap = CAT + (size_t)(row0 + pp) * 1536 + 1024 + g * 128 + ch * 64 + 4 * hi;
#pragma unroll
    for (int dd = 0; dd < 2; ++dd)
#pragma unroll
      for (int q = 0; q < 4; ++q) {
        const u32x2 uw = *(const u32x2*)(gup + dd * 32 + q * 8);
        const float s0 = acc[dd][4 * q] + bb, s1 = acc[dd][4 * q + 1] + bb, s2 = acc[dd][4 * q + 2] + bb, s3 = acc[dd][4 * q + 3] + bb;
        u32x2 ow = {pk2h(bflo(uw[0]) * s0, bfhi(uw[0]) * s1), pk2h(bflo(uw[1]) * s2, bfhi(uw[1]) * s3)};
        *(u32x2*)(cap + dd * 32 + q * 8) = ow;
      }
  }
  __syncthreads();
}

__device__ void phase_mixer_fast(const Params& p, int layer, char* shm, int tid_) {
  const int jl = layer >> 1;
  const bool ctxq = layer == 0;
  const float lam = ((const float*)(p.ws + OFF_LAM))[jl * 2 + 0];
  const float lam_init = ((const float*)(p.ws + OFF_LAM))[jl * 2 + 1];
  const float* ng = PIN(p, diff_norm_g) + (size_t)jl * 128;
  const bf16_t* Q = (const bf16_t*)(p.ws + OFF_Q);
  const bf16_t* K = (const bf16_t*)(p.ws + OFF_K);
  const bf16_t* V = (const bf16_t*)(p.ws + OFF_V);
  bf16_t* CAT = (bf16_t*)(p.ws + OFF_CAT);
  const int bid = lbid();
  const int NC = ctxq ? 32 : 0;
  const int NS = ctxq ? (NTOK / 128) : (NLAT / 128);
  for (int u = bid; u < 1024 + NC + NS; u += gridDim.x) {
    if (u < 1024 + NC) {
      int bh, pos0, seq, orow;
      if (u < 1024) {
        const int xcd = u & 7, ul = (u >> 8) * 32 + ((u & 255) >> 3), qb = ul & 63;
        bh = xcd * 2 + (ul >> 6);
        pos0 = CTXL + qb * 128; seq = LKV; orow = (bh >> 3) * SEQ + qb * 128;
      } else {
        const int v = u - 1024, qb = v & 1;
        bh = v >> 1;
        pos0 = qb * 128; seq = CTXL; orow = NLAT + (bh >> 3) * CTXL + qb * 128;
      }
      const size_t hb = (size_t)bh * LKV * 128;
      attn_unit(Q + hb + (size_t)pos0 * 128, K + hb, V + hb, seq, CAT + (size_t)orow * 1536 + (bh & 7) * 128, ng, lam, lam_init, (const unsigned*)(p.ws + OFF_BAR + 256) + jl * 32 + bh * 2, shm, tid_);
    } else {
      sgu_unit(p, u - 1024 - NC, jl, shm, tid_);
    }
  }
}

__device__ __forceinline__ void ld8h(const bf16_t* p, float (&v)[8]) {
  const u32x4 w = *(const u32x4*)p;
#pragma unroll
  for (int i = 0; i < 4; ++i) { v[2 * i] = hlo(w[i]); v[2 * i + 1] = hhi(w[i]); }
}
__device__ void phase_pool(const Params& p, int nrows, int tid_) {
  const bf16_t* M1 = (const bf16_t*)(p.ws + OFF_M1);
  bf16_t* M2 = (bf16_t*)(p.ws + OFF_M2);
  const int nitems = (nrows >> 5) * 128;
  for (int it = lbid() * 512 + tid_; it < nitems; it += gridDim.x * 512) {
    const int cg = it & 127, seg = it >> 7;
    const int row0 = seg * 32;
    int base, T;
    if (row0 < NLAT) { base = row0 & ~(SEQ - 1); T = SEQ; } else { base = NLAT + ((row0 - NLAT) & ~255); T = CTXL; }
    const int t0 = row0 - base;
    const int h = 1 << (cg >> 5);
    const bf16_t* colp = M1 + (size_t)base * 1024 + cg * 8;
    float S[8];
#pragma unroll
    for (int i = 0; i < 8; ++i) S[i] = 0.f;
    {
      const int lo = t0 - h < 0 ? 0 : t0 - h, hi = t0 + h > T ? T : t0 + h;
      for (int q = lo; q < hi; ++q) { float v[8]; ld8h(colp + (size_t)q * 1024, v);
#pragma unroll
        for (int i = 0; i < 8; ++i) S[i] += v[i]; }
    }
    for (int t = t0; t < t0 + 32; ++t) {
      const int lo = t - h < 0 ? 0 : t - h, hi = t + h > T ? T : t + h;
      const float inv = 1.0f / (float)(hi - lo);
      float x[8];
      ld8h(colp + (size_t)t * 1024, x);
      u32x4 w;
#pragma unroll
      for (int i = 0; i < 4; ++i) w[i] = pk2h(S[2 * i] * inv - x[2 * i], S[2 * i + 1] * inv - x[2 * i + 1]);
      *(u32x4*)(M2 + (size_t)(base + t) * 1024 + cg * 8) = w;
      if (t + h < T) { float v[8]; ld8h(colp + (size_t)(t + h) * 1024, v);
#pragma unroll
        for (int i = 0; i < 8; ++i) S[i] += v[i]; }
      if (t - h >= 0) { float v[8]; ld8h(colp + (size_t)(t - h) * 1024, v);
#pragma unroll
        for (int i = 0; i < 8; ++i) S[i] -= v[i]; }
    }
  }
}

#define DPP_ADD_F(keep, send, ctrlstr) ({ float _r; asm("s_nop 1\n\tv_add_f32_dpp %0, %1, %2 " ctrlstr " row_mask:0xf bank_mask:0xf bound_ctrl:1" : "=v"(_r) : "v"(send), "v"(keep)); _r; })
__device__ __forceinline__ float hadd2(f32x2v v) { float r; asm("v_add_f32 %0, %1, %2" : "=v"(r) : "v"(v[0]), "v"(v[1])); return r; }
#define PEER_LOAD_IDX(dst, k) do { const int _t = wv + (k) * nwv; dst = *(const u32x4*)(IDX + ((size_t)g * NTOK + _t) * 8 + (c & 1) * 4); } while (0)
#define PEER_SPLIT_IDX(src) do { u32x4 _p; \
    _Pragma("unroll") for (int q = 0; q < 4; ++q) _p[q] = (unsigned)__builtin_amdgcn_update_dpp(0, (int)src[q], 0xB1, 0xf, 0xf, true); \
    _Pragma("unroll") for (int q = 0; q < 4; ++q) { idA[q] = (c & 1) ? _p[q] : src[q]; idB[q] = (c & 1) ? src[q] : _p[q]; } } while (0)
#define PEER_ROWLO(TAB, w) (*(const u32x4*)((TAB) + ((((w) << 7) & 0x7fff80u) | (unsigned)c16)))
#define PEER_ROWHI(TAB, w) (*(const u32x4*)((TAB) + ((((w) >> 9) & 0x7fff80u) | (unsigned)c16)))
#define PEER_GATHER_H0(buf, TAB, id) do { \
    buf[0] = PEER_ROWLO(TAB, id##A[0]); buf[1] = PEER_ROWHI(TAB, id##A[0]); buf[2] = PEER_ROWLO(TAB, id##A[1]); buf[3] = PEER_ROWHI(TAB, id##A[1]); \
    buf[4] = PEER_ROWLO(TAB, id##A[2]); buf[5] = PEER_ROWHI(TAB, id##A[2]); buf[6] = PEER_ROWLO(TAB, id##A[3]); buf[7] = PEER_ROWHI(TAB, id##A[3]); } while (0)
#define PEER_GATHER_H1(buf, TAB, id) do { \
    buf[0] = PEER_ROWLO(TAB, id##B[0]); buf[1] = PEER_ROWHI(TAB, id##B[0]); buf[2] = PEER_ROWLO(TAB, id##B[1]); buf[3] = PEER_ROWHI(TAB, id##B[1]); \
    buf[4] = PEER_ROWLO(TAB, id##B[2]); buf[5] = PEER_ROWHI(TAB, id##B[2]); buf[6] = PEER_ROWLO(TAB, id##B[3]); buf[7] = PEER_ROWHI(TAB, id##B[3]); } while (0)

__device__ void phase_peer_u(const Params& p, int layer, int nrows, int tid_) {
  const int tid = tid_, wid = __builtin_amdgcn_readfirstlane(tid >> 6), lane = tid & 63, bid = lbid();
  const int s = bid & 7, wv = (bid >> 3) * 8 + wid, nwv = (gridDim.x >> 3) * 8;
  const int g = lane >> 3, c = lane & 7, c16 = c * 16;
  const bool b2 = (lane & 4) != 0, b1 = (lane & 2) != 0, b0 = (lane & 1) != 0;
  const unsigned char* H = (const unsigned char*)(p.ws + OFF_H8) + s * 128 + c * 16;
  const unsigned char* U = (const unsigned char*)(p.ws + OFF_U8) + (size_t)(layer * 8 + s) * NEXP * 128;
  const unsigned* IDX = (const unsigned*)(p.ws + OFF_IDX16);
  float* PART = (float*)(p.ws + OFF_PART);
  const int n = wv < nrows ? (nrows - wv + nwv - 1) / nwv : 0;
  if (n == 0) return;
  u32x4 idA, idB;
  u32x4 bufA[8], bufB[8], hn, hc;
#define PU_HLOAD(h, k) do { const int _t = wv + (k) * nwv; h = *(const u32x4*)(H + (size_t)_t * DM); } while (0)
#define PU_HCVT() do { hc = hn; } while (0)
#define PU_HALF(buf, base) do { \
    int ia[8]; \
    _Pragma("unroll") for (int i = 0; i < 8; ++i) ia[i] = __builtin_amdgcn_sdot4((int)buf[i][0], (int)hc[0], 0, false); \
    _Pragma("unroll") for (int q = 1; q < 4; ++q) { _Pragma("unroll") for (int i = 0; i < 8; ++i) ia[i] = __builtin_amdgcn_sdot4((int)buf[i][q], (int)hc[q], ia[i], false); } \
    _Pragma("unroll") for (int i = 0; i < 8; ++i) pd[(base) + i] = (float)ia[i]; } while (0)
  u32x4 idX;
  PEER_LOAD_IDX(idX, 0);
  PEER_SPLIT_IDX(idX);
  PEER_GATHER_H0(bufA, U, id); PU_HLOAD(hn, 0);
  { const int k1 = n > 1 ? 1 : 0; PEER_LOAD_IDX(idX, k1); }
  PU_HCVT();
  for (int k = 0; k < n; ++k) {
    const int k1 = k + 1 < n ? k + 1 : k, k2 = k + 2 < n ? k + 2 : n - 1;
    PEER_GATHER_H1(bufB, U, id);
    __builtin_amdgcn_sched_barrier(0);
    float pd[16];
    PU_HALF(bufA, 0);
    __builtin_amdgcn_sched_barrier(0);
    PEER_SPLIT_IDX(idX);
    PEER_GATHER_H0(bufA, U, id); PU_HLOAD(hn, k1);
    __builtin_amdgcn_sched_barrier(0);
    PEER_LOAD_IDX(idX, k2);
    __builtin_amdgcn_sched_barrier(0);
    PU_HALF(bufB, 8);
    float r8[8], r4[4], r2[2];
#pragma unroll
    for (int i = 0; i < 8; ++i) { const float keep = b2 ? pd[8 + i] : pd[i], send = b2 ? pd[i] : pd[8 + i]; r8[i] = DPP_ADD_F(keep, send, "row_half_mirror"); }
#pragma unroll
    for (int i = 0; i < 4; ++i) { const float keep = b1 ? r8[4 + i] : r8[i], send = b1 ? r8[i] : r8[4 + i]; r4[i] = DPP_ADD_F(keep, send, "quad_perm:[2,3,0,1]"); }
#pragma unroll
    for (int i = 0; i < 2; ++i) { const float keep = b0 ? r4[2 + i] : r4[i], send = b0 ? r4[i] : r4[2 + i]; r2[i] = DPP_ADD_F(keep, send, "quad_perm:[1,0,3,2]"); }
    *(f32x2v*)(PART + ((size_t)(wv + k * nwv) * 8 + s) * 128 + lane * 2) = (f32x2v){r2[0], r2[1]};
    PU_HCVT();
    __builtin_amdgcn_sched_barrier(0);
  }
#undef PU_HLOAD
#undef PU_HCVT
#undef PU_HALF
}
__device__ void phase_peer_w(const Params& p, int layer, int nrows, int tid_) {
  const int wid = __builtin_amdgcn_readfirstlane(tid_ >> 6), lane = tid_ & 63;
  const float* PART = (const float*)(p.ws + OFF_PART);
  const float* GATE = (const float*)(p.ws + OFF_GATE);
  unsigned char* W8 = (unsigned char*)(p.ws + OFF_W8);
  float* WSC = (float*)(p.ws + OFF_WSC);
  const float* VSC = (const float*)(p.ws + OFF_VSC) + (size_t)layer * NEXP;
  const int* IDX = (const int*)(p.ws + OFF_IDX);
  const float* HSC = (const float*)(p.ws + OFF_HSC);
  const float* USC = (const float*)(p.ws + OFF_USC) + (size_t)layer * NEXP;
  for (int t = lbid() * 8 + wid; t < nrows; t += gridDim.x * 8) {
    f32x2v acc2 = {0.f, 0.f};
#pragma unroll
    for (int q = 0; q < 8; ++q) acc2 += *(const f32x2v*)(PART + ((size_t)t * 8 + q) * 128 + lane * 2);
    const size_t go = ((size_t)(lane >> 3) * NTOK + t) * 16 + (lane & 7) * 2;
    const f32x2v gt = *(const f32x2v*)(GATE + go);
    const int id0 = IDX[go], id1 = IDX[go + 1];
    const float hs = HSC[t];
    const float d0 = acc2[0] * (hs * USC[id0]), d1 = acc2[1] * (hs * USC[id1]);
    const float w0 = gt[0] * gelu_tanh(d0) * VSC[id0], w1 = gt[1] * gelu_tanh(d1) * VSC[id1];
    const float mx = wave_max(fmaxf(fabsf(w0), fabsf(w1))), inv = mx > 0.f ? 127.0f / mx : 0.f;
    const int q0 = __float2int_rn(w0 * inv), q1 = __float2int_rn(w1 * inv);
    *(unsigned short*)(W8 + (size_t)t * 128 + lane * 2) = (unsigned short)((q0 & 255) | ((q1 & 255) << 8));
    if (lane == 0) WSC[t] = mx * (1.0f / 127.0f);
  }
}
#define PERM_B(hi, lo, sel) __builtin_amdgcn_perm((unsigned)(hi), (unsigned)(lo), (unsigned)(sel))
#define DPP_ADD_I(keep, send, ctrlstr) ({ int _r; asm("s_nop 1\n\tv_add_u32_dpp %0, %1, %2 " ctrlstr " row_mask:0xf bank_mask:0xf bound_ctrl:1" : "=v"(_r) : "v"(send), "v"(keep)); _r; })
__device__ void phase_peer_v(const Params& p, int layer, const hstream_t* XSin, hstream_t* Zout, int nrows, int tid_) {
  const int tid = tid_, wid = __builtin_amdgcn_readfirstlane(tid >> 6), lane = tid & 63, bid = lbid();
  const int s = bid & 7, wv = (bid >> 3) * 8 + wid, nwv = (gridDim.x >> 3) * 8;
  const int g = lane >> 3, c = lane & 7, c16 = c * 16;
  const bool b3 = (lane & 8) != 0;
  const unsigned char* Vt = (const unsigned char*)(p.ws + OFF_V8) + (size_t)(layer * 8 + s) * NEXP * 128;
  const unsigned* IDX = (const unsigned*)(p.ws + OFF_IDX16);
  const unsigned char* W8 = (const unsigned char*)(p.ws + OFF_W8) + g * 16;
  const float* WSC = (const float*)(p.ws + OFF_WSC);
  const int col = s * 128 + c * 16 + g * 2;
  const int n = wv < nrows ? (nrows - wv + nwv - 1) / nwv : 0;
  if (n == 0) return;
  u32x4 idA, idB;
  u32x4 bufA[8], bufB[8], wq, wqn;
  unsigned xw;
  const f32x2v g2w0 = *(const f32x2v*)(mod_ptr(p, layer, 0, 5) + col), g2w1 = *(const f32x2v*)(mod_ptr(p, layer, 1, 5) + col), g2w2 = *(const f32x2v*)(mod_ptr(p, layer, 2, 5) + col);
#define PV_QUAD(buf, r0, wd) do { \
    _Pragma("unroll") for (int q = 0; q < 4; ++q) { \
      const unsigned x01l = PERM_B(buf[(r0) + 1][q], buf[(r0)][q], 0x05010400u), x01h = PERM_B(buf[(r0) + 1][q], buf[(r0)][q], 0x07030602u); \
      const unsigned x23l = PERM_B(buf[(r0) + 3][q], buf[(r0) + 2][q], 0x05010400u), x23h = PERM_B(buf[(r0) + 3][q], buf[(r0) + 2][q], 0x07030602u); \
      acc[4 * q + 0] = __builtin_amdgcn_sdot4((int)PERM_B(x23l, x01l, 0x05040100u), (int)(wd), acc[4 * q + 0], false); \
      acc[4 * q + 1] = __builtin_amdgcn_sdot4((int)PERM_B(x23l, x01l, 0x07060302u), (int)(wd), acc[4 * q + 1], false); \
      acc[4 * q + 2] = __builtin_amdgcn_sdot4((int)PERM_B(x23h, x01h, 0x05040100u), (int)(wd), acc[4 * q + 2], false); \
      acc[4 * q + 3] = __builtin_amdgcn_sdot4((int)PERM_B(x23h, x01h, 0x07060302u), (int)(wd), acc[4 * q + 3], false); } } while (0)
  u32x4 idX;
  PEER_LOAD_IDX(idX, 0);
  PEER_SPLIT_IDX(idX);
  PEER_GATHER_H0(bufA, Vt, id);
  wq = *(const u32x4*)(W8 + (size_t)wv * 128);
  { const int k1 = n > 1 ? 1 : 0; PEER_LOAD_IDX(idX, k1); }
  for (int k = 0; k < n; ++k) {
    const int k1 = k + 1 < n ? k + 1 : k, k2 = k + 2 < n ? k + 2 : n - 1;
    const int t = wv + k * nwv;
    PEER_GATHER_H1(bufB, Vt, id);
    __builtin_amdgcn_sched_barrier(0);
    xw = *(const unsigned*)(XSin + (size_t)t * DM + col);
    const float wsc = WSC[t];
    __builtin_amdgcn_sched_barrier(0);
    int acc[16];
#pragma unroll
    for (int j = 0; j < 16; ++j) acc[j] = 0;
    PV_QUAD(bufA, 0, wq[0]); PV_QUAD(bufA, 4, wq[1]);
    __builtin_amdgcn_sched_barrier(0);
    PEER_SPLIT_IDX(idX);
    PEER_GATHER_H0(bufA, Vt, id);
    wqn = *(const u32x4*)(W8 + (size_t)(wv + k1 * nwv) * 128);
    __builtin_amdgcn_sched_barrier(0);
    PEER_LOAD_IDX(idX, k2);
    __builtin_amdgcn_sched_barrier(0);
    PV_QUAD(bufB, 0, wq[2]); PV_QUAD(bufB, 4, wq[3]);
    int r8[8], r4[4], r2[2];
#pragma unroll
    for (int i = 0; i < 8; ++i) { auto rr = __builtin_amdgcn_permlane32_swap((unsigned)acc[i], (unsigned)acc[8 + i], false, false); r8[i] = (int)rr[0] + (int)rr[1]; }
#pragma unroll
    for (int i = 0; i < 4; ++i) { auto rr = __builtin_amdgcn_permlane16_swap((unsigned)r8[i], (unsigned)r8[4 + i], false, false); r4[i] = (int)rr[0] + (int)rr[1]; }
#pragma unroll
    for (int i = 0; i < 2; ++i) { const int keep = b3 ? r4[2 + i] : r4[i], send = b3 ? r4[i] : r4[2 + i]; r2[i] = DPP_ADD_I(keep, send, "row_ror:8"); }
    const int who = who_of_row(t);
    const f32x2v g2 = who == 0 ? g2w0 : (who == 1 ? g2w1 : g2w2);
    *(unsigned*)(Zout + (size_t)t * DM + col) = pk2h(ALPHA * hlo(xw) + g2[0] * ((float)r2[0] * wsc), ALPHA * hhi(xw) + g2[1] * ((float)r2[1] * wsc));
    wq = wqn;
    __builtin_amdgcn_sched_barrier(0);
  }
#undef PV_QUAD
}

constexpr int NSTEP = 9;
constexpr int NPHASE = 2 + NSTEP * DEPTH;

__device__ void run_phase(const Params& pin, int ph, char* shm, int tid_) {
  Params p = pin;
  { unsigned zoff = 0; asm volatile("" : "+s"(zoff));
    p.ws = pin.ws + zoff; }
  if (ph == 0) { phase_prologue_a(p, shm, tid_); return; }
  if (ph == 1) { phase_prologue_b(p, tid_); return; }
  const int layer = (ph - 2) / NSTEP, step = (ph - 2) % NSTEP;
  const bool even = (layer & 1) == 0;
  const int jl = layer >> 1;
  const bool ctx_out = layer < 2;
  const int nrows = ctx_out ? NTOK : NLAT;
  const int mt_upd = nrows / 256;
  hstream_t* XSA = (hstream_t*)(p.ws + OFF_XSA);
  hstream_t* XSB = (hstream_t*)(p.ws + OFF_XSB);
  hstream_t* Z = (hstream_t*)(p.ws + OFF_Z);
  const float* modl = (const float*)(p.ws + OFF_MOD) + (size_t)layer * 3 * 6144;
  if (step == 0) {
    if (even) {
      const EpiInProj eq{(bf16_t*)(p.ws + OFF_Q), (bf16_t*)(p.ws + OFF_K), (const float*)(p.ws + OFF_HSC), (const float*)(p.ws + OFF_WINSC) + (size_t)jl * 4096, (const float*)(p.ws + OFF_ROPE), (unsigned*)(p.ws + OFF_BAR + 256) + jl * 32};
      const EpiInProjVG ev{(bf16_t*)(p.ws + OFF_V), (bf16_t*)(p.ws + OFF_GU), (bf16_t*)(p.ws + OFF_GV), (const float*)(p.ws + OFF_HSC), (const float*)(p.ws + OFF_WINSC) + (size_t)jl * 4096 + 2048};
      const int mt = (layer <= 2) ? NTOK / 256 : NLAT / 256;
      const char* W8 = p.ws + OFF_WIN8 + (size_t)jl * 4096 * 1024;
      const char* H8 = p.ws + OFF_H8;
      const int nu_big = (NLAT / 256) * 16, nu_small = ((mt * 256 - NLAT) >> 6) * 16;
      for (int u = lbid(); u < nu_big; u += gridDim.x) {
        const int xcd = u & 7, v = u >> 3;
        const int pn = ((v & 15) + 8 * ((v >> 5) & 1)) & 15, pm = (v >> 4) * 8 + xcd;
        if (pn < 8) gemm_tile<2, 8>((const bf16_t*)(H8 + (size_t)pm * 256 * 1024), (const bf16_t*)(W8 + (size_t)pn * 256 * 1024), pm * 256, pn, 512, eq, shm, tid_);
      }
      for (int u = lbid(); u < nu_big; u += gridDim.x) {
        const int xcd = u & 7, v = u >> 3;
        const int pn = ((v & 15) + 8 * ((v >> 5) & 1)) & 15, pm = (v >> 4) * 8 + xcd;
        if (pn >= 8) gemm_tile<2, 8>((const bf16_t*)(H8 + (size_t)pm * 256 * 1024), (const bf16_t*)(W8 + (size_t)pn * 256 * 1024), pm * 256, pn, 512, ev, shm, tid_);
      }
      const int u0 = nu_big + ((lbid() + gridDim.x - nu_big % gridDim.x) % gridDim.x);
      for (int u = u0; u < nu_big + nu_small; u += gridDim.x) {
        const int w = u - nu_big, pn = w & 15, row0 = NLAT + (w >> 4) * 64;
        if (pn < 8) gemm_tile<2, 2>((const bf16_t*)(H8 + (size_t)row0 * 1024), (const bf16_t*)(W8 + (size_t)pn * 256 * 1024), row0, pn, 512, eq, shm, tid_);
      }
      for (int u = u0; u < nu_big + nu_small; u += gridDim.x) {
        const int w = u - nu_big, pn = w & 15, row0 = NLAT + (w >> 4) * 64;
        if (pn >= 8) gemm_tile<2, 2>((const bf16_t*)(H8 + (size_t)row0 * 1024), (const bf16_t*)(W8 + (size_t)pn * 256 * 1024), row0, pn, 512, ev, shm, tid_);
      }
    } else {
      EpiBf16Store e{(bf16_t*)(p.ws + OFF_M1), 1024, (const float*)(p.ws + OFF_HSC), (const float*)(p.ws + OFF_PINSC) + (size_t)jl * 1024};
      gemm_phase<2>((const bf16_t*)(p.ws + OFF_H8), (const bf16_t*)(p.ws + OFF_PIN8 + (size_t)jl * 1024 * 1024), NLAT / 256, nrows - NLAT, 4, 512, e, shm, tid_);
    }
  } else if (step == 1) {
    if (even) phase_mixer_fast(p, layer, shm, tid_);
    else phase_pool(p, nrows, tid_);
  } else if (step == 2) {
    EpiResid e{XSA, Z, modl, 2};
    if (even) gemm_phase<true>((const bf16_t*)(p.ws + OFF_CAT), (const bf16_t*)(p.ws + OFF_WOUT) + (size_t)jl * 1024 * 1536, NLAT / 256, nrows - NLAT, 4, 1536, e, shm, tid_);
    else gemm_phase<true>((const bf16_t*)(p.ws + OFF_M2), (const bf16_t*)(p.ws + OFF_POUT) + (size_t)jl * 1024 * 1024, NLAT / 256, nrows - NLAT, 4, 1024, e, shm, tid_);
  } else if (step == 3) {
    phase_ln(p, Z, XSB, layer, 0, nrows, nullptr, layer, 3, nrows, false, true, tid_);
  } else if (step == 4) {
    EpiTopK e{(int*)(p.ws + OFF_IDX), (float*)(p.ws + OFF_GATE), (unsigned*)(p.ws + OFF_IDX16), (const float*)(p.ws + OFF_HSC), (const float*)(p.ws + OFF_WQSC) + (size_t)layer * 2048};
    gemm_phase<2>((const bf16_t*)(p.ws + OFF_H8), (const bf16_t*)(p.ws + OFF_WQK8 + (size_t)layer * 2048 * 1024), NLAT / 256, nrows - NLAT, 8, 512, e, shm, tid_);
  } else if (step == 5) {
    phase_peer_u(p, layer, nrows, tid_);
  } else if (step == 6) {
    phase_peer_w(p, layer, nrows, tid_);
  } else if (step == 7) {
    phase_peer_v(p, layer, XSB, Z, nrows, tid_);
  } else {
    const int nl = layer + 1;
    const int nrows_next = (nl <= 2) ? NTOK : NLAT;
    phase_ln(p, Z, XSA, layer, 1, nrows, nullptr, nl, 0, nrows_next < nrows ? nrows_next : nrows, layer == DEPTH - 1, true, tid_);
  }
}

#define XB_XCNT(j) (64 * (j))
#define XB_XSUB(j) (512 + 64 * (j))
#define XB_XGEN(j) (1024 + 64 * (j))
#define XB_TOP 1536
#define XB_TOPGEN 1600
#define XB_WORDS 1664
__device__ __forceinline__ unsigned xb_ld(unsigned* p) { return __hip_atomic_load(p, __ATOMIC_RELAXED, __HIP_MEMORY_SCOPE_AGENT); }
__device__ __forceinline__ unsigned xb_add(unsigned* p, unsigned v) { return __hip_atomic_fetch_add(p, v, __ATOMIC_RELAXED, __HIP_MEMORY_SCOPE_AGENT); }
__device__ __forceinline__ void grid_barrier(unsigned* bar, int xcc, unsigned nloc, unsigned nx, int tid_) {
  asm volatile("s_waitcnt vmcnt(0) lgkmcnt(0)" ::: "memory");
  __syncthreads();
  if (tid_ == 0) {
    const unsigned old = xb_add(&bar[XB_XSUB(xcc)], 1u);
    const unsigned gen = old / nloc;
    if (old + 1u == (gen + 1u) * nloc) {
      __builtin_amdgcn_fence(__ATOMIC_RELEASE, "agent");
      asm volatile("s_waitcnt vmcnt(0)" ::: "memory");
      const unsigned og = xb_add(&bar[XB_TOP], 1u);
      const unsigned tg = og / nx;
      if (og + 1u == (tg + 1u) * nx) {
#pragma unroll
        for (int j = 0; j < 8; ++j) xb_add(&bar[XB_XGEN(j)], 1u);
      } else while (xb_ld(&bar[XB_XGEN(xcc)]) == gen) __builtin_amdgcn_s_sleep(1);
      __builtin_amdgcn_fence(__ATOMIC_ACQUIRE, "agent");
      asm volatile("s_waitcnt vmcnt(0)" ::: "memory");
    } else {
      while (xb_ld(&bar[XB_XGEN(xcc)]) == gen) __builtin_amdgcn_s_sleep(1);
      __builtin_amdgcn_fence(__ATOMIC_ACQUIRE, "agent");
      asm volatile("s_waitcnt vmcnt(0)" ::: "memory");
    }
  }
  __syncthreads();
}

__device__ __forceinline__ int phase_cat(int ph) {
  if (ph < 2) return 0;
  const int layer = (ph - 2) / NSTEP, step = (ph - 2) % NSTEP;
  const bool even = (layer & 1) == 0;
  if (step == 0) return even ? 1 : 7;
  if (step == 1) return even ? 2 : 8;
  if (step == 2) return 3;
  if (step == 3) return 4;
  if (step == 4) return 5;
  if (step == 5) return 6;
  if (step == 6) return 12;
  if (step == 7) return 10;
  return 11;
}

__global__ void __launch_bounds__(512) mega(KArgs ka, int ph_lo, int ph_hi) {
  Params p;
  p.in = (const float* const*)__builtin_amdgcn_kernarg_segment_ptr();
  p.out = ka.out; p.ws = ka.ws;
  __shared__ __attribute__((aligned(1024))) char shm[LDS_BYTES];
  cg::grid_group grid = cg::this_grid();
  unsigned* bar = (unsigned*)(p.ws + OFF_BAR + 512);
  int rep = 0;
  const int swid = __builtin_amdgcn_readfirstlane((int)(threadIdx.x >> 6));
  const int my_xcc = (int)(__builtin_amdgcn_s_getreg((3 << 11) | 20) & 0x7);
  if (threadIdx.x == 0) xb_add(&bar[XB_XCNT(my_xcc)], 1u);
  unsigned nloc = 1, nx = 1;
  for (int ph = ph_lo; ph < ph_hi;) {
    run_phase(p, ph, shm, make_tid(swid));
    bool again = false;
#ifdef DUP_CAT
    if (phase_cat(ph) == DUP_CAT && rep == 0) again = true;
#endif
    if (again || ph + 1 < ph_hi) {
      if (ph == ph_lo && !again && rep == 0) {
        grid.sync();
        unsigned cnt = 0, mine = 0;
#pragma unroll
        for (int j = 0; j < 8; ++j) { const unsigned c = xb_ld(&bar[XB_XCNT(j)]); cnt += c > 0u ? 1u : 0u; mine = j == my_xcc ? c : mine; }
        nloc = __builtin_amdgcn_readfirstlane(mine > 0u ? mine : 1u); nx = __builtin_amdgcn_readfirstlane(cnt > 0u ? cnt : 1u);
      } else grid_barrier(bar, my_xcc, nloc, nx, make_tid(swid));
    }
    if (again) rep = 1; else { rep = 0; ++ph; }
  }
}

extern "C" void kernel_launch(void* const* d_in, const int* in_sizes, int n_in, void* d_out, int out_size, void* d_ws, size_t ws_size,
                              hipStream_t stream) {
  static int grid_blocks = 0;
  if (!grid_blocks) {
    int dev = 0, cus = 0, per_cu = 0;
    (void)hipGetDevice(&dev);
    (void)hipDeviceGetAttribute(&cus, hipDeviceAttributeMultiprocessorCount, dev);
    (void)hipOccupancyMaxActiveBlocksPerMultiprocessor(&per_cu, mega, 512, 0);
    if (per_cu > 1) per_cu = 1;
    grid_blocks = cus * per_cu;
    if (ws_size < WS_END) fprintf(stderr, "kernel_launch: workspace too small: %zu < %zu\n", ws_size, (size_t)WS_END);
    if (grid_blocks <= 0) fprintf(stderr, "kernel_launch: occupancy query returned 0\n");
  }
  KArgs p{};
  for (int i = 0; i < 24; ++i) p.in[i] = (const float*)d_in[i];
  p.out = (float*)d_out;
  p.ws = (char*)d_ws;
  (void)hipMemsetAsync((char*)d_ws + OFF_BAR, 0, 512 + 8192, stream);
  int lo = 0, hi = NPHASE;
  void* args[] = {&p, &lo, &hi};
  hipError_t e = hipLaunchCooperativeKernel((void*)mega, dim3(grid_blocks), dim3(512), args, 0, stream);
  if (e != hipSuccess) fprintf(stderr, "cooperative launch failed: %s (grid %d)\n", hipGetErrorString(e), grid_blocks);
}
```

```cpp
#include <hip/hip_runtime.h>
#include <hip/hip_cooperative_groups.h>
#include <cstdio>
#include <cstdint>
namespace cg = cooperative_groups;

typedef unsigned short bf16_t;
typedef short bf16x8 __attribute__((ext_vector_type(8)));
typedef float f32x4 __attribute__((ext_vector_type(4)));
typedef unsigned u32x4 __attribute__((ext_vector_type(4)));
typedef unsigned u32x2 __attribute__((ext_vector_type(2)));
typedef float f32x2v __attribute__((ext_vector_type(2)));
typedef int i32x4 __attribute__((ext_vector_type(4)));
typedef __bf16 bf16x2_t __attribute__((ext_vector_type(2)));

constexpr int DM = 1024, NBATCH = 2, SEQ = 8192, CTXL = 256, DEPTH = 4;
constexpr int NLAT = NBATCH * SEQ;
constexpr int NCTX = NBATCH * CTXL;
constexpr int NTOK = NLAT + NCTX;
constexpr int LKV = CTXL + SEQ;
constexpr int NH = 8;
constexpr int NEXP = 16384;
constexpr float LN_EPS = 1e-5f;
constexpr float ALPHA = 1.6817928305074290f;
constexpr float QSCALE = 0.125f * 1.4426950408889634f;

constexpr size_t al256(size_t x) { return (x + 255) / 256 * 256; }
constexpr size_t SZ_TAB = (size_t)DEPTH * NEXP * DM;
constexpr size_t SZ_QKV = (size_t)NBATCH * NH * LKV * 128 * 2;
constexpr size_t SZ_XS = (size_t)NTOK * DM * 4;
constexpr size_t OFF_U8 = 0;
constexpr size_t OFF_V8 = OFF_U8 + SZ_TAB;
constexpr size_t OFF_Q = OFF_V8 + SZ_TAB;
constexpr size_t OFF_K = OFF_Q + SZ_QKV;
constexpr size_t OFF_V = OFF_K + SZ_QKV;
constexpr size_t OFF_XSA = OFF_V + SZ_QKV;
constexpr size_t OFF_XSB = OFF_XSA + SZ_XS;
constexpr size_t OFF_Z = OFF_XSB + SZ_XS;
constexpr size_t OFF_H = OFF_Z + SZ_XS;
constexpr size_t OFF_HB = OFF_H + (size_t)NTOK * DM * 2;
constexpr size_t OFF_CAT = OFF_HB + (size_t)NTOK * DM * 2;
constexpr size_t OFF_GU = OFF_CAT + (size_t)NTOK * 1536 * 2;
constexpr size_t OFF_GV = OFF_GU + (size_t)NTOK * 512 * 2;
constexpr size_t OFF_M1 = OFF_GV + (size_t)NTOK * 512 * 2;
constexpr size_t OFF_M2 = OFF_M1 + (size_t)NTOK * DM * 2;
constexpr size_t OFF_SC = OFF_M2 + (size_t)NTOK * DM * 2;
constexpr size_t OFF_IDX = OFF_SC;
constexpr size_t OFF_GATE = OFF_IDX + (size_t)NTOK * 128 * 4;
constexpr size_t OFF_WIN = OFF_GATE + (size_t)NTOK * 128 * 4;
constexpr size_t OFF_WOUT = OFF_WIN + (size_t)2 * 4096 * 1024 * 2;
constexpr size_t OFF_PIN = OFF_WOUT + (size_t)2 * 1024 * 1536 * 2;
constexpr size_t OFF_POUT = OFF_PIN + (size_t)2 * 1024 * 1024 * 2;
constexpr size_t OFF_WQK = OFF_POUT + (size_t)2 * 1024 * 1024 * 2;
constexpr size_t OFF_MOD = OFF_WQK + (size_t)4 * 2048 * 1024 * 2;
constexpr size_t OFF_MODP = OFF_MOD + al256((size_t)4 * 3 * 6144 * 4);
constexpr size_t OFF_ROPE = OFF_MODP + al256((size_t)2 * 4 * 3 * 6144 * 4);
constexpr size_t OFF_LAM = OFF_ROPE + al256((size_t)128 * 16 * 2 * 4);
constexpr size_t OFF_PART = OFF_LAM + 256;
constexpr size_t OFF_PW = OFF_PART + (size_t)NTOK * 8 * 128 * 4;
constexpr size_t OFF_H8 = OFF_PW + (size_t)NTOK * 128 * 4;
constexpr size_t OFF_HSC = OFF_H8 + (size_t)NTOK * DM;
constexpr size_t OFF_USC = OFF_HSC + al256((size_t)NTOK * 4);
constexpr size_t OFF_VSC = OFF_USC + (size_t)DEPTH * NEXP * 4;
constexpr size_t OFF_W8 = OFF_VSC + (size_t)DEPTH * NEXP * 4;
constexpr size_t OFF_WSC = OFF_W8 + (size_t)NTOK * 128;
constexpr size_t OFF_IDX16 = OFF_WSC + al256((size_t)NTOK * 4);
constexpr size_t OFF_WQK8 = OFF_IDX16 + (size_t)NTOK * 128 * 2;
constexpr size_t OFF_WQSC = OFF_WQK8 + (size_t)DEPTH * 2048 * 1024;
constexpr size_t OFF_PIN8 = OFF_WQSC + (size_t)DEPTH * 2048 * 4;
constexpr size_t OFF_PINSC = OFF_PIN8 + (size_t)2 * 1024 * 1024;
constexpr size_t OFF_WIN8 = OFF_PINSC + (size_t)2 * 1024 * 4;
constexpr size_t OFF_WINSC = OFF_WIN8 + (size_t)2 * 4096 * 1024;
constexpr size_t OFF_BAR = OFF_WINSC + (size_t)2 * 4096 * 4;
constexpr size_t WS_END = OFF_BAR + 512 + 8192;

struct KArgs {
  const float* in[24];
  float* out;
  char* ws;
};
struct Params {
  const float* const* in;
  float* out;
  char* ws;
};
enum { IN_x, IN_c, IN_ctx, IN_c_ctx, IN_ada_w, IN_ada_b, IN_ln_g, IN_ln_b, IN_ab_w_in, IN_ab_w_out, IN_diff_lam, IN_diff_norm_g, IN_sgu_ln_g, IN_sgu_ln_b,
       IN_sgu_w, IN_sgu_b, IN_pool_w_in, IN_pool_w_grp, IN_pool_scale, IN_pool_w_out, IN_peer_wq, IN_peer_keys, IN_peer_u, IN_peer_v };
#define AS_GLOBAL(T, ptr) ((T)(__attribute__((address_space(1))) char*)(char*)(ptr))
#define PIN(p, name) AS_GLOBAL(const float*, (p).in[IN_##name])

constexpr int LDS_BYTES = 144 * 1024;

__device__ __forceinline__ int make_tid(int swid) {
  int t;
  asm volatile("v_mbcnt_lo_u32_b32 %0, -1, 0\n\tv_mbcnt_hi_u32_b32 %0, -1, %0" : "=v"(t));
  return (swid << 6) | t;
}
__device__ __forceinline__ int lbid() { int b = blockIdx.x; asm volatile("" : "+s"(b)); return b; }
__device__ __forceinline__ bf16_t f2bf(float f) {
  unsigned u = __float_as_uint(f);
  u += 0x7fffu + ((u >> 16) & 1u);
  return (bf16_t)(u >> 16);
}
__device__ __forceinline__ float bf2f(bf16_t b) { return __uint_as_float(((unsigned)b) << 16); }
__device__ __forceinline__ unsigned pk2(float lo, float hi) { return (unsigned)f2bf(lo) | ((unsigned)f2bf(hi) << 16); }
typedef _Float16 f16x8 __attribute__((ext_vector_type(8)));
typedef _Float16 f16x2 __attribute__((ext_vector_type(2)));
__device__ __forceinline__ unsigned pk2h(float lo, float hi) { const f16x2 v = {(_Float16)lo, (_Float16)hi}; return __builtin_bit_cast(unsigned, v); }
__device__ __forceinline__ float hlo(unsigned w) { return (float)__builtin_bit_cast(f16x2, w)[0]; }
__device__ __forceinline__ float hhi(unsigned w) { return (float)__builtin_bit_cast(f16x2, w)[1]; }
typedef _Float16 hstream_t;
__device__ __forceinline__ f32x4 ld4h(const hstream_t* p) { const u32x2 w = *(const u32x2*)p; return (f32x4){hlo(w[0]), hhi(w[0]), hlo(w[1]), hhi(w[1])}; }
__device__ __forceinline__ void st4h(hstream_t* p, f32x4 v) { *(u32x2*)p = (u32x2){pk2h(v[0], v[1]), pk2h(v[2], v[3])}; }
__device__ __forceinline__ bf16_t f2h(float f) { return __builtin_bit_cast(unsigned short, (_Float16)f); }
__device__ __forceinline__ float h2f(bf16_t b) { return (float)__builtin_bit_cast(_Float16, b); }
__device__ __forceinline__ float bflo(unsigned w) { return __uint_as_float(w << 16); }
__device__ __forceinline__ float bfhi(unsigned w) { return __uint_as_float(w & 0xffff0000u); }
__device__ __forceinline__ float gelu_tanh(float x) {
  const float u = 0.7978845608028654f * (x + 0.044715f * x * x * x);
  return x / (1.0f + __expf(-2.0f * u));
}
__device__ __forceinline__ float dot2bf(unsigned a, unsigned b, float c) {
  return __builtin_amdgcn_fdot2_f32_bf16(__builtin_bit_cast(bf16x2_t, a), __builtin_bit_cast(bf16x2_t, b), c, false);
}
__device__ __forceinline__ float shx_f(float v, int mask, int lane) { return __int_as_float(__builtin_amdgcn_ds_bpermute((lane ^ mask) << 2, __float_as_int(v))); }
__device__ __forceinline__ int shx_i(int v, int mask, int lane) { return __builtin_amdgcn_ds_bpermute((lane ^ mask) << 2, v); }
__device__ __forceinline__ float shl_f(float v, int src) { return __int_as_float(__builtin_amdgcn_ds_bpermute(src << 2, __float_as_int(v))); }
__device__ __forceinline__ float wave_sum(float v, int  ) {
#define DPP_ADD(ctrl, rmask) v += __int_as_float(__builtin_amdgcn_update_dpp(0, __float_as_int(v), ctrl, rmask, 0xf, false))
  DPP_ADD(0xB1, 0xf);
  DPP_ADD(0x4E, 0xf);
  DPP_ADD(0x141, 0xf);
  DPP_ADD(0x140, 0xf);
  DPP_ADD(0x142, 0xa);
  DPP_ADD(0x143, 0xc);
#undef DPP_ADD
  return __int_as_float(__builtin_amdgcn_readlane(__float_as_int(v), 63));
}
__device__ __forceinline__ float wave_max(float v) {
#define DPP_MAX(ctrl, rmask) v = fmaxf(v, __int_as_float(__builtin_amdgcn_update_dpp(0, __float_as_int(v), ctrl, rmask, 0xf, false)))
  DPP_MAX(0xB1, 0xf); DPP_MAX(0x4E, 0xf); DPP_MAX(0x141, 0xf); DPP_MAX(0x140, 0xf); DPP_MAX(0x142, 0xa); DPP_MAX(0x143, 0xc);
#undef DPP_MAX
  return __int_as_float(__builtin_amdgcn_readlane(__float_as_int(v), 63));
}
__device__ __forceinline__ unsigned pack_i8x4(f32x4 v) {
  const int a = __float2int_rn(v[0]), b = __float2int_rn(v[1]), c = __float2int_rn(v[2]), d = __float2int_rn(v[3]);
  return (unsigned)(a & 255) | ((unsigned)(b & 255) << 8) | ((unsigned)(c & 255) << 16) | ((unsigned)d << 24);
}
__device__ __forceinline__ int who_of_row(int row) { return row < NLAT ? (row >= SEQ ? 1 : 0) : 2; }
__device__ __forceinline__ const float* mod_ptr(const Params& p, int layer, int who, int which) {
  return (const float*)(p.ws + OFF_MOD) + ((size_t)(layer * 3 + who) * 6 + which) * 1024;
}
__device__ __forceinline__ void row_bpos(int row, int& b, int& pos) {
  if (row < NLAT) { b = row >> 13; pos = CTXL + (row & (SEQ - 1)); }
  else { const int r = row - NLAT; b = r >> 8; pos = r & 255; }
}

__device__ __forceinline__ int lds_byte2(int r, int c) {
  int st = (r >> 4) * 2 + (c >> 5), ob = (r & 15) * 64 + (c & 31) * 2;
  return st * 1024 + (ob ^ (((ob >> 9) & 1) << 5));
}
__device__ __forceinline__ void stage_rc2(int b, int& R, int& C) {
  int st = b >> 10, sb = b & 1023, swz = sb ^ (((sb >> 9) & 1) << 5);
  R = (st / 2) * 16 + swz / 64;
  C = (st % 2) * 32 + (swz % 64) / 2;
}
#define WAIT_V0() asm volatile("s_waitcnt vmcnt(0)" ::: "memory")

template <int MODE, int MFR, class Epi>
__device__ __forceinline__ void gemm_tile(const bf16_t* __restrict__ Arow0, const bf16_t* __restrict__ Bcol0, int row0, int pn, int K,
                                          const Epi& epi, char* shm, int tid_) {
  constexpr int BK = 32, TILE_B = 256 * BK * 2, STAGE_B = 2 * TILE_B;
  constexpr int LPS = MFR == 8 ? 4 : 3;
  const int tid = tid_, wid = __builtin_amdgcn_readfirstlane(tid >> 6), lane = tid & 63, wr = wid >> 2, wc = wid & 3, fr = lane & 15, fq = lane >> 4;
  const int sb_ = lane * 16, swz_ = sb_ ^ (((sb_ >> 9) & 1) << 5);
  const int C0 = (swz_ % 64) / 2;
  const int R0b = wid * 16 + swz_ / 64;
  const int R0a = (MFR == 8 ? wid : (wid & 3)) * 16 + swz_ / 64;
  const char* Ab = (const char*)Arow0 + (unsigned)(R0a * K + C0) * 2u;
  const int R0bp = Epi::perm(pn) ? ((R0b & ~63) | (((R0b & 15) >> 2) << 4) | (((R0b >> 4) & 3) << 2) | (R0b & 3)) : R0b;
  const char* Bb = (const char*)Bcol0 + (unsigned)(R0bp * K + C0) * 2u;
  const int ob_ = fr * 64 + fq * 16, frag_swz = ob_ ^ (((ob_ >> 9) & 1) << 5);
  const int a_base = wr * (MFR * 1024) + frag_swz, b_base = wc * 4096 + frag_swz;
  const int nt = K / BK;
  f32x4 acc[MFR][4];
#pragma unroll
  for (int m = 0; m < MFR; ++m)
#pragma unroll
    for (int n = 0; n < 4; ++n) acc[m][n] = (f32x4){0.f, 0.f, 0.f, 0.f};
  typename Epi::template Pre<MFR> pre;
  epi.template preload<MFR>(pre, row0, pn, wr, wc, fr, fq);
#define GLDS_STAGE(buf, kt)                                                                                                               \
  do {                                                                                                                                    \
    if (MFR == 8) {                                                                                                                       \
      _Pragma("unroll") for (int i = 0; i < 2; ++i)                                                                                       \
        __builtin_amdgcn_global_load_lds((const unsigned*)(Ab + (size_t)(i * 128) * K * 2 + (kt) * (BK * 2)),                           \
                                         (unsigned*)(shm + (buf) * STAGE_B + wid * 1024 + i * 8192), 16, 0, 0);                           \
    } else {                                                                                                                              \
      __builtin_amdgcn_global_load_lds((const unsigned*)(Ab + (kt) * (BK * 2)), (unsigned*)(shm + (buf) * STAGE_B + (wid & 3) * 1024), 16, 0, 0); \
    }                                                                                                                                     \
    _Pragma("unroll") for (int i = 0; i < 2; ++i)                                                                                         \
      __builtin_amdgcn_global_load_lds((const unsigned*)(Bb + (size_t)(i * 128) * K * 2 + (kt) * (BK * 2)),                             \
                                       (unsigned*)(shm + (buf) * STAGE_B + TILE_B + wid * 1024 + i * 8192), 16, 0, 0);                    \
  } while (0)
#define RAW_BARRIER() do { asm volatile("s_waitcnt lgkmcnt(0)" ::: "memory"); __builtin_amdgcn_s_barrier(); } while (0)
#define WAIT_2STAGES() do { if (LPS == 4) asm volatile("s_waitcnt vmcnt(8)" ::: "memory"); else asm volatile("s_waitcnt vmcnt(6)" ::: "memory"); } while (0)
#define WAIT_1STAGE() do { if (LPS == 4) asm volatile("s_waitcnt vmcnt(4)" ::: "memory"); else asm volatile("s_waitcnt vmcnt(3)" ::: "memory"); } while (0)
  GLDS_STAGE(0, 0); GLDS_STAGE(1, 1); GLDS_STAGE(2, 2);
  WAIT_2STAGES();
  RAW_BARRIER();
  for (int t = 0; t < nt; ++t) {
    if (t + 3 < nt) GLDS_STAGE((t + 3) & 3, t + 3);
    const char* sa = shm + (t & 3) * STAGE_B;
    const char* sb = sa + TILE_B;
    {
      bf16x8 At[MFR], Bf[4];
#pragma unroll
      for (int m = 0; m < MFR; ++m) At[m] = *(const bf16x8*)(sa + a_base + m * 1024);
#pragma unroll
      for (int n = 0; n < 4; ++n) Bf[n] = *(const bf16x8*)(sb + b_base + n * 1024);
#pragma unroll
      for (int m = 0; m < MFR; ++m)
#pragma unroll
        for (int n = 0; n < 4; ++n) {
          if (MODE == 1) acc[m][n] = __builtin_amdgcn_mfma_f32_16x16x32_f16(__builtin_bit_cast(f16x8, Bf[n]), __builtin_bit_cast(f16x8, At[m]), acc[m][n], 0, 0, 0);
          else if (MODE == 2) acc[m][n] = __builtin_bit_cast(f32x4, __builtin_amdgcn_mfma_i32_16x16x64_i8(__builtin_bit_cast(i32x4, Bf[n]), __builtin_bit_cast(i32x4, At[m]),
                                                                                                         __builtin_bit_cast(i32x4, acc[m][n]), 0, 0, 0));
          else acc[m][n] = __builtin_amdgcn_mfma_f32_16x16x32_bf16(Bf[n], At[m], acc[m][n], 0, 0, 0);
        }
    }
    if (t + 3 < nt) WAIT_2STAGES();
    else if (t + 2 < nt) WAIT_1STAGE();
    else asm volatile("s_waitcnt vmcnt(0)" ::: "memory");
    RAW_BARRIER();
  }
#undef GLDS_STAGE
#undef RAW_BARRIER
#undef WAIT_2STAGES
#undef WAIT_1STAGE
  if (MODE == 2) {
#pragma unroll
    for (int m = 0; m < MFR; ++m)
#pragma unroll
      for (int n = 0; n < 4; ++n)
#pragma unroll
        for (int j = 0; j < 4; ++j) acc[m][n][j] = (float)__float_as_int(acc[m][n][j]);
  }
  epi.template run<MFR>(acc, pre, row0, pn, wr, wc, fr, fq, shm, tid_);
}

template <int MODE = 0, class Epi>
__device__ __forceinline__ void gemm_phase(const bf16_t* __restrict__ A, const bf16_t* __restrict__ Bt, int mt_big, int small_rows, int ntiles, int K,
                                           const Epi& epi, char* shm, int tid_) {
  const int nu_big = ((mt_big + 7) >> 3) * ntiles * 8, nu_small = (small_rows >> 6) * ntiles;
  int u = lbid();
  for (; u < nu_big; u += gridDim.x) {
    const int xcd = u & 7, v = u >> 3;
    const int pn = v % ntiles, pm = (v / ntiles) * 8 + xcd;
    if (pm >= mt_big) continue;
    gemm_tile<MODE, 8>(A + (size_t)pm * 256 * K, Bt + (size_t)pn * 256 * K, pm * 256, pn, K, epi, shm, tid_);
  }
  for (; u < nu_big + nu_small; u += gridDim.x) {
    const int w = u - nu_big, pn = w % ntiles, row0 = mt_big * 256 + (w / ntiles) * 64;
    gemm_tile<MODE, 2>(A + (size_t)row0 * K, Bt + (size_t)pn * 256 * K, row0, pn, K, epi, shm, tid_);
  }
}

struct EpiInProj {
  static __device__ __forceinline__ bool perm(int) { return false; }
  bf16_t *Q, *K;
  const float* rs; const float* cs;
  const float* rope;
  unsigned* KMAX;
  template <int MFR> struct Pre {};
  template <int MFR> __device__ __forceinline__ void preload(Pre<MFR>&, int, int, int, int, int, int) const {}
  template <int MFR>
  __device__ __forceinline__ void run(const f32x4 (&acc)[MFR][4], const Pre<MFR>&, int row0, int pn, int wr, int wc, int fr, int fq, char*, int) const {
    const int region = pn >> 2;
    const int lane = fq * 16 + fr;
    float kn2 = 0.f, kmax2 = 0.f;
    f32x4 csl[4];
#pragma unroll
    for (int n = 0; n < 4; ++n) csl[n] = *(const f32x4*)(cs + pn * 256 + wc * 64 + n * 16 + fq * 4);
#pragma unroll
    for (int m = 0; m < MFR; ++m) {
      const int row = row0 + wr * (16 * MFR) + m * 16 + fr;
      int b, pos;
      row_bpos(row, b, pos);
      const float rsm = rs[row];
      if (region <= 1) {
        bf16_t* dst = region == 0 ? Q : K;
        const int head = (pn & 3) * 2 + (wc >> 1), msub = wc & 1;
        bf16_t* rp = dst + ((size_t)(b * NH + head) * LKV + pos) * 128 + msub * 64;
        const bool lat = row < NLAT;
        const int t = row & (SEQ - 1);
        const int prow = t >> 6, pcol = t & 63;
#pragma unroll
        for (int n = 0; n < 2; ++n) {
          float oa[4], ob[4];
          if (n == 0) kn2 = 0.f;
          const int pp = (n == 0) ? prow : pcol;
          const f32x4 r0 = lat ? *(const f32x4*)(rope + (pp * 16 + fq * 4) * 2) : (f32x4){1.f, 0.f, 1.f, 0.f};
          const f32x4 r1 = lat ? *(const f32x4*)(rope + (pp * 16 + fq * 4) * 2 + 4) : (f32x4){1.f, 0.f, 1.f, 0.f};
          const float csv[4] = {r0[0], r0[2], r1[0], r1[2]}, snv[4] = {r0[1], r0[3], r1[1], r1[3]};
#pragma unroll
          for (int j = 0; j < 4; ++j) {
            const float a = acc[m][n][j] * (rsm * csl[n][j]), bb = acc[m][n + 2][j] * (rsm * csl[n + 2][j]);
            oa[j] = a * csv[j] - bb * snv[j];
            ob[j] = a * snv[j] + bb * csv[j];
          }
          if (region == 0) {
#pragma unroll
            for (int j = 0; j < 4; ++j) { oa[j] *= QSCALE; ob[j] *= QSCALE; }
          } else {
#pragma unroll
            for (int j = 0; j < 4; ++j) kn2 += oa[j] * oa[j] + ob[j] * ob[j];
          }
          u32x2 wa = {pk2(oa[0], oa[1]), pk2(oa[2], oa[3])};
          u32x2 wb = {pk2(ob[0], ob[1]), pk2(ob[2], ob[3])};
          *(u32x2*)(rp + n * 16 + fq * 4) = wa;
          *(u32x2*)(rp + 32 + n * 16 + fq * 4) = wb;
        }
        if (region == 1) {
          kn2 += shx_f(kn2, 16, lane); kn2 += shx_f(kn2, 32, lane);
          kmax2 = fmaxf(kmax2, kn2);
        }
      }
      asm volatile("" ::: "memory");
    }
    if (region == 1) {
#pragma unroll
      for (int o = 1; o < 16; o <<= 1) kmax2 = fmaxf(kmax2, shx_f(kmax2, o, lane));
      if (lane == 0) {
        const int b = row0 < NLAT ? (row0 >> 13) : ((row0 - NLAT) >> 8);
        const int head = (pn & 3) * 2 + (wc >> 1), msub = wc & 1;
        atomicMax(KMAX + (b * NH + head) * 2 + msub, __float_as_uint(kmax2));
      }
    }
  }
};
struct EpiInProjVG {
  static __device__ __forceinline__ bool perm(int) { return true; }
  bf16_t *V, *GU, *GV;
  const float* rs; const float* cs;
  template <int MFR> struct Pre {};
  template <int MFR> __device__ __forceinline__ void preload(Pre<MFR>&, int, int, int, int, int, int) const {}
  template <int MFR>
  __device__ __forceinline__ void run(const f32x4 (&acc)[MFR][4], const Pre<MFR>&, int row0, int pn, int wr, int wc, int fr, int fq, char*, int) const {
    const int region = pn >> 2;
    f32x4 csv[4];
#pragma unroll
    for (int n = 0; n < 4; ++n) csv[n] = *(const f32x4*)(cs + (pn - 8) * 256 + wc * 64 + fq * 16 + n * 4);
#pragma unroll
    for (int m = 0; m < MFR; ++m) {
      const int row = row0 + wr * (16 * MFR) + m * 16 + fr;
      const float r_ = rs[row];
      f32x4 a_[4];
#pragma unroll
      for (int n = 0; n < 4; ++n) a_[n] = acc[m][n] * (csv[n] * r_);
      bf16_t* rp;
      if (region == 2) {
        int b, pos;
        row_bpos(row, b, pos);
        const int head = (pn & 3) * 2 + (wc >> 1);
        rp = V + ((size_t)(b * NH + head) * LKV + pos) * 128 + (wc & 1) * 64 + fq * 16;
      } else {
        const int isv = (pn >> 1) & 1;
        rp = (isv ? GV : GU) + (size_t)row * 512 + (pn & 1) * 256 + wc * 64 + fq * 16;
#pragma unroll
        for (int n = 0; n < 4; ++n)
#pragma unroll
          for (int j = 0; j < 4; ++j) a_[n][j] = gelu_tanh(a_[n][j]);
      }
      const u32x4 w0 = {pk2(a_[0][0], a_[0][1]), pk2(a_[0][2], a_[0][3]), pk2(a_[1][0], a_[1][1]), pk2(a_[1][2], a_[1][3])};
      const u32x4 w1 = {pk2(a_[2][0], a_[2][1]), pk2(a_[2][2], a_[2][3]), pk2(a_[3][0], a_[3][1]), pk2(a_[3][2], a_[3][3])};
      *(u32x4*)rp = w0; *(u32x4*)(rp + 8) = w1;
      asm volatile("" ::: "memory");
    }
  }
};
struct EpiResid {
  static __device__ __forceinline__ bool perm(int) { return true; }
  const hstream_t* XS; hstream_t* Z; const float* modbase;
  int which;
  template <int MFR> struct Pre { u32x4 xs[MFR][2]; };
  template <int MFR> __device__ __forceinline__ void preload(Pre<MFR>& pre, int row0, int pn, int wr, int wc, int fr, int fq) const {
#pragma unroll
    for (int m = 0; m < MFR; ++m) {
      const hstream_t* rp = XS + (size_t)(row0 + wr * (16 * MFR) + m * 16 + fr) * DM + pn * 256 + wc * 64 + fq * 16;
      pre.xs[m][0] = *(const u32x4*)rp; pre.xs[m][1] = *(const u32x4*)(rp + 8);
    }
  }
  template <int MFR>
  __device__ __forceinline__ void run(const f32x4 (&acc)[MFR][4], const Pre<MFR>& pre, int row0, int pn, int wr, int wc, int fr, int fq, char*, int) const {
    const int who = row0 < SEQ ? 0 : (row0 < NLAT ? 1 : 2);
    const int col = pn * 256 + wc * 64 + fq * 16;
    const float* g = modbase + ((size_t)who * 6 + which) * 1024 + col;
    f32x4 gv[4];
#pragma unroll
    for (int n = 0; n < 4; ++n) gv[n] = *(const f32x4*)(g + n * 4);
#pragma unroll
    for (int m = 0; m < MFR; ++m) {
      hstream_t* zp = Z + (size_t)(row0 + wr * (16 * MFR) + m * 16 + fr) * DM + col;
      u32x4 o[2];
#pragma unroll
      for (int n = 0; n < 4; ++n) {
        const unsigned w0 = pre.xs[m][n >> 1][(n & 1) * 2], w1 = pre.xs[m][n >> 1][(n & 1) * 2 + 1];
        const f32x4 xs = {hlo(w0), hhi(w0), hlo(w1), hhi(w1)};
        const f32x4 r = xs * ALPHA + gv[n] * acc[m][n];
        o[n >> 1][(n & 1) * 2] = pk2h(r[0], r[1]); o[n >> 1][(n & 1) * 2 + 1] = pk2h(r[2], r[3]);
      }
      *(u32x4*)zp = o[0]; *(u32x4*)(zp + 8) = o[1];
    }
  }
};
struct EpiBf16Store {
  static __device__ __forceinline__ bool perm(int) { return true; }
  bf16_t* O; int ld; const float* rs; const float* cs;
  template <int MFR> struct Pre {};
  template <int MFR> __device__ __forceinline__ void preload(Pre<MFR>&, int, int, int, int, int, int) const {}
  template <int MFR>
  __device__ __forceinline__ void run(const f32x4 (&acc)[MFR][4], const Pre<MFR>&, int row0, int pn, int wr, int wc, int fr, int fq, char*, int) const {
    f32x4 csv[4];
#pragma unroll
    for (int n = 0; n < 4; ++n) csv[n] = *(const f32x4*)(cs + pn * 256 + wc * 64 + fq * 16 + n * 4);
#pragma unroll
    for (int m = 0; m < MFR; ++m) {
      const int row = row0 + wr * (16 * MFR) + m * 16 + fr;
      bf16_t* rp = O + (size_t)row * ld + pn * 256 + wc * 64 + fq * 16;
      const float r_ = rs[row];
      f32x4 a_[4];
#pragma unroll
      for (int n = 0; n < 4; ++n) a_[n] = acc[m][n] * (csv[n] * r_);
      const u32x4 w0 = {pk2h(a_[0][0], a_[0][1]), pk2h(a_[0][2], a_[0][3]), pk2h(a_[1][0], a_[1][1]), pk2h(a_[1][2], a_[1][3])};
      const u32x4 w1 = {pk2h(a_[2][0], a_[2][1]), pk2h(a_[2][2], a_[2][3]), pk2h(a_[3][0], a_[3][1]), pk2h(a_[3][2], a_[3][3])};
      *(u32x4*)rp = w0; *(u32x4*)(rp + 8) = w1;
    }
  }
};
#define FMX(a, b) __float_as_int(__builtin_fmaxf(__int_as_float(a), __int_as_float(b)))
#define FMN(a, b) __float_as_int(__builtin_fminf(__int_as_float(a), __int_as_float(b)))
#define CE(a, b) do { const int _h = FMX(a, b), _l = FMN(a, b); a = _h; b = _l; } while (0)
#define SORT16(v) do { CE(v[0], v[1]); CE(v[2], v[3]); CE(v[0], v[2]); CE(v[1], v[3]); CE(v[1], v[2]); CE(v[4], v[5]); CE(v[6], v[7]); CE(v[4], v[6]); CE(v[5], v[7]); CE(v[5], v[6]); CE(v[0], v[4]); CE(v[2], v[6]); CE(v[2], v[4]); CE(v[1], v[5]); CE(v[3], v[7]); CE(v[3], v[5]); CE(v[1], v[2]); CE(v[3], v[4]); CE(v[5], v[6]); CE(v[8], v[9]); CE(v[10], v[11]); CE(v[8], v[10]); CE(v[9], v[11]); CE(v[9], v[10]); CE(v[12], v[13]); CE(v[14], v[15]); CE(v[12], v[14]); CE(v[13], v[15]); CE(v[13], v[14]); CE(v[8], v[12]); CE(v[10], v[14]); CE(v[10], v[12]); CE(v[9], v[13]); CE(v[11], v[15]); CE(v[11], v[13]); CE(v[9], v[10]); CE(v[11], v[12]); CE(v[13], v[14]); CE(v[0], v[8]); CE(v[4], v[12]); CE(v[4], v[8]); CE(v[2], v[10]); CE(v[6], v[14]); CE(v[6], v[10]); CE(v[2], v[4]); CE(v[6], v[8]); CE(v[10], v[12]); CE(v[1], v[9]); CE(v[5], v[13]); CE(v[5], v[9]); CE(v[3], v[11]); CE(v[7], v[15]); CE(v[7], v[11]); CE(v[3], v[5]); CE(v[7], v[9]); CE(v[11], v[13]); CE(v[1], v[2]); CE(v[3], v[4]); CE(v[5], v[6]); CE(v[7], v[8]); CE(v[9], v[10]); CE(v[11], v[12]); CE(v[13], v[14]); } while (0)
#define BMERGE16(v) do { CE(v[0], v[8]); CE(v[1], v[9]); CE(v[2], v[10]); CE(v[3], v[11]); CE(v[4], v[12]); CE(v[5], v[13]); CE(v[6], v[14]); CE(v[7], v[15]); CE(v[0], v[4]); CE(v[1], v[5]); CE(v[2], v[6]); CE(v[3], v[7]); CE(v[8], v[12]); CE(v[9], v[13]); CE(v[10], v[14]); CE(v[11], v[15]); CE(v[0], v[2]); CE(v[1], v[3]); CE(v[4], v[6]); CE(v[5], v[7]); CE(v[8], v[10]); CE(v[9], v[11]); CE(v[12], v[14]); CE(v[13], v[15]); CE(v[0], v[1]); CE(v[2], v[3]); CE(v[4], v[5]); CE(v[6], v[7]); CE(v[8], v[9]); CE(v[10], v[11]); CE(v[12], v[13]); CE(v[14], v[15]); } while (0)
#define CAND_CHUNK0 do { T[0] = CK(0, 0); T[1] = CK(0, 1); T[2] = CK(0, 2); T[3] = CK(0, 3); T[4] = CK(0, 4); T[5] = CK(0, 5); T[6] = CK(0, 6); T[7] = CK(0, 7); T[8] = CK(0, 8); T[9] = CK(0, 9); T[10] = CK(0, 10); T[11] = CK(0, 11); T[12] = CK(0, 12); T[13] = CK(0, 13); T[14] = CK(0, 14); T[15] = CK(0, 15); } while (0)
#define CAND_CHUNK1 do { X[0] = CK(1, 0); X[1] = CK(1, 1); X[2] = CK(1, 2); X[3] = CK(1, 3); X[4] = CK(1, 4); X[5] = CK(1, 5); X[6] = CK(1, 6); X[7] = CK(1, 7); X[8] = CK(2, 0); X[9] = CK(2, 1); X[10] = CK(2, 2); X[11] = CK(2, 3); X[12] = CK(2, 4); X[13] = CK(3, 0); X[14] = CK(3, 1); X[15] = CK(3, 2); } while (0)
#define CAND_CHUNK2 do { X[0] = CK(3, 3); X[1] = CK(4, 0); X[2] = CK(4, 1); X[3] = CK(4, 2); X[4] = CK(5, 0); X[5] = CK(5, 1); X[6] = CK(6, 0); X[7] = CK(6, 1); X[8] = CK(7, 0); X[9] = CK(7, 1); X[10] = CK(8, 0); X[11] = CK(9, 0); X[12] = CK(10, 0); X[13] = CK(11, 0); X[14] = CK(12, 0); X[15] = CK(13, 0); } while (0)
#define CAND_CHUNK3 do { X[0] = CK(14, 0); X[1] = CK(15, 0); X[2] = (int)0xFF800000; X[3] = (int)0xFF800000; X[4] = (int)0xFF800000; X[5] = (int)0xFF800000; X[6] = (int)0xFF800000; X[7] = (int)0xFF800000; X[8] = (int)0xFF800000; X[9] = (int)0xFF800000; X[10] = (int)0xFF800000; X[11] = (int)0xFF800000; X[12] = (int)0xFF800000; X[13] = (int)0xFF800000; X[14] = (int)0xFF800000; X[15] = (int)0xFF800000; } while (0)

__device__ __forceinline__ int packkey7(float f, int idx) { return (__float_as_int(f) & ~0x7F) | (127 - idx); }
__device__ __forceinline__ float keyval7(int k) { return __int_as_float(k & ~0x7F); }
__device__ __forceinline__ int packkey8(float f, int pos) { return (__float_as_int(f) & ~0xFF) | (255 - pos); }
__device__ __forceinline__ float keyval8(int k) { return __int_as_float(k & ~0xFF); }
#define LD16(dst, ptr) do { const i32x4 _a = *(const i32x4*)(ptr), _b = *(const i32x4*)((ptr) + 4), _c = *(const i32x4*)((ptr) + 8), _d = *(const i32x4*)((ptr) + 12); \
    dst[0] = _a[0]; dst[1] = _a[1]; dst[2] = _a[2]; dst[3] = _a[3]; dst[4] = _b[0]; dst[5] = _b[1]; dst[6] = _b[2]; dst[7] = _b[3];                                \
    dst[8] = _c[0]; dst[9] = _c[1]; dst[10] = _c[2]; dst[11] = _c[3]; dst[12] = _d[0]; dst[13] = _d[1]; dst[14] = _d[2]; dst[15] = _d[3]; } while (0)
#define ST16(ptr, src) do { *(i32x4*)(ptr) = (i32x4){src[0], src[1], src[2], src[3]}; *(i32x4*)((ptr) + 4) = (i32x4){src[4], src[5], src[6], src[7]};           \
    *(i32x4*)((ptr) + 8) = (i32x4){src[8], src[9], src[10], src[11]}; *(i32x4*)((ptr) + 12) = (i32x4){src[12], src[13], src[14], src[15]}; } while (0)
#define MERGE_TOP16(T, X) do { _Pragma("unroll") for (int _i = 0; _i < 16; ++_i) T[_i] = FMX(T[_i], X[15 - _i]); BMERGE16(T); } while (0)
struct EpiTopK {
  static __device__ __forceinline__ bool perm(int) { return false; }
  int* IDX; float* GATE; unsigned* IDX16;
  const float* rs; const float* cs;
  template <int MFR> struct Pre {};
  template <int MFR> __device__ __forceinline__ void preload(Pre<MFR>&, int, int, int, int, int, int) const {}
  template <int MFR>
  __device__ __forceinline__ void run(const f32x4 (&acc)[MFR][4], const Pre<MFR>&, int row0, int pn, int wr, int wc, int fr, int fq, char* shm, int tid_) const {
    constexpr int LST = 68, BM = 32 * MFR;
    int* lst = (int*)shm;
    const int tid = tid_, lane = tid_ & 63;
    float csl[16];
#pragma unroll
    for (int n = 0; n < 4; ++n) { const f32x4 c4 = *(const f32x4*)(cs + pn * 256 + wc * 64 + n * 16 + fq * 4); csl[n * 4] = c4[0]; csl[n * 4 + 1] = c4[1]; csl[n * 4 + 2] = c4[2]; csl[n * 4 + 3] = c4[3]; }
#pragma unroll
    for (int m = 0; m < MFR; ++m) {
      int T[16], X[16];
      const float hsr = rs[row0 + wr * (16 * MFR) + m * 16 + fr];
#pragma unroll
      for (int n = 0; n < 4; ++n)
#pragma unroll
        for (int j = 0; j < 4; ++j) T[n * 4 + j] = packkey7(acc[m][n][j] * (hsr * csl[n * 4 + j]), (wc & 1) * 64 + n * 16 + fq * 4 + j);
      SORT16(T);
#pragma unroll
      for (int i = 0; i < 16; ++i) { auto rr = __builtin_amdgcn_permlane16_swap(T[i], T[i], false, false); T[i] = rr[0]; X[i] = rr[1]; }
      MERGE_TOP16(T, X);
#pragma unroll
      for (int i = 0; i < 16; ++i) { auto rr = __builtin_amdgcn_permlane32_swap(T[i], T[i], false, false); T[i] = rr[0]; X[i] = rr[1]; }
      MERGE_TOP16(T, X);
      i32x4 w;
#pragma unroll
      for (int q = 0; q < 4; ++q) {
        const int m1 = -(fq & 1), m2 = -((fq >> 1) & 1);
        const int lo_ = (T[q] & ~m1) | (T[4 + q] & m1), hi_ = (T[8 + q] & ~m1) | (T[12 + q] & m1);
        w[q] = (lo_ & ~m2) | (hi_ & m2);
      }
      *(i32x4*)(lst + (wr * (16 * MFR) + m * 16 + fr) * LST + wc * 16 + fq * 4) = w;
    }
    __syncthreads();
    if (tid < 2 * BM) {
      const int row = tid & (BM - 1), pp = tid / BM;
      int T[16], X[16];
      LD16(T, lst + row * LST + pp * 32);
      LD16(X, lst + row * LST + pp * 32 + 16);
      MERGE_TOP16(T, X);
      ST16(lst + row * LST + pp * 32, T);
    }
    __syncthreads();
    if (tid < BM) {
      const int row = tid;
      int T[16], X[16];
      float a[16], b[16];
      LD16(T, lst + row * LST);
      LD16(X, lst + row * LST + 32);
#pragma unroll
      for (int i = 0; i < 16; ++i) { a[i] = keyval7(T[i]); b[i] = keyval7(X[i]); }
#define CK(i, j) packkey8(a[i] + b[j], (i) * 16 + (j))
      CAND_CHUNK0; SORT16(T);
      CAND_CHUNK1; SORT16(X); MERGE_TOP16(T, X);
      CAND_CHUNK2; SORT16(X); MERGE_TOP16(T, X);
      CAND_CHUNK3; SORT16(X); MERGE_TOP16(T, X);
#undef CK
      const float v0 = keyval8(T[0]);
      float e[16], sum = 0.f;
#pragma unroll
      for (int r = 0; r < 16; ++r) { e[r] = __expf(keyval8(T[r]) - v0); sum += e[r]; }
      const float inv = 1.0f / sum;
      const size_t go = ((size_t)pn * NTOK + (size_t)(row0 + row)) * 16;
#pragma unroll
      for (int r = 0; r < 16; ++r) {
        const int pos = 255 - (T[r] & 0xFF);
        const int ia = 127 - (lst[row * LST + (pos >> 4)] & 0x7F), ib = 127 - (lst[row * LST + 32 + (pos & 15)] & 0x7F);
        X[r] = ia * 128 + ib;
        e[r] *= inv;
      }
      ST16(IDX + go, X);
      {
        const i32x4 h0 = {X[0] | (X[1] << 16), X[2] | (X[3] << 16), X[4] | (X[5] << 16), X[6] | (X[7] << 16)};
        const i32x4 h1 = {X[8] | (X[9] << 16), X[10] | (X[11] << 16), X[12] | (X[13] << 16), X[14] | (X[15] << 16)};
        *(i32x4*)(IDX16 + go / 2) = h0; *(i32x4*)(IDX16 + go / 2 + 4) = h1;
      }
      *(f32x4*)(GATE + go) = (f32x4){e[0], e[1], e[2], e[3]}; *(f32x4*)(GATE + go + 4) = (f32x4){e[4], e[5], e[6], e[7]};
      *(f32x4*)(GATE + go + 8) = (f32x4){e[8], e[9], e[10], e[11]}; *(f32x4*)(GATE + go + 12) = (f32x4){e[12], e[13], e[14], e[15]};
    }
    __syncthreads();
  }
};

__device__ void transpose_unit(const float* __restrict__ W, bf16_t* __restrict__ Wt, int K, int N, int unit, char* shm, int tid_) {
  float* tl = (float*)shm;
  const int ntn = N / 256;
  const int k0 = (unit / ntn) * 64, n0 = (unit % ntn) * 256;
  const int tid = tid_;
#pragma unroll 8
  for (int i = 0; i < 32; ++i) {
    const int idx = tid + i * 512, r = idx >> 8, c = idx & 255;
    tl[r * 257 + c] = W[(size_t)(k0 + r) * N + n0 + c];
  }
  __syncthreads();
#pragma unroll 8
  for (int i = 0; i < 32; ++i) {
    const int idx = tid + i * 512, r = idx >> 6, c = idx & 63;
    Wt[(size_t)(n0 + r) * K + k0 + c] = f2h(tl[c * 257 + r]);
  }
  __syncthreads();
}

__device__ void foldqk_unit(const Params& p, int unit, char* shm, int tid_) {
  const int l = unit >> 8, hp = (unit >> 4) & 15, ct = unit & 15;
  float* kl = (float*)shm;
  float* wl = kl + 128 * 132;
  const float* keys = PIN(p, peer_keys) + ((size_t)(l * 16 + hp) * 128) * 128;
  const float* wq = PIN(p, peer_wq) + (size_t)l * 1024 * 2048;
  const int tid = tid_;
  for (int idx = tid; idx < 128 * 128; idx += 512) { const int k = idx >> 7, d = idx & 127; kl[d * 132 + k] = keys[k * 128 + d]; }
  for (int idx = tid; idx < 64 * 128; idx += 512) { const int c = idx >> 7, d = idx & 127; wl[d * 68 + c] = wq[(size_t)(ct * 64 + c) * 2048 + hp * 128 + d]; }
  __syncthreads();
  const int wid = __builtin_amdgcn_readfirstlane(tid >> 6), ln = tid & 15, lq = (tid & 63) >> 4;
  const int tc = wid & 3, tk0 = (wid >> 2) * 4;
  f32x4 acc[4];
#pragma unroll
  for (int t = 0; t < 4; ++t) acc[t] = (f32x4){0.f, 0.f, 0.f, 0.f};
#pragma unroll 4
  for (int st = 0; st < 32; ++st) {
    const float a = wl[(4 * st + lq) * 68 + 16 * tc + ln];
#pragma unroll
    for (int t = 0; t < 4; ++t) acc[t] = __builtin_amdgcn_mfma_f32_16x16x4f32(a, kl[(4 * st + lq) * 132 + 16 * (tk0 + t) + ln], acc[t], 0, 0, 0);
  }
  bf16_t* outp = (bf16_t*)(p.ws + OFF_WQK) + (size_t)l * 2048 * 1024;
#pragma unroll
  for (int t = 0; t < 4; ++t) {
    u32x2 w = {pk2h(acc[t][0], acc[t][1]), pk2h(acc[t][2], acc[t][3])};
    *(u32x2*)(outp + (size_t)(hp * 128 + 16 * (tk0 + t) + ln) * 1024 + ct * 64 + 16 * tc + 4 * lq) = w;
  }
  __syncthreads();
}
__device__ void foldpool_unit(const Params& p, int unit, char* shm, int tid_) {
  const int j = unit >> 8, g = (unit >> 6) & 3, cit = (unit >> 4) & 3, et = unit & 15;
  float* gl = (float*)shm;
  float* ol = gl + 256 * 68;
  const float* wg = PIN(p, pool_w_grp) + ((size_t)(j * 4 + g) * 256) * 256;
  const float* sc = PIN(p, pool_scale) + (size_t)j * 1024 + g * 256;
  const float* wo = PIN(p, pool_w_out) + ((size_t)j * 1024 + g * 256) * 1024;
  const int tid = tid_;
  for (int idx = tid; idx < 64 * 256; idx += 512) { const int r = idx >> 8, m = idx & 255; gl[m * 68 + r] = wg[(size_t)(cit * 64 + r) * 256 + m] * sc[m]; }
  for (int idx = tid; idx < 256 * 64; idx += 512) { const int m = idx >> 6, e = idx & 63; ol[m * 68 + e] = wo[(size_t)m * 1024 + et * 64 + e]; }
  __syncthreads();
  const int wid = __builtin_amdgcn_readfirstlane(tid >> 6), ln = tid & 15, lq = (tid & 63) >> 4;
  const int tci = wid & 3, te0 = (wid >> 2) * 2;
  f32x4 acc[2] = {{0.f, 0.f, 0.f, 0.f}, {0.f, 0.f, 0.f, 0.f}};
#pragma unroll 4
  for (int st = 0; st < 64; ++st) {
    const float a = gl[(4 * st + lq) * 68 + 16 * tci + ln];
#pragma unroll
    for (int t = 0; t < 2; ++t) acc[t] = __builtin_amdgcn_mfma_f32_16x16x4f32(a, ol[(4 * st + lq) * 68 + 16 * (te0 + t) + ln], acc[t], 0, 0, 0);
  }
  bf16_t* outp = (bf16_t*)(p.ws + OFF_POUT) + (size_t)j * 1024 * 1024;
#pragma unroll
  for (int t = 0; t < 2; ++t) {
    u32x2 w = {pk2h(acc[t][0], acc[t][1]), pk2h(acc[t][2], acc[t][3])};
    *(u32x2*)(outp + (size_t)(et * 64 + 16 * (te0 + t) + ln) * 1024 + g * 256 + cit * 64 + 16 * tci + 4 * lq) = w;
  }
  __syncthreads();
}
__device__ void mod_unit(const Params& p, int unit, char* shm, int tid_) {
  const int l = unit / 48, rem = unit % 48, cgp = rem >> 1, kh = rem & 1;
  float* sv = (float*)shm;
  float* red = sv + 3 * 512;
  const int tid = tid_, lane = tid & 63, ks = __builtin_amdgcn_readfirstlane(tid >> 6);
  for (int idx = tid; idx < 3 * 512; idx += 512) {
    const int w = idx >> 9, k = kh * 512 + (idx & 511);
    const float xv = w < 2 ? PIN(p, c)[w * 1024 + k] : PIN(p, c_ctx)[k];
    sv[idx] = xv / (1.0f + __expf(-xv));
  }
  __syncthreads();
  const float* aw = PIN(p, ada_w) + (size_t)l * 1024 * 6144 + (size_t)(kh * 512 + ks * 64) * 6144 + cgp * 256 + lane * 4;
  f32x4 a0 = {0.f, 0.f, 0.f, 0.f}, a1 = a0, a2 = a0;
#pragma unroll 8
  for (int k = 0; k < 64; ++k) {
    const f32x4 w = *(const f32x4*)(aw + (size_t)k * 6144);
    a0 += w * sv[ks * 64 + k]; a1 += w * sv[512 + ks * 64 + k]; a2 += w * sv[1024 + ks * 64 + k];
  }
  *(f32x4*)(red + (ks * 3 + 0) * 256 + lane * 4) = a0; *(f32x4*)(red + (ks * 3 + 1) * 256 + lane * 4) = a1; *(f32x4*)(red + (ks * 3 + 2) * 256 + lane * 4) = a2;
  __syncthreads();
  for (int idx = tid; idx < 768; idx += 512) {
    const int w = idx >> 8, cc = idx & 255;
    float s = 0.f;
#pragma unroll
    for (int q = 0; q < 8; ++q) s += red[(q * 3 + w) * 256 + cc];
    const int n = cgp * 256 + cc;
    ((float*)(p.ws + OFF_MODP))[((size_t)kh * 12 + l * 3 + w) * 6144 + n] = s;
  }
  __syncthreads();
}

__device__ void phase_prologue_a(const Params& p, char* shm, int tid_) {
  constexpr int U_MOD = 192;
  constexpr int U_TWIN = 2 * 16 * 16, U_TWOUT = 2 * 24 * 4, U_TPIN = 2 * 16 * 4;
  constexpr int U_FQK = 1024, U_FP = 512, U_TAB = 2048, U_MISC = 1;
  constexpr int E0 = U_MOD, E1 = E0 + U_TWIN, E2 = E1 + U_TWOUT, E3 = E2 + U_TPIN, E4 = E3 + U_FQK, E5 = E4 + U_FP, E6 = E5 + U_TAB, E7 = E6 + U_MISC;
  const int bid_ = lbid(), G_ = gridDim.x;
  const bool tab_first = ((bid_ >> 3) & 1) != 0;
  const int nr_ = (E7 + G_ - 1) / G_;
  for (int j = 0; j < 2 * nr_; ++j) {
    const int u = bid_ + (j < nr_ ? j : j - nr_) * G_;
    if (u >= E7 || (u >= E5 && u < E6) != ((j < nr_) == tab_first)) continue;
    if (u < E0) mod_unit(p, u, shm, tid_);
    else if (u < E1) { const int v = u - E0, j = v / (16 * 16), r = v % (16 * 16);
      transpose_unit(PIN(p, ab_w_in) + (size_t)j * 1024 * 4096, (bf16_t*)(p.ws + OFF_WIN) + (size_t)j * 4096 * 1024, 1024, 4096, r, shm, tid_); }
    else if (u < E2) { const int v = u - E1, j = v / (24 * 4), r = v % (24 * 4);
      transpose_unit(PIN(p, ab_w_out) + (size_t)j * 1536 * 1024, (bf16_t*)(p.ws + OFF_WOUT) + (size_t)j * 1024 * 1536, 1536, 1024, r, shm, tid_); }
    else if (u < E3) { const int v = u - E2, j = v / 64, r = v % 64;
      transpose_unit(PIN(p, pool_w_in) + (size_t)j * 1024 * 1024, (bf16_t*)(p.ws + OFF_PIN) + (size_t)j * 1024 * 1024, 1024, 1024, r, shm, tid_); }
    else if (u < E4) foldqk_unit(p, u - E3, shm, tid_);
    else if (u < E5) foldpool_unit(p, u - E4, shm, tid_);
    else if (u < E6) {
      const int v = u - E5;
      const int tb = v >> 10;
      const float* src = tb ? PIN(p, peer_v) : PIN(p, peer_u);
      unsigned char* dst = (unsigned char*)(p.ws + (tb ? OFF_V8 : OFF_U8));
      const int wid = __builtin_amdgcn_readfirstlane(tid_ >> 6), lane = tid_ & 63;
#pragma unroll 4
      for (int i = 0; i < 8; ++i) {
        const int row = (v & 1023) * 64 + i * 8 + wid;
        const int layer = row >> 14, e = row & 16383;
        const float* rp = src + (size_t)row * DM + lane * 16;
        f32x4 a = *(const f32x4*)rp, b = *(const f32x4*)(rp + 4), c = *(const f32x4*)(rp + 8), d = *(const f32x4*)(rp + 12);
        u32x4 w;
        {
          float mx = 0.f;
#pragma unroll
          for (int j = 0; j < 4; ++j) mx = fmaxf(mx, fmaxf(fmaxf(fabsf(a[j]), fabsf(b[j])), fmaxf(fabsf(c[j]), fabsf(d[j]))));
          mx = wave_max(mx);
          const float inv = mx > 0.f ? 127.0f / mx : 0.f;
          if (lane == 0) ((float*)(p.ws + (tb ? OFF_VSC : OFF_USC)))[row] = mx * (1.0f / 127.0f);
          w[0] = pack_i8x4(a * inv); w[1] = pack_i8x4(b * inv); w[2] = pack_i8x4(c * inv); w[3] = pack_i8x4(d * inv);
        }
        *(u32x4*)(dst + ((size_t)(layer * 8 + (lane >> 3)) * NEXP + e) * 128 + (lane & 7) * 16) = w;
      }
    } else {
      float* rope = (float*)(p.ws + OFF_ROPE);
      for (int idx = tid_; idx < 128 * 16; idx += 512) {
        const int pos = idx >> 4, i = idx & 15;
        const float inv = powf(10000.0f, -(float)i / 16.0f);
        const float ang = (float)pos * inv;
        rope[idx * 2 + 0] = cosf(ang);
        rope[idx * 2 + 1] = sinf(ang);
      }
      if (tid_ < 2) {
        const int j = tid_;
        const float* lv = PIN(p, diff_lam) + (size_t)j * 4 * 64;
        float s1 = 0.f, s2 = 0.f;
        for (int d = 0; d < 64; ++d) { s1 += lv[d] * lv[64 + d]; s2 += lv[128 + d] * lv[192 + d]; }
        const float lam_init = 0.8f - 0.6f * expf(-0.3f * (float)(2 * j));
        float* lam = (float*)(p.ws + OFF_LAM);
        lam[j * 2 + 0] = expf(s1) - expf(s2) + lam_init;
        lam[j * 2 + 1] = lam_init;
      }
    }
  }
}

__device__ void phase_prologue_b(const Params& p, int tid_) {
  const int wid = __builtin_amdgcn_readfirstlane(tid_ >> 6), lane = tid_ & 63;
  {
    const float* mp = (const float*)(p.ws + OFF_MODP);
    float* md = (float*)(p.ws + OFF_MOD);
    for (int idx = lbid() * 512 + tid_; idx < 12 * 6144; idx += gridDim.x * 512) {
      const int l = idx / (3 * 6144), n = idx % 6144;
      md[idx] = mp[idx] + mp[12 * 6144 + idx] + PIN(p, ada_b)[(size_t)l * 6144 + n];
    }
  }
  {
    const bf16_t* wq = (const bf16_t*)(p.ws + OFF_WQK);
    unsigned char* w8 = (unsigned char*)(p.ws + OFF_WQK8);
    float* wsc = (float*)(p.ws + OFF_WQSC);
    for (int r = lbid() * 8 + wid; r < DEPTH * 2048; r += gridDim.x * 8) {
      const u32x4 a = *(const u32x4*)(wq + (size_t)r * 1024 + lane * 16), b = *(const u32x4*)(wq + (size_t)r * 1024 + lane * 16 + 8);
      float v[16];
#pragma unroll
      for (int i = 0; i < 4; ++i) { v[2 * i] = hlo(a[i]); v[2 * i + 1] = hhi(a[i]); v[8 + 2 * i] = hlo(b[i]); v[8 + 2 * i + 1] = hhi(b[i]); }
      float mx = 0.f;
#pragma unroll
      for (int i = 0; i < 16; ++i) mx = fmaxf(mx, fabsf(v[i]));
      mx = wave_max(mx);
      const float inv = mx > 0.f ? 127.0f / mx : 0.f;
      u32x4 o;
#pragma unroll
      for (int i = 0; i < 4; ++i) o[i] = pack_i8x4((f32x4){v[4 * i], v[4 * i + 1], v[4 * i + 2], v[4 * i + 3]} * inv);
      *(u32x4*)(w8 + (size_t)r * 1024 + lane * 16) = o;
      if (lane == 0) wsc[r] = mx * (1.0f / 127.0f);
    }
  }
  {
    const bf16_t* wq = (const bf16_t*)(p.ws + OFF_WIN);
    unsigned char* w8 = (unsigned char*)(p.ws + OFF_WIN8);
    float* wsc = (float*)(p.ws + OFF_WINSC);
    for (int r = lbid() * 8 + wid; r < 2 * 4096; r += gridDim.x * 8) {
      const size_t src = (size_t)r * 1024 + lane * 16;
      const u32x4 a = *(const u32x4*)(wq + src), b = *(const u32x4*)(wq + src + 8);
      float v[16];
#pragma unroll
      for (int i = 0; i < 4; ++i) { v[2 * i] = hlo(a[i]); v[2 * i + 1] = hhi(a[i]); v[8 + 2 * i] = hlo(b[i]); v[8 + 2 * i + 1] = hhi(b[i]); }
      float mx = 0.f;
#pragma unroll
      for (int i = 0; i < 16; ++i) mx = fmaxf(mx, fabsf(v[i]));
      mx = wave_max(mx);
      const float inv = mx > 0.f ? 127.0f / mx : 0.f;
      u32x4 o;
#pragma unroll
      for (int i = 0; i < 4; ++i) o[i] = pack_i8x4((f32x4){v[4 * i], v[4 * i + 1], v[4 * i + 2], v[4 * i + 3]} * inv);
      *(u32x4*)(w8 + (size_t)r * 1024 + lane * 16) = o;
      if (lane == 0) wsc[r] = mx * (1.0f / 127.0f);
    }
  }
  {
    const bf16_t* wq = (const bf16_t*)(p.ws + OFF_PIN);
    unsigned char* w8 = (unsigned char*)(p.ws + OFF_PIN8);
    float* wsc = (float*)(p.ws + OFF_PINSC);
    for (int r = lbid() * 8 + wid; r < 2 * 1024; r += gridDim.x * 8) {
      const u32x4 a = *(const u32x4*)(wq + (size_t)r * 1024 + lane * 16), b = *(const u32x4*)(wq + (size_t)r * 1024 + lane * 16 + 8);
      float v[16];
#pragma unroll
      for (int i = 0; i < 4; ++i) { v[2 * i] = hlo(a[i]); v[2 * i + 1] = hhi(a[i]); v[8 + 2 * i] = hlo(b[i]); v[8 + 2 * i + 1] = hhi(b[i]); }
      float mx = 0.f;
#pragma unroll
      for (int i = 0; i < 16; ++i) mx = fmaxf(mx, fabsf(v[i]));
      mx = wave_max(mx);
      const float inv = mx > 0.f ? 127.0f / mx : 0.f;
      u32x4 o;
#pragma unroll
      for (int i = 0; i < 4; ++i) o[i] = pack_i8x4((f32x4){v[4 * i], v[4 * i + 1], v[4 * i + 2], v[4 * i + 3]} * inv);
      *(u32x4*)(w8 + (size_t)r * 1024 + lane * 16) = o;
      if (lane == 0) wsc[r] = mx * (1.0f / 127.0f);
    }
  }
  hstream_t* XS = (hstream_t*)(p.ws + OFF_XSA);
  for (int row = lbid() * 8 + wid; row < NTOK; row += gridDim.x * 8) {
    const float* src = row < NLAT ? PIN(p, x) + (size_t)row * DM : PIN(p, ctx) + (size_t)(row - NLAT) * DM;
    const int who = who_of_row(row);
    const float* mp0 = (const float*)(p.ws + OFF_MODP) + (size_t)who * 6144;
    const float* mp1 = mp0 + 12 * 6144;
    f32x4 hq[4];
    float hmx = 0.f;
#pragma unroll
    for (int i = 0; i < 4; ++i) {
      const int col = i * 256 + lane * 4;
      const f32x4 v = *(const f32x4*)(src + col);
      st4h(XS + (size_t)row * DM + col, v);
      const f32x4 s1 = *(const f32x4*)(mp0 + col) + *(const f32x4*)(mp1 + col) + *(const f32x4*)(PIN(p, ada_b) + col);
      const f32x4 s2 = *(const f32x4*)(mp0 + 1024 + col) + *(const f32x4*)(mp1 + 1024 + col) + *(const f32x4*)(PIN(p, ada_b) + 1024 + col);
      const f32x4 h = v * (s2 + 1.0f) + s1;
      hq[i] = h; hmx = fmaxf(hmx, fmaxf(fmaxf(fabsf(h[0]), fabsf(h[1])), fmaxf(fabsf(h[2]), fabsf(h[3]))));
    }
    {
      const float mx = wave_max(hmx), inv = mx > 0.f ? 127.0f / mx : 0.f;
      unsigned char* h8 = (unsigned char*)(p.ws + OFF_H8) + (size_t)row * DM + lane * 4;
#pragma unroll
      for (int i = 0; i < 4; ++i) *(unsigned*)(h8 + i * 256) = pack_i8x4(hq[i] * inv);
      if (lane == 0) ((float*)(p.ws + OFF_HSC))[row] = mx * (1.0f / 127.0f);
    }
  }
}

__device__ void phase_ln(const Params& p, const hstream_t* Zin, hstream_t* XSo, int layer, int lnidx, int nrows, bf16_t* Hout, int mlayer, int msh, int nrows_h, bool final, bool wi8, int tid_) {
  const int wid = __builtin_amdgcn_readfirstlane(tid_ >> 6), lane = tid_ & 63;
  const float* g = PIN(p, ln_g) + (size_t)(layer * 2 + lnidx) * DM;
  const float* bt = PIN(p, ln_b) + (size_t)(layer * 2 + lnidx) * DM;
  for (int row = lbid() * 8 + wid; row < nrows; row += gridDim.x * 8) {
    const int who = who_of_row(row);
    f32x4 v[4];
    float s = 0.f;
#pragma unroll
    for (int i = 0; i < 4; ++i) { v[i] = ld4h(Zin + (size_t)row * DM + i * 256 + lane * 4); s += (v[i][0] + v[i][1]) + (v[i][2] + v[i][3]); }
    const float mu = wave_sum(s, lane) * (1.0f / DM);
    float q = 0.f;
#pragma unroll
    for (int i = 0; i < 4; ++i) { const f32x4 d = v[i] - mu; q += (d[0] * d[0] + d[1] * d[1]) + (d[2] * d[2] + d[3] * d[3]); }
    const float rstd = rsqrtf(wave_sum(q, lane) * (1.0f / DM) + LN_EPS);
    f32x4 hq[4];
    float hmx = 0.f;
#pragma unroll
    for (int i = 0; i < 4; ++i) {
      const int col = i * 256 + lane * 4;
      const f32x4 gg = *(const f32x4*)(g + col), bb = *(const f32x4*)(bt + col);
      const f32x4 xo = (v[i] - mu) * rstd * gg + bb;
      if (final) { *(f32x4*)(p.out + (size_t)row * DM + col) = xo; }
      else {
        st4h(XSo + (size_t)row * DM + col, xo);
        if (row < nrows_h) {
          const f32x4 s1 = *(const f32x4*)(mod_ptr(p, mlayer, who, msh) + col), s2 = *(const f32x4*)(mod_ptr(p, mlayer, who, msh + 1) + col);
          const f32x4 h = xo * (s2 + 1.0f) + s1;
          const u32x2 w = {pk2h(h[0], h[1]), pk2h(h[2], h[3])};
          if (Hout != nullptr) *(u32x2*)(Hout + (size_t)row * DM + col) = w;
          hq[i] = h; hmx = fmaxf(hmx, fmaxf(fmaxf(fabsf(h[0]), fabsf(h[1])), fmaxf(fabsf(h[2]), fabsf(h[3]))));
        }
      }
    }
    if (wi8 && !final && row < nrows_h) {
      const float mx = wave_max(hmx), inv = mx > 0.f ? 127.0f / mx : 0.f;
      unsigned char* h8 = (unsigned char*)(p.ws + OFF_H8) + (size_t)row * DM + lane * 4;
#pragma unroll
      for (int i = 0; i < 4; ++i) *(unsigned*)(h8 + i * 256) = pack_i8x4(hq[i] * inv);
      if (lane == 0) ((float*)(p.ws + OFF_HSC))[row] = mx * (1.0f / 127.0f);
    }
  }
}

typedef short s16x4 __attribute__((ext_vector_type(4)));
typedef float f32x16 __attribute__((ext_vector_type(16)));
#define KSWZ(row, colB) ((row) * 256 + ((colB) ^ (((row) & 7) << 4)))
#define SBAR() __builtin_amdgcn_sched_barrier(0)
constexpr float ATT_SCALE = 0.125f, ATT_THR = 8.f;
#ifndef ATT_SDEPTH
#define ATT_SDEPTH 1
#endif
constexpr int SHM_KV = 64 * 128 * 2;
__device__ __forceinline__ int crow(int r, int hi) { return (r & 3) + 8 * (r >> 2) + 4 * hi; }
__device__ __forceinline__ unsigned cvtpk(float lo, float hi) {
  unsigned r; asm volatile("v_cvt_pk_bf16_f32 %0, %1, %2" : "=v"(r) : "v"(lo), "v"(hi)); return r;
}
__device__ __forceinline__ void qkt(f32x16& p0, f32x16& p1, const char* Ks, const bf16x8* qr, int r32, int hi, int m, float negM) {
#pragma unroll
  for (int r = 0; r < 16; ++r) { p0[r] = negM; p1[r] = negM; }
#pragma unroll
  for (int d0 = 0; d0 < 4; ++d0) {
    const int cb = (m * 64 + d0 * 16 + hi * 8) * 2;
    const bf16x8 b0 = *reinterpret_cast<const bf16x8*>(Ks + KSWZ(r32, cb));
    const bf16x8 b1 = *reinterpret_cast<const bf16x8*>(Ks + KSWZ(32 + r32, cb));
    p0 = __builtin_amdgcn_mfma_f32_32x32x16_bf16(b0, qr[d0], p0, 0, 0, 0);
    p1 = __builtin_amdgcn_mfma_f32_32x32x16_bf16(b1, qr[d0], p1, 0, 0, 0);
  }
}
__device__ __forceinline__ int v_st(int k, int c) { const int kk = (k & ~0xC) | ((k & 4) << 1) | ((k & 8) >> 1); return ((kk >> 3) * 4 + (c >> 5)) * 512 + ((kk & 7) * 32 + (c & 31)) * 2; }
__device__ __forceinline__ int v_rd_base(int lane) { return ((lane & 3) << 3) | (((lane >> 2) & 3) << 6) | (((lane >> 4) & 1) << 5) | (((lane >> 5) & 1) << 8); }
constexpr int v_rd_off(int d0, int ks, int half) { return d0 * 512 + ks * 4096 + half * 2048; }
template <int OFF> __device__ __forceinline__ s16x4 tr_read(int vb) {
  s16x4 r; asm volatile("ds_read_b64_tr_b16 %0, %1 offset:%2" : "=&v"(r) : "v"(vb), "i"(OFF) : "memory"); return r;
}
template <int D0> __device__ __forceinline__ void pv_one(f32x16& od, int vb, bf16x8 pa0, bf16x8 pa1, bf16x8 pa2, bf16x8 pa3) {
  const s16x4 l0 = tr_read<v_rd_off(D0, 0, 0)>(vb), h0 = tr_read<v_rd_off(D0, 0, 1)>(vb), l1 = tr_read<v_rd_off(D0, 1, 0)>(vb), h1 = tr_read<v_rd_off(D0, 1, 1)>(vb);
  const s16x4 l2 = tr_read<v_rd_off(D0, 2, 0)>(vb), h2 = tr_read<v_rd_off(D0, 2, 1)>(vb), l3 = tr_read<v_rd_off(D0, 3, 0)>(vb), h3 = tr_read<v_rd_off(D0, 3, 1)>(vb);
  asm volatile("s_waitcnt lgkmcnt(0)" ::: "memory"); SBAR();
#define PKV(L, H) (bf16x8){L[0], L[1], L[2], L[3], H[0], H[1], H[2], H[3]}
  od = __builtin_amdgcn_mfma_f32_32x32x16_bf16(pa0, PKV(l0, h0), od, 0, 0, 0);
  od = __builtin_amdgcn_mfma_f32_32x32x16_bf16(pa1, PKV(l1, h1), od, 0, 0, 0);
  od = __builtin_amdgcn_mfma_f32_32x32x16_bf16(pa2, PKV(l2, h2), od, 0, 0, 0);
  od = __builtin_amdgcn_mfma_f32_32x32x16_bf16(pa3, PKV(l3, h3), od, 0, 0, 0);
#undef PKV
}
template <int D0> __device__ __forceinline__ void pv_one_t(f32x16& od, int vb, bf16x8 pa0, bf16x8 pa1, bf16x8 pa2, bf16x8 pa3) {
  const s16x4 l0 = tr_read<v_rd_off(D0, 0, 0)>(vb), h0 = tr_read<v_rd_off(D0, 0, 1)>(vb), l1 = tr_read<v_rd_off(D0, 1, 0)>(vb), h1 = tr_read<v_rd_off(D0, 1, 1)>(vb);
  const s16x4 l2 = tr_read<v_rd_off(D0, 2, 0)>(vb), h2 = tr_read<v_rd_off(D0, 2, 1)>(vb), l3 = tr_read<v_rd_off(D0, 3, 0)>(vb), h3 = tr_read<v_rd_off(D0, 3, 1)>(vb);
  asm volatile("s_waitcnt lgkmcnt(0)" ::: "memory"); SBAR();
#define PKV(L, H) (bf16x8){L[0], L[1], L[2], L[3], H[0], H[1], H[2], H[3]}
  od = __builtin_amdgcn_mfma_f32_32x32x16_bf16(PKV(l0, h0), pa0, od, 0, 0, 0);
  od = __builtin_amdgcn_mfma_f32_32x32x16_bf16(PKV(l1, h1), pa1, od, 0, 0, 0);
  od = __builtin_amdgcn_mfma_f32_32x32x16_bf16(PKV(l2, h2), pa2, od, 0, 0, 0);
  od = __builtin_amdgcn_mfma_f32_32x32x16_bf16(PKV(l3, h3), pa3, od, 0, 0, 0);
#undef PKV
}

__device__ __forceinline__ void attn_unit(const bf16_t* __restrict__ Qb, const bf16_t* __restrict__ Kh, const bf16_t* __restrict__ Vh, int seq,
                                          bf16_t* __restrict__ CATp  , const float* __restrict__ ng, float lam, float lam_init,
                                          const unsigned* __restrict__ kmaxp  , char* lds, int tid_) {
  const int tid = tid_, wid = __builtin_amdgcn_readfirstlane(tid >> 6), lane = tid & 63, r32 = lane & 31, hi = lane >> 5;
  const int rg = wid & 3, m = wid >> 2;
  constexpr int SLOT = 2 * SHM_KV;
  float* wsp = (float*)(lds + 4 * SLOT) + wid * 64; float* li_l = wsp;
  float l_reg = 0; f32x16 o[4] = {}; bf16x8 qr[4];
  const bf16_t* Qw = Qb + (size_t)(rg * 32 + r32) * 128 + m * 64 + hi * 8;
#pragma unroll
  for (int d0 = 0; d0 < 4; ++d0) qr[d0] = *reinterpret_cast<const bf16x8*>(Qw + d0 * 16);
  float negM;
  {
    float q2 = 0.f;
#pragma unroll
    for (int d0 = 0; d0 < 4; ++d0)
#pragma unroll
      for (int e = 0; e < 8; ++e) { const float v = bf2f((bf16_t)qr[d0][e]); q2 += v * v; }
    { auto rr = __builtin_amdgcn_permlane32_swap(__float_as_uint(q2), __float_as_uint(q2), false, false); q2 = __uint_as_float(rr[0]) + __uint_as_float(rr[1]); }
    const float k2 = __uint_as_float(kmaxp[m]);
    negM = -1.01f * sqrtf(q2 * k2);
  }
  unsigned vsrc[2], ksrc[2];
#pragma unroll
  for (int j = 0; j < 2; ++j) {
    const int p_ = wid + 8 * j;
    const int g_ = p_ * 64 + lane, sub = g_ >> 5, within = g_ & 31;
    const int kk = (sub >> 2) * 8 + (within >> 2), c_ = (sub & 3) * 32 + (within & 3) * 8;
    const int k_ = (kk & ~0xC) | ((kk & 4) << 1) | ((kk & 8) >> 1);
    vsrc[j] = (unsigned)(k_ * 256 + c_ * 2);
    const int row = p_ * 4 + (lane >> 4), chunk = (lane & 15) ^ (row & 7);
    ksrc[j] = (unsigned)(row * 256 + chunk * 16);
  }
  const int vb0 = (int)(uintptr_t)lds + v_rd_base(lane);
#define SLOAD_DMA(k0, slot) do { \
    const char* _vg = (const char*)(Vh + (size_t)(k0) * 128); const char* _kg = (const char*)(Kh + (size_t)(k0) * 128); char* _b = lds + (slot) * SLOT; \
    __builtin_amdgcn_global_load_lds((const unsigned*)(_vg + vsrc[0]), (unsigned*)(_b + wid * 1024), 16, 0, 0); \
    __builtin_amdgcn_global_load_lds((const unsigned*)(_vg + vsrc[1]), (unsigned*)(_b + (wid + 8) * 1024), 16, 0, 0); \
    __builtin_amdgcn_global_load_lds((const unsigned*)(_kg + ksrc[0]), (unsigned*)(_b + SHM_KV + wid * 1024), 16, 0, 0); \
    __builtin_amdgcn_global_load_lds((const unsigned*)(_kg + ksrc[1]), (unsigned*)(_b + SHM_KV + (wid + 8) * 1024), 16, 0, 0); } while (0)
#define TILE_PUBLISH() do { asm volatile("s_waitcnt vmcnt(0) lgkmcnt(0)" ::: "memory"); __builtin_amdgcn_s_barrier(); asm volatile("" ::: "memory"); } while (0)
#define PKV(L, H) (bf16x8){L[0], L[1], L[2], L[3], H[0], H[1], H[2], H[3]}
#define VRD(D0, KH, vb, f0, f1, f2, f3) do { f0 = tr_read<v_rd_off(D0, 2 * (KH), 0)>(vb); f1 = tr_read<v_rd_off(D0, 2 * (KH), 1)>(vb); \
    f2 = tr_read<v_rd_off(D0, 2 * (KH) + 1, 0)>(vb); f3 = tr_read<v_rd_off(D0, 2 * (KH) + 1, 1)>(vb); } while (0)
#define VMM(D0, qa, qb, f0, f1, f2, f3) do { \
    o[D0] = __builtin_amdgcn_mfma_f32_32x32x16_bf16(qa, PKV(f0, f1), o[D0], 0, 0, 0); \
    o[D0] = __builtin_amdgcn_mfma_f32_32x32x16_bf16(qb, PKV(f2, f3), o[D0], 0, 0, 0); } while (0)
#define LW4() do { asm volatile("s_waitcnt lgkmcnt(4)" ::: "memory"); SBAR(); } while (0)
#define LW0() do { asm volatile("s_waitcnt lgkmcnt(0)" ::: "memory"); SBAR(); } while (0)
#define PV_TILE(vb, q0, q1, q2, q3, C0, C1, C2, C3, C4, C5, C6, C7) do { \
    s16x4 a0, a1, a2, a3; \
    SBAR(); VRD(0, 0, vb, a0, a1, a2, a3); C0; LW0(); VMM(0, q0, q1, a0, a1, a2, a3); SBAR(); \
    VRD(0, 1, vb, a0, a1, a2, a3); C1; LW0(); VMM(0, q2, q3, a0, a1, a2, a3); SBAR(); \
    VRD(1, 0, vb, a0, a1, a2, a3); C2; LW0(); VMM(1, q0, q1, a0, a1, a2, a3); SBAR(); \
    VRD(1, 1, vb, a0, a1, a2, a3); C3; LW0(); VMM(1, q2, q3, a0, a1, a2, a3); SBAR(); \
    VRD(2, 0, vb, a0, a1, a2, a3); C4; LW0(); VMM(2, q0, q1, a0, a1, a2, a3); SBAR(); \
    VRD(2, 1, vb, a0, a1, a2, a3); C5; LW0(); VMM(2, q2, q3, a0, a1, a2, a3); SBAR(); \
    VRD(3, 0, vb, a0, a1, a2, a3); C6; LW0(); VMM(3, q0, q1, a0, a1, a2, a3); SBAR(); \
    VRD(3, 1, vb, a0, a1, a2, a3); C7; LW0(); VMM(3, q2, q3, a0, a1, a2, a3); SBAR(); } while (0)
#define PK4(P, BASE, OUT) do { unsigned a0 = cvtpk(P[BASE + 0], P[BASE + 1]), a1 = cvtpk(P[BASE + 2], P[BASE + 3]);   \
    unsigned b0 = cvtpk(P[BASE + 4], P[BASE + 5]), b1 = cvtpk(P[BASE + 6], P[BASE + 7]);                              \
    auto r0 = __builtin_amdgcn_permlane32_swap(a0, b0, false, false); auto r1 = __builtin_amdgcn_permlane32_swap(a1, b1, false, false); \
    u32x4 w = {r0[0], r1[0], r0[1], r1[1]}; OUT = *reinterpret_cast<bf16x8*>(&w); } while (0)
#define E1(S0) do { _Pragma("unroll") for (int r = 0; r < 16; ++r) S0[r] = __builtin_amdgcn_exp2f(S0[r]); } while (0)
#define E1H(S0, H) do { _Pragma("unroll") for (int r = 8 * (H); r < 8 * (H) + 8; ++r) S0[r] = __builtin_amdgcn_exp2f(S0[r]); } while (0)
#define E3(S0, S1) do { float ps = 0; _Pragma("unroll") for (int r = 0; r < 16; ++r) ps += S0[r]; _Pragma("unroll") for (int r = 0; r < 16; ++r) ps += S1[r]; l_reg += ps; } while (0)
#define E3H(S0) do { float ps = 0; _Pragma("unroll") for (int r = 0; r < 16; ++r) ps += S0[r]; l_reg += ps; } while (0)
#define E4(S0, S1, n0, n1, n2, n3) do { PK4(S0, 0, n0); PK4(S0, 8, n1); PK4(S1, 0, n2); PK4(S1, 8, n3); } while (0)
#define ITER(SN0, SN1, ks, SP0, SP1, vs) do { \
    const int _vb = vb0 + (vs) * SLOT; \
    PV_TILE(_vb, p0, p1, p2, p3, E1H(SP0, 0), E1H(SP0, 1), E1H(SP1, 0), E1H(SP1, 1), E3H(SP0), E3H(SP1), (void)0, (void)0); \
    qkt(SN0, SN1, lds + (ks) * SLOT + SHM_KV, qr, r32, hi, m, negM); \
    E4(SP0, SP1, p0, p1, p2, p3); SBAR(); } while (0)
  f32x16 sA0, sA1, sB0, sB1; bf16x8 p0, p1, p2, p3; const int NT = seq / 64;
  SLOAD_DMA(0, 0); TILE_PUBLISH();
  SLOAD_DMA(64, 1);
  qkt(sA0, sA1, lds + SHM_KV, qr, r32, hi, m, negM);
  TILE_PUBLISH();
  if (2 < NT) SLOAD_DMA(2 * 64, 2);
  qkt(sB0, sB1, lds + SLOT + SHM_KV, qr, r32, hi, m, negM);
  E1(sA0); E1(sA1); E3(sA0, sA1); E4(sA0, sA1, p0, p1, p2, p3);
  TILE_PUBLISH();
  for (int i = 2; i < NT; i += 2) {
    SLOAD_DMA((i + 1) * 64, (i + 1) & 3);
    ITER(sA0, sA1, i & 3, sB0, sB1, (i - 2) & 3);
    TILE_PUBLISH();
    if (i + 2 < NT) SLOAD_DMA((i + 2) * 64, (i + 2) & 3);
    ITER(sB0, sB1, (i + 1) & 3, sA0, sA1, (i - 1) & 3);
    TILE_PUBLISH();
  }
  {
    const int _vb = vb0 + ((NT - 2) & 3) * SLOT;
    PV_TILE(_vb, p0, p1, p2, p3, E1H(sB0, 0), E1H(sB0, 1), E1H(sB1, 0), E1H(sB1, 1), E3H(sB0), E3H(sB1), (void)0, (void)0);
    E4(sB0, sB1, p0, p1, p2, p3); SBAR();
    const int _vb2 = vb0 + ((NT - 1) & 3) * SLOT;
    PV_TILE(_vb2, p0, p1, p2, p3, (void)0, (void)0, (void)0, (void)0, (void)0, (void)0, (void)0, (void)0);
  }
#undef SLOAD_DMA
#undef TILE_PUBLISH
#undef PKV
#undef PV_TILE
#undef VRD
#undef VMM
#undef LW4
#undef LW0
#undef PK4
#undef E1
#undef E1H
#undef E3H
#undef E3
#undef E4
#undef ITER
  int r32e = r32, hie = hi;
  asm volatile("" : "+v"(r32e), "+v"(hie));
  { auto rr = __builtin_amdgcn_permlane32_swap(__float_as_uint(l_reg), __float_as_uint(l_reg), false, false); l_reg = __uint_as_float(rr[0]) + __uint_as_float(rr[1]); }
  if (hie == 0) li_l[r32e] = l_reg;
  asm volatile("s_waitcnt lgkmcnt(0)" ::: "memory");
  float rli[16];
#pragma unroll
  for (int r = 0; r < 16; ++r) rli[r] = __builtin_amdgcn_rcpf(li_l[crow(r, hie)]);
  __syncthreads();
  float* comb = (float*)lds;
  if (m == 1) {
#pragma unroll
    for (int r = 0; r < 16; ++r)
#pragma unroll
      for (int d0 = 0; d0 < 4; ++d0) comb[(rg * 32 + crow(r, hie)) * 128 + d0 * 32 + r32e] = o[d0][r] * rli[r] * lam;
  }
  __syncthreads();
  if (m == 0) {
    float ss[16];
#pragma unroll
    for (int r = 0; r < 16; ++r) {
      float a = 0.f;
#pragma unroll
      for (int d0 = 0; d0 < 4; ++d0) {
        const float v = o[d0][r] * rli[r] - comb[(rg * 32 + crow(r, hie)) * 128 + d0 * 32 + r32e];
        o[d0][r] = v; a += v * v;
      }
      ss[r] = a;
    }
#pragma unroll
    for (int off = 1; off < 32; off <<= 1)
#pragma unroll
      for (int r = 0; r < 16; ++r) ss[r] += shx_f(ss[r], off, lane);
    const float om = 1.0f - lam_init;
    float gq[4];
#pragma unroll
    for (int d0 = 0; d0 < 4; ++d0) gq[d0] = ng[d0 * 32 + r32e] * om;
#pragma unroll
    for (int r = 0; r < 16; ++r) {
      const float rs = rsqrtf(ss[r] * (1.0f / 128.0f) + LN_EPS);
      bf16_t* cp = CATp + (size_t)(rg * 32 + crow(r, hie)) * 1536;
#pragma unroll
      for (int d0 = 0; d0 < 4; ++d0) cp[d0 * 32 + r32e] = f2h(o[d0][r] * rs * gq[d0]);
    }
  }
  __syncthreads();
}

__device__ __forceinline__ void sgu_unit(const Params& p, int chunk, int jl, char* lds, int tid_) {
  const int tid = tid_, wid = __builtin_amdgcn_readfirstlane(tid >> 6), lane = tid & 63, r32 = lane & 31, hi = lane >> 5;
  const int row0 = chunk * 128;
  const bf16_t* GV = (const bf16_t*)(p.ws + OFF_GV);
  const bf16_t* GU = (const bf16_t*)(p.ws + OFF_GU);
  bf16_t* CAT = (bf16_t*)(p.ws + OFF_CAT);
  const float* lg = PIN(p, sgu_ln_g) + (size_t)jl * 512;
  const float* lb = PIN(p, sgu_ln_b) + (size_t)jl * 512;
  {
    const f32x4 g0 = *(const f32x4*)(lg + lane * 8), g1 = *(const f32x4*)(lg + lane * 8 + 4);
    const f32x4 b0 = *(const f32x4*)(lb + lane * 8), b1 = *(const f32x4*)(lb + lane * 8 + 4);
    const int c = lane * 8, g = c >> 7, cg = c & 127;
    for (int q = wid; q < 128; q += 8) {
      const u32x4 w = *(const u32x4*)(GV + (size_t)(row0 + q) * 512 + c);
      float v[8];
#pragma unroll
      for (int i = 0; i < 4; ++i) { v[2 * i] = bflo(w[i]); v[2 * i + 1] = bfhi(w[i]); }
      float s = 0.f;
#pragma unroll
      for (int i = 0; i < 8; ++i) s += v[i];
      const float mu = wave_sum(s, lane) * (1.0f / 512.0f);
      float qq = 0.f;
#pragma unroll
      for (int i = 0; i < 8; ++i) { const float d = v[i] - mu; qq += d * d; }
      const float rstd = rsqrtf(wave_sum(qq, lane) * (1.0f / 512.0f) + LN_EPS);
      u32x4 ow;
      ow[0] = pk2((v[0] - mu) * rstd * g0[0] + b0[0], (v[1] - mu) * rstd * g0[1] + b0[1]);
      ow[1] = pk2((v[2] - mu) * rstd * g0[2] + b0[2], (v[3] - mu) * rstd * g0[3] + b0[3]);
      ow[2] = pk2((v[4] - mu) * rstd * g1[0] + b1[0], (v[5] - mu) * rstd * g1[1] + b1[1]);
      ow[3] = pk2((v[6] - mu) * rstd * g1[2] + b1[2], (v[7] - mu) * rstd * g1[3] + b1[3]);
      *(u32x4*)(lds + (g * 2 + (q >> 6)) * SHM_KV + v_st(q & 63, cg)) = ow;
    }
  }
  __syncthreads();
  const int pg = wid & 3, ch = wid >> 2;
  const int vbase = (int)(uintptr_t)lds + v_rd_base(lane);
  for (int g = 0; g < 4; ++g) {
    const float* Wg = PIN(p, sgu_w) + ((size_t)(jl * 4 + g) * 128) * 128;
    bf16x8 af[8];
#pragma unroll
    for (int ks = 0; ks < 8; ++ks) {
      const float* wp = Wg + (size_t)(pg * 32 + r32) * 128 + ks * 16 + hi * 8;
      const f32x4 a = *(const f32x4*)wp, b = *(const f32x4*)(wp + 4);
      u32x4 w = {pk2(a[0], a[1]), pk2(a[2], a[3]), pk2(b[0], b[1]), pk2(b[2], b[3])};
      af[ks] = *reinterpret_cast<bf16x8*>(&w);
    }
    f32x16 acc[2] = {};
#pragma unroll
    for (int kt = 0; kt < 2; ++kt) {
      const int vb = vbase + (g * 2 + kt) * SHM_KV;
      if (ch == 0) { pv_one_t<0>(acc[0], vb, af[kt * 4 + 0], af[kt * 4 + 1], af[kt * 4 + 2], af[kt * 4 + 3]); pv_one_t<1>(acc[1], vb, af[kt * 4 + 0], af[kt * 4 + 1], af[kt * 4 + 2], af[kt * 4 + 3]); }
      else         { pv_one_t<2>(acc[0], vb, af[kt * 4 + 0], af[kt * 4 + 1], af[kt * 4 + 2], af[kt * 4 + 3]); pv_one_t<3>(acc[1], vb, af[kt * 4 + 0], af[kt * 4 + 1], af[kt * 4 + 2], af[kt * 4 + 3]); }
    }
    const int pp = pg * 32 + r32;
    const float bb = (PIN(p, sgu_b) + (size_t)(jl * 4 + g) * 128)[pp];
    const bf16_t* gup = GU + (size_t)(row0 + pp) * 512 + g * 128 + ch * 64 + 4 * hi;
    bf16_t* cap = CAT + (size_t)(row0 + pp) * 1536 + 1024 + g * 128 + ch * 64 + 4 * hi;
#pragma unroll
    for (int dd = 0; dd < 2; ++dd)
#pragma unroll
      for (int q = 0; q < 4; ++q) {
        const u32x2 uw = *(const u32x2*)(gup + dd * 32 + q * 8);
        const float s0 = acc[dd][4 * q] + bb, s1 = acc[dd][4 * q + 1] + bb, s2 = acc[dd][4 * q + 2] + bb, s3 = acc[dd][4 * q + 3] + bb;
        u32x2 ow = {pk2h(bflo(uw[0]) * s0, bfhi(uw[0]) * s1), pk2h(bflo(uw[1]) * s2, bfhi(uw[1]) * s3)};
        *(u32x2*)(cap + dd * 32 + q * 8) = ow;
      }
  }
  __syncthreads();
}

__device__ void phase_mixer_fast(const Params& p, int layer, char* shm, int tid_) {
  const int jl = layer >> 1;
  const bool ctxq = layer == 0;
  const float lam = ((const float*)(p.ws + OFF_LAM))[jl * 2 + 0];
  const float lam_init = ((const float*)(p.ws + OFF_LAM))[jl * 2 + 1];
  const float* ng = PIN(p, diff_norm_g) + (size_t)jl * 128;
  const bf16_t* Q = (const bf16_t*)(p.ws + OFF_Q);
  const bf16_t* K = (const bf16_t*)(p.ws + OFF_K);
  const bf16_t* V = (const bf16_t*)(p.ws + OFF_V);
  bf16_t* CAT = (bf16_t*)(p.ws + OFF_CAT);
  const int bid = lbid();
  const int NC = ctxq ? 32 : 0;
  const int NS = ctxq ? (NTOK / 128) : (NLAT / 128);
  for (int u = bid; u < 1024 + NC + NS; u += gridDim.x) {
    if (u < 1024 + NC) {
      int bh, pos0, seq, orow;
      if (u < 1024) {
        const int xcd = u & 7, ul = (u >> 8) * 32 + ((u & 255) >> 3), qb = ul & 63;
        bh = xcd * 2 + (ul >> 6);
        pos0 = CTXL + qb * 128; seq = LKV; orow = (bh >> 3) * SEQ + qb * 128;
      } else {
        const int v = u - 1024, qb = v & 1;
        bh = v >> 1;
        pos0 = qb * 128; seq = CTXL; orow = NLAT + (bh >> 3) * CTXL + qb * 128;
      }
      const size_t hb = (size_t)bh * LKV * 128;
      attn_unit(Q + hb + (size_t)pos0 * 128, K + hb, V + hb, seq, CAT + (size_t)orow * 1536 + (bh & 7) * 128, ng, lam, lam_init, (const unsigned*)(p.ws + OFF_BAR + 256) + jl * 32 + bh * 2, shm, tid_);
    } else {
      sgu_unit(p, u - 1024 - NC, jl, shm, tid_);
    }
  }
}

__device__ __forceinline__ void ld8h(const bf16_t* p, float (&v)[8]) {
  const u32x4 w = *(const u32x4*)p;
#pragma unroll
  for (int i = 0; i < 4; ++i) { v[2 * i] = hlo(w[i]); v[2 * i + 1] = hhi(w[i]); }
}
__device__ void phase_pool(const Params& p, int nrows, int tid_) {
  const bf16_t* M1 = (const bf16_t*)(p.ws + OFF_M1);
  bf16_t* M2 = (bf16_t*)(p.ws + OFF_M2);
  const int nitems = (nrows >> 5) * 128;
  for (int it = lbid() * 512 + tid_; it < nitems; it += gridDim.x * 512) {
    const int cg = it & 127, seg = it >> 7;
    const int row0 = seg * 32;
    int base, T;
    if (row0 < NLAT) { base = row0 & ~(SEQ - 1); T = SEQ; } else { base = NLAT + ((row0 - NLAT) & ~255); T = CTXL; }
    const int t0 = row0 - base;
    const int h = 1 << (cg >> 5);
    const bf16_t* colp = M1 + (size_t)base * 1024 + cg * 8;
    float S[8];
#pragma unroll
    for (int i = 0; i < 8; ++i) S[i] = 0.f;
    {
      const int lo = t0 - h < 0 ? 0 : t0 - h, hi = t0 + h > T ? T : t0 + h;
      for (int q = lo; q < hi; ++q) { float v[8]; ld8h(colp + (size_t)q * 1024, v);
#pragma unroll
        for (int i = 0; i < 8; ++i) S[i] += v[i]; }
    }
    for (int t = t0; t < t0 + 32; ++t) {
      const int lo = t - h < 0 ? 0 : t - h, hi = t + h > T ? T : t + h;
      const float inv = 1.0f / (float)(hi - lo);
      float x[8];
      ld8h(colp + (size_t)t * 1024, x);
      u32x4 w;
#pragma unroll
      for (int i = 0; i < 4; ++i) w[i] = pk2h(S[2 * i] * inv - x[2 * i], S[2 * i + 1] * inv - x[2 * i + 1]);
      *(u32x4*)(M2 + (size_t)(base + t) * 1024 + cg * 8) = w;
      if (t + h < T) { float v[8]; ld8h(colp + (size_t)(t + h) * 1024, v);
#pragma unroll
        for (int i = 0; i < 8; ++i) S[i] += v[i]; }
      if (t - h >= 0) { float v[8]; ld8h(colp + (size_t)(t - h) * 1024, v);
#pragma unroll
        for (int i = 0; i < 8; ++i) S[i] -= v[i]; }
    }
  }
}

#define DPP_ADD_F(keep, send, ctrlstr) ({ float _r; asm("s_nop 1\n\tv_add_f32_dpp %0, %1, %2 " ctrlstr " row_mask:0xf bank_mask:0xf bound_ctrl:1" : "=v"(_r) : "v"(send), "v"(keep)); _r; })
__device__ __forceinline__ float hadd2(f32x2v v) { float r; asm("v_add_f32 %0, %1, %2" : "=v"(r) : "v"(v[0]), "v"(v[1])); return r; }
#define PEER_LOAD_IDX(dst, k) do { const int _t = wv + (k) * nwv; dst = *(const u32x4*)(IDX + ((size_t)g * NTOK + _t) * 8 + (c & 1) * 4); } while (0)
#define PEER_SPLIT_IDX(src) do { u32x4 _p; \
    _Pragma("unroll") for (int q = 0; q < 4; ++q) _p[q] = (unsigned)__builtin_amdgcn_update_dpp(0, (int)src[q], 0xB1, 0xf, 0xf, true); \
    _Pragma("unroll") for (int q = 0; q < 4; ++q) { idA[q] = (c & 1) ? _p[q] : src[q]; idB[q] = (c & 1) ? src[q] : _p[q]; } } while (0)
#define PEER_ROWLO(TAB, w) (*(const u32x4*)((TAB) + ((((w) << 7) & 0x7fff80u) | (unsigned)c16)))
#define PEER_ROWHI(TAB, w) (*(const u32x4*)((TAB) + ((((w) >> 9) & 0x7fff80u) | (unsigned)c16)))
#define PEER_GATHER_H0(buf, TAB, id) do { \
    buf[0] = PEER_ROWLO(TAB, id##A[0]); buf[1] = PEER_ROWHI(TAB, id##A[0]); buf[2] = PEER_ROWLO(TAB, id##A[1]); buf[3] = PEER_ROWHI(TAB, id##A[1]); \
    buf[4] = PEER_ROWLO(TAB, id##A[2]); buf[5] = PEER_ROWHI(TAB, id##A[2]); buf[6] = PEER_ROWLO(TAB, id##A[3]); buf[7] = PEER_ROWHI(TAB, id##A[3]); } while (0)
#define PEER_GATHER_H1(buf, TAB, id) do { \
    buf[0] = PEER_ROWLO(TAB, id##B[0]); buf[1] = PEER_ROWHI(TAB, id##B[0]); buf[2] = PEER_ROWLO(TAB, id##B[1]); buf[3] = PEER_ROWHI(TAB, id##B[1]); \
    buf[4] = PEER_ROWLO(TAB, id##B[2]); buf[5] = PEER_ROWHI(TAB, id##B[2]); buf[6] = PEER_ROWLO(TAB, id##B[3]); buf[7] = PEER_ROWHI(TAB, id##B[3]); } while (0)

__device__ void phase_peer_u(const Params& p, int layer, int nrows, int tid_) {
  const int tid = tid_, wid = __builtin_amdgcn_readfirstlane(tid >> 6), lane = tid & 63, bid = lbid();
  const int s = bid & 7, wv = (bid >> 3) * 8 + wid, nwv = (gridDim.x >> 3) * 8;
  const int g = lane >> 3, c = lane & 7, c16 = c * 16;
  const bool b2 = (lane & 4) != 0, b1 = (lane & 2) != 0, b0 = (lane & 1) != 0;
  const unsigned char* H = (const unsigned char*)(p.ws + OFF_H8) + s * 128 + c * 16;
  const unsigned char* U = (const unsigned char*)(p.ws + OFF_U8) + (size_t)(layer * 8 + s) * NEXP * 128;
  const unsigned* IDX = (const unsigned*)(p.ws + OFF_IDX16);
  float* PART = (float*)(p.ws + OFF_PART);
  const int n = wv < nrows ? (nrows - wv + nwv - 1) / nwv : 0;
  if (n == 0) return;
  u32x4 idA, idB;
  u32x4 bufA[8], bufB[8], hn, hc;
#define PU_HLOAD(h, k) do { const int _t = wv + (k) * nwv; h = *(const u32x4*)(H + (size_t)_t * DM); } while (0)
#define PU_HCVT() do { hc = hn; } while (0)
#define PU_HALF(buf, base) do { \
    int ia[8]; \
    _Pragma("unroll") for (int i = 0; i < 8; ++i) ia[i] = __builtin_amdgcn_sdot4((int)buf[i][0], (int)hc[0], 0, false); \
    _Pragma("unroll") for (int q = 1; q < 4; ++q) { _Pragma("unroll") for (int i = 0; i < 8; ++i) ia[i] = __builtin_amdgcn_sdot4((int)buf[i][q], (int)hc[q], ia[i], false); } \
    _Pragma("unroll") for (int i = 0; i < 8; ++i) pd[(base) + i] = (float)ia[i]; } while (0)
  u32x4 idX;
  PEER_LOAD_IDX(idX, 0);
  PEER_SPLIT_IDX(idX);
  PEER_GATHER_H0(bufA, U, id); PU_HLOAD(hn, 0);
  { const int k1 = n > 1 ? 1 : 0; PEER_LOAD_IDX(idX, k1); }
  PU_HCVT();
  for (int k = 0; k < n; ++k) {
    const int k1 = k + 1 < n ? k + 1 : k, k2 = k + 2 < n ? k + 2 : n - 1;
    PEER_GATHER_H1(bufB, U, id);
    __builtin_amdgcn_sched_barrier(0);
    float pd[16];
    PU_HALF(bufA, 0);
    __builtin_amdgcn_sched_barrier(0);
    PEER_SPLIT_IDX(idX);
    PEER_GATHER_H0(bufA, U, id); PU_HLOAD(hn, k1);
    __builtin_amdgcn_sched_barrier(0);
    PEER_LOAD_IDX(idX, k2);
    __builtin_amdgcn_sched_barrier(0);
    PU_HALF(bufB, 8);
    float r8[8], r4[4], r2[2];
#pragma unroll
    for (int i = 0; i < 8; ++i) { const float keep = b2 ? pd[8 + i] : pd[i], send = b2 ? pd[i] : pd[8 + i]; r8[i] = DPP_ADD_F(keep, send, "row_half_mirror"); }
#pragma unroll
    for (int i = 0; i < 4; ++i) { const float keep = b1 ? r8[4 + i] : r8[i], send = b1 ? r8[i] : r8[4 + i]; r4[i] = DPP_ADD_F(keep, send, "quad_perm:[2,3,0,1]"); }
#pragma unroll
    for (int i = 0; i < 2; ++i) { const float keep = b0 ? r4[2 + i] : r4[i], send = b0 ? r4[i] : r4[2 + i]; r2[i] = DPP_ADD_F(keep, send, "quad_perm:[1,0,3,2]"); }
    *(f32x2v*)(PART + ((size_t)(wv + k * nwv) * 8 + s) * 128 + lane * 2) = (f32x2v){r2[0], r2[1]};
    PU_HCVT();
    __builtin_amdgcn_sched_barrier(0);
  }
#undef PU_HLOAD
#undef PU_HCVT
#undef PU_HALF
}
__device__ void phase_peer_w(const Params& p, int layer, int nrows, int tid_) {
  const int wid = __builtin_amdgcn_readfirstlane(tid_ >> 6), lane = tid_ & 63;
  const float* PART = (const float*)(p.ws + OFF_PART);
  const float* GATE = (const float*)(p.ws + OFF_GATE);
  unsigned char* W8 = (unsigned char*)(p.ws + OFF_W8);
  float* WSC = (float*)(p.ws + OFF_WSC);
  const float* VSC = (const float*)(p.ws + OFF_VSC) + (size_t)layer * NEXP;
  const int* IDX = (const int*)(p.ws + OFF_IDX);
  const float* HSC = (const float*)(p.ws + OFF_HSC);
  const float* USC = (const float*)(p.ws + OFF_USC) + (size_t)layer * NEXP;
  for (int t = lbid() * 8 + wid; t < nrows; t += gridDim.x * 8) {
    f32x2v acc2 = {0.f, 0.f};
#pragma unroll
    for (int q = 0; q < 8; ++q) acc2 += *(const f32x2v*)(PART + ((size_t)t * 8 + q) * 128 + lane * 2);
    const size_t go = ((size_t)(lane >> 3) * NTOK + t) * 16 + (lane & 7) * 2;
    const f32x2v gt = *(const f32x2v*)(GATE + go);
    const int id0 = IDX[go], id1 = IDX[go + 1];
    const float hs = HSC[t];
    const float d0 = acc2[0] * (hs * USC[id0]), d1 = acc2[1] * (hs * USC[id1]);
    const float w0 = gt[0] * gelu_tanh(d0) * VSC[id0], w1 = gt[1] * gelu_tanh(d1) * VSC[id1];
    const float mx = wave_max(fmaxf(fabsf(w0), fabsf(w1))), inv = mx > 0.f ? 127.0f / mx : 0.f;
    const int q0 = __float2int_rn(w0 * inv), q1 = __float2int_rn(w1 * inv);
    *(unsigned short*)(W8 + (size_t)t * 128 + lane * 2) = (unsigned short)((q0 & 255) | ((q1 & 255) << 8));
    if (lane == 0) WSC[t] = mx * (1.0f / 127.0f);
  }
}
#define PERM_B(hi, lo, sel) __builtin_amdgcn_perm((unsigned)(hi), (unsigned)(lo), (unsigned)(sel))
#define DPP_ADD_I(keep, send, ctrlstr) ({ int _r; asm("s_nop 1\n\tv_add_u32_dpp %0, %1, %2 " ctrlstr " row_mask:0xf bank_mask:0xf bound_ctrl:1" : "=v"(_r) : "v"(send), "v"(keep)); _r; })
__device__ void phase_peer_v(const Params& p, int layer, const hstream_t* XSin, hstream_t* Zout, int nrows, int tid_) {
  const int tid = tid_, wid = __builtin_amdgcn_readfirstlane(tid >> 6), lane = tid & 63, bid = lbid();
  const int s = bid & 7, wv = (bid >> 3) * 8 + wid, nwv = (gridDim.x >> 3) * 8;
  const int g = lane >> 3, c = lane & 7, c16 = c * 16;
  const bool b3 = (lane & 8) != 0;
  const unsigned char* Vt = (const unsigned char*)(p.ws + OFF_V8) + (size_t)(layer * 8 + s) * NEXP * 128;
  const unsigned* IDX = (const unsigned*)(p.ws + OFF_IDX16);
  const unsigned char* W8 = (const unsigned char*)(p.ws + OFF_W8) + g * 16;
  const float* WSC = (const float*)(p.ws + OFF_WSC);
  const int col = s * 128 + c * 16 + g * 2;
  const int n = wv < nrows ? (nrows - wv + nwv - 1) / nwv : 0;
  if (n == 0) return;
  u32x4 idA, idB;
  u32x4 bufA[8], bufB[8], wq, wqn;
  unsigned xw;
  const f32x2v g2w0 = *(const f32x2v*)(mod_ptr(p, layer, 0, 5) + col), g2w1 = *(const f32x2v*)(mod_ptr(p, layer, 1, 5) + col), g2w2 = *(const f32x2v*)(mod_ptr(p, layer, 2, 5) + col);
#define PV_QUAD(buf, r0, wd) do { \
    _Pragma("unroll") for (int q = 0; q < 4; ++q) { \
      const unsigned x01l = PERM_B(buf[(r0) + 1][q], buf[(r0)][q], 0x05010400u), x01h = PERM_B(buf[(r0) + 1][q], buf[(r0)][q], 0x07030602u); \
      const unsigned x23l = PERM_B(buf[(r0) + 3][q], buf[(r0) + 2][q], 0x05010400u), x23h = PERM_B(buf[(r0) + 3][q], buf[(r0) + 2][q], 0x07030602u); \
      acc[4 * q + 0] = __builtin_amdgcn_sdot4((int)PERM_B(x23l, x01l, 0x05040100u), (int)(wd), acc[4 * q + 0], false); \
      acc[4 * q + 1] = __builtin_amdgcn_sdot4((int)PERM_B(x23l, x01l, 0x07060302u), (int)(wd), acc[4 * q + 1], false); \
      acc[4 * q + 2] = __builtin_amdgcn_sdot4((int)PERM_B(x23h, x01h, 0x05040100u), (int)(wd), acc[4 * q + 2], false); \
      acc[4 * q + 3] = __builtin_amdgcn_sdot4((int)PERM_B(x23h, x01h, 0x07060302u), (int)(wd), acc[4 * q + 3], false); } } while (0)
  u32x4 idX;
  PEER_LOAD_IDX(idX, 0);
  PEER_SPLIT_IDX(idX);
  PEER_GATHER_H0(bufA, Vt, id);
  wq = *(const u32x4*)(W8 + (size_t)wv * 128);
  { const int k1 = n > 1 ? 1 : 0; PEER_LOAD_IDX(idX, k1); }
  for (int k = 0; k < n; ++k) {
    const int k1 = k + 1 < n ? k + 1 : k, k2 = k + 2 < n ? k + 2 : n - 1;
    const int t = wv + k * nwv;
    PEER_GATHER_H1(bufB, Vt, id);
    __builtin_amdgcn_sched_barrier(0);
    xw = *(const unsigned*)(XSin + (size_t)t * DM + col);
    const float wsc = WSC[t];
    __builtin_amdgcn_sched_barrier(0);
    int acc[16];
#pragma unroll
    for (int j = 0; j < 16; ++j) acc[j] = 0;
    PV_QUAD(bufA, 0, wq[0]); PV_QUAD(bufA, 4, wq[1]);
    __builtin_amdgcn_sched_barrier(0);
    PEER_SPLIT_IDX(idX);
    PEER_GATHER_H0(bufA, Vt, id);
    wqn = *(const u32x4*)(W8 + (size_t)(wv + k1 * nwv) * 128);
    __builtin_amdgcn_sched_barrier(0);
    PEER_LOAD_IDX(idX, k2);
    __builtin_amdgcn_sched_barrier(0);
    PV_QUAD(bufB, 0, wq[2]); PV_QUAD(bufB, 4, wq[3]);
    int r8[8], r4[4], r2[2];
#pragma unroll
    for (int i = 0; i < 8; ++i) { auto rr = __builtin_amdgcn_permlane32_swap((unsigned)acc[i], (unsigned)acc[8 + i], false, false); r8[i] = (int)rr[0] + (int)rr[1]; }
#pragma unroll
    for (int i = 0; i < 4; ++i) { auto rr = __builtin_amdgcn_permlane16_swap((unsigned)r8[i], (unsigned)r8[4 + i], false, false); r4[i] = (int)rr[0] + (int)rr[1]; }
#pragma unroll
    for (int i = 0; i < 2; ++i) { const int keep = b3 ? r4[2 + i] : r4[i], send = b3 ? r4[i] : r4[2 + i]; r2[i] = DPP_ADD_I(keep, send, "row_ror:8"); }
    const int who = who_of_row(t);
    const f32x2v g2 = who == 0 ? g2w0 : (who == 1 ? g2w1 : g2w2);
    *(unsigned*)(Zout + (size_t)t * DM + col) = pk2h(ALPHA * hlo(xw) + g2[0] * ((float)r2[0] * wsc), ALPHA * hhi(xw) + g2[1] * ((float)r2[1] * wsc));
    wq = wqn;
    __builtin_amdgcn_sched_barrier(0);
  }
#undef PV_QUAD
}

constexpr int NSTEP = 9;
constexpr int NPHASE = 2 + NSTEP * DEPTH;

__device__ void run_phase(const Params& pin, int ph, char* shm, int tid_) {
  Params p = pin;
  { unsigned zoff = 0; asm volatile("" : "+s"(zoff));
    p.ws = pin.ws + zoff; }
  if (ph == 0) { phase_prologue_a(p, shm, tid_); return; }
  if (ph == 1) { phase_prologue_b(p, tid_); return; }
  const int layer = (ph - 2) / NSTEP, step = (ph - 2) % NSTEP;
  const bool even = (layer & 1) == 0;
  const int jl = layer >> 1;
  const bool ctx_out = layer < 2;
  const int nrows = ctx_out ? NTOK : NLAT;
  const int mt_upd = nrows / 256;
  hstream_t* XSA = (hstream_t*)(p.ws + OFF_XSA);
  hstream_t* XSB = (hstream_t*)(p.ws + OFF_XSB);
  hstream_t* Z = (hstream_t*)(p.ws + OFF_Z);
  const float* modl = (const float*)(p.ws + OFF_MOD) + (size_t)layer * 3 * 6144;
  if (step == 0) {
    if (even) {
      const EpiInProj eq{(bf16_t*)(p.ws + OFF_Q), (bf16_t*)(p.ws + OFF_K), (const float*)(p.ws + OFF_HSC), (const float*)(p.ws + OFF_WINSC) + (size_t)jl * 4096, (const float*)(p.ws + OFF_ROPE), (unsigned*)(p.ws + OFF_BAR + 256) + jl * 32};
      const EpiInProjVG ev{(bf16_t*)(p.ws + OFF_V), (bf16_t*)(p.ws + OFF_GU), (bf16_t*)(p.ws + OFF_GV), (const float*)(p.ws + OFF_HSC), (const float*)(p.ws + OFF_WINSC) + (size_t)jl * 4096 + 2048};
      const int mt = (layer <= 2) ? NTOK / 256 : NLAT / 256;
      const char* W8 = p.ws + OFF_WIN8 + (size_t)jl * 4096 * 1024;
      const char* H8 = p.ws + OFF_H8;
      const int nu_big = (NLAT / 256) * 16, nu_small = ((mt * 256 - NLAT) >> 6) * 16;
      for (int u = lbid(); u < nu_big; u += gridDim.x) {
        const int xcd = u & 7, v = u >> 3;
        const int pn = ((v & 15) + 8 * ((v >> 5) & 1)) & 15, pm = (v >> 4) * 8 + xcd;
        if (pn < 8) gemm_tile<2, 8>((const bf16_t*)(H8 + (size_t)pm * 256 * 1024), (const bf16_t*)(W8 + (size_t)pn * 256 * 1024), pm * 256, pn, 512, eq, shm, tid_);
      }
      for (int u = lbid(); u < nu_big; u += gridDim.x) {
        const int xcd = u & 7, v = u >> 3;
        const int pn = ((v & 15) + 8 * ((v >> 5) & 1)) & 15, pm = (v >> 4) * 8 + xcd;
        if (pn >= 8) gemm_tile<2, 8>((const bf16_t*)(H8 + (size_t)pm * 256 * 1024), (const bf16_t*)(W8 + (size_t)pn * 256 * 1024), pm * 256, pn, 512, ev, shm, tid_);
      }
      const int u0 = nu_big + ((lbid() + gridDim.x - nu_big % gridDim.x) % gridDim.x);
      for (int u = u0; u < nu_big + nu_small; u += gridDim.x) {
        const int w = u - nu_big, pn = w & 15, row0 = NLAT + (w >> 4) * 64;
        if (pn < 8) gemm_tile<2, 2>((const bf16_t*)(H8 + (size_t)row0 * 1024), (const bf16_t*)(W8 + (size_t)pn * 256 * 1024), row0, pn, 512, eq, shm, tid_);
      }
      for (int u = u0; u < nu_big + nu_small; u += gridDim.x) {
        const int w = u - nu_big, pn = w & 15, row0 = NLAT + (w >> 4) * 64;
        if (pn >= 8) gemm_tile<2, 2>((const bf16_t*)(H8 + (size_t)row0 * 1024), (const bf16_t*)(W8 + (size_t)pn * 256 * 1024), row0, pn, 512, ev, shm, tid_);
      }
    } else {
      EpiBf16Store e{(bf16_t*)(p.ws + OFF_M1), 1024, (const float*)(p.ws + OFF_HSC), (const float*)(p.ws + OFF_PINSC) + (size_t)jl * 1024};
      gemm_phase<2>((const bf16_t*)(p.ws + OFF_H8), (const bf16_t*)(p.ws + OFF_PIN8 + (size_t)jl * 1024 * 1024), NLAT / 256, nrows - NLAT, 4, 512, e, shm, tid_);
    }
  } else if (step == 1) {
    if (even) phase_mixer_fast(p, layer, shm, tid_);
    else phase_pool(p, nrows, tid_);
  } else if (step == 2) {
    EpiResid e{XSA, Z, modl, 2};
    if (even) gemm_phase<true>((const bf16_t*)(p.ws + OFF_CAT), (const bf16_t*)(p.ws + OFF_WOUT) + (size_t)jl * 1024 * 1536, NLAT / 256, nrows - NLAT, 4, 1536, e, shm, tid_);
    else gemm_phase<true>((const bf16_t*)(p.ws + OFF_M2), (const bf16_t*)(p.ws + OFF_POUT) + (size_t)jl * 1024 * 1024, NLAT / 256, nrows - NLAT, 4, 1024, e, shm, tid_);
  } else if (step == 3) {
    phase_ln(p, Z, XSB, layer, 0, nrows, nullptr, layer, 3, nrows, false, true, tid_);
  } else if (step == 4) {
    EpiTopK e{(int*)(p.ws + OFF_IDX), (float*)(p.ws + OFF_GATE), (unsigned*)(p.ws + OFF_IDX16), (const float*)(p.ws + OFF_HSC), (const float*)(p.ws + OFF_WQSC) + (size_t)layer * 2048};
    gemm_phase<2>((const bf16_t*)(p.ws + OFF_H8), (const bf16_t*)(p.ws + OFF_WQK8 + (size_t)layer * 2048 * 1024), NLAT / 256, nrows - NLAT, 8, 512, e, shm, tid_);
  } else if (step == 5) {
    phase_peer_u(p, layer, nrows, tid_);
  } else if (step == 6) {
    phase_peer_w(p, layer, nrows, tid_);
  } else if (step == 7) {
    phase_peer_v(p, layer, XSB, Z, nrows, tid_);
  } else {
    const int nl = layer + 1;
    const int nrows_next = (nl <= 2) ? NTOK : NLAT;
    phase_ln(p, Z, XSA, layer, 1, nrows, nullptr, nl, 0, nrows_next < nrows ? nrows_next : nrows, layer == DEPTH - 1, true, tid_);
  }
}

#define XB_XCNT(j) (64 * (j))
#define XB_XSUB(j) (512 + 64 * (j))
#define XB_XGEN(j) (1024 + 64 * (j))
#define XB_TOP 1536
#define XB_TOPGEN 1600
#define XB_WORDS 1664
__device__ __forceinline__ unsigned xb_ld(unsigned* p) { return __hip_atomic_load(p, __ATOMIC_RELAXED, __HIP_MEMORY_SCOPE_AGENT); }
__device__ __forceinline__ unsigned xb_add(unsigned* p, unsigned v) { return __hip_atomic_fetch_add(p, v, __ATOMIC_RELAXED, __HIP_MEMORY_SCOPE_AGENT); }
__device__ __forceinline__ void grid_barrier(unsigned* bar, int xcc, unsigned nloc, unsigned nx, int tid_) {
  asm volatile("s_waitcnt vmcnt(0) lgkmcnt(0)" ::: "memory");
  __syncthreads();
  if (tid_ == 0) {
    const unsigned old = xb_add(&bar[XB_XSUB(xcc)], 1u);
    const unsigned gen = old / nloc;
    if (old + 1u == (gen + 1u) * nloc) {
      __builtin_amdgcn_fence(__ATOMIC_RELEASE, "agent");
      asm volatile("s_waitcnt vmcnt(0)" ::: "memory");
      const unsigned og = xb_add(&bar[XB_TOP], 1u);
      const unsigned tg = og / nx;
      if (og + 1u == (tg + 1u) * nx) {
#pragma unroll
        for (int j = 0; j < 8; ++j) xb_add(&bar[XB_XGEN(j)], 1u);
      } else while (xb_ld(&bar[XB_XGEN(xcc)]) == gen) __builtin_amdgcn_s_sleep(1);
      __builtin_amdgcn_fence(__ATOMIC_ACQUIRE, "agent");
      asm volatile("s_waitcnt vmcnt(0)" ::: "memory");
    } else {
      while (xb_ld(&bar[XB_XGEN(xcc)]) == gen) __builtin_amdgcn_s_sleep(1);
      __builtin_amdgcn_fence(__ATOMIC_ACQUIRE, "agent");
      asm volatile("s_waitcnt vmcnt(0)" ::: "memory");
    }
  }
  __syncthreads();
}

__device__ __forceinline__ int phase_cat(int ph) {
  if (ph < 2) return 0;
  const int layer = (ph - 2) / NSTEP, step = (ph - 2) % NSTEP;
  const bool even = (layer & 1) == 0;
  if (step == 0) return even ? 1 : 7;
  if (step == 1) return even ? 2 : 8;
  if (step == 2) return 3;
  if (step == 3) return 4;
  if (step == 4) return 5;
  if (step == 5) return 6;
  if (step == 6) return 12;
  if (step == 7) return 10;
  return 11;
}

__global__ void __launch_bounds__(512) mega(KArgs ka, int ph_lo, int ph_hi) {
  Params p;
  p.in = (const float* const*)__builtin_amdgcn_kernarg_segment_ptr();
  p.out = ka.out; p.ws = ka.ws;
  __shared__ __attribute__((aligned(1024))) char shm[LDS_BYTES];
  cg::grid_group grid = cg::this_grid();
  unsigned* bar = (unsigned*)(p.ws + OFF_BAR + 512);
  int rep = 0;
  const int swid = __builtin_amdgcn_readfirstlane((int)(threadIdx.x >> 6));
  const int my_xcc = (int)(__builtin_amdgcn_s_getreg((3 << 11) | 20) & 0x7);
  if (threadIdx.x == 0) xb_add(&bar[XB_XCNT(my_xcc)], 1u);
  unsigned nloc = 1, nx = 1;
  for (int ph = ph_lo; ph < ph_hi;) {
    run_phase(p, ph, shm, make_tid(swid));
    bool again = false;
#ifdef DUP_CAT
    if (phase_cat(ph) == DUP_CAT && rep == 0) again = true;
#endif
    if (again || ph + 1 < ph_hi) {
      if (ph == ph_lo && !again && rep == 0) {
        grid.sync();
        unsigned cnt = 0, mine = 0;
#pragma unroll
        for (int j = 0; j < 8; ++j) { const unsigned c = xb_ld(&bar[XB_XCNT(j)]); cnt += c > 0u ? 1u : 0u; mine = j == my_xcc ? c : mine; }
        nloc = __builtin_amdgcn_readfirstlane(mine > 0u ? mine : 1u); nx = __builtin_amdgcn_readfirstlane(cnt > 0u ? cnt : 1u);
      } else grid_barrier(bar, my_xcc, nloc, nx, make_tid(swid));
    }
    if (again) rep = 1; else { rep = 0; ++ph; }
  }
}

extern "C" void kernel_launch(void* const* d_in, const int* in_sizes, int n_in, void* d_out, int out_size, void* d_ws, size_t ws_size,
                              hipStream_t stream) {
  static int grid_blocks = 0;
  if (!grid_blocks) {
    int dev = 0, cus = 0, per_cu = 0;
    (void)hipGetDevice(&dev);
    (void)hipDeviceGetAttribute(&cus, hipDeviceAttributeMultiprocessorCount, dev);
    (void)hipOccupancyMaxActiveBlocksPerMultiprocessor(&per_cu, mega, 512, 0);
    if (per_cu > 1) per_cu = 1;
    grid_blocks = cus * per_cu;
    if (ws_size < WS_END) fprintf(stderr, "kernel_launch: workspace too small: %zu < %zu\n", ws_size, (size_t)WS_END);
    if (grid_blocks <= 0) fprintf(stderr, "kernel_launch: occupancy query returned 0\n");
  }
  KArgs p{};
  for (int i = 0; i < 24; ++i) p.in[i] = (const float*)d_in[i];
  p.out = (float*)d_out;
  p.ws = (char*)d_ws;
  (void)hipMemsetAsync((char*)d_ws + OFF_BAR, 0, 512 + 8192, stream);
  int lo = 0, hi = NPHASE;
  void* args[] = {&p, &lo, &hi};
  hipError_t e = hipLaunchCooperativeKernel((void*)mega, dim3(grid_blocks), dim3(512), args, 0, stream);
  if (e != hipSuccess) fprintf(stderr, "cooperative launch failed: %s (grid %d)\n", hipGetErrorString(e), grid_blocks);
}
```

```cpp
#include <hip/hip_runtime.h>
#include <hip/hip_cooperative_groups.h>
#include <cstdio>
#include <cstdint>
namespace cg = cooperative_groups;

typedef unsigned short bf16_t;
typedef short bf16x8 __attribute__((ext_vector_type(8)));
typedef float f32x4 __attribute__((ext_vector_type(4)));
typedef unsigned u32x4 __attribute__((ext_vector_type(4)));
typedef unsigned u32x2 __attribute__((ext_vector_type(2)));
typedef float f32x2v __attribute__((ext_vector_type(2)));
typedef int i32x4 __attribute__((ext_vector_type(4)));
typedef __bf16 bf16x2_t __attribute__((ext_vector_type(2)));

constexpr int DM = 1024, NBATCH = 2, SEQ = 8192, CTXL = 256, DEPTH = 4;
constexpr int NLAT = NBATCH * SEQ;
constexpr int NCTX = NBATCH * CTXL;
constexpr int NTOK = NLAT + NCTX;
constexpr int LKV = CTXL + SEQ;
constexpr int NH = 8;
constexpr int NEXP = 16384;
constexpr float LN_EPS = 1e-5f;
constexpr float ALPHA = 1.6817928305074290f;
constexpr float QSCALE = 0.125f * 1.4426950408889634f;

constexpr size_t al256(size_t x) { return (x + 255) / 256 * 256; }
constexpr size_t SZ_TAB = (size_t)DEPTH * NEXP * DM;
constexpr size_t SZ_QKV = (size_t)NBATCH * NH * LKV * 128 * 2;
constexpr size_t SZ_XS = (size_t)NTOK * DM * 4;
constexpr size_t OFF_U8 = 0;
constexpr size_t OFF_V8 = OFF_U8 + SZ_TAB;
constexpr size_t OFF_Q = OFF_V8 + SZ_TAB;
constexpr size_t OFF_K = OFF_Q + SZ_QKV;
constexpr size_t OFF_V = OFF_K + SZ_QKV;
constexpr size_t OFF_XSA = OFF_V + SZ_QKV;
constexpr size_t OFF_XSB = OFF_XSA + SZ_XS;
constexpr size_t OFF_Z = OFF_XSB + SZ_XS;
constexpr size_t OFF_H = OFF_Z + SZ_XS;
constexpr size_t OFF_HB = OFF_H + (size_t)NTOK * DM * 2;
constexpr size_t OFF_CAT = OFF_HB + (size_t)NTOK * DM * 2;
constexpr size_t OFF_GU = OFF_CAT + (size_t)NTOK * 1536 * 2;
constexpr size_t OFF_GV = OFF_GU + (size_t)NTOK * 512 * 2;
constexpr size_t OFF_M1 = OFF_GV + (size_t)NTOK * 512 * 2;
constexpr size_t OFF_M2 = OFF_M1 + (size_t)NTOK * DM * 2;
constexpr size_t OFF_SC = OFF_M2 + (size_t)NTOK * DM * 2;
constexpr size_t OFF_IDX = OFF_SC;
constexpr size_t OFF_GATE = OFF_IDX + (size_t)NTOK * 128 * 4;
constexpr size_t OFF_WIN = OFF_GATE + (size_t)NTOK * 128 * 4;
constexpr size_t OFF_WOUT = OFF_WIN + (size_t)2 * 4096 * 1024 * 2;
constexpr size_t OFF_PIN = OFF_WOUT + (size_t)2 * 1024 * 1536 * 2;
constexpr size_t OFF_POUT = OFF_PIN + (size_t)2 * 1024 * 1024 * 2;
constexpr size_t OFF_WQK = OFF_POUT + (size_t)2 * 1024 * 1024 * 2;
constexpr size_t OFF_MOD = OFF_WQK + (size_t)4 * 2048 * 1024 * 2;
constexpr size_t OFF_MODP = OFF_MOD + al256((size_t)4 * 3 * 6144 * 4);
constexpr size_t OFF_ROPE = OFF_MODP + al256((size_t)2 * 4 * 3 * 6144 * 4);
constexpr size_t OFF_LAM = OFF_ROPE + al256((size_t)128 * 16 * 2 * 4);
constexpr size_t OFF_PART = OFF_LAM + 256;
constexpr size_t OFF_PW = OFF_PART + (size_t)NTOK * 8 * 128 * 4;
constexpr size_t OFF_H8 = OFF_PW + (size_t)NTOK * 128 * 4;
constexpr size_t OFF_HSC = OFF_H8 + (size_t)NTOK * DM;
constexpr size_t OFF_USC = OFF_HSC + al256((size_t)NTOK * 4);
constexpr size_t OFF_VSC = OFF_USC + (size_t)DEPTH * NEXP * 4;
constexpr size_t OFF_W8 = OFF_VSC + (size_t)DEPTH * NEXP * 4;
constexpr size_t OFF_WSC = OFF_W8 + (size_t)NTOK * 128;
constexpr size_t OFF_IDX16 = OFF_WSC + al256((size_t)NTOK * 4);
constexpr size_t OFF_WQK8 = OFF_IDX16 + (size_t)NTOK * 128 * 2;
constexpr size_t OFF_WQSC = OFF_WQK8 + (size_t)DEPTH * 2048 * 1024;
constexpr size_t OFF_PIN8 = OFF_WQSC + (size_t)DEPTH * 2048 * 4;
constexpr size_t OFF_PINSC = OFF_PIN8 + (size_t)2 * 1024 * 1024;
constexpr size_t OFF_LNST = OFF_PINSC + (size_t)2 * 1024 * 4;
constexpr size_t OFF_WIN8 = OFF_LNST + al256((size_t)NTOK * 8);
constexpr size_t OFF_WINSC = OFF_WIN8 + (size_t)2 * 4096 * 1024;
constexpr size_t OFF_BAR = OFF_WINSC + (size_t)2 * 4096 * 4;
constexpr size_t WS_END = OFF_BAR + 512 + 8192;

struct KArgs {
  const float* in[24];
  float* out;
  char* ws;
};
struct Params {
  const float* const* in;
  float* out;
  char* ws;
};
enum { IN_x, IN_c, IN_ctx, IN_c_ctx, IN_ada_w, IN_ada_b, IN_ln_g, IN_ln_b, IN_ab_w_in, IN_ab_w_out, IN_diff_lam, IN_diff_norm_g, IN_sgu_ln_g, IN_sgu_ln_b,
       IN_sgu_w, IN_sgu_b, IN_pool_w_in, IN_pool_w_grp, IN_pool_scale, IN_pool_w_out, IN_peer_wq, IN_peer_keys, IN_peer_u, IN_peer_v };
#define AS_GLOBAL(T, ptr) ((T)(__attribute__((address_space(1))) char*)(char*)(ptr))
#define PIN(p, name) AS_GLOBAL(const float*, (p).in[IN_##name])

constexpr int LDS_BYTES = 144 * 1024;

__device__ __forceinline__ int make_tid(int swid) {
  int t;
  asm volatile("v_mbcnt_lo_u32_b32 %0, -1, 0\n\tv_mbcnt_hi_u32_b32 %0, -1, %0" : "=v"(t));
  return (swid << 6) | t;
}
__device__ __forceinline__ int lbid() { int b = blockIdx.x; asm volatile("" : "+s"(b)); return b; }
__device__ __forceinline__ bf16_t f2bf(float f) {
  unsigned u = __float_as_uint(f);
  u += 0x7fffu + ((u >> 16) & 1u);
  return (bf16_t)(u >> 16);
}
__device__ __forceinline__ float bf2f(bf16_t b) { return __uint_as_float(((unsigned)b) << 16); }
__device__ __forceinline__ unsigned pk2(float lo, float hi) { return (unsigned)f2bf(lo) | ((unsigned)f2bf(hi) << 16); }
typedef _Float16 f16x8 __attribute__((ext_vector_type(8)));
typedef _Float16 f16x2 __attribute__((ext_vector_type(2)));
__device__ __forceinline__ unsigned pk2h(float lo, float hi) { const f16x2 v = {(_Float16)lo, (_Float16)hi}; return __builtin_bit_cast(unsigned, v); }
__device__ __forceinline__ float hlo(unsigned w) { return (float)__builtin_bit_cast(f16x2, w)[0]; }
__device__ __forceinline__ float hhi(unsigned w) { return (float)__builtin_bit_cast(f16x2, w)[1]; }
typedef _Float16 hstream_t;
__device__ __forceinline__ f32x4 ld4h(const hstream_t* p) { const u32x2 w = *(const u32x2*)p; return (f32x4){hlo(w[0]), hhi(w[0]), hlo(w[1]), hhi(w[1])}; }
__device__ __forceinline__ void st4h(hstream_t* p, f32x4 v) { *(u32x2*)p = (u32x2){pk2h(v[0], v[1]), pk2h(v[2], v[3])}; }
__device__ __forceinline__ bf16_t f2h(float f) { return __builtin_bit_cast(unsigned short, (_Float16)f); }
__device__ __forceinline__ float h2f(bf16_t b) { return (float)__builtin_bit_cast(_Float16, b); }
__device__ __forceinline__ float bflo(unsigned w) { return __uint_as_float(w << 16); }
__device__ __forceinline__ float bfhi(unsigned w) { return __uint_as_float(w & 0xffff0000u); }
__device__ __forceinline__ float gelu_tanh(float x) {
  const float u = 0.7978845608028654f * (x + 0.044715f * x * x * x);
  return x / (1.0f + __expf(-2.0f * u));
}
__device__ __forceinline__ float dot2bf(unsigned a, unsigned b, float c) {
  return __builtin_amdgcn_fdot2_f32_bf16(__builtin_bit_cast(bf16x2_t, a), __builtin_bit_cast(bf16x2_t, b), c, false);
}
__device__ __forceinline__ float shx_f(float v, int mask, int lane) { return __int_as_float(__builtin_amdgcn_ds_bpermute((lane ^ mask) << 2, __float_as_int(v))); }
__device__ __forceinline__ int shx_i(int v, int mask, int lane) { return __builtin_amdgcn_ds_bpermute((lane ^ mask) << 2, v); }
__device__ __forceinline__ float shl_f(float v, int src) { return __int_as_float(__builtin_amdgcn_ds_bpermute(src << 2, __float_as_int(v))); }
__device__ __forceinline__ float wave_sum(float v, int  ) {
#define DPP_ADD(ctrl, rmask) v += __int_as_float(__builtin_amdgcn_update_dpp(0, __float_as_int(v), ctrl, rmask, 0xf, false))
  DPP_ADD(0xB1, 0xf);
  DPP_ADD(0x4E, 0xf);
  DPP_ADD(0x141, 0xf);
  DPP_ADD(0x140, 0xf);
  DPP_ADD(0x142, 0xa);
  DPP_ADD(0x143, 0xc);
#undef DPP_ADD
  return __int_as_float(__builtin_amdgcn_readlane(__float_as_int(v), 63));
}
__device__ __forceinline__ float wave_max(float v) {
#define DPP_MAX(ctrl, rmask) v = fmaxf(v, __int_as_float(__builtin_amdgcn_update_dpp(0, __float_as_int(v), ctrl, rmask, 0xf, false)))
  DPP_MAX(0xB1, 0xf); DPP_MAX(0x4E, 0xf); DPP_MAX(0x141, 0xf); DPP_MAX(0x140, 0xf); DPP_MAX(0x142, 0xa); DPP_MAX(0x143, 0xc);
#undef DPP_MAX
  return __int_as_float(__builtin_amdgcn_readlane(__float_as_int(v), 63));
}
__device__ __forceinline__ unsigned pack_i8x4(f32x4 v) {
  const int a = __float2int_rn(v[0]), b = __float2int_rn(v[1]), c = __float2int_rn(v[2]), d = __float2int_rn(v[3]);
  return (unsigned)(a & 255) | ((unsigned)(b & 255) << 8) | ((unsigned)(c & 255) << 16) | ((unsigned)d << 24);
}
__device__ __forceinline__ int who_of_row(int row) { return row < NLAT ? (row >= SEQ ? 1 : 0) : 2; }
__device__ __forceinline__ const float* mod_ptr(const Params& p, int layer, int who, int which) {
  return (const float*)(p.ws + OFF_MOD) + ((size_t)(layer * 3 + who) * 6 + which) * 1024;
}
__device__ __forceinline__ void row_bpos(int row, int& b, int& pos) {
  if (row < NLAT) { b = row >> 13; pos = CTXL + (row & (SEQ - 1)); }
  else { const int r = row - NLAT; b = r >> 8; pos = r & 255; }
}

__device__ __forceinline__ int lds_byte2(int r, int c) {
  int st = (r >> 4) * 2 + (c >> 5), ob = (r & 15) * 64 + (c & 31) * 2;
  return st * 1024 + (ob ^ (((ob >> 9) & 1) << 5));
}
__device__ __forceinline__ void stage_rc2(int b, int& R, int& C) {
  int st = b >> 10, sb = b & 1023, swz = sb ^ (((sb >> 9) & 1) << 5);
  R = (st / 2) * 16 + swz / 64;
  C = (st % 2) * 32 + (swz % 64) / 2;
}
#define WAIT_V0() asm volatile("s_waitcnt vmcnt(0)" ::: "memory")

template <int MODE, int MFR, class Epi>
__device__ __forceinline__ void gemm_tile(const bf16_t* __restrict__ Arow0, const bf16_t* __restrict__ Bcol0, int row0, int pn, int K,
                                          const Epi& epi, char* shm, int tid_) {
  constexpr int BK = 32, TILE_B = 256 * BK * 2, STAGE_B = 2 * TILE_B;
  constexpr int LPS = MFR == 8 ? 4 : 3;
  const int tid = tid_, wid = __builtin_amdgcn_readfirstlane(tid >> 6), lane = tid & 63, wr = wid >> 2, wc = wid & 3, fr = lane & 15, fq = lane >> 4;
  const int sb_ = lane * 16, swz_ = sb_ ^ (((sb_ >> 9) & 1) << 5);
  const int C0 = (swz_ % 64) / 2;
  const int R0b = wid * 16 + swz_ / 64;
  const int R0a = (MFR == 8 ? wid : (wid & 3)) * 16 + swz_ / 64;
  const char* Ab = (const char*)Arow0 + (unsigned)(R0a * K + C0) * 2u;
  const int R0bp = Epi::perm(pn) ? ((R0b & ~63) | (((R0b & 15) >> 2) << 4) | (((R0b >> 4) & 3) << 2) | (R0b & 3)) : R0b;
  const char* Bb = (const char*)Bcol0 + (unsigned)(R0bp * K + C0) * 2u;
  const int ob_ = fr * 64 + fq * 16, frag_swz = ob_ ^ (((ob_ >> 9) & 1) << 5);
  const int a_base = wr * (MFR * 1024) + frag_swz, b_base = wc * 4096 + frag_swz;
  const int nt = K / BK;
  f32x4 acc[MFR][4];
#pragma unroll
  for (int m = 0; m < MFR; ++m)
#pragma unroll
    for (int n = 0; n < 4; ++n) acc[m][n] = (f32x4){0.f, 0.f, 0.f, 0.f};
  typename Epi::template Pre<MFR> pre;
  epi.template preload<MFR>(pre, row0, pn, wr, wc, fr, fq);
#define GLDS_STAGE(buf, kt)                                                                                                               \
  do {                                                                                                                                    \
    if (MFR == 8) {                                                                                                                       \
      _Pragma("unroll") for (int i = 0; i < 2; ++i)                                                                                       \
        __builtin_amdgcn_global_load_lds((const unsigned*)(Ab + (size_t)(i * 128) * K * 2 + (kt) * (BK * 2)),                           \
                                         (unsigned*)(shm + (buf) * STAGE_B + wid * 1024 + i * 8192), 16, 0, 0);                           \
    } else {                                                                                                                              \
      __builtin_amdgcn_global_load_lds((const unsigned*)(Ab + (kt) * (BK * 2)), (unsigned*)(shm + (buf) * STAGE_B + (wid & 3) * 1024), 16, 0, 0); \
    }                                                                                                                                     \
    _Pragma("unroll") for (int i = 0; i < 2; ++i)                                                                                         \
      __builtin_amdgcn_global_load_lds((const unsigned*)(Bb + (size_t)(i * 128) * K * 2 + (kt) * (BK * 2)),                             \
                                       (unsigned*)(shm + (buf) * STAGE_B + TILE_B + wid * 1024 + i * 8192), 16, 0, 0);                    \
  } while (0)
#define RAW_BARRIER() do { asm volatile("s_waitcnt lgkmcnt(0)" ::: "memory"); __builtin_amdgcn_s_barrier(); } while (0)
#define WAIT_2STAGES() do { if (LPS == 4) asm volatile("s_waitcnt vmcnt(8)" ::: "memory"); else asm volatile("s_waitcnt vmcnt(6)" ::: "memory"); } while (0)
#define WAIT_1STAGE() do { if (LPS == 4) asm volatile("s_waitcnt vmcnt(4)" ::: "memory"); else asm volatile("s_waitcnt vmcnt(3)" ::: "memory"); } while (0)
  GLDS_STAGE(0, 0); GLDS_STAGE(1, 1); GLDS_STAGE(2, 2);
  WAIT_2STAGES();
  RAW_BARRIER();
  for (int t = 0; t < nt; ++t) {
    if (t + 3 < nt) GLDS_STAGE((t + 3) & 3, t + 3);
    const char* sa = shm + (t & 3) * STAGE_B;
    const char* sb = sa + TILE_B;
    {
      bf16x8 At[MFR], Bf[4];
#pragma unroll
      for (int m = 0; m < MFR; ++m) At[m] = *(const bf16x8*)(sa + a_base + m * 1024);
#pragma unroll
      for (int n = 0; n < 4; ++n) Bf[n] = *(const bf16x8*)(sb + b_base + n * 1024);
#pragma unroll
      for (int m = 0; m < MFR; ++m)
#pragma unroll
        for (int n = 0; n < 4; ++n) {
          if (MODE == 1) acc[m][n] = __builtin_amdgcn_mfma_f32_16x16x32_f16(__builtin_bit_cast(f16x8, Bf[n]), __builtin_bit_cast(f16x8, At[m]), acc[m][n], 0, 0, 0);
          else if (MODE == 2) acc[m][n] = __builtin_bit_cast(f32x4, __builtin_amdgcn_mfma_i32_16x16x64_i8(__builtin_bit_cast(i32x4, Bf[n]), __builtin_bit_cast(i32x4, At[m]),
                                                                                                         __builtin_bit_cast(i32x4, acc[m][n]), 0, 0, 0));
          else acc[m][n] = __builtin_amdgcn_mfma_f32_16x16x32_bf16(Bf[n], At[m], acc[m][n], 0, 0, 0);
        }
    }
    if (t + 3 < nt) WAIT_2STAGES();
    else if (t + 2 < nt) WAIT_1STAGE();
    else asm volatile("s_waitcnt vmcnt(0)" ::: "memory");
    RAW_BARRIER();
  }
#undef GLDS_STAGE
#undef RAW_BARRIER
#undef WAIT_2STAGES
#undef WAIT_1STAGE
  if (MODE == 2) {
#pragma unroll
    for (int m = 0; m < MFR; ++m)
#pragma unroll
      for (int n = 0; n < 4; ++n)
#pragma unroll
        for (int j = 0; j < 4; ++j) acc[m][n][j] = (float)__float_as_int(acc[m][n][j]);
  }
  epi.template run<MFR>(acc, pre, row0, pn, wr, wc, fr, fq, shm, tid_);
}

template <int MODE = 0, class Epi>
__device__ __forceinline__ void gemm_phase(const bf16_t* __restrict__ A, const bf16_t* __restrict__ Bt, int mt_big, int small_rows, int ntiles, int K,
                                           const Epi& epi, char* shm, int tid_) {
  const int nu_big = ((mt_big + 7) >> 3) * ntiles * 8, nu_small = (small_rows >> 6) * ntiles;
  int u = lbid();
  for (; u < nu_big; u += gridDim.x) {
    const int xcd = u & 7, v = u >> 3;
    const int pn = v % ntiles, pm = (v / ntiles) * 8 + xcd;
    if (pm >= mt_big) continue;
    gemm_tile<MODE, 8>(A + (size_t)pm * 256 * K, Bt + (size_t)pn * 256 * K, pm * 256, pn, K, epi, shm, tid_);
  }
  for (; u < nu_big + nu_small; u += gridDim.x) {
    const int w = u - nu_big, pn = w % ntiles, row0 = mt_big * 256 + (w / ntiles) * 64;
    gemm_tile<MODE, 2>(A + (size_t)row0 * K, Bt + (size_t)pn * 256 * K, row0, pn, K, epi, shm, tid_);
  }
}

struct EpiInProj {
  static __device__ __forceinline__ bool perm(int) { return false; }
  bf16_t *Q, *K;
  const float* rs; const float* cs;
  const float* rope;
  unsigned* KMAX;
  template <int MFR> struct Pre {};
  template <int MFR> __device__ __forceinline__ void preload(Pre<MFR>&, int, int, int, int, int, int) const {}
  template <int MFR>
  __device__ __forceinline__ void run(const f32x4 (&acc)[MFR][4], const Pre<MFR>&, int row0, int pn, int wr, int wc, int fr, int fq, char*, int) const {
    const int region = pn >> 2;
    const int lane = fq * 16 + fr;
    float kn2 = 0.f, kmax2 = 0.f;
    f32x4 csl[4];
#pragma unroll
    for (int n = 0; n < 4; ++n) csl[n] = *(const f32x4*)(cs + pn * 256 + wc * 64 + n * 16 + fq * 4);
#pragma unroll
    for (int m = 0; m < MFR; ++m) {
      const int row = row0 + wr * (16 * MFR) + m * 16 + fr;
      int b, pos;
      row_bpos(row, b, pos);
      const float rsm = rs[row];
      if (region <= 1) {
        bf16_t* dst = region == 0 ? Q : K;
        const int head = (pn & 3) * 2 + (wc >> 1), msub = wc & 1;
        bf16_t* rp = dst + ((size_t)(b * NH + head) * LKV + pos) * 128 + msub * 64;
        const bool lat = row < NLAT;
        const int t = row & (SEQ - 1);
        const int prow = t >> 6, pcol = t & 63;
#pragma unroll
        for (int n = 0; n < 2; ++n) {
          float oa[4], ob[4];
          if (n == 0) kn2 = 0.f;
          const int pp = (n == 0) ? prow : pcol;
          const f32x4 r0 = lat ? *(const f32x4*)(rope + (pp * 16 + fq * 4) * 2) : (f32x4){1.f, 0.f, 1.f, 0.f};
          const f32x4 r1 = lat ? *(const f32x4*)(rope + (pp * 16 + fq * 4) * 2 + 4) : (f32x4){1.f, 0.f, 1.f, 0.f};
          const float csv[4] = {r0[0], r0[2], r1[0], r1[2]}, snv[4] = {r0[1], r0[3], r1[1], r1[3]};
#pragma unroll
          for (int j = 0; j < 4; ++j) {
            const float a = acc[m][n][j] * (rsm * csl[n][j]), bb = acc[m][n + 2][j] * (rsm * csl[n + 2][j]);
            oa[j] = a * csv[j] - bb * snv[j];
            ob[j] = a * snv[j] + bb * csv[j];
          }
          if (region == 0) {
#pragma unroll
            for (int j = 0; j < 4; ++j) { oa[j] *= QSCALE; ob[j] *= QSCALE; }
          } else {
#pragma unroll
            for (int j = 0; j < 4; ++j) kn2 += oa[j] * oa[j] + ob[j] * ob[j];
          }
          u32x2 wa = {pk2(oa[0], oa[1]), pk2(oa[2], oa[3])};
          u32x2 wb = {pk2(ob[0], ob[1]), pk2(ob[2], ob[3])};
          *(u32x2*)(rp + n * 16 + fq * 4) = wa;
          *(u32x2*)(rp + 32 + n * 16 + fq * 4) = wb;
        }
        if (region == 1) {
          kn2 += shx_f(kn2, 16, lane); kn2 += shx_f(kn2, 32, lane);
          kmax2 = fmaxf(kmax2, kn2);
        }
      }
      asm volatile("" ::: "memory");
    }
    if (region == 1) {
#pragma unroll
      for (int o = 1; o < 16; o <<= 1) kmax2 = fmaxf(kmax2, shx_f(kmax2, o, lane));
      if (lane == 0) {
        const int b = row0 < NLAT ? (row0 >> 13) : ((row0 - NLAT) >> 8);
        const int head = (pn & 3) * 2 + (wc >> 1), msub = wc & 1;
        atomicMax(KMAX + (b * NH + head) * 2 + msub, __float_as_uint(kmax2));
      }
    }
  }
};
struct EpiInProjVG {
  static __device__ __forceinline__ bool perm(int) { return true; }
  bf16_t *V, *GU, *GV;
  const float* rs; const float* cs;
  template <int MFR> struct Pre {};
  template <int MFR> __device__ __forceinline__ void preload(Pre<MFR>&, int, int, int, int, int, int) const {}
  template <int MFR>
  __device__ __forceinline__ void run(const f32x4 (&acc)[MFR][4], const Pre<MFR>&, int row0, int pn, int wr, int wc, int fr, int fq, char*, int) const {
    const int region = pn >> 2;
    f32x4 csv[4];
#pragma unroll
    for (int n = 0; n < 4; ++n) csv[n] = *(const f32x4*)(cs + (pn - 8) * 256 + wc * 64 + fq * 16 + n * 4);
#pragma unroll
    for (int m = 0; m < MFR; ++m) {
      const int row = row0 + wr * (16 * MFR) + m * 16 + fr;
      const float r_ = rs[row];
      f32x4 a_[4];
#pragma unroll
      for (int n = 0; n < 4; ++n) a_[n] = acc[m][n] * (csv[n] * r_);
      bf16_t* rp;
      if (region == 2) {
        int b, pos;
        row_bpos(row, b, pos);
        const int head = (pn & 3) * 2 + (wc >> 1);
        rp = V + ((size_t)(b * NH + head) * LKV + pos) * 128 + (wc & 1) * 64 + fq * 16;
      } else {
        const int isv = (pn >> 1) & 1;
        rp = (isv ? GV : GU) + (size_t)row * 512 + (pn & 1) * 256 + wc * 64 + fq * 16;
#pragma unroll
        for (int n = 0; n < 4; ++n)
#pragma unroll
          for (int j = 0; j < 4; ++j) a_[n][j] = gelu_tanh(a_[n][j]);
      }
      const u32x4 w0 = {pk2(a_[0][0], a_[0][1]), pk2(a_[0][2], a_[0][3]), pk2(a_[1][0], a_[1][1]), pk2(a_[1][2], a_[1][3])};
      const u32x4 w1 = {pk2(a_[2][0], a_[2][1]), pk2(a_[2][2], a_[2][3]), pk2(a_[3][0], a_[3][1]), pk2(a_[3][2], a_[3][3])};
      *(u32x4*)rp = w0; *(u32x4*)(rp + 8) = w1;
      asm volatile("" ::: "memory");
    }
  }
};
struct EpiResid {
  static __device__ __forceinline__ bool perm(int) { return true; }
  const hstream_t* XS; hstream_t* Z; const float* modbase;
  int which;
  template <int MFR> struct Pre { u32x4 xs[MFR][2]; };
  template <int MFR> __device__ __forceinline__ void preload(Pre<MFR>& pre, int row0, int pn, int wr, int wc, int fr, int fq) const {
#pragma unroll
    for (int m = 0; m < MFR; ++m) {
      const hstream_t* rp = XS + (size_t)(row0 + wr * (16 * MFR) + m * 16 + fr) * DM + pn * 256 + wc * 64 + fq * 16;
      pre.xs[m][0] = *(const u32x4*)rp; pre.xs[m][1] = *(const u32x4*)(rp + 8);
    }
  }
  template <int MFR>
  __device__ __forceinline__ void run(const f32x4 (&acc)[MFR][4], const Pre<MFR>& pre, int row0, int pn, int wr, int wc, int fr, int fq, char*, int) const {
    const int who = row0 < SEQ ? 0 : (row0 < NLAT ? 1 : 2);
    const int col = pn * 256 + wc * 64 + fq * 16;
    const float* g = modbase + ((size_t)who * 6 + which) * 1024 + col;
    f32x4 gv[4];
#pragma unroll
    for (int n = 0; n < 4; ++n) gv[n] = *(const f32x4*)(g + n * 4);
#pragma unroll
    for (int m = 0; m < MFR; ++m) {
      hstream_t* zp = Z + (size_t)(row0 + wr * (16 * MFR) + m * 16 + fr) * DM + col;
      u32x4 o[2];
#pragma unroll
      for (int n = 0; n < 4; ++n) {
        const unsigned w0 = pre.xs[m][n >> 1][(n & 1) * 2], w1 = pre.xs[m][n >> 1][(n & 1) * 2 + 1];
        const f32x4 xs = {hlo(w0), hhi(w0), hlo(w1), hhi(w1)};
        const f32x4 r = xs * ALPHA + gv[n] * acc[m][n];
        o[n >> 1][(n & 1) * 2] = pk2h(r[0], r[1]); o[n >> 1][(n & 1) * 2 + 1] = pk2h(r[2], r[3]);
      }
      *(u32x4*)zp = o[0]; *(u32x4*)(zp + 8) = o[1];
    }
  }
};
struct EpiBf16Store {
  static __device__ __forceinline__ bool perm(int) { return true; }
  bf16_t* O; int ld; const float* rs; const float* cs;
  template <int MFR> struct Pre {};
  template <int MFR> __device__ __forceinline__ void preload(Pre<MFR>&, int, int, int, int, int, int) const {}
  template <int MFR>
  __device__ __forceinline__ void run(const f32x4 (&acc)[MFR][4], const Pre<MFR>&, int row0, int pn, int wr, int wc, int fr, int fq, char*, int) const {
    f32x4 csv[4];
#pragma unroll
    for (int n = 0; n < 4; ++n) csv[n] = *(const f32x4*)(cs + pn * 256 + wc * 64 + fq * 16 + n * 4);
#pragma unroll
    for (int m = 0; m < MFR; ++m) {
      const int row = row0 + wr * (16 * MFR) + m * 16 + fr;
      bf16_t* rp = O + (size_t)row * ld + pn * 256 + wc * 64 + fq * 16;
      const float r_ = rs[row];
      f32x4 a_[4];
#pragma unroll
      for (int n = 0; n < 4; ++n) a_[n] = acc[m][n] * (csv[n] * r_);
      const u32x4 w0 = {pk2h(a_[0][0], a_[0][1]), pk2h(a_[0][2], a_[0][3]), pk2h(a_[1][0], a_[1][1]), pk2h(a_[1][2], a_[1][3])};
      const u32x4 w1 = {pk2h(a_[2][0], a_[2][1]), pk2h(a_[2][2], a_[2][3]), pk2h(a_[3][0], a_[3][1]), pk2h(a_[3][2], a_[3][3])};
      *(u32x4*)rp = w0; *(u32x4*)(rp + 8) = w1;
    }
  }
};
#define FMX(a, b) __float_as_int(__builtin_fmaxf(__int_as_float(a), __int_as_float(b)))
#define FMN(a, b) __float_as_int(__builtin_fminf(__int_as_float(a), __int_as_float(b)))
#define CE(a, b) do { const int _h = FMX(a, b), _l = FMN(a, b); a = _h; b = _l; } while (0)
#define SORT16(v) do { CE(v[0], v[1]); CE(v[2], v[3]); CE(v[0], v[2]); CE(v[1], v[3]); CE(v[1], v[2]); CE(v[4], v[5]); CE(v[6], v[7]); CE(v[4], v[6]); CE(v[5], v[7]); CE(v[5], v[6]); CE(v[0], v[4]); CE(v[2], v[6]); CE(v[2], v[4]); CE(v[1], v[5]); CE(v[3], v[7]); CE(v[3], v[5]); CE(v[1], v[2]); CE(v[3], v[4]); CE(v[5], v[6]); CE(v[8], v[9]); CE(v[10], v[11]); CE(v[8], v[10]); CE(v[9], v[11]); CE(v[9], v[10]); CE(v[12], v[13]); CE(v[14], v[15]); CE(v[12], v[14]); CE(v[13], v[15]); CE(v[13], v[14]); CE(v[8], v[12]); CE(v[10], v[14]); CE(v[10], v[12]); CE(v[9], v[13]); CE(v[11], v[15]); CE(v[11], v[13]); CE(v[9], v[10]); CE(v[11], v[12]); CE(v[13], v[14]); CE(v[0], v[8]); CE(v[4], v[12]); CE(v[4], v[8]); CE(v[2], v[10]); CE(v[6], v[14]); CE(v[6], v[10]); CE(v[2], v[4]); CE(v[6], v[8]); CE(v[10], v[12]); CE(v[1], v[9]); CE(v[5], v[13]); CE(v[5], v[9]); CE(v[3], v[11]); CE(v[7], v[15]); CE(v[7], v[11]); CE(v[3], v[5]); CE(v[7], v[9]); CE(v[11], v[13]); CE(v[1], v[2]); CE(v[3], v[4]); CE(v[5], v[6]); CE(v[7], v[8]); CE(v[9], v[10]); CE(v[11], v[12]); CE(v[13], v[14]); } while (0)
#define BMERGE16(v) do { CE(v[0], v[8]); CE(v[1], v[9]); CE(v[2], v[10]); CE(v[3], v[11]); CE(v[4], v[12]); CE(v[5], v[13]); CE(v[6], v[14]); CE(v[7], v[15]); CE(v[0], v[4]); CE(v[1], v[5]); CE(v[2], v[6]); CE(v[3], v[7]); CE(v[8], v[12]); CE(v[9], v[13]); CE(v[10], v[14]); CE(v[11], v[15]); CE(v[0], v[2]); CE(v[1], v[3]); CE(v[4], v[6]); CE(v[5], v[7]); CE(v[8], v[10]); CE(v[9], v[11]); CE(v[12], v[14]); CE(v[13], v[15]); CE(v[0], v[1]); CE(v[2], v[3]); CE(v[4], v[5]); CE(v[6], v[7]); CE(v[8], v[9]); CE(v[10], v[11]); CE(v[12], v[13]); CE(v[14], v[15]); } while (0)
#define CAND_CHUNK0 do { T[0] = CK(0, 0); T[1] = CK(0, 1); T[2] = CK(0, 2); T[3] = CK(0, 3); T[4] = CK(0, 4); T[5] = CK(0, 5); T[6] = CK(0, 6); T[7] = CK(0, 7); T[8] = CK(0, 8); T[9] = CK(0, 9); T[10] = CK(0, 10); T[11] = CK(0, 11); T[12] = CK(0, 12); T[13] = CK(0, 13); T[14] = CK(0, 14); T[15] = CK(0, 15); } while (0)
#define CAND_CHUNK1 do { X[0] = CK(1, 0); X[1] = CK(1, 1); X[2] = CK(1, 2); X[3] = CK(1, 3); X[4] = CK(1, 4); X[5] = CK(1, 5); X[6] = CK(1, 6); X[7] = CK(1, 7); X[8] = CK(2, 0); X[9] = CK(2, 1); X[10] = CK(2, 2); X[11] = CK(2, 3); X[12] = CK(2, 4); X[13] = CK(3, 0); X[14] = CK(3, 1); X[15] = CK(3, 2); } while (0)
#define CAND_CHUNK2 do { X[0] = CK(3, 3); X[1] = CK(4, 0); X[2] = CK(4, 1); X[3] = CK(4, 2); X[4] = CK(5, 0); X[5] = CK(5, 1); X[6] = CK(6, 0); X[7] = CK(6, 1); X[8] = CK(7, 0); X[9] = CK(7, 1); X[10] = CK(8, 0); X[11] = CK(9, 0); X[12] = CK(10, 0); X[13] = CK(11, 0); X[14] = CK(12, 0); X[15] = CK(13, 0); } while (0)
#define CAND_CHUNK3 do { X[0] = CK(14, 0); X[1] = CK(15, 0); X[2] = (int)0xFF800000; X[3] = (int)0xFF800000; X[4] = (int)0xFF800000; X[5] = (int)0xFF800000; X[6] = (int)0xFF800000; X[7] = (int)0xFF800000; X[8] = (int)0xFF800000; X[9] = (int)0xFF800000; X[10] = (int)0xFF800000; X[11] = (int)0xFF800000; X[12] = (int)0xFF800000; X[13] = (int)0xFF800000; X[14] = (int)0xFF800000; X[15] = (int)0xFF800000; } while (0)

__device__ __forceinline__ int packkey7(float f, int idx) { return (__float_as_int(f) & ~0x7F) | (127 - idx); }
__device__ __forceinline__ float keyval7(int k) { return __int_as_float(k & ~0x7F); }
__device__ __forceinline__ int packkey8(float f, int pos) { return (__float_as_int(f) & ~0xFF) | (255 - pos); }
__device__ __forceinline__ float keyval8(int k) { return __int_as_float(k & ~0xFF); }
#define LD16(dst, ptr) do { const i32x4 _a = *(const i32x4*)(ptr), _b = *(const i32x4*)((ptr) + 4), _c = *(const i32x4*)((ptr) + 8), _d = *(const i32x4*)((ptr) + 12); \
    dst[0] = _a[0]; dst[1] = _a[1]; dst[2] = _a[2]; dst[3] = _a[3]; dst[4] = _b[0]; dst[5] = _b[1]; dst[6] = _b[2]; dst[7] = _b[3];                                \
    dst[8] = _c[0]; dst[9] = _c[1]; dst[10] = _c[2]; dst[11] = _c[3]; dst[12] = _d[0]; dst[13] = _d[1]; dst[14] = _d[2]; dst[15] = _d[3]; } while (0)
#define ST16(ptr, src) do { *(i32x4*)(ptr) = (i32x4){src[0], src[1], src[2], src[3]}; *(i32x4*)((ptr) + 4) = (i32x4){src[4], src[5], src[6], src[7]};           \
    *(i32x4*)((ptr) + 8) = (i32x4){src[8], src[9], src[10], src[11]}; *(i32x4*)((ptr) + 12) = (i32x4){src[12], src[13], src[14], src[15]}; } while (0)
#define MERGE_TOP16(T, X) do { _Pragma("unroll") for (int _i = 0; _i < 16; ++_i) T[_i] = FMX(T[_i], X[15 - _i]); BMERGE16(T); } while (0)
struct EpiTopK {
  static __device__ __forceinline__ bool perm(int) { return false; }
  int* IDX; float* GATE; unsigned* IDX16;
  const float* rs; const float* cs;
  template <int MFR> struct Pre {};
  template <int MFR> __device__ __forceinline__ void preload(Pre<MFR>&, int, int, int, int, int, int) const {}
  template <int MFR>
  __device__ __forceinline__ void run(const f32x4 (&acc)[MFR][4], const Pre<MFR>&, int row0, int pn, int wr, int wc, int fr, int fq, char* shm, int tid_) const {
    constexpr int LST = 68, BM = 32 * MFR;
    int* lst = (int*)shm;
    const int tid = tid_, lane = tid_ & 63;
    float csl[16];
#pragma unroll
    for (int n = 0; n < 4; ++n) { const f32x4 c4 = *(const f32x4*)(cs + pn * 256 + wc * 64 + n * 16 + fq * 4); csl[n * 4] = c4[0]; csl[n * 4 + 1] = c4[1]; csl[n * 4 + 2] = c4[2]; csl[n * 4 + 3] = c4[3]; }
#pragma unroll
    for (int m = 0; m < MFR; ++m) {
      int T[16], X[16];
      const float hsr = rs[row0 + wr * (16 * MFR) + m * 16 + fr];
#pragma unroll
      for (int n = 0; n < 4; ++n)
#pragma unroll
        for (int j = 0; j < 4; ++j) T[n * 4 + j] = packkey7(acc[m][n][j] * (hsr * csl[n * 4 + j]), (wc & 1) * 64 + n * 16 + fq * 4 + j);
      SORT16(T);
#pragma unroll
      for (int i = 0; i < 16; ++i) { auto rr = __builtin_amdgcn_permlane16_swap(T[i], T[i], false, false); T[i] = rr[0]; X[i] = rr[1]; }
      MERGE_TOP16(T, X);
#pragma unroll
      for (int i = 0; i < 16; ++i) { auto rr = __builtin_amdgcn_permlane32_swap(T[i], T[i], false, false); T[i] = rr[0]; X[i] = rr[1]; }
      MERGE_TOP16(T, X);
      i32x4 w;
#pragma unroll
      for (int q = 0; q < 4; ++q) {
        const int m1 = -(fq & 1), m2 = -((fq >> 1) & 1);
        const int lo_ = (T[q] & ~m1) | (T[4 + q] & m1), hi_ = (T[8 + q] & ~m1) | (T[12 + q] & m1);
        w[q] = (lo_ & ~m2) | (hi_ & m2);
      }
      *(i32x4*)(lst + (wr * (16 * MFR) + m * 16 + fr) * LST + wc * 16 + fq * 4) = w;
    }
    __syncthreads();
    if (tid < 2 * BM) {
      const int row = tid & (BM - 1), pp = tid / BM;
      int T[16], X[16];
      LD16(T, lst + row * LST + pp * 32);
      LD16(X, lst + row * LST + pp * 32 + 16);
      MERGE_TOP16(T, X);
      ST16(lst + row * LST + pp * 32, T);
    }
    __syncthreads();
    if (tid < BM) {
      const int row = tid;
      int T[16], X[16];
      float a[16], b[16];
      LD16(T, lst + row * LST);
      LD16(X, lst + row * LST + 32);
#pragma unroll
      for (int i = 0; i < 16; ++i) { a[i] = keyval7(T[i]); b[i] = keyval7(X[i]); }
#define CK(i, j) packkey8(a[i] + b[j], (i) * 16 + (j))
      CAND_CHUNK0; SORT16(T);
      CAND_CHUNK1; SORT16(X); MERGE_TOP16(T, X);
      CAND_CHUNK2; SORT16(X); MERGE_TOP16(T, X);
      CAND_CHUNK3; SORT16(X); MERGE_TOP16(T, X);
#undef CK
      const float v0 = keyval8(T[0]);
      float e[16], sum = 0.f;
#pragma unroll
      for (int r = 0; r < 16; ++r) { e[r] = __expf(keyval8(T[r]) - v0); sum += e[r]; }
      const float inv = 1.0f / sum;
      const size_t go = ((size_t)pn * NTOK + (size_t)(row0 + row)) * 16;
#pragma unroll
      for (int r = 0; r < 16; ++r) {
        const int pos = 255 - (T[r] & 0xFF);
        const int ia = 127 - (lst[row * LST + (pos >> 4)] & 0x7F), ib = 127 - (lst[row * LST + 32 + (pos & 15)] & 0x7F);
        X[r] = ia * 128 + ib;
        e[r] *= inv;
      }
      {
        const i32x4 h0 = {X[0] | (X[1] << 16), X[2] | (X[3] << 16), X[4] | (X[5] << 16), X[6] | (X[7] << 16)};
        const i32x4 h1 = {X[8] | (X[9] << 16), X[10] | (X[11] << 16), X[12] | (X[13] << 16), X[14] | (X[15] << 16)};
        *(i32x4*)(IDX16 + go / 2) = h0; *(i32x4*)(IDX16 + go / 2 + 4) = h1;
      }
      *(f32x4*)(GATE + go) = (f32x4){e[0], e[1], e[2], e[3]}; *(f32x4*)(GATE + go + 4) = (f32x4){e[4], e[5], e[6], e[7]};
      *(f32x4*)(GATE + go + 8) = (f32x4){e[8], e[9], e[10], e[11]}; *(f32x4*)(GATE + go + 12) = (f32x4){e[12], e[13], e[14], e[15]};
    }
    __syncthreads();
  }
};

__device__ void transpose_unit(const float* __restrict__ W, bf16_t* __restrict__ Wt, int K, int N, int unit, char* shm, int tid_) {
  float* tl = (float*)shm;
  const int ntn = N / 256;
  const int k0 = (unit / ntn) * 64, n0 = (unit % ntn) * 256;
  const int tid = tid_;
#pragma unroll
  for (int i = 0; i < 8; ++i) {
    const int idx = tid + i * 512, r = idx >> 6, c4 = idx & 63;
    *(f32x4*)(tl + r * 260 + 4 * c4) = *(const f32x4*)(W + (size_t)(k0 + r) * N + n0 + 4 * c4);
  }
  __syncthreads();
#pragma unroll
  for (int i = 0; i < 4; ++i) {
    const int idx = tid + i * 512, n = idx & 255, kc = idx >> 8;
    const float* tp = tl + (kc * 8) * 260 + n;
    const u32x4 w = {pk2h(tp[0], tp[260]), pk2h(tp[2 * 260], tp[3 * 260]), pk2h(tp[4 * 260], tp[5 * 260]), pk2h(tp[6 * 260], tp[7 * 260])};
    *(u32x4*)(Wt + (size_t)(n0 + n) * K + k0 + kc * 8) = w;
  }
  __syncthreads();
}

__device__ void foldqk_unit(const Params& p, int unit, char* shm, int tid_) {
  const int l = unit >> 8, hp = (unit >> 4) & 15, ct = unit & 15;
  float* kl = (float*)shm;
  float* wl = kl + 128 * 133;
  const float* keys = PIN(p, peer_keys) + ((size_t)(l * 16 + hp) * 128) * 128;
  const float* wq = PIN(p, peer_wq) + (size_t)l * 1024 * 2048;
  const int tid = tid_;
#pragma unroll
  for (int it = 0; it < 8; ++it) { const int idx = tid + it * 512, k = idx >> 5, d = (idx & 31) * 4; const f32x4 v = *(const f32x4*)(keys + k * 128 + d);
    kl[d * 133 + k] = v[0]; kl[(d + 1) * 133 + k] = v[1]; kl[(d + 2) * 133 + k] = v[2]; kl[(d + 3) * 133 + k] = v[3]; }
#pragma unroll
  for (int it = 0; it < 4; ++it) { const int idx = tid + it * 512, c = idx >> 5, d = (idx & 31) * 4; const f32x4 v = *(const f32x4*)(wq + (size_t)(ct * 64 + c) * 2048 + hp * 128 + d);
    wl[d * 69 + c] = v[0]; wl[(d + 1) * 69 + c] = v[1]; wl[(d + 2) * 69 + c] = v[2]; wl[(d + 3) * 69 + c] = v[3]; }
  __syncthreads();
  const int wid = __builtin_amdgcn_readfirstlane(tid >> 6), ln = tid & 15, lq = (tid & 63) >> 4;
  const int tc = wid & 3, tk0 = (wid >> 2) * 4;
  f32x4 acc[4];
#pragma unroll
  for (int t = 0; t < 4; ++t) acc[t] = (f32x4){0.f, 0.f, 0.f, 0.f};
#pragma unroll 4
  for (int st = 0; st < 32; ++st) {
    const float a = wl[(4 * st + lq) * 69 + 16 * tc + ln];
#pragma unroll
    for (int t = 0; t < 4; ++t) acc[t] = __builtin_amdgcn_mfma_f32_16x16x4f32(a, kl[(4 * st + lq) * 133 + 16 * (tk0 + t) + ln], acc[t], 0, 0, 0);
  }
  bf16_t* outp = (bf16_t*)(p.ws + OFF_WQK) + (size_t)l * 2048 * 1024;
#pragma unroll
  for (int t = 0; t < 4; ++t) {
    u32x2 w = {pk2h(acc[t][0], acc[t][1]), pk2h(acc[t][2], acc[t][3])};
    *(u32x2*)(outp + (size_t)(hp * 128 + 16 * (tk0 + t) + ln) * 1024 + ct * 64 + 16 * tc + 4 * lq) = w;
  }
  __syncthreads();
}
__device__ void foldpool_unit(const Params& p, int unit, char* shm, int tid_) {
  const int j = unit >> 8, g = (unit >> 6) & 3, cit = (unit >> 4) & 3, et = unit & 15;
  float* gl = (float*)shm;
  float* ol = gl + 256 * 69;
  const float* wg = PIN(p, pool_w_grp) + ((size_t)(j * 4 + g) * 256) * 256;
  const float* sc = PIN(p, pool_scale) + (size_t)j * 1024 + g * 256;
  const float* wo = PIN(p, pool_w_out) + ((size_t)j * 1024 + g * 256) * 1024;
  const int tid = tid_;
#pragma unroll
  for (int it = 0; it < 8; ++it) { const int idx = tid + it * 512, r = idx >> 6, m = (idx & 63) * 4; const f32x4 v = *(const f32x4*)(wg + (size_t)(cit * 64 + r) * 256 + m) * *(const f32x4*)(sc + m);
    gl[m * 69 + r] = v[0]; gl[(m + 1) * 69 + r] = v[1]; gl[(m + 2) * 69 + r] = v[2]; gl[(m + 3) * 69 + r] = v[3]; }
#pragma unroll
  for (int it = 0; it < 8; ++it) { const int idx = tid + it * 512, m = idx >> 4, e = (idx & 15) * 4; *(f32x4*)(ol + m * 68 + e) = *(const f32x4*)(wo + (size_t)m * 1024 + et * 64 + e); }
  __syncthreads();
  const int wid = __builtin_amdgcn_readfirstlane(tid >> 6), ln = tid & 15, lq = (tid & 63) >> 4;
  const int tci = wid & 3, te0 = (wid >> 2) * 2;
  f32x4 acc[2] = {{0.f, 0.f, 0.f, 0.f}, {0.f, 0.f, 0.f, 0.f}};
#pragma unroll 4
  for (int st = 0; st < 64; ++st) {
    const float a = gl[(4 * st + lq) * 69 + 16 * tci + ln];
#pragma unroll
    for (int t = 0; t < 2; ++t) acc[t] = __builtin_amdgcn_mfma_f32_16x16x4f32(a, ol[(4 * st + lq) * 68 + 16 * (te0 + t) + ln], acc[t], 0, 0, 0);
  }
  bf16_t* outp = (bf16_t*)(p.ws + OFF_POUT) + (size_t)j * 1024 * 1024;
#pragma unroll
  for (int t = 0; t < 2; ++t) {
    u32x2 w = {pk2h(acc[t][0], acc[t][1]), pk2h(acc[t][2], acc[t][3])};
    *(u32x2*)(outp + (size_t)(et * 64 + 16 * (te0 + t) + ln) * 1024 + g * 256 + cit * 64 + 16 * tci + 4 * lq) = w;
  }
  __syncthreads();
}
__device__ void mod_unit(const Params& p, int unit, char* shm, int tid_) {
  const int l = unit / 48, rem = unit % 48, cgp = rem >> 1, kh = rem & 1;
  float* sv = (float*)shm;
  float* red = sv + 3 * 512;
  const int tid = tid_, lane = tid & 63, ks = __builtin_amdgcn_readfirstlane(tid >> 6);
  for (int idx = tid; idx < 3 * 512; idx += 512) {
    const int w = idx >> 9, k = kh * 512 + (idx & 511);
    const float xv = w < 2 ? PIN(p, c)[w * 1024 + k] : PIN(p, c_ctx)[k];
    sv[idx] = xv / (1.0f + __expf(-xv));
  }
  __syncthreads();
  const float* aw = PIN(p, ada_w) + (size_t)l * 1024 * 6144 + (size_t)(kh * 512 + ks * 64) * 6144 + cgp * 256 + lane * 4;
  f32x4 a0 = {0.f, 0.f, 0.f, 0.f}, a1 = a0, a2 = a0;
#pragma unroll 8
  for (int k = 0; k < 64; ++k) {
    const f32x4 w = *(const f32x4*)(aw + (size_t)k * 6144);
    a0 += w * sv[ks * 64 + k]; a1 += w * sv[512 + ks * 64 + k]; a2 += w * sv[1024 + ks * 64 + k];
  }
  *(f32x4*)(red + (ks * 3 + 0) * 256 + lane * 4) = a0; *(f32x4*)(red + (ks * 3 + 1) * 256 + lane * 4) = a1; *(f32x4*)(red + (ks * 3 + 2) * 256 + lane * 4) = a2;
  __syncthreads();
  for (int idx = tid; idx < 768; idx += 512) {
    const int w = idx >> 8, cc = idx & 255;
    float s = 0.f;
#pragma unroll
    for (int q = 0; q < 8; ++q) s += red[(q * 3 + w) * 256 + cc];
    const int n = cgp * 256 + cc;
    ((float*)(p.ws + OFF_MODP))[((size_t)kh * 12 + l * 3 + w) * 6144 + n] = s;
  }
  __syncthreads();
}

__device__ void phase_prologue_a(const Params& p, char* shm, int tid_) {
  constexpr int U_MOD = 192;
  constexpr int U_TWIN = 2 * 16 * 16, U_TWOUT = 2 * 24 * 4, U_TPIN = 2 * 16 * 4;
  constexpr int U_FQK = 1024, U_FP = 512, U_TAB = 2048, U_MISC = 1;
  constexpr int E0 = U_MOD, E1 = E0 + U_TWIN, E2 = E1 + U_TWOUT, E3 = E2 + U_TPIN, E4 = E3 + U_FQK, E5 = E4 + U_FP, E6 = E5 + U_TAB, E7 = E6 + U_MISC;
  const int bid_ = lbid(), G_ = gridDim.x;
  const bool tab_first = ((bid_ >> 3) & 1) != 0;
  const int nr_ = (E7 + G_ - 1) / G_;
  for (int j = 0; j <= 2 * nr_; ++j) {
    int u;
    if (j == 2 * nr_) { if (bid_ != G_ - 1) break; u = E6; }
    else {
      u = bid_ + (j < nr_ ? j : j - nr_) * G_;
      if (u >= E6 || (u >= E5) != ((j < nr_) == tab_first)) continue;
    }
    if (u < E0) mod_unit(p, u, shm, tid_);
    else if (u < E1) { const int v = u - E0, j = v / (16 * 16), r = v % (16 * 16);
      transpose_unit(PIN(p, ab_w_in) + (size_t)j * 1024 * 4096, (bf16_t*)(p.ws + OFF_WIN) + (size_t)j * 4096 * 1024, 1024, 4096, r, shm, tid_); }
    else if (u < E2) { const int v = u - E1, j = v / (24 * 4), r = v % (24 * 4);
      transpose_unit(PIN(p, ab_w_out) + (size_t)j * 1536 * 1024, (bf16_t*)(p.ws + OFF_WOUT) + (size_t)j * 1024 * 1536, 1536, 1024, r, shm, tid_); }
    else if (u < E3) { const int v = u - E2, j = v / 64, r = v % 64;
      transpose_unit(PIN(p, pool_w_in) + (size_t)j * 1024 * 1024, (bf16_t*)(p.ws + OFF_PIN) + (size_t)j * 1024 * 1024, 1024, 1024, r, shm, tid_); }
    else if (u < E4) foldqk_unit(p, u - E3, shm, tid_);
    else if (u < E5) foldpool_unit(p, u - E4, shm, tid_);
    else if (u < E6) {
      const int v = u - E5;
      const int tb = v >> 10;
      const float* src = tb ? PIN(p, peer_v) : PIN(p, peer_u);
      unsigned char* dst = (unsigned char*)(p.ws + (tb ? OFF_V8 : OFF_U8));
      const int wid = __builtin_amdgcn_readfirstlane(tid_ >> 6), lane = tid_ & 63;
      for (int i0 = 0; i0 < 8; i0 += 4) {
        f32x4 ra[4], rb[4], rc[4], rd[4];
#pragma unroll
        for (int j = 0; j < 4; ++j) {
          const int row = (v & 1023) * 64 + (i0 + j) * 8 + wid;
          const float* rp = src + (size_t)row * DM + lane * 16;
          ra[j] = *(const f32x4*)rp; rb[j] = *(const f32x4*)(rp + 4); rc[j] = *(const f32x4*)(rp + 8); rd[j] = *(const f32x4*)(rp + 12);
        }
#pragma unroll
        for (int j = 0; j < 4; ++j) {
          const int row = (v & 1023) * 64 + (i0 + j) * 8 + wid;
          const int layer = row >> 14, e = row & 16383;
          const f32x4 a = ra[j], b = rb[j], c = rc[j], d = rd[j];
          u32x4 w;
          float mx = 0.f;
#pragma unroll
          for (int q = 0; q < 4; ++q) mx = fmaxf(mx, fmaxf(fmaxf(fabsf(a[q]), fabsf(b[q])), fmaxf(fabsf(c[q]), fabsf(d[q]))));
          mx = wave_max(mx);
          const float inv = mx > 0.f ? 127.0f / mx : 0.f;
          if (lane == 0) ((float*)(p.ws + (tb ? OFF_VSC : OFF_USC)))[row] = mx * (1.0f / 127.0f);
          w[0] = pack_i8x4(a * inv); w[1] = pack_i8x4(b * inv); w[2] = pack_i8x4(c * inv); w[3] = pack_i8x4(d * inv);
          *(u32x4*)(dst + ((size_t)(layer * 8 + (lane >> 3)) * NEXP + e) * 128 + (lane & 7) * 16) = w;
        }
      }
    } else {
      float* rope = (float*)(p.ws + OFF_ROPE);
      for (int idx = tid_; idx < 128 * 16; idx += 512) {
        const int pos = idx >> 4, i = idx & 15;
        const float inv = powf(10000.0f, -(float)i / 16.0f);
        const float ang = (float)pos * inv;
        rope[idx * 2 + 0] = cosf(ang);
        rope[idx * 2 + 1] = sinf(ang);
      }
      if (tid_ < 128) {
        const int j = __builtin_amdgcn_readfirstlane(tid_ >> 6), ln_ = tid_ & 63;
        const float* lv = PIN(p, diff_lam) + (size_t)j * 4 * 64;
        const float s1 = wave_sum(lv[ln_] * lv[64 + ln_], ln_), s2 = wave_sum(lv[128 + ln_] * lv[192 + ln_], ln_);
        if (ln_ == 0) {
          const float lam_init = 0.8f - 0.6f * expf(-0.3f * (float)(2 * j));
          float* lam = (float*)(p.ws + OFF_LAM);
          lam[j * 2 + 0] = expf(s1) - expf(s2) + lam_init;
          lam[j * 2 + 1] = lam_init;
        }
      }
    }
  }
}

__device__ void f16rows_to_i8(const bf16_t* __restrict__ wq, unsigned char* __restrict__ w8, float* __restrict__ wsc, int nrows, int wid, int lane) {
  constexpr int RB = 3;
  const int stride = gridDim.x * 8;
  for (int r0 = lbid() * 8 + wid; r0 < nrows; r0 += RB * stride) {
    u32x4 a[RB], b[RB];
#pragma unroll
    for (int j = 0; j < RB; ++j) {
      const int r = r0 + j * stride < nrows ? r0 + j * stride : r0;
      a[j] = *(const u32x4*)(wq + (size_t)r * 1024 + lane * 16); b[j] = *(const u32x4*)(wq + (size_t)r * 1024 + lane * 16 + 8);
    }
#pragma unroll
    for (int j = 0; j < RB; ++j) {
      const int r = r0 + j * stride;
      if (r >= nrows) continue;
      float v[16];
#pragma unroll
      for (int i = 0; i < 4; ++i) { v[2 * i] = hlo(a[j][i]); v[2 * i + 1] = hhi(a[j][i]); v[8 + 2 * i] = hlo(b[j][i]); v[8 + 2 * i + 1] = hhi(b[j][i]); }
      float mx = 0.f;
#pragma unroll
      for (int i = 0; i < 16; ++i) mx = fmaxf(mx, fabsf(v[i]));
      mx = wave_max(mx);
      const float inv = mx > 0.f ? 127.0f / mx : 0.f;
      u32x4 o;
#pragma unroll
      for (int i = 0; i < 4; ++i) o[i] = pack_i8x4((f32x4){v[4 * i], v[4 * i + 1], v[4 * i + 2], v[4 * i + 3]} * inv);
      *(u32x4*)(w8 + (size_t)r * 1024 + lane * 16) = o;
      if (lane == 0) wsc[r] = mx * (1.0f / 127.0f);
    }
  }
}
__device__ void phase_prologue_b(const Params& p, int tid_) {
  const int wid = __builtin_amdgcn_readfirstlane(tid_ >> 6), lane = tid_ & 63;
  {
    const float* mp = (const float*)(p.ws + OFF_MODP);
    float* md = (float*)(p.ws + OFF_MOD);
    for (int idx = lbid() * 512 + tid_; idx < 12 * 6144; idx += gridDim.x * 512) {
      const int l = idx / (3 * 6144), n = idx % 6144;
      md[idx] = mp[idx] + mp[12 * 6144 + idx] + PIN(p, ada_b)[(size_t)l * 6144 + n];
    }
  }
  f16rows_to_i8((const bf16_t*)(p.ws + OFF_WQK), (unsigned char*)(p.ws + OFF_WQK8), (float*)(p.ws + OFF_WQSC), DEPTH * 2048, wid, lane);
  f16rows_to_i8((const bf16_t*)(p.ws + OFF_WIN), (unsigned char*)(p.ws + OFF_WIN8), (float*)(p.ws + OFF_WINSC), 2 * 4096, wid, lane);
  f16rows_to_i8((const bf16_t*)(p.ws + OFF_PIN), (unsigned char*)(p.ws + OFF_PIN8), (float*)(p.ws + OFF_PINSC), 2 * 1024, wid, lane);
  hstream_t* XS = (hstream_t*)(p.ws + OFF_XSA);
  constexpr int RB = 3;
  const int stride = gridDim.x * 8;
  f32x4 s1v[4], s2v[4];
  int who_cur = -1;
  for (int row0 = lbid() * 8 + wid; row0 < NTOK; row0 += RB * stride) {
    f32x4 v[RB][4];
#pragma unroll
    for (int j = 0; j < RB; ++j) {
      const int row = row0 + j * stride < NTOK ? row0 + j * stride : row0;
      const float* src = row < NLAT ? PIN(p, x) + (size_t)row * DM : PIN(p, ctx) + (size_t)(row - NLAT) * DM;
#pragma unroll
      for (int i = 0; i < 4; ++i) v[j][i] = *(const f32x4*)(src + i * 256 + lane * 4);
    }
#pragma unroll
    for (int j = 0; j < RB; ++j) {
      const int row = row0 + j * stride;
      if (row >= NTOK) continue;
      const int who = who_of_row(row);
      if (who != who_cur) {
        who_cur = who;
        const float* mp0 = (const float*)(p.ws + OFF_MODP) + (size_t)who * 6144;
        const float* mp1 = mp0 + 12 * 6144;
#pragma unroll
        for (int i = 0; i < 4; ++i) {
          const int col = i * 256 + lane * 4;
          s1v[i] = *(const f32x4*)(mp0 + col) + *(const f32x4*)(mp1 + col) + *(const f32x4*)(PIN(p, ada_b) + col);
          s2v[i] = *(const f32x4*)(mp0 + 1024 + col) + *(const f32x4*)(mp1 + 1024 + col) + *(const f32x4*)(PIN(p, ada_b) + 1024 + col) + 1.0f;
        }
      }
      f32x4 hq[4];
      float hmx = 0.f;
#pragma unroll
      for (int i = 0; i < 4; ++i) {
        const int col = i * 256 + lane * 4;
        st4h(XS + (size_t)row * DM + col, v[j][i]);
        const f32x4 h = v[j][i] * s2v[i] + s1v[i];
        hq[i] = h; hmx = fmaxf(hmx, fmaxf(fmaxf(fabsf(h[0]), fabsf(h[1])), fmaxf(fabsf(h[2]), fabsf(h[3]))));
      }
      {
        const float mx = wave_max(hmx), inv = mx > 0.f ? 127.0f / mx : 0.f;
        unsigned char* h8 = (unsigned char*)(p.ws + OFF_H8) + (size_t)row * DM + lane * 4;
#pragma unroll
        for (int i = 0; i < 4; ++i) *(unsigned*)(h8 + i * 256) = pack_i8x4(hq[i] * inv);
        if (lane == 0) ((float*)(p.ws + OFF_HSC))[row] = mx * (1.0f / 127.0f);
      }
    }
  }
}

__device__ void phase_ln(const Params& p, const hstream_t* Zin, hstream_t* XSo, int layer, int lnidx, int nrows, bf16_t* Hout, int mlayer, int msh, int nrows_h, bool final, bool wi8, int tid_) {
  const int wid = __builtin_amdgcn_readfirstlane(tid_ >> 6), lane = tid_ & 63;
  const float* g = PIN(p, ln_g) + (size_t)(layer * 2 + lnidx) * DM;
  const float* bt = PIN(p, ln_b) + (size_t)(layer * 2 + lnidx) * DM;
  constexpr int RB = 3;
  const int stride = gridDim.x * 8;
  f32x4 gg[4], bbv[4], s1v[4], s2v[4];
#pragma unroll
  for (int i = 0; i < 4; ++i) { gg[i] = *(const f32x4*)(g + i * 256 + lane * 4); bbv[i] = *(const f32x4*)(bt + i * 256 + lane * 4); s1v[i] = gg[i]; s2v[i] = gg[i]; }
  int who_cur = -1;
  for (int row0 = lbid() * 8 + wid; row0 < nrows; row0 += RB * stride) {
    f32x4 v[RB][4];
    float s[RB], mu[RB], rstd[RB];
#pragma unroll
    for (int j = 0; j < RB; ++j) {
      const int row = row0 + j * stride < nrows ? row0 + j * stride : row0;
      s[j] = 0.f;
#pragma unroll
      for (int i = 0; i < 4; ++i) v[j][i] = ld4h(Zin + (size_t)row * DM + i * 256 + lane * 4);
    }
#pragma unroll
    for (int j = 0; j < RB; ++j) {
#pragma unroll
      for (int i = 0; i < 4; ++i) s[j] += (v[j][i][0] + v[j][i][1]) + (v[j][i][2] + v[j][i][3]);
    }
#pragma unroll
    for (int j = 0; j < RB; ++j) mu[j] = wave_sum(s[j], lane) * (1.0f / DM);
#pragma unroll
    for (int j = 0; j < RB; ++j) {
      float q = 0.f;
#pragma unroll
      for (int i = 0; i < 4; ++i) { const f32x4 d = v[j][i] - mu[j]; q += (d[0] * d[0] + d[1] * d[1]) + (d[2] * d[2] + d[3] * d[3]); }
      s[j] = q;
    }
#pragma unroll
    for (int j = 0; j < RB; ++j) rstd[j] = rsqrtf(wave_sum(s[j], lane) * (1.0f / DM) + LN_EPS);
#pragma unroll
    for (int j = 0; j < RB; ++j) {
      const int row = row0 + j * stride;
      if (row >= nrows) continue;
      const int who = who_of_row(row);
      if (!final && row < nrows_h && who != who_cur) {
        who_cur = who;
#pragma unroll
        for (int i = 0; i < 4; ++i) { s1v[i] = *(const f32x4*)(mod_ptr(p, mlayer, who, msh) + i * 256 + lane * 4); s2v[i] = *(const f32x4*)(mod_ptr(p, mlayer, who, msh + 1) + i * 256 + lane * 4) + 1.0f; }
      }
      f32x4 hq[4];
      float hmx = 0.f;
#pragma unroll
      for (int i = 0; i < 4; ++i) {
        const int col = i * 256 + lane * 4;
        const f32x4 xo = (v[j][i] - mu[j]) * rstd[j] * gg[i] + bbv[i];
        if (final) { *(f32x4*)(p.out + (size_t)row * DM + col) = xo; }
        else {
          if (XSo != nullptr) st4h(XSo + (size_t)row * DM + col, xo);
          if (row < nrows_h) {
            const f32x4 h = xo * s2v[i] + s1v[i];
            const u32x2 w = {pk2h(h[0], h[1]), pk2h(h[2], h[3])};
            if (Hout != nullptr) *(u32x2*)(Hout + (size_t)row * DM + col) = w;
            hq[i] = h; hmx = fmaxf(hmx, fmaxf(fmaxf(fabsf(h[0]), fabsf(h[1])), fmaxf(fabsf(h[2]), fabsf(h[3]))));
          }
        }
      }
      if (XSo == nullptr && lane == 0) *(f32x2v*)((float*)(p.ws + OFF_LNST) + (size_t)row * 2) = (f32x2v){mu[j], rstd[j]};
      if (wi8 && !final && row < nrows_h) {
        const float mx = wave_max(hmx), inv = mx > 0.f ? 127.0f / mx : 0.f;
        unsigned char* h8 = (unsigned char*)(p.ws + OFF_H8) + (size_t)row * DM + lane * 4;
#pragma unroll
        for (int i = 0; i < 4; ++i) *(unsigned*)(h8 + i * 256) = pack_i8x4(hq[i] * inv);
        if (lane == 0) ((float*)(p.ws + OFF_HSC))[row] = mx * (1.0f / 127.0f);
      }
    }
  }
}

typedef short s16x4 __attribute__((ext_vector_type(4)));
typedef float f32x16 __attribute__((ext_vector_type(16)));
#define KSWZ(row, colB) ((row) * 256 + ((colB) ^ (((row) & 7) << 4)))
#define SBAR() __builtin_amdgcn_sched_barrier(0)
constexpr float ATT_SCALE = 0.125f, ATT_THR = 8.f;
#ifndef ATT_SDEPTH
#define ATT_SDEPTH 1
#endif
constexpr int SHM_KV = 64 * 128 * 2;
__device__ __forceinline__ int crow(int r, int hi) { return (r & 3) + 8 * (r >> 2) + 4 * hi; }
__device__ __forceinline__ unsigned cvtpk(float lo, float hi) {
  unsigned r; asm volatile("v_cvt_pk_bf16_f32 %0, %1, %2" : "=v"(r) : "v"(lo), "v"(hi)); return r;
}
__device__ __forceinline__ void qkt(f32x16& p0, f32x16& p1, const char* Ks, const bf16x8* qr, int r32, int hi, int m, float negM) {
#pragma unroll
  for (int r = 0; r < 16; ++r) { p0[r] = negM; p1[r] = negM; }
  const int cb0 = (m * 64 + hi * 8) * 2;
  bf16x8 b0 = *reinterpret_cast<const bf16x8*>(Ks + KSWZ(r32, cb0));
  bf16x8 b1 = *reinterpret_cast<const bf16x8*>(Ks + KSWZ(32 + r32, cb0));
#pragma unroll
  for (int d0 = 0; d0 < 4; ++d0) {
    bf16x8 n0 = b0, n1 = b1;
    if (d0 < 3) {
      const int cb = (m * 64 + (d0 + 1) * 16 + hi * 8) * 2;
      n0 = *reinterpret_cast<const bf16x8*>(Ks + KSWZ(r32, cb));
      n1 = *reinterpret_cast<const bf16x8*>(Ks + KSWZ(32 + r32, cb));
    }
    __builtin_amdgcn_sched_barrier(0);
    p0 = __builtin_amdgcn_mfma_f32_32x32x16_bf16(b0, qr[d0], p0, 0, 0, 0);
    p1 = __builtin_amdgcn_mfma_f32_32x32x16_bf16(b1, qr[d0], p1, 0, 0, 0);
    b0 = n0; b1 = n1;
  }
}
__device__ __forceinline__ int v_st(int k, int c) { const int kk = (k & ~0xC) | ((k & 4) << 1) | ((k & 8) >> 1); return ((kk >> 3) * 4 + (c >> 5)) * 512 + ((kk & 7) * 32 + (c & 31)) * 2; }
__device__ __forceinline__ int v_rd_base(int lane) { return ((lane & 3) << 3) | (((lane >> 2) & 3) << 6) | (((lane >> 4) & 1) << 5) | (((lane >> 5) & 1) << 8); }
constexpr int v_rd_off(int d0, int ks, int half) { return d0 * 512 + ks * 4096 + half * 2048; }
template <int OFF> __device__ __forceinline__ s16x4 tr_read(int vb) {
  s16x4 r; asm volatile("ds_read_b64_tr_b16 %0, %1 offset:%2" : "=&v"(r) : "v"(vb), "i"(OFF) : "memory"); return r;
}
template <int D0> __device__ __forceinline__ void pv_one(f32x16& od, int vb, bf16x8 pa0, bf16x8 pa1, bf16x8 pa2, bf16x8 pa3) {
  const s16x4 l0 = tr_read<v_rd_off(D0, 0, 0)>(vb), h0 = tr_read<v_rd_off(D0, 0, 1)>(vb), l1 = tr_read<v_rd_off(D0, 1, 0)>(vb), h1 = tr_read<v_rd_off(D0, 1, 1)>(vb);
  const s16x4 l2 = tr_read<v_rd_off(D0, 2, 0)>(vb), h2 = tr_read<v_rd_off(D0, 2, 1)>(vb), l3 = tr_read<v_rd_off(D0, 3, 0)>(vb), h3 = tr_read<v_rd_off(D0, 3, 1)>(vb);
  asm volatile("s_waitcnt lgkmcnt(0)" ::: "memory"); SBAR();
#define PKV(L, H) (bf16x8){L[0], L[1], L[2], L[3], H[0], H[1], H[2], H[3]}
  od = __builtin_amdgcn_mfma_f32_32x32x16_bf16(pa0, PKV(l0, h0), od, 0, 0, 0);
  od = __builtin_amdgcn_mfma_f32_32x32x16_bf16(pa1, PKV(l1, h1), od, 0, 0, 0);
  od = __builtin_amdgcn_mfma_f32_32x32x16_bf16(pa2, PKV(l2, h2), od, 0, 0, 0);
  od = __builtin_amdgcn_mfma_f32_32x32x16_bf16(pa3, PKV(l3, h3), od, 0, 0, 0);
#undef PKV
}
template <int D0> __device__ __forceinline__ void pv_one_t(f32x16& od, int vb, bf16x8 pa0, bf16x8 pa1, bf16x8 pa2, bf16x8 pa3) {
  const s16x4 l0 = tr_read<v_rd_off(D0, 0, 0)>(vb), h0 = tr_read<v_rd_off(D0, 0, 1)>(vb), l1 = tr_read<v_rd_off(D0, 1, 0)>(vb), h1 = tr_read<v_rd_off(D0, 1, 1)>(vb);
  const s16x4 l2 = tr_read<v_rd_off(D0, 2, 0)>(vb), h2 = tr_read<v_rd_off(D0, 2, 1)>(vb), l3 = tr_read<v_rd_off(D0, 3, 0)>(vb), h3 = tr_read<v_rd_off(D0, 3, 1)>(vb);
  asm volatile("s_waitcnt lgkmcnt(0)" ::: "memory"); SBAR();
#define PKV(L, H) (bf16x8){L[0], L[1], L[2], L[3], H[0], H[1], H[2], H[3]}
  od = __builtin_amdgcn_mfma_f32_32x32x16_bf16(PKV(l0, h0), pa0, od, 0, 0, 0);
  od = __builtin_amdgcn_mfma_f32_32x32x16_bf16(PKV(l1, h1), pa1, od, 0, 0, 0);
  od = __builtin_amdgcn_mfma_f32_32x32x16_bf16(PKV(l2, h2), pa2, od, 0, 0, 0);
  od = __builtin_amdgcn_mfma_f32_32x32x16_bf16(PKV(l3, h3), pa3, od, 0, 0, 0);
#undef PKV
}

__device__ __forceinline__ void attn_unit(const bf16_t* __restrict__ Qb, const bf16_t* __restrict__ Kh, const bf16_t* __restrict__ Vh, int seq,
                                          bf16_t* __restrict__ CATp  , const float* __restrict__ ng, float lam, float lam_init,
                                          const unsigned* __restrict__ kmaxp  , char* lds, int tid_) {
  const int tid = tid_, wid = __builtin_amdgcn_readfirstlane(tid >> 6), lane = tid & 63, r32 = lane & 31, hi = lane >> 5;
  const int rg = wid & 3, m = wid >> 2;
  constexpr int SLOT = 2 * SHM_KV;
  float* wsp = (float*)(lds + 4 * SLOT) + wid * 64; float* li_l = wsp;
  float l_reg = 0; f32x16 o[4] = {}; bf16x8 qr[4];
  const bf16_t* Qw = Qb + (size_t)(rg * 32 + r32) * 128 + m * 64 + hi * 8;
#pragma unroll
  for (int d0 = 0; d0 < 4; ++d0) qr[d0] = *reinterpret_cast<const bf16x8*>(Qw + d0 * 16);
  float negM;
  {
    float q2 = 0.f;
#pragma unroll
    for (int d0 = 0; d0 < 4; ++d0)
#pragma unroll
      for (int e = 0; e < 8; ++e) { const float v = bf2f((bf16_t)qr[d0][e]); q2 += v * v; }
    { auto rr = __builtin_amdgcn_permlane32_swap(__float_as_uint(q2), __float_as_uint(q2), false, false); q2 = __uint_as_float(rr[0]) + __uint_as_float(rr[1]); }
    const float k2 = __uint_as_float(kmaxp[m]);
    negM = -1.01f * sqrtf(q2 * k2);
  }
  unsigned vsrc[2], ksrc[2];
#pragma unroll
  for (int j = 0; j < 2; ++j) {
    const int p_ = wid + 8 * j;
    const int g_ = p_ * 64 + lane, sub = g_ >> 5, within = g_ & 31;
    const int kk = (sub >> 2) * 8 + (within >> 2), c_ = (sub & 3) * 32 + (within & 3) * 8;
    const int k_ = (kk & ~0xC) | ((kk & 4) << 1) | ((kk & 8) >> 1);
    vsrc[j] = (unsigned)(k_ * 256 + c_ * 2);
    const int row = p_ * 4 + (lane >> 4), chunk = (lane & 15) ^ (row & 7);
    ksrc[j] = (unsigned)(row * 256 + chunk * 16);
  }
  const int vb0 = (int)(uintptr_t)lds + v_rd_base(lane);
#define SLOAD_DMA(k0, slot) do { \
    const char* _vg = (const char*)(Vh + (size_t)(k0) * 128); const char* _kg = (const char*)(Kh + (size_t)(k0) * 128); char* _b = lds + (slot) * SLOT; \
    __builtin_amdgcn_global_load_lds((const unsigned*)(_vg + vsrc[0]), (unsigned*)(_b + wid * 1024), 16, 0, 0); \
    __builtin_amdgcn_global_load_lds((const unsigned*)(_vg + vsrc[1]), (unsigned*)(_b + (wid + 8) * 1024), 16, 0, 0); \
    __builtin_amdgcn_global_load_lds((const unsigned*)(_kg + ksrc[0]), (unsigned*)(_b + SHM_KV + wid * 1024), 16, 0, 0); \
    __builtin_amdgcn_global_load_lds((const unsigned*)(_kg + ksrc[1]), (unsigned*)(_b + SHM_KV + (wid + 8) * 1024), 16, 0, 0); } while (0)
#define TILE_PUBLISH() do { asm volatile("s_waitcnt vmcnt(0) lgkmcnt(0)" ::: "memory"); __builtin_amdgcn_s_barrier(); asm volatile("" ::: "memory"); } while (0)
#define PKV(L, H) (bf16x8){L[0], L[1], L[2], L[3], H[0], H[1], H[2], H[3]}
#define VRD(D0, KH, vb, f0, f1, f2, f3) do { f0 = tr_read<v_rd_off(D0, 2 * (KH), 0)>(vb); f1 = tr_read<v_rd_off(D0, 2 * (KH), 1)>(vb); \
    f2 = tr_read<v_rd_off(D0, 2 * (KH) + 1, 0)>(vb); f3 = tr_read<v_rd_off(D0, 2 * (KH) + 1, 1)>(vb); } while (0)
#define VMM(D0, qa, qb, f0, f1, f2, f3) do { \
    o[D0] = __builtin_amdgcn_mfma_f32_32x32x16_bf16(qa, PKV(f0, f1), o[D0], 0, 0, 0); \
    o[D0] = __builtin_amdgcn_mfma_f32_32x32x16_bf16(qb, PKV(f2, f3), o[D0], 0, 0, 0); } while (0)
#define LW4() do { asm volatile("s_waitcnt lgkmcnt(4)" ::: "memory"); SBAR(); } while (0)
#define LW0() do { asm volatile("s_waitcnt lgkmcnt(0)" ::: "memory"); SBAR(); } while (0)
#define PV_TILE(vb, q0, q1, q2, q3, C0, C1, C2, C3, C4, C5, C6, C7) do { \
    s16x4 a0, a1, a2, a3; \
    SBAR(); VRD(0, 0, vb, a0, a1, a2, a3); C0; LW0(); VMM(0, q0, q1, a0, a1, a2, a3); SBAR(); \
    VRD(0, 1, vb, a0, a1, a2, a3); C1; LW0(); VMM(0, q2, q3, a0, a1, a2, a3); SBAR(); \
    VRD(1, 0, vb, a0, a1, a2, a3); C2; LW0(); VMM(1, q0, q1, a0, a1, a2, a3); SBAR(); \
    VRD(1, 1, vb, a0, a1, a2, a3); C3; LW0(); VMM(1, q2, q3, a0, a1, a2, a3); SBAR(); \
    VRD(2, 0, vb, a0, a1, a2, a3); C4; LW0(); VMM(2, q0, q1, a0, a1, a2, a3); SBAR(); \
    VRD(2, 1, vb, a0, a1, a2, a3); C5; LW0(); VMM(2, q2, q3, a0, a1, a2, a3); SBAR(); \
    VRD(3, 0, vb, a0, a1, a2, a3); C6; LW0(); VMM(3, q0, q1, a0, a1, a2, a3); SBAR(); \
    VRD(3, 1, vb, a0, a1, a2, a3); C7; LW0(); VMM(3, q2, q3, a0, a1, a2, a3); SBAR(); } while (0)
#define PK4(P, BASE, OUT) do { unsigned a0 = cvtpk(P[BASE + 0], P[BASE + 1]), a1 = cvtpk(P[BASE + 2], P[BASE + 3]);   \
    unsigned b0 = cvtpk(P[BASE + 4], P[BASE + 5]), b1 = cvtpk(P[BASE + 6], P[BASE + 7]);                              \
    auto r0 = __builtin_amdgcn_permlane32_swap(a0, b0, false, false); auto r1 = __builtin_amdgcn_permlane32_swap(a1, b1, false, false); \
    u32x4 w = {r0[0], r1[0], r0[1], r1[1]}; OUT = *reinterpret_cast<bf16x8*>(&w); } while (0)
#define E1(S0) do { _Pragma("unroll") for (int r = 0; r < 16; ++r) S0[r] = __builtin_amdgcn_exp2f(S0[r]); } while (0)
#define E1H(S0, H) do { _Pragma("unroll") for (int r = 8 * (H); r < 8 * (H) + 8; ++r) S0[r] = __builtin_amdgcn_exp2f(S0[r]); } while (0)
#define E3(S0, S1) do { float ps = 0; _Pragma("unroll") for (int r = 0; r < 16; ++r) ps += S0[r]; _Pragma("unroll") for (int r = 0; r < 16; ++r) ps += S1[r]; l_reg += ps; } while (0)
#define E3H(S0) do { float ps = 0; _Pragma("unroll") for (int r = 0; r < 16; ++r) ps += S0[r]; l_reg += ps; } while (0)
#define E4(S0, S1, n0, n1, n2, n3) do { PK4(S0, 0, n0); PK4(S0, 8, n1); PK4(S1, 0, n2); PK4(S1, 8, n3); } while (0)
#define E4A(S0, n0, n1) do { PK4(S0, 0, n0); PK4(S0, 8, n1); } while (0)
#define E4B(S1, n2, n3) do { PK4(S1, 0, n2); PK4(S1, 8, n3); } while (0)
#define ITER(SN0, SN1, ks, SP0, SP1, vs) do { \
    const int _vb = vb0 + (vs) * SLOT; \
    PV_TILE(_vb, p0, p1, p2, p3, E1H(SP0, 0), E1H(SP0, 1), E1H(SP1, 0), E1H(SP1, 1), E3H(SP0), E3H(SP1), (void)0, E4A(SP0, p0, p1)); \
    qkt(SN0, SN1, lds + (ks) * SLOT + SHM_KV, qr, r32, hi, m, negM); \
    E4B(SP1, p2, p3); SBAR(); } while (0)
  f32x16 sA0, sA1, sB0, sB1; bf16x8 p0, p1, p2, p3; const int NT = seq / 64;
  SLOAD_DMA(0, 0); TILE_PUBLISH();
  SLOAD_DMA(64, 1);
  qkt(sA0, sA1, lds + SHM_KV, qr, r32, hi, m, negM);
  TILE_PUBLISH();
  if (2 < NT) SLOAD_DMA(2 * 64, 2);
  qkt(sB0, sB1, lds + SLOT + SHM_KV, qr, r32, hi, m, negM);
  E1(sA0); E1(sA1); E3(sA0, sA1); E4(sA0, sA1, p0, p1, p2, p3);
  TILE_PUBLISH();
  for (int i = 2; i < NT; i += 2) {
    SLOAD_DMA((i + 1) * 64, (i + 1) & 3);
    ITER(sA0, sA1, i & 3, sB0, sB1, (i - 2) & 3);
    TILE_PUBLISH();
    if (i + 2 < NT) SLOAD_DMA((i + 2) * 64, (i + 2) & 3);
    ITER(sB0, sB1, (i + 1) & 3, sA0, sA1, (i - 1) & 3);
    TILE_PUBLISH();
  }
  {
    const int _vb = vb0 + ((NT - 2) & 3) * SLOT;
    PV_TILE(_vb, p0, p1, p2, p3, E1H(sB0, 0), E1H(sB0, 1), E1H(sB1, 0), E1H(sB1, 1), E3H(sB0), E3H(sB1), (void)0, (void)0);
    E4(sB0, sB1, p0, p1, p2, p3); SBAR();
    const int _vb2 = vb0 + ((NT - 1) & 3) * SLOT;
    PV_TILE(_vb2, p0, p1, p2, p3, (void)0, (void)0, (void)0, (void)0, (void)0, (void)0, (void)0, (void)0);
  }
#undef SLOAD_DMA
#undef TILE_PUBLISH
#undef PKV
#undef PV_TILE
#undef VRD
#undef VMM
#undef LW4
#undef LW0
#undef PK4
#undef E1
#undef E1H
#undef E3H
#undef E3
#undef E4
#undef E4A
#undef E4B
#undef ITER
  int r32e = r32, hie = hi;
  asm volatile("" : "+v"(r32e), "+v"(hie));
  { auto rr = __builtin_amdgcn_permlane32_swap(__float_as_uint(l_reg), __float_as_uint(l_reg), false, false); l_reg = __uint_as_float(rr[0]) + __uint_as_float(rr[1]); }
  if (hie == 0) li_l[r32e] = l_reg;
  asm volatile("s_waitcnt lgkmcnt(0)" ::: "memory");
  float rli[16];
#pragma unroll
  for (int r = 0; r < 16; ++r) rli[r] = __builtin_amdgcn_rcpf(li_l[crow(r, hie)]);
  __syncthreads();
  float* comb = (float*)lds;
  if (m == 1) {
#pragma unroll
    for (int r = 0; r < 16; ++r)
#pragma unroll
      for (int d0 = 0; d0 < 4; ++d0) comb[(rg * 32 + crow(r, hie)) * 128 + d0 * 32 + r32e] = o[d0][r] * rli[r] * lam;
  }
  __syncthreads();
  if (m == 0) {
    float ss[16];
#pragma unroll
    for (int r = 0; r < 16; ++r) {
      float a = 0.f;
#pragma unroll
      for (int d0 = 0; d0 < 4; ++d0) {
        const float v = o[d0][r] * rli[r] - comb[(rg * 32 + crow(r, hie)) * 128 + d0 * 32 + r32e];
        o[d0][r] = v; a += v * v;
      }
      ss[r] = a;
    }
#pragma unroll
    for (int off = 1; off < 32; off <<= 1)
#pragma unroll
      for (int r = 0; r < 16; ++r) ss[r] += shx_f(ss[r], off, lane);
    const float om = 1.0f - lam_init;
    float gq[4];
#pragma unroll
    for (int d0 = 0; d0 < 4; ++d0) gq[d0] = ng[d0 * 32 + r32e] * om;
#pragma unroll
    for (int r = 0; r < 16; ++r) {
      const float rs = rsqrtf(ss[r] * (1.0f / 128.0f) + LN_EPS);
      bf16_t* cp = CATp + (size_t)(rg * 32 + crow(r, hie)) * 1536;
#pragma unroll
      for (int d0 = 0; d0 < 4; ++d0) cp[d0 * 32 + r32e] = f2h(o[d0][r] * rs * gq[d0]);
    }
  }
  __syncthreads();
}

__device__ __forceinline__ void sgu_unit(const Params& p, int chunk, int jl, char* lds, int tid_) {
  const int tid = tid_, wid = __builtin_amdgcn_readfirstlane(tid >> 6), lane = tid & 63, r32 = lane & 31, hi = lane >> 5;
  const int row0 = chunk * 128;
  const bf16_t* GV = (const bf16_t*)(p.ws + OFF_GV);
  const bf16_t* GU = (const bf16_t*)(p.ws + OFF_GU);
  bf16_t* CAT = (bf16_t*)(p.ws + OFF_CAT);
  const float* lg = PIN(p, sgu_ln_g) + (size_t)jl * 512;
  const float* lb = PIN(p, sgu_ln_b) + (size_t)jl * 512;
  {
    const f32x4 g0 = *(const f32x4*)(lg + lane * 8), g1 = *(const f32x4*)(lg + lane * 8 + 4);
    const f32x4 b0 = *(const f32x4*)(lb + lane * 8), b1 = *(const f32x4*)(lb + lane * 8 + 4);
    const int c = lane * 8, g = c >> 7, cg = c & 127;
    for (int qb = wid; qb < 128; qb += 32) {
      u32x4 w[4];
      float v[4][8], mu[4], rstd[4], sq[4];
#pragma unroll
      for (int j = 0; j < 4; ++j) w[j] = *(const u32x4*)(GV + (size_t)(row0 + qb + 8 * j) * 512 + c);
#pragma unroll
      for (int j = 0; j < 4; ++j) {
#pragma unroll
        for (int i = 0; i < 4; ++i) { v[j][2 * i] = bflo(w[j][i]); v[j][2 * i + 1] = bfhi(w[j][i]); }
        float s = 0.f;
#pragma unroll
        for (int i = 0; i < 8; ++i) s += v[j][i];
        sq[j] = s;
      }
#pragma unroll
      for (int j = 0; j < 4; ++j) mu[j] = wave_sum(sq[j], lane) * (1.0f / 512.0f);
#pragma unroll
      for (int j = 0; j < 4; ++j) {
        float qq = 0.f;
#pragma unroll
        for (int i = 0; i < 8; ++i) { const float d = v[j][i] - mu[j]; qq += d * d; }
        sq[j] = qq;
      }
#pragma unroll
      for (int j = 0; j < 4; ++j) rstd[j] = rsqrtf(wave_sum(sq[j], lane) * (1.0f / 512.0f) + LN_EPS);
#pragma unroll
      for (int j = 0; j < 4; ++j) {
        const int q = qb + 8 * j;
        u32x4 ow;
        ow[0] = pk2((v[j][0] - mu[j]) * rstd[j] * g0[0] + b0[0], (v[j][1] - mu[j]) * rstd[j] * g0[1] + b0[1]);
        ow[1] = pk2((v[j][2] - mu[j]) * rstd[j] * g0[2] + b0[2], (v[j][3] - mu[j]) * rstd[j] * g0[3] + b0[3]);
        ow[2] = pk2((v[j][4] - mu[j]) * rstd[j] * g1[0] + b1[0], (v[j][5] - mu[j]) * rstd[j] * g1[1] + b1[1]);
        ow[3] = pk2((v[j][6] - mu[j]) * rstd[j] * g1[2] + b1[2], (v[j][7] - mu[j]) * rstd[j] * g1[3] + b1[3]);
        *(u32x4*)(lds + (g * 2 + (q >> 6)) * SHM_KV + v_st(q & 63, cg)) = ow;
      }
    }
  }
  __syncthreads();
  const int pg = wid & 3, ch = wid >> 2;
  const int vbase = (int)(uintptr_t)lds + v_rd_base(lane);
  for (int g = 0; g < 4; ++g) {
    const float* Wg = PIN(p, sgu_w) + ((size_t)(jl * 4 + g) * 128) * 128;
    bf16x8 af[8];
#pragma unroll
    for (int ks = 0; ks < 8; ++ks) {
      const float* wp = Wg + (size_t)(pg * 32 + r32) * 128 + ks * 16 + hi * 8;
      const f32x4 a = *(const f32x4*)wp, b = *(const f32x4*)(wp + 4);
      u32x4 w = {pk2(a[0], a[1]), pk2(a[2], a[3]), pk2(b[0], b[1]), pk2(b[2], b[3])};
      af[ks] = *reinterpret_cast<bf16x8*>(&w);
    }
    f32x16 acc[2] = {};
#pragma unroll
    for (int kt = 0; kt < 2; ++kt) {
      const int vb = vbase + (g * 2 + kt) * SHM_KV;
      if (ch == 0) { pv_one_t<0>(acc[0], vb, af[kt * 4 + 0], af[kt * 4 + 1], af[kt * 4 + 2], af[kt * 4 + 3]); pv_one_t<1>(acc[1], vb, af[kt * 4 + 0], af[kt * 4 + 1], af[kt * 4 + 2], af[kt * 4 + 3]); }
      else         { pv_one_t<2>(acc[0], vb, af[kt * 4 + 0], af[kt * 4 + 1], af[kt * 4 + 2], af[kt * 4 + 3]); pv_one_t<3>(acc[1], vb, af[kt * 4 + 0], af[kt * 4 + 1], af[kt * 4 + 2], af[kt * 4 + 3]); }
    }
    const int pp = pg * 32 + r32;
    const float bb = (PIN(p, sgu_b) + (size_t)(jl * 4 + g) * 128)[pp];
    const bf16_t* gup = GU + (size_t)(row0 + pp) * 512 + g * 128 + ch * 64 + 4 * hi;
    bf16_t* cap = CAT + (size_t)(row0 + pp) * 1536 + 1024 + g * 128 + ch * 64 + 4 * hi;
#pragma unroll
    for (int dd = 0; dd < 2; ++dd)
#pragma unroll
      for (int q = 0; q < 4; ++q) {
        const u32x2 uw = *(const u32x2*)(gup + dd * 32 + q * 8);
        const float s0 = acc[dd][4 * q] + bb, s1 = acc[dd][4 * q + 1] + bb, s2 = acc[dd][4 * q + 2] + bb, s3 = acc[dd][4 * q + 3] + bb;
        u32x2 ow = {pk2h(bflo(uw[0]) * s0, bfhi(uw[0]) * s1), pk2h(bflo(uw[1]) * s2, bfhi(uw[1]) * s3)};
        *(u32x2*)(cap + dd * 32 + q * 8) = ow;
      }
  }
  __syncthreads();
}

__device__ void phase_mixer_fast(const Params& p, int layer, char* shm, int tid_) {
  const int jl = layer >> 1;
  const bool ctxq = layer == 0;
  const float lam = ((const float*)(p.ws + OFF_LAM))[jl * 2 + 0];
  const float lam_init = ((const float*)(p.ws + OFF_LAM))[jl * 2 + 1];
  const float* ng = PIN(p, diff_norm_g) + (size_t)jl * 128;
  const bf16_t* Q = (const bf16_t*)(p.ws + OFF_Q);
  const bf16_t* K = (const bf16_t*)(p.ws + OFF_K);
  const bf16_t* V = (const bf16_t*)(p.ws + OFF_V);
  bf16_t* CAT = (bf16_t*)(p.ws + OFF_CAT);
  const int bid = lbid();
  const int NC = ctxq ? 32 : 0;
  const int NS = ctxq ? (NTOK / 128) : (NLAT / 128);
  for (int u = bid; u < 1024 + NC + NS; u += gridDim.x) {
    if (u < 1024 + NC) {
      int bh, pos0, seq, orow;
      if (u < 1024) {
        const int xcd = u & 7, ul = (u >> 8) * 32 + ((u & 255) >> 3), qb = ul & 63;
        bh = xcd * 2 + (ul >> 6);
        pos0 = CTXL + qb * 128; seq = LKV; orow = (bh >> 3) * SEQ + qb * 128;
      } else {
        const int v = u - 1024, qb = v & 1;
        bh = v >> 1;
        pos0 = qb * 128; seq = CTXL; orow = NLAT + (bh >> 3) * CTXL + qb * 128;
      }
      const size_t hb = (size_t)bh * LKV * 128;
      attn_unit(Q + hb + (size_t)pos0 * 128, K + hb, V + hb, seq, CAT + (size_t)orow * 1536 + (bh & 7) * 128, ng, lam, lam_init, (const unsigned*)(p.ws + OFF_BAR + 256) + jl * 32 + bh * 2, shm, tid_);
    } else {
      sgu_unit(p, u - 1024 - NC, jl, shm, tid_);
    }
  }
}

__device__ __forceinline__ void ld8h(const bf16_t* p, float (&v)[8]) {
  const u32x4 w = *(const u32x4*)p;
#pragma unroll
  for (int i = 0; i < 4; ++i) { v[2 * i] = hlo(w[i]); v[2 * i + 1] = hhi(w[i]); }
}
__device__ void phase_pool(const Params& p, int nrows, int tid_) {
  const bf16_t* M1 = (const bf16_t*)(p.ws + OFF_M1);
  bf16_t* M2 = (bf16_t*)(p.ws + OFF_M2);
  const int nitems = (nrows >> 4) * 128;
  for (int it = lbid() * 512 + tid_; it < nitems; it += gridDim.x * 512) {
    const int cg = it & 127, seg = it >> 7;
    const int row0 = seg * 16;
    int base, T;
    if (row0 < NLAT) { base = row0 & ~(SEQ - 1); T = SEQ; } else { base = NLAT + ((row0 - NLAT) & ~255); T = CTXL; }
    const int t0 = row0 - base;
    const int h = 1 << (cg >> 5);
    const bf16_t* colp = M1 + (size_t)base * 1024 + cg * 8;
    float S[8];
#pragma unroll
    for (int i = 0; i < 8; ++i) S[i] = 0.f;
    {
      const int lo = t0 - h < 0 ? 0 : t0 - h, hi = t0 + h > T ? T : t0 + h;
      for (int q0 = lo; q0 < hi; q0 += 8) {
        u32x4 w[8];
#pragma unroll
        for (int j = 0; j < 8; ++j) { const int q = q0 + j < hi ? q0 + j : hi - 1; w[j] = *(const u32x4*)(colp + (size_t)q * 1024); }
#pragma unroll
        for (int j = 0; j < 8; ++j) {
          const float f = q0 + j < hi ? 1.0f : 0.0f;
#pragma unroll
          for (int i = 0; i < 4; ++i) { S[2 * i] += f * hlo(w[j][i]); S[2 * i + 1] += f * hhi(w[j][i]); }
        }
      }
    }
    for (int t = t0; t < t0 + 16; t += 4) {
      u32x4 xw[4], aw[4], sw[4];
#pragma unroll
      for (int j = 0; j < 4; ++j) {
        const int tt = t + j, ia = tt + h < T ? tt + h : T - 1, is = tt - h >= 0 ? tt - h : 0;
        xw[j] = *(const u32x4*)(colp + (size_t)tt * 1024);
        aw[j] = *(const u32x4*)(colp + (size_t)ia * 1024);
        sw[j] = *(const u32x4*)(colp + (size_t)is * 1024);
      }
#pragma unroll
      for (int j = 0; j < 4; ++j) {
        const int tt = t + j;
        const int lo = tt - h < 0 ? 0 : tt - h, hi = tt + h > T ? T : tt + h;
        const float inv = 1.0f / (float)(hi - lo);
        u32x4 w;
#pragma unroll
        for (int i = 0; i < 4; ++i) w[i] = pk2h(S[2 * i] * inv - hlo(xw[j][i]), S[2 * i + 1] * inv - hhi(xw[j][i]));
        *(u32x4*)(M2 + (size_t)(base + tt) * 1024 + cg * 8) = w;
        const float fa = tt + h < T ? 1.0f : 0.0f, fs = tt - h >= 0 ? 1.0f : 0.0f;
#pragma unroll
        for (int i = 0; i < 4; ++i) {
          S[2 * i] += fa * hlo(aw[j][i]) - fs * hlo(sw[j][i]);
          S[2 * i + 1] += fa * hhi(aw[j][i]) - fs * hhi(sw[j][i]);
        }
      }
    }
  }
}

#define DPP_ADD_F(keep, send, ctrlstr) ({ float _r; asm("s_nop 1\n\tv_add_f32_dpp %0, %1, %2 " ctrlstr " row_mask:0xf bank_mask:0xf bound_ctrl:1" : "=v"(_r) : "v"(send), "v"(keep)); _r; })
__device__ __forceinline__ float hadd2(f32x2v v) { float r; asm("v_add_f32 %0, %1, %2" : "=v"(r) : "v"(v[0]), "v"(v[1])); return r; }
#define PEER_LOAD_IDX(dst, k) do { const int _t = wv + (k) * nwv; dst = *(const u32x4*)(IDX + ((size_t)g * NTOK + _t) * 8 + (c & 1) * 4); } while (0)
#define PEER_SPLIT_IDX(src) do { u32x4 _p; \
    _Pragma("unroll") for (int q = 0; q < 4; ++q) _p[q] = (unsigned)__builtin_amdgcn_update_dpp(0, (int)src[q], 0xB1, 0xf, 0xf, true); \
    _Pragma("unroll") for (int q = 0; q < 4; ++q) { idA[q] = (c & 1) ? _p[q] : src[q]; idB[q] = (c & 1) ? src[q] : _p[q]; } } while (0)
#define PEER_ROWLO(TAB, w) (*(const u32x4*)((TAB) + ((((w) << 7) & 0x7fff80u) | (unsigned)c16)))
#define PEER_ROWHI(TAB, w) (*(const u32x4*)((TAB) + ((((w) >> 9) & 0x7fff80u) | (unsigned)c16)))
#define PEER_GATHER_H0(buf, TAB, id) do { \
    buf[0] = PEER_ROWLO(TAB, id##A[0]); buf[1] = PEER_ROWHI(TAB, id##A[0]); buf[2] = PEER_ROWLO(TAB, id##A[1]); buf[3] = PEER_ROWHI(TAB, id##A[1]); \
    buf[4] = PEER_ROWLO(TAB, id##A[2]); buf[5] = PEER_ROWHI(TAB, id##A[2]); buf[6] = PEER_ROWLO(TAB, id##A[3]); buf[7] = PEER_ROWHI(TAB, id##A[3]); } while (0)
#define PEER_GATHER_H1(buf, TAB, id) do { \
    buf[0] = PEER_ROWLO(TAB, id##B[0]); buf[1] = PEER_ROWHI(TAB, id##B[0]); buf[2] = PEER_ROWLO(TAB, id##B[1]); buf[3] = PEER_ROWHI(TAB, id##B[1]); \
    buf[4] = PEER_ROWLO(TAB, id##B[2]); buf[5] = PEER_ROWHI(TAB, id##B[2]); buf[6] = PEER_ROWLO(TAB, id##B[3]); buf[7] = PEER_ROWHI(TAB, id##B[3]); } while (0)

__device__ void phase_peer_u(const Params& p, int layer, int nrows, int tid_) {
  const int tid = tid_, wid = __builtin_amdgcn_readfirstlane(tid >> 6), lane = tid & 63, bid = lbid();
  const int s = bid & 7, wv = (bid >> 3) * 8 + wid, nwv = (gridDim.x >> 3) * 8;
  const int g = lane >> 3, c = lane & 7, c16 = c * 16;
  const bool b2 = (lane & 4) != 0, b1 = (lane & 2) != 0, b0 = (lane & 1) != 0;
  const unsigned char* H = (const unsigned char*)(p.ws + OFF_H8) + s * 128 + c * 16;
  const unsigned char* U = (const unsigned char*)(p.ws + OFF_U8) + (size_t)(layer * 8 + s) * NEXP * 128;
  const unsigned* IDX = (const unsigned*)(p.ws + OFF_IDX16);
  float* PART = (float*)(p.ws + OFF_PART);
  const int n = wv < nrows ? (nrows - wv + nwv - 1) / nwv : 0;
  if (n == 0) return;
  u32x4 idA, idB;
  u32x4 bufA[8], bufB[8], hn, hc;
#define PU_HLOAD(h, k) do { const int _t = wv + (k) * nwv; h = *(const u32x4*)(H + (size_t)_t * DM); } while (0)
#define PU_HCVT() do { hc = hn; } while (0)
#define PU_HALF(buf, base) do { \
    int ia[8]; \
    _Pragma("unroll") for (int i = 0; i < 8; ++i) ia[i] = __builtin_amdgcn_sdot4((int)buf[i][0], (int)hc[0], 0, false); \
    _Pragma("unroll") for (int q = 1; q < 4; ++q) { _Pragma("unroll") for (int i = 0; i < 8; ++i) ia[i] = __builtin_amdgcn_sdot4((int)buf[i][q], (int)hc[q], ia[i], false); } \
    _Pragma("unroll") for (int i = 0; i < 8; ++i) pd[(base) + i] = (float)ia[i]; } while (0)
  u32x4 idX;
  PEER_LOAD_IDX(idX, 0);
  PEER_SPLIT_IDX(idX);
  PEER_GATHER_H0(bufA, U, id); PU_HLOAD(hn, 0);
  { const int k1 = n > 1 ? 1 : 0; PEER_LOAD_IDX(idX, k1); }
  PU_HCVT();
  for (int k = 0; k < n; ++k) {
    const int k1 = k + 1 < n ? k + 1 : k, k2 = k + 2 < n ? k + 2 : n - 1;
    PEER_GATHER_H1(bufB, U, id);
    __builtin_amdgcn_sched_barrier(0);
    float pd[16];
    PU_HALF(bufA, 0);
    __builtin_amdgcn_sched_barrier(0);
    PEER_SPLIT_IDX(idX);
    PEER_GATHER_H0(bufA, U, id); PU_HLOAD(hn, k1);
    __builtin_amdgcn_sched_barrier(0);
    PEER_LOAD_IDX(idX, k2);
    __builtin_amdgcn_sched_barrier(0);
    PU_HALF(bufB, 8);
    float r8[8], r4[4], r2[2];
#pragma unroll
    for (int i = 0; i < 8; ++i) { const float keep = b2 ? pd[8 + i] : pd[i], send = b2 ? pd[i] : pd[8 + i]; r8[i] = DPP_ADD_F(keep, send, "row_half_mirror"); }
#pragma unroll
    for (int i = 0; i < 4; ++i) { const float keep = b1 ? r8[4 + i] : r8[i], send = b1 ? r8[i] : r8[4 + i]; r4[i] = DPP_ADD_F(keep, send, "quad_perm:[2,3,0,1]"); }
#pragma unroll
    for (int i = 0; i < 2; ++i) { const float keep = b0 ? r4[2 + i] : r4[i], send = b0 ? r4[i] : r4[2 + i]; r2[i] = DPP_ADD_F(keep, send, "quad_perm:[1,0,3,2]"); }
    *(f32x2v*)(PART + ((size_t)(wv + k * nwv) * 8 + s) * 128 + lane * 2) = (f32x2v){r2[0], r2[1]};
    PU_HCVT();
    __builtin_amdgcn_sched_barrier(0);
  }
#undef PU_HLOAD
#undef PU_HCVT
#undef PU_HALF
}
__device__ void phase_peer_w(const Params& p, int layer, int nrows, int tid_) {
  const int wid = __builtin_amdgcn_readfirstlane(tid_ >> 6), lane = tid_ & 63;
  const float* PART = (const float*)(p.ws + OFF_PART);
  const float* GATE = (const float*)(p.ws + OFF_GATE);
  unsigned char* W8 = (unsigned char*)(p.ws + OFF_W8);
  float* WSC = (float*)(p.ws + OFF_WSC);
  const float* VSC = (const float*)(p.ws + OFF_VSC) + (size_t)layer * NEXP;
  const unsigned* IDX16 = (const unsigned*)(p.ws + OFF_IDX16);
  const float* HSC = (const float*)(p.ws + OFF_HSC);
  const float* USC = (const float*)(p.ws + OFF_USC) + (size_t)layer * NEXP;
  for (int t = lbid() * 8 + wid; t < nrows; t += gridDim.x * 8) {
    f32x2v acc2 = {0.f, 0.f};
#pragma unroll
    for (int q = 0; q < 8; ++q) acc2 += *(const f32x2v*)(PART + ((size_t)t * 8 + q) * 128 + lane * 2);
    const size_t go = ((size_t)(lane >> 3) * NTOK + t) * 16 + (lane & 7) * 2;
    const f32x2v gt = *(const f32x2v*)(GATE + go);
    const unsigned idp = IDX16[go >> 1];
    const int id0 = (int)(idp & 0xffffu), id1 = (int)(idp >> 16);
    const float hs = HSC[t];
    const float d0 = acc2[0] * (hs * USC[id0]), d1 = acc2[1] * (hs * USC[id1]);
    const float w0 = gt[0] * gelu_tanh(d0) * VSC[id0], w1 = gt[1] * gelu_tanh(d1) * VSC[id1];
    const float mx = wave_max(fmaxf(fabsf(w0), fabsf(w1))), inv = mx > 0.f ? 127.0f / mx : 0.f;
    const int q0 = __float2int_rn(w0 * inv), q1 = __float2int_rn(w1 * inv);
    *(unsigned short*)(W8 + (size_t)t * 128 + lane * 2) = (unsigned short)((q0 & 255) | ((q1 & 255) << 8));
    if (lane == 0) WSC[t] = mx * (1.0f / 127.0f);
  }
}
#define PERM_B(hi, lo, sel) __builtin_amdgcn_perm((unsigned)(hi), (unsigned)(lo), (unsigned)(sel))
#define DPP_ADD_I(keep, send, ctrlstr) ({ int _r; asm("s_nop 1\n\tv_add_u32_dpp %0, %1, %2 " ctrlstr " row_mask:0xf bank_mask:0xf bound_ctrl:1" : "=v"(_r) : "v"(send), "v"(keep)); _r; })
__device__ void phase_peer_v(const Params& p, int layer, const hstream_t* XSin, hstream_t* Zout, int nrows, int tid_) {
  const int tid = tid_, wid = __builtin_amdgcn_readfirstlane(tid >> 6), lane = tid & 63, bid = lbid();
  const int s = bid & 7, wv = (bid >> 3) * 8 + wid, nwv = (gridDim.x >> 3) * 8;
  const int g = lane >> 3, c = lane & 7, c16 = c * 16;
  const bool b3 = (lane & 8) != 0;
  const unsigned char* Vt = (const unsigned char*)(p.ws + OFF_V8) + (size_t)(layer * 8 + s) * NEXP * 128;
  const unsigned* IDX = (const unsigned*)(p.ws + OFF_IDX16);
  const unsigned char* W8 = (const unsigned char*)(p.ws + OFF_W8) + g * 16;
  const float* WSC = (const float*)(p.ws + OFF_WSC);
  const int col = s * 128 + c * 16 + g * 2;
  const int n = wv < nrows ? (nrows - wv + nwv - 1) / nwv : 0;
  if (n == 0) return;
  u32x4 idA, idB;
  u32x4 bufA[8], bufB[8], wq, wqn;
  unsigned xw;
  const f32x2v lng = *(const f32x2v*)(PIN(p, ln_g) + (size_t)(layer * 2) * DM + col), lnb = *(const f32x2v*)(PIN(p, ln_b) + (size_t)(layer * 2) * DM + col);
  const float* LNST = (const float*)(p.ws + OFF_LNST);
  const f32x2v g2w0 = *(const f32x2v*)(mod_ptr(p, layer, 0, 5) + col), g2w1 = *(const f32x2v*)(mod_ptr(p, layer, 1, 5) + col), g2w2 = *(const f32x2v*)(mod_ptr(p, layer, 2, 5) + col);
#define PV_QUAD(buf, r0, wd) do { \
    _Pragma("unroll") for (int q = 0; q < 4; ++q) { \
      const unsigned x01l = PERM_B(buf[(r0) + 1][q], buf[(r0)][q], 0x05010400u), x01h = PERM_B(buf[(r0) + 1][q], buf[(r0)][q], 0x07030602u); \
      const unsigned x23l = PERM_B(buf[(r0) + 3][q], buf[(r0) + 2][q], 0x05010400u), x23h = PERM_B(buf[(r0) + 3][q], buf[(r0) + 2][q], 0x07030602u); \
      acc[4 * q + 0] = __builtin_amdgcn_sdot4((int)PERM_B(x23l, x01l, 0x05040100u), (int)(wd), acc[4 * q + 0], false); \
      acc[4 * q + 1] = __builtin_amdgcn_sdot4((int)PERM_B(x23l, x01l, 0x07060302u), (int)(wd), acc[4 * q + 1], false); \
      acc[4 * q + 2] = __builtin_amdgcn_sdot4((int)PERM_B(x23h, x01h, 0x05040100u), (int)(wd), acc[4 * q + 2], false); \
      acc[4 * q + 3] = __builtin_amdgcn_sdot4((int)PERM_B(x23h, x01h, 0x07060302u), (int)(wd), acc[4 * q + 3], false); } } while (0)
  u32x4 idX;
  PEER_LOAD_IDX(idX, 0);
  PEER_SPLIT_IDX(idX);
  PEER_GATHER_H0(bufA, Vt, id);
  wq = *(const u32x4*)(W8 + (size_t)wv * 128);
  { const int k1 = n > 1 ? 1 : 0; PEER_LOAD_IDX(idX, k1); }
  for (int k = 0; k < n; ++k) {
    const int k1 = k + 1 < n ? k + 1 : k, k2 = k + 2 < n ? k + 2 : n - 1;
    const int t = wv + k * nwv;
    PEER_GATHER_H1(bufB, Vt, id);
    __builtin_amdgcn_sched_barrier(0);
    xw = *(const unsigned*)(XSin + (size_t)t * DM + col);
    const float wsc = WSC[t];
    const f32x2v st = *(const f32x2v*)(LNST + (size_t)t * 2);
    __builtin_amdgcn_sched_barrier(0);
    int acc[16];
#pragma unroll
    for (int j = 0; j < 16; ++j) acc[j] = 0;
    PV_QUAD(bufA, 0, wq[0]); PV_QUAD(bufA, 4, wq[1]);
    __builtin_amdgcn_sched_barrier(0);
    PEER_SPLIT_IDX(idX);
    PEER_GATHER_H0(bufA, Vt, id);
    wqn = *(const u32x4*)(W8 + (size_t)(wv + k1 * nwv) * 128);
    __builtin_amdgcn_sched_barrier(0);
    PEER_LOAD_IDX(idX, k2);
    __builtin_amdgcn_sched_barrier(0);
    PV_QUAD(bufB, 0, wq[2]); PV_QUAD(bufB, 4, wq[3]);
    int r8[8], r4[4], r2[2];
#pragma unroll
    for (int i = 0; i < 8; ++i) { auto rr = __builtin_amdgcn_permlane32_swap((unsigned)acc[i], (unsigned)acc[8 + i], false, false); r8[i] = (int)rr[0] + (int)rr[1]; }
#pragma unroll
    for (int i = 0; i < 4; ++i) { auto rr = __builtin_amdgcn_permlane16_swap((unsigned)r8[i], (unsigned)r8[4 + i], false, false); r4[i] = (int)rr[0] + (int)rr[1]; }
#pragma unroll
    for (int i = 0; i < 2; ++i) { const int keep = b3 ? r4[2 + i] : r4[i], send = b3 ? r4[i] : r4[2 + i]; r2[i] = DPP_ADD_I(keep, send, "row_ror:8"); }
    const int who = who_of_row(t);
    const f32x2v g2 = who == 0 ? g2w0 : (who == 1 ? g2w1 : g2w2);
    const float x0 = (hlo(xw) - st[0]) * st[1] * lng[0] + lnb[0], x1 = (hhi(xw) - st[0]) * st[1] * lng[1] + lnb[1];
    *(unsigned*)(Zout + (size_t)t * DM + col) = pk2h(ALPHA * x0 + g2[0] * ((float)r2[0] * wsc), ALPHA * x1 + g2[1] * ((float)r2[1] * wsc));
    wq = wqn;
    __builtin_amdgcn_sched_barrier(0);
  }
#undef PV_QUAD
}

constexpr int NSTEP = 9;
constexpr int NPHASE = 2 + NSTEP * DEPTH;

__device__ void run_phase(const Params& pin, int ph, char* shm, int tid_) {
  Params p = pin;
  { unsigned zoff = 0; asm volatile("" : "+s"(zoff));
    p.ws = pin.ws + zoff; }
  if (ph == 0) { phase_prologue_a(p, shm, tid_); return; }
  if (ph == 1) { phase_prologue_b(p, tid_); return; }
  const int layer = (ph - 2) / NSTEP, step = (ph - 2) % NSTEP;
  const bool even = (layer & 1) == 0;
  const int jl = layer >> 1;
  const bool ctx_out = layer < 2;
  const int nrows = ctx_out ? NTOK : NLAT;
  const int mt_upd = nrows / 256;
  hstream_t* XSA = (hstream_t*)(p.ws + OFF_XSA);
  hstream_t* Z = (hstream_t*)(p.ws + OFF_Z);
  const float* modl = (const float*)(p.ws + OFF_MOD) + (size_t)layer * 3 * 6144;
  if (step == 0) {
    if (even) {
      const EpiInProj eq{(bf16_t*)(p.ws + OFF_Q), (bf16_t*)(p.ws + OFF_K), (const float*)(p.ws + OFF_HSC), (const float*)(p.ws + OFF_WINSC) + (size_t)jl * 4096, (const float*)(p.ws + OFF_ROPE), (unsigned*)(p.ws + OFF_BAR + 256) + jl * 32};
      const EpiInProjVG ev{(bf16_t*)(p.ws + OFF_V), (bf16_t*)(p.ws + OFF_GU), (bf16_t*)(p.ws + OFF_GV), (const float*)(p.ws + OFF_HSC), (const float*)(p.ws + OFF_WINSC) + (size_t)jl * 4096 + 2048};
      const int mt = (layer <= 2) ? NTOK / 256 : NLAT / 256;
      const char* W8 = p.ws + OFF_WIN8 + (size_t)jl * 4096 * 1024;
      const char* H8 = p.ws + OFF_H8;
      const int nu_big = (NLAT / 256) * 16, nu_small = ((mt * 256 - NLAT) >> 6) * 16;
      for (int u = lbid(); u < nu_big; u += gridDim.x) {
        const int xcd = u & 7, v = u >> 3;
        const int pn = ((v & 15) + 8 * ((v >> 5) & 1)) & 15, pm = (v >> 4) * 8 + xcd;
        if (pn < 8) gemm_tile<2, 8>((const bf16_t*)(H8 + (size_t)pm * 256 * 1024), (const bf16_t*)(W8 + (size_t)pn * 256 * 1024), pm * 256, pn, 512, eq, shm, tid_);
      }
      for (int u = lbid(); u < nu_big; u += gridDim.x) {
        const int xcd = u & 7, v = u >> 3;
        const int pn = ((v & 15) + 8 * ((v >> 5) & 1)) & 15, pm = (v >> 4) * 8 + xcd;
        if (pn >= 8) gemm_tile<2, 8>((const bf16_t*)(H8 + (size_t)pm * 256 * 1024), (const bf16_t*)(W8 + (size_t)pn * 256 * 1024), pm * 256, pn, 512, ev, shm, tid_);
      }
      const int u0 = nu_big + ((lbid() + gridDim.x - nu_big % gridDim.x) % gridDim.x);
      for (int u = u0; u < nu_big + nu_small; u += gridDim.x) {
        const int w = u - nu_big, pn = w & 15, row0 = NLAT + (w >> 4) * 64;
        if (pn < 8) gemm_tile<2, 2>((const bf16_t*)(H8 + (size_t)row0 * 1024), (const bf16_t*)(W8 + (size_t)pn * 256 * 1024), row0, pn, 512, eq, shm, tid_);
      }
      for (int u = u0; u < nu_big + nu_small; u += gridDim.x) {
        const int w = u - nu_big, pn = w & 15, row0 = NLAT + (w >> 4) * 64;
        if (pn >= 8) gemm_tile<2, 2>((const bf16_t*)(H8 + (size_t)row0 * 1024), (const bf16_t*)(W8 + (size_t)pn * 256 * 1024), row0, pn, 512, ev, shm, tid_);
      }
    } else {
      EpiBf16Store e{(bf16_t*)(p.ws + OFF_M1), 1024, (const float*)(p.ws + OFF_HSC), (const float*)(p.ws + OFF_PINSC) + (size_t)jl * 1024};
      gemm_phase<2>((const bf16_t*)(p.ws + OFF_H8), (const bf16_t*)(p.ws + OFF_PIN8 + (size_t)jl * 1024 * 1024), NLAT / 256, nrows - NLAT, 4, 512, e, shm, tid_);
    }
  } else if (step == 1) {
    if (even) phase_mixer_fast(p, layer, shm, tid_);
    else phase_pool(p, nrows, tid_);
  } else if (step == 2) {
    EpiResid e{XSA, Z, modl, 2};
    if (even) gemm_phase<true>((const bf16_t*)(p.ws + OFF_CAT), (const bf16_t*)(p.ws + OFF_WOUT) + (size_t)jl * 1024 * 1536, NLAT / 256, nrows - NLAT, 4, 1536, e, shm, tid_);
    else gemm_phase<true>((const bf16_t*)(p.ws + OFF_M2), (const bf16_t*)(p.ws + OFF_POUT) + (size_t)jl * 1024 * 1024, NLAT / 256, nrows - NLAT, 4, 1024, e, shm, tid_);
  } else if (step == 3) {
    phase_ln(p, Z, nullptr, layer, 0, nrows, nullptr, layer, 3, nrows, false, true, tid_);
  } else if (step == 4) {
    EpiTopK e{(int*)(p.ws + OFF_IDX), (float*)(p.ws + OFF_GATE), (unsigned*)(p.ws + OFF_IDX16), (const float*)(p.ws + OFF_HSC), (const float*)(p.ws + OFF_WQSC) + (size_t)layer * 2048};
    gemm_phase<2>((const bf16_t*)(p.ws + OFF_H8), (const bf16_t*)(p.ws + OFF_WQK8 + (size_t)layer * 2048 * 1024), NLAT / 256, nrows - NLAT, 8, 512, e, shm, tid_);
  } else if (step == 5) {
    phase_peer_u(p, layer, nrows, tid_);
  } else if (step == 6) {
    phase_peer_w(p, layer, nrows, tid_);
  } else if (step == 7) {
    phase_peer_v(p, layer, Z, Z, nrows, tid_);
  } else {
    const int nl = layer + 1;
    const int nrows_next = (nl <= 2) ? NTOK : NLAT;
    phase_ln(p, Z, XSA, layer, 1, nrows, nullptr, nl, 0, nrows_next < nrows ? nrows_next : nrows, layer == DEPTH - 1, true, tid_);
  }
}

#define XB_XCNT(j) (64 * (j))
#define XB_XSUB(j) (512 + 64 * (j))
#define XB_XGEN(j) (1024 + 64 * (j))
#define XB_TOP 1536
#define XB_TOPGEN 1600
#define XB_WORDS 1664
__device__ __forceinline__ unsigned xb_ld(unsigned* p) { return __hip_atomic_load(p, __ATOMIC_RELAXED, __HIP_MEMORY_SCOPE_AGENT); }
__device__ __forceinline__ unsigned xb_add(unsigned* p, unsigned v) { return __hip_atomic_fetch_add(p, v, __ATOMIC_RELAXED, __HIP_MEMORY_SCOPE_AGENT); }
__device__ __forceinline__ void grid_barrier(unsigned* bar, int xcc, unsigned nloc, unsigned nx, int tid_) {
  asm volatile("s_waitcnt vmcnt(0) lgkmcnt(0)" ::: "memory");
  __syncthreads();
  if (tid_ == 0) {
    const unsigned old = xb_add(&bar[XB_XSUB(xcc)], 1u);
    const unsigned gen = old / nloc;
    if (old + 1u == (gen + 1u) * nloc) {
      __builtin_amdgcn_fence(__ATOMIC_RELEASE, "agent");
      asm volatile("s_waitcnt vmcnt(0)" ::: "memory");
      const unsigned og = xb_add(&bar[XB_TOP], 1u);
      const unsigned tg = og / nx;
      if (og + 1u == (tg + 1u) * nx) {
#pragma unroll
        for (int j = 0; j < 8; ++j) xb_add(&bar[XB_XGEN(j)], 1u);
      } else while (xb_ld(&bar[XB_XGEN(xcc)]) == gen) __builtin_amdgcn_s_sleep(1);
      __builtin_amdgcn_fence(__ATOMIC_ACQUIRE, "agent");
      asm volatile("s_waitcnt vmcnt(0)" ::: "memory");
    } else {
      while (xb_ld(&bar[XB_XGEN(xcc)]) == gen) __builtin_amdgcn_s_sleep(1);
      __builtin_amdgcn_fence(__ATOMIC_ACQUIRE, "agent");
      asm volatile("s_waitcnt vmcnt(0)" ::: "memory");
    }
  }
  __syncthreads();
}

__device__ __forceinline__ int phase_cat(int ph) {
  if (ph < 2) return 0;
  const int layer = (ph - 2) / NSTEP, step = (ph - 2) % NSTEP;
  const bool even = (layer & 1) == 0;
  if (step == 0) return even ? 1 : 7;
  if (step == 1) return even ? 2 : 8;
  if (step == 2) return 3;
  if (step == 3) return 4;
  if (step == 4) return 5;
  if (step == 5) return 6;
  if (step == 6) return 12;
  if (step == 7) return 10;
  return 11;
}

__global__ void __launch_bounds__(512) mega(KArgs ka, int ph_lo, int ph_hi) {
  Params p;
  p.in = (const float* const*)__builtin_amdgcn_kernarg_segment_ptr();
  p.out = ka.out; p.ws = ka.ws;
  __shared__ __attribute__((aligned(1024))) char shm[LDS_BYTES];
  cg::grid_group grid = cg::this_grid();
  unsigned* bar = (unsigned*)(p.ws + OFF_BAR + 512);
  int rep = 0;
  const int swid = __builtin_amdgcn_readfirstlane((int)(threadIdx.x >> 6));
  const int my_xcc = (int)(__builtin_amdgcn_s_getreg((3 << 11) | 20) & 0x7);
  if (threadIdx.x == 0) xb_add(&bar[XB_XCNT(my_xcc)], 1u);
  unsigned nloc = 1, nx = 1;
  for (int ph = ph_lo; ph < ph_hi;) {
    run_phase(p, ph, shm, make_tid(swid));
    bool again = false;
#ifdef DUP_CAT
    if (phase_cat(ph) == DUP_CAT && rep == 0) again = true;
#endif
    if (again || ph + 1 < ph_hi) {
      if (ph == ph_lo && !again && rep == 0) {
        grid.sync();
        unsigned cnt = 0, mine = 0;
#pragma unroll
        for (int j = 0; j < 8; ++j) { const unsigned c = xb_ld(&bar[XB_XCNT(j)]); cnt += c > 0u ? 1u : 0u; mine = j == my_xcc ? c : mine; }
        nloc = __builtin_amdgcn_readfirstlane(mine > 0u ? mine : 1u); nx = __builtin_amdgcn_readfirstlane(cnt > 0u ? cnt : 1u);
      } else grid_barrier(bar, my_xcc, nloc, nx, make_tid(swid));
    }
    if (again) rep = 1; else { rep = 0; ++ph; }
  }
}

extern "C" void kernel_launch(void* const* d_in, const int* in_sizes, int n_in, void* d_out, int out_size, void* d_ws, size_t ws_size,
                              hipStream_t stream) {
  static int grid_blocks = 0;
  if (!grid_blocks) {
    int dev = 0, cus = 0, per_cu = 0;
    (void)hipGetDevice(&dev);
    (void)hipDeviceGetAttribute(&cus, hipDeviceAttributeMultiprocessorCount, dev);
    (void)hipOccupancyMaxActiveBlocksPerMultiprocessor(&per_cu, mega, 512, 0);
    if (per_cu > 1) per_cu = 1;
    grid_blocks = cus * per_cu;
    if (ws_size < WS_END) fprintf(stderr, "kernel_launch: workspace too small: %zu < %zu\n", ws_size, (size_t)WS_END);
    if (grid_blocks <= 0) fprintf(stderr, "kernel_launch: occupancy query returned 0\n");
  }
  KArgs p{};
  for (int i = 0; i < 24; ++i) p.in[i] = (const float*)d_in[i];
  p.out = (float*)d_out;
  p.ws = (char*)d_ws;
  (void)hipMemsetAsync((char*)d_ws + OFF_BAR, 0, 512 + 8192, stream);
  int lo = 0, hi = NPHASE;
  void* args[] = {&p, &lo, &hi};
  hipError_t e = hipLaunchCooperativeKernel((void*)mega, dim3(grid_blocks), dim3(512), args, 0, stream);
  if (e != hipSuccess) fprintf(stderr, "cooperative launch failed: %s (grid %d)\n", hipGetErrorString(e), grid_blocks);
}
```
